# Optimizing an MI355X kernel written in HIP

```python
import math
import jax, jax.numpy as jnp
from jax import lax
import numpy as np

D_MODEL = 1024
BATCH = 8
SEQ = 4096
DEPTH = 4

CHUNK = 64
N_EVEN = (DEPTH + 1) // 2
N_ODD = DEPTH // 2
EPS = 1e-6

POOL_WIDTH = D_MODEL // 2
POOL_WINDOWS = (2, 4, 8, 16)
POOL_N_GROUPS = len(POOL_WINDOWS)
POOL_GROUP = POOL_WIDTH // POOL_N_GROUPS
ATT_HEAD_DIM = 64
ATT_HEADS = (D_MODEL // 2) // ATT_HEAD_DIM
ATT_WIDTH = ATT_HEADS * ATT_HEAD_DIM
ATT_PREV_CHUNKS = 8
REL_CLIP = 256
MIX_IN = POOL_WIDTH + 3 * ATT_WIDTH
MIX_OUT = POOL_WIDTH + ATT_WIDTH

SSM_EXPAND = 2
SSM_D_INNER = SSM_EXPAND * D_MODEL
SSM_HEAD_DIM = 64
SSM_HEADS = SSM_D_INNER // SSM_HEAD_DIM
SSM_GROUPS = 8
SSM_HEADS_PER_GROUP = SSM_HEADS // SSM_GROUPS
SSM_D_STATE = 128
SSM_D_CONV = 4
SSM_CONV_DIM = SSM_D_INNER + 2 * SSM_GROUPS * SSM_D_STATE
SSM_IN = SSM_D_INNER + SSM_CONV_DIM + SSM_HEADS
DT_MIN = 0.001
DT_MAX = 0.1

MOE_GROUPS = 4
MOE_EXPERTS_PER_GROUP = 8
MOE_EXPERTS = MOE_GROUPS * MOE_EXPERTS_PER_GROUP
MOE_TOP_K = 2
MOE_D_FF = D_MODEL // 8

kernel_name = 'hybrid_pool_chunkattn_ssd_hmoe_adaln'


def rmsnorm(x, w):
    xf = x.astype(jnp.float32)
    y = xf * lax.rsqrt(jnp.mean(xf * xf, axis=-1, keepdims=True) + EPS)
    return (y * w.astype(jnp.float32)).astype(x.dtype)


def modulate(h, shift, scale):
    return h * (1 + scale[:, None, :]) + shift[:, None, :]


def pool_mixer(u, pool_w, pool_scale):
    b, s, _ = u.shape
    uf = u.astype(jnp.float32)
    cs = jnp.pad(jnp.cumsum(uf, axis=1), ((0, 0), (1, 0), (0, 0)))
    pos = jnp.arange(1, s + 1, dtype=jnp.float32)
    outs = []
    for g, w in enumerate(POOL_WINDOWS):
        lo, hi = g * POOL_GROUP, (g + 1) * POOL_GROUP
        upper = cs[:, 1:, lo:hi]
        lower = jnp.pad(cs[:, :s + 1 - w, lo:hi], ((0, 0), (w - 1, 0), (0, 0)))
        count = jnp.minimum(pos, w)[None, :, None]
        outs.append((upper - lower) / count - uf[:, :, lo:hi])
    pooled = jnp.stack(outs, axis=2).astype(u.dtype)
    y = jnp.einsum('bsgc,gcd->bsgd', pooled, pool_w).reshape(b, s, POOL_WIDTH)
    return y * pool_scale


def chunk_attention(q, k, v, rel_bias):
    b, s, _ = q.shape
    nc = s // CHUNK
    band = (ATT_PREV_CHUNKS + 1) * CHUNK
    q = q.reshape(b, nc, CHUNK, ATT_HEADS, ATT_HEAD_DIM)
    k = k.reshape(b, nc, CHUNK, ATT_HEADS, ATT_HEAD_DIM)
    v = v.reshape(b, nc, CHUNK, ATT_HEADS, ATT_HEAD_DIM)
    pad = ((0, 0), (ATT_PREV_CHUNKS, 0), (0, 0), (0, 0), (0, 0))
    kp = jnp.pad(k, pad)
    vp = jnp.pad(v, pad)
    k_band = jnp.concatenate([kp[:, j:j + nc] for j in range(ATT_PREV_CHUNKS + 1)], axis=2)
    v_band = jnp.concatenate([vp[:, j:j + nc] for j in range(ATT_PREV_CHUNKS + 1)], axis=2)
    q_off = jnp.arange(CHUNK)[:, None] + ATT_PREV_CHUNKS * CHUNK
    k_off = jnp.arange(band)[None, :]
    rel_idx = jnp.clip(q_off - k_off, -REL_CLIP, REL_CLIP) + REL_CLIP
    bias = rel_bias[:, rel_idx].astype(jnp.float32)
    key_chunk = jnp.arange(nc)[:, None] - ATT_PREV_CHUNKS + jnp.arange(band)[None, :] // CHUNK
    valid = key_chunk >= 0
    scores = jnp.einsum('bclhd,bcshd->bchls', q, k_band).astype(jnp.float32) * (ATT_HEAD_DIM ** -0.5)
    scores = scores + bias[None, None]
    scores = jnp.where(valid[None, :, None, None, :], scores, -1e30)
    p = jax.nn.softmax(scores, axis=-1).astype(v.dtype)
    o = jnp.einsum('bchls,bcshd->bclhd', p, v_band)
    return o.reshape(b, s, ATT_WIDTH)


def mamba2_mixer(h, w_in, conv_w, conv_b, dt_bias, A_log, D_skip, norm_w, w_out):
    b, s, _ = h.shape
    nc = s // CHUNK
    G, R, P, N = SSM_GROUPS, SSM_HEADS_PER_GROUP, SSM_HEAD_DIM, SSM_D_STATE
    f32 = jnp.float32
    zxbcdt = h @ w_in
    z, xbc, dt = jnp.split(zxbcdt, [SSM_D_INNER, SSM_D_INNER + SSM_CONV_DIM], axis=-1)
    xp = jnp.pad(xbc, ((0, 0), (SSM_D_CONV - 1, 0), (0, 0)))
    conv = xp[:, 0:s] * conv_w[0]
    for tap in range(1, SSM_D_CONV):
        conv = conv + xp[:, tap:tap + s] * conv_w[tap]
    xbc = jax.nn.silu(conv + conv_b)
    xs, Bm, Cm = jnp.split(xbc, [SSM_D_INNER, SSM_D_INNER + G * N], axis=-1)
    dt = jax.nn.softplus(dt.astype(f32) + dt_bias.astype(f32))
    A = -jnp.exp(A_log.astype(f32))
    a = (dt * A).reshape(b, nc, CHUNK, G, R)
    xs = xs.astype(f32).reshape(b, nc, CHUNK, G, R, P)
    x_dt = xs * dt.reshape(b, nc, CHUNK, G, R)[..., None]
    Bm = Bm.astype(f32).reshape(b, nc, CHUNK, G, N)
    Cm = Cm.astype(f32).reshape(b, nc, CHUNK, G, N)
    a_cs = jnp.moveaxis(jnp.cumsum(a, axis=2), 2, -1)
    tril = jnp.tril(jnp.ones((CHUNK, CHUNK), dtype=bool))
    seg = jnp.exp(jnp.where(tril, a_cs[..., :, None] - a_cs[..., None, :], -jnp.inf))
    cb = jnp.einsum('bclgn,bcsgn->bcgls', Cm, Bm)
    y_diag = jnp.einsum('bcgls,bcgrls,bcsgrp->bclgrp', cb, seg, x_dt)
    decay_states = jnp.exp(a_cs[..., -1:] - a_cs)
    states = jnp.einsum('bclgn,bcgrl,bclgrp->bcgrpn', Bm, decay_states, x_dt)
    chunk_decay = jnp.exp(a_cs[..., -1])

    def step(carry, inp):
        st, dec = inp
        return carry * dec[..., None, None] + st, carry

    init = jnp.zeros((b, G, R, P, N), f32)
    _, prev = lax.scan(step, init, (jnp.moveaxis(states, 1, 0), jnp.moveaxis(chunk_decay, 1, 0)))
    prev = jnp.moveaxis(prev, 0, 1)
    y_off = jnp.einsum('bclgn,bcgrpn,bcgrl->bclgrp', Cm, prev, jnp.exp(a_cs))
    y = y_diag + y_off + xs * D_skip.astype(f32).reshape(G, R)[:, :, None]
    y = y.reshape(b, s, SSM_D_INNER)
    g = (y * jax.nn.silu(z.astype(f32))).reshape(b, s, G, SSM_D_INNER // G)
    g = g * lax.rsqrt(jnp.mean(g * g, axis=-1, keepdims=True) + EPS)
    g = g.reshape(b, s, SSM_D_INNER) * norm_w.astype(f32)
    return g.astype(h.dtype) @ w_out


def hier_moe(h, w_group, b_group, w_expert, b_expert, w1, w3, w2):
    b, s, d = h.shape
    t = h.reshape(b * s, d)
    tf = t.astype(jnp.float32)
    g_prob = jax.nn.softmax(tf @ w_group.astype(jnp.float32) + b_group.astype(jnp.float32), axis=-1)
    g_val, g_idx = lax.top_k(g_prob, 1)
    e_logits = jnp.einsum('td,dge->tge', tf, w_expert.astype(jnp.float32)) + b_expert.astype(jnp.float32)
    e_logits = e_logits[jnp.arange(b * s), g_idx[:, 0]]
    e_val, e_idx = lax.top_k(jax.nn.softmax(e_logits, axis=-1), MOE_TOP_K)
    e_val = e_val / jnp.sum(e_val, axis=-1, keepdims=True)
    weights = g_val * e_val
    expert_id = g_idx * MOE_EXPERTS_PER_GROUP + e_idx
    combine = jnp.sum(jax.nn.one_hot(expert_id, MOE_EXPERTS, dtype=jnp.float32) * weights[..., None], axis=1)
    hid = jax.nn.silu(jnp.einsum('td,edf->tef', t, w1)) * jnp.einsum('td,edf->tef', t, w3)
    hid = hid * combine.astype(hid.dtype)[:, :, None]
    y = jnp.einsum('tef,efd->td', hid, w2)
    return y.reshape(b, s, d)


def _normal(key, shape, scale):
    return jax.random.normal(key, shape, jnp.float32) * scale


def setup_inputs(seed: int = 0) -> dict:
    key = jax.random.key(seed)
    ks = jax.random.split(key, 28)
    D = D_MODEL
    f32 = jnp.float32
    dt0 = jnp.exp(jax.random.uniform(ks[14], (N_ODD, SSM_HEADS), f32) * (math.log(DT_MAX) - math.log(DT_MIN)) + math.log(DT_MIN))
    dt0 = jnp.maximum(dt0, 1e-4)
    return {
        'x': _normal(ks[0], (BATCH, SEQ, D), 1.0),
        'c': _normal(ks[1], (BATCH, D), 1.0),
        'ada_w': _normal(ks[2], (DEPTH, D, 6 * D), 0.5 * D ** -0.5),
        'ada_b': _normal(ks[3], (DEPTH, 6 * D), 0.02),
        'norm1_w': 1.0 + _normal(ks[4], (DEPTH, D), 0.05),
        'norm2_w': 1.0 + _normal(ks[5], (DEPTH, D), 0.05),
        'mix_w_in': _normal(ks[6], (N_EVEN, D, MIX_IN), D ** -0.5),
        'pool_w': _normal(ks[7], (N_EVEN, POOL_N_GROUPS, POOL_GROUP, POOL_GROUP), POOL_GROUP ** -0.5),
        'pool_scale': 1.0 + _normal(ks[8], (N_EVEN, POOL_WIDTH), 0.05),
        'rel_bias': _normal(ks[9], (N_EVEN, ATT_HEADS, 2 * REL_CLIP + 1), 0.2),
        'mix_w_out': _normal(ks[10], (N_EVEN, MIX_OUT, D), MIX_OUT ** -0.5),
        'ssm_w_in': _normal(ks[11], (N_ODD, D, SSM_IN), D ** -0.5),
        'ssm_conv_w': _normal(ks[12], (N_ODD, SSM_D_CONV, SSM_CONV_DIM), SSM_D_CONV ** -0.5),
        'ssm_conv_b': _normal(ks[13], (N_ODD, SSM_CONV_DIM), 0.02),
        'ssm_dt_bias': dt0 + jnp.log(-jnp.expm1(-dt0)),
        'ssm_A_log': jnp.log(jax.random.uniform(ks[15], (N_ODD, SSM_HEADS), f32, 1.0, 16.0)),
        'ssm_D': 1.0 + _normal(ks[16], (N_ODD, SSM_HEADS), 0.1),
        'ssm_norm_w': 1.0 + _normal(ks[17], (N_ODD, SSM_D_INNER), 0.05),
        'ssm_w_out': _normal(ks[18], (N_ODD, SSM_D_INNER, D), SSM_D_INNER ** -0.5),
        'moe_w_group': _normal(ks[19], (DEPTH, D, MOE_GROUPS), D ** -0.5),
        'moe_b_group': _normal(ks[20], (DEPTH, MOE_GROUPS), 0.01),
        'moe_w_expert': _normal(ks[21], (DEPTH, D, MOE_GROUPS, MOE_EXPERTS_PER_GROUP), D ** -0.5),
        'moe_b_expert': _normal(ks[22], (DEPTH, MOE_GROUPS, MOE_EXPERTS_PER_GROUP), 0.01),
        'moe_w1': _normal(ks[23], (DEPTH, MOE_EXPERTS, D, MOE_D_FF), D ** -0.5),
        'moe_w3': _normal(ks[24], (DEPTH, MOE_EXPERTS, D, MOE_D_FF), D ** -0.5),
        'moe_w2': _normal(ks[25], (DEPTH, MOE_EXPERTS, MOE_D_FF, D), MOE_D_FF ** -0.5),
        'final_norm_w': 1.0 + _normal(ks[26], (D,), 0.05),
    }


def reference(x, c, ada_w, ada_b, norm1_w, norm2_w, mix_w_in, pool_w, pool_scale, rel_bias, mix_w_out,
              ssm_w_in, ssm_conv_w, ssm_conv_b, ssm_dt_bias, ssm_A_log, ssm_D, ssm_norm_w, ssm_w_out,
              moe_w_group, moe_b_group, moe_w_expert, moe_b_expert, moe_w1, moe_w3, moe_w2, final_norm_w):
    c_act = jax.nn.silu(c)
    for layer in range(DEPTH):
        mod = c_act @ ada_w[layer] + ada_b[layer]
        shift1, scale1, gate1, shift2, scale2, gate2 = jnp.split(mod, 6, axis=-1)
        h = modulate(rmsnorm(x, norm1_w[layer]), shift1, scale1)
        i = layer // 2
        if layer % 2 == 0:
            proj = h @ mix_w_in[i]
            u, q, k, v = jnp.split(proj, [POOL_WIDTH, POOL_WIDTH + ATT_WIDTH, POOL_WIDTH + 2 * ATT_WIDTH], axis=-1)
            a_out = pool_mixer(u, pool_w[i], pool_scale[i])
            b_out = chunk_attention(q, k, v, rel_bias[i])
            mix = jnp.concatenate([a_out, b_out], axis=-1) @ mix_w_out[i]
        else:
            mix = mamba2_mixer(h, ssm_w_in[i], ssm_conv_w[i], ssm_conv_b[i], ssm_dt_bias[i], ssm_A_log[i],
                               ssm_D[i], ssm_norm_w[i], ssm_w_out[i])
        x = x + gate1[:, None, :] * mix
        h2 = modulate(rmsnorm(x, norm2_w[layer]), shift2, scale2)
        ffn = hier_moe(h2, moe_w_group[layer], moe_b_group[layer], moe_w_expert[layer], moe_b_expert[layer],
                       moe_w1[layer], moe_w3[layer], moe_w2[layer])
        x = x + gate2[:, None, :] * ffn
    return rmsnorm(x, final_norm_w)
```

```cpp
#include <hip/hip_runtime.h>
#include <cstdio>
#include <cstdint>

#ifndef PROBE_DUP
#define PROBE_DUP -1
#endif
typedef unsigned short bf16_t;
typedef float f32x4 __attribute__((ext_vector_type(4)));
typedef unsigned u32x4 __attribute__((ext_vector_type(4)));
typedef unsigned u32x2 __attribute__((ext_vector_type(2)));
typedef float f32x2 __attribute__((ext_vector_type(2)));

constexpr int D = 1024, NB = 8, SEQ = 4096, DEPTH = 4, T = NB * SEQ;
constexpr int CHUNK = 64, NCH = SEQ / CHUNK;
constexpr float EPS = 1e-6f;
constexpr int POOLW = 512, NHEAD = 8, HD = 64, ATTW = 512, MIX_IN = 2048;
constexpr int SSM_DI = 2048, SSM_H = 32, SSM_G = 8, SSM_N = 128, SSM_P = 64, SSM_CONV = 4096, SSM_IN = 6176;
constexpr int MOE_E = 32, MOE_FF = 128, NBUCKET = 112;
constexpr float QSCALE = 0.125f * 1.4426950408889634f;
constexpr float LOG2E = 1.4426950408889634f;

constexpr size_t MiB = 1u << 20;
constexpr size_t WS_CTL = 0, CTL_BYTES = 1 * MiB;
constexpr size_t WS_MOD = 1 * MiB;
constexpr size_t WS_TOKE = 2 * MiB;
constexpr size_t WS_TOKW = 2 * MiB + 512 * 1024;
constexpr size_t WS_LIST = 3 * MiB;
constexpr size_t WS_WMI = 17 * MiB, WS_WMO = 25 * MiB, WS_WSX = 29 * MiB, WS_WSZ = 45 * MiB, WS_WSO = 53 * MiB, WS_WPL = 61 * MiB;
constexpr size_t WS_W13 = 62 * MiB, WS_W2T = 126 * MiB;
constexpr size_t WS_WRH = 61 * MiB + 256 * 1024, WS_WRL = WS_WRH + 384 * 1024;
constexpr size_t WS_WDH = 1 * MiB + 768 * 1024, WS_WDL = WS_WDH + 128 * 1024;
constexpr size_t WS_XB = 158 * MiB;
constexpr size_t WS_BIG = 222 * MiB;
constexpr size_t WS_U = WS_BIG, WS_Q = WS_BIG + 32 * MiB, WS_K = WS_BIG + 64 * MiB, WS_VT = WS_BIG + 96 * MiB, WS_CAT = WS_BIG + 128 * MiB;
constexpr size_t WS_XS = WS_BIG, WS_BC = WS_BIG + 128 * MiB, WS_DT = WS_BIG + 256 * MiB;
constexpr size_t WS_SSP = WS_BIG + 260 * MiB;
constexpr size_t WS_END = WS_SSP + 2 * MiB;
constexpr int CW_BAR = 4096;
constexpr int CW_CNT = 16384;

struct Params {
    const float* in[27];
    float* out;
    unsigned char* ws;
    int ph_lo, ph_hi;
};
enum { I_X = 0, I_C, I_ADAW, I_ADAB, I_N1W, I_N2W, I_MIXIN, I_POOLW, I_POOLS, I_RELB, I_MIXOUT, I_SSMIN, I_CONVW, I_CONVB, I_DTB, I_ALOG, I_SSMD, I_SSMNW, I_SSMOUT,
       I_WG, I_BG, I_WE, I_BE, I_W1, I_W3, I_W2, I_FNW };

#define LAS __attribute__((address_space(3)))
__device__ __forceinline__ float bf2f(unsigned v) { return __uint_as_float(v << 16); }
typedef __bf16 bf16x2_t __attribute__((ext_vector_type(2)));
__device__ __forceinline__ unsigned pk2(float lo, float hi) { f32x2 v = {lo, hi}; bf16x2_t b = __builtin_convertvector(v, bf16x2_t); return __builtin_bit_cast(unsigned, b); }
__device__ __forceinline__ unsigned f2bf(float f) { return pk2(f, f) & 0xffffu; }
__device__ __forceinline__ float xhalf_max(float x) { const auto r = __builtin_amdgcn_permlane32_swap(__float_as_uint(x), __float_as_uint(x), false, false); return fmaxf(__uint_as_float(r[0]), __uint_as_float(r[1])); }
__device__ __forceinline__ float xhalf_sum(float x) { const auto r = __builtin_amdgcn_permlane32_swap(__float_as_uint(x), __float_as_uint(x), false, false); return __uint_as_float(r[0]) + __uint_as_float(r[1]); }
__device__ __forceinline__ float x16_sum(float x) { const auto r = __builtin_amdgcn_permlane16_swap(__float_as_uint(x), __float_as_uint(x), false, false); return __uint_as_float(r[0]) + __uint_as_float(r[1]); }
#define DPP_F32(SRC, CTRL, RM) __uint_as_float(__builtin_amdgcn_update_dpp(0u, __float_as_uint(SRC), CTRL, RM, 0xf, false))
__device__ __forceinline__ float wave_incl_scan(float x) {
    x += DPP_F32(x, 0x111, 0xf); x += DPP_F32(x, 0x112, 0xf); x += DPP_F32(x, 0x114, 0xf); x += DPP_F32(x, 0x118, 0xf);
    x += DPP_F32(x, 0x142, 0xa); x += DPP_F32(x, 0x143, 0xc);
    return x;
}
__device__ __forceinline__ float wave_last(float x) { return __uint_as_float(__builtin_amdgcn_readlane(__float_as_uint(x), 63)); }
__device__ __forceinline__ float wave_sum(float v) {
#pragma unroll
    for (int o = 1; o < 64; o <<= 1) v += __shfl_xor(v, o);
    return v;
}
__device__ __forceinline__ float silu_f(float x) { return x * __builtin_amdgcn_rcpf(1.f + __expf(-x)); }
__device__ __forceinline__ float softplus_f(float x) { return x > 20.f ? x : log1pf(__expf(x)); }

struct Geo { int tid, lane, wave, vcu, G; };

__device__ __forceinline__ void phase_mod(const Params& P, const Geo& g, float* cs  ) {
    const float* c = P.in[I_C];
    for (int i = g.tid; i < NB * D; i += 512) cs[i] = silu_f(c[i]);
    __syncthreads();
    float* mod = (float*)(P.ws + WS_MOD);
    float* red = cs + 8192 + 8 * (64 * 33);
    for (int u = g.vcu; u < DEPTH * 96; u += g.G) {
        const int L = u / 96, col = (u % 96) * 64 + g.lane;
        const float* w = P.in[I_ADAW] + (size_t)L * D * 6144 + col + (size_t)g.wave * 128 * 6144;
        const float* cw = cs + g.wave * 128;
        float acc[NB];
#pragma unroll
        for (int b = 0; b < NB; ++b) acc[b] = 0.f;
#pragma unroll 32
        for (int k = 0; k < 128; ++k) {
            const float wv = w[(size_t)k * 6144];
#pragma unroll
            for (int b = 0; b < NB; ++b) acc[b] += cw[b * D + k] * wv;
        }
#pragma unroll
        for (int b = 0; b < NB; ++b) red[(g.wave * NB + b) * 64 + g.lane] = acc[b];
        __syncthreads();
        { const int b = g.wave; float sum = P.in[I_ADAB][L * 6144 + col];
#pragma unroll
            for (int ww = 0; ww < 8; ++ww) sum += red[(ww * NB + b) * 64 + g.lane];
            mod[(size_t)(L * NB + b) * 6144 + col] = sum; }
        __syncthreads();
    }
}

template <int PROJ>
__device__ __forceinline__ void phase_norm(const Params& P, const Geo& g, float* wlds, int L, const float* xsrc, const float* nw, int shift_off, int scale_off, bool dry = false, const bf16_t* xb = nullptr  ) {
    constexpr int NPROJ = PROJ == 1 ? 32 : (PROJ == 2 ? 36 : 0);
    const int i2 = L >> 1;
    if (PROJ == 1) {
        const float* w = P.in[I_SSMIN] + (size_t)i2 * D * SSM_IN + 6144;
        for (int e = g.tid; e < 32 * D; e += 512) { const int k = e >> 5, j = e & 31; wlds[j * D + k] = w[(size_t)k * SSM_IN + j]; }
        __syncthreads();
    } else if (PROJ == 2) {
        const float* wg = P.in[I_WG] + (size_t)L * D * 4;
        const float* we = P.in[I_WE] + (size_t)L * D * 32;
        for (int e = g.tid; e < 4 * D; e += 512) { const int k = e >> 2, j = e & 3; wlds[j * D + k] = wg[e]; }
        for (int e = g.tid; e < 32 * D; e += 512) { const int k = e >> 5, j = e & 31; wlds[(4 + j) * D + k] = we[e]; }
        __syncthreads();
    }
    const float* mod = (const float*)(P.ws + WS_MOD);
    bf16_t* H = (bf16_t*)P.out;
    const int gw = g.vcu * 8 + g.wave, NGW = g.G * 8;
    int my_row = -1, my_bucket = 0; int nrows = 0;
    for (int m = gw; m < T; m += NGW) {
        const int b = m / SEQ;
        f32x4 v[4]; float ss = 0.f;
        if (xb) { const u32x2* xr2 = (const u32x2*)(xb + (size_t)m * D) + g.lane;
#pragma unroll
            for (int j = 0; j < 4; ++j) { const u32x2 t2 = xr2[64 * j]; v[j].x = bf2f(t2.x & 0xffffu); v[j].y = bf2f(t2.x >> 16); v[j].z = bf2f(t2.y & 0xffffu); v[j].w = bf2f(t2.y >> 16); } }
        else { const f32x4* xr = (const f32x4*)(xsrc + (size_t)m * D) + g.lane;
#pragma unroll
            for (int j = 0; j < 4; ++j) v[j] = xr[64 * j]; }
#pragma unroll
        for (int j = 0; j < 4; ++j) ss += v[j].x * v[j].x + v[j].y * v[j].y + v[j].z * v[j].z + v[j].w * v[j].w;
        const float rstd = rsqrtf(wave_sum(ss) * (1.f / D) + EPS);
        const float* mrow = mod + (size_t)(L * NB + b) * 6144;
#pragma unroll
        for (int j = 0; j < 4; ++j) {
            const int k = 4 * g.lane + 256 * j;
            const f32x4 w4 = *(const f32x4*)(nw + k), sc = *(const f32x4*)(mrow + scale_off + k), sh = *(const f32x4*)(mrow + shift_off + k);
            v[j] = v[j] * rstd * w4 * (sc + 1.f) + sh;
            u32x2 o; o.x = pk2(v[j].x, v[j].y); o.y = pk2(v[j].z, v[j].w);
            *(u32x2*)(H + (size_t)m * D + k) = o;
        }
        if (NPROJ > 0) {
            float mine = 0.f;
#pragma unroll 2
            for (int q = 0; q < NPROJ; ++q) {
                float a = 0.f;
#pragma unroll
                for (int j = 0; j < 4; ++j) { const f32x4 w4 = *(const f32x4*)(wlds + q * D + 4 * g.lane + 256 * j); a += v[j].x * w4.x + v[j].y * w4.y + v[j].z * w4.z + v[j].w * w4.w; }
                a = wave_sum(a);
                mine = (g.lane == q) ? a : mine;
            }
            if (PROJ == 1) {
                float* DT = (float*)(P.ws + WS_DT);
                const float* dtb = P.in[I_DTB] + i2 * SSM_H;
                if (g.lane < 32) DT[(size_t)m * 32 + g.lane] = softplus_f(mine + dtb[g.lane]);
            } else if (PROJ == 2) {
                const float* bg = P.in[I_BG] + L * 4; const float* be = P.in[I_BE] + L * 32;
                float gl[4]; float gm = -3.0e38f; int gi = 0;
#pragma unroll
                for (int q = 0; q < 4; ++q) { gl[q] = __shfl(mine, q) + bg[q]; if (gl[q] > gm) { gm = gl[q]; gi = q; } }
                float gs = 0.f;
#pragma unroll
                for (int q = 0; q < 4; ++q) gs += __expf(gl[q] - gm);
                const float gval = 1.f / gs;
                float el[8];
#pragma unroll
                for (int e = 0; e < 8; ++e) el[e] = __shfl(mine, 4 + gi * 8 + e) + be[gi * 8 + e];
                float m0 = -3.0e38f; int i0 = 0;
#pragma unroll
                for (int e = 0; e < 8; ++e) if (el[e] > m0) { m0 = el[e]; i0 = e; }
                float m1 = -3.0e38f; int i1 = 0;
#pragma unroll
                for (int e = 0; e < 8; ++e) if (e != i0 && el[e] > m1) { m1 = el[e]; i1 = e; }
                float es = 0.f;
#pragma unroll
                for (int e = 0; e < 8; ++e) es += __expf(el[e] - m0);
                const float p0 = 1.f / es, p1 = __expf(m1 - m0) / es;
                const float w0 = gval * (p0 / (p0 + p1)), w1 = gval * (p1 / (p0 + p1));
                const int lo = i0 < i1 ? i0 : i1, hi = i0 < i1 ? i1 : i0;
                const float wlo = i0 < i1 ? w0 : w1, whi = i0 < i1 ? w1 : w0;
                const int bucket = gi * 28 + 7 * lo - (lo * (lo - 1)) / 2 + (hi - lo - 1);
                if (g.lane == 0) {
                    ((int2*)(P.ws + WS_TOKE))[m] = make_int2(gi * 8 + lo, gi * 8 + hi);
                    ((float2*)(P.ws + WS_TOKW))[m] = make_float2(wlo, whi);
                }
                if (g.lane == (nrows & 63)) { my_row = m; my_bucket = bucket; }
                ++nrows;
                if ((nrows & 63) == 0 && !dry) {
                    unsigned* cnt = (unsigned*)(P.ws + WS_CTL) + CW_CNT + (L * 128 + my_bucket) * 16;
                    const unsigned rank = atomicAdd(cnt, 1u);
                    ((int*)(P.ws + WS_LIST))[(size_t)my_bucket * T + rank] = my_row;
                    my_row = -1;
                }
            }
        }
    }
    if (PROJ == 2) {
        if (my_row >= 0 && !dry) {
            unsigned* cnt = (unsigned*)(P.ws + WS_CTL) + CW_CNT + (L * 128 + my_bucket) * 16;
            const unsigned rank = atomicAdd(cnt, 1u);
            ((int*)(P.ws + WS_LIST))[(size_t)my_bucket * T + rank] = my_row;
        }
    }
}


typedef short bf16x8 __attribute__((ext_vector_type(8)));
template <int PROJ>
__device__ __forceinline__ void phase_norm16(const Params& P, const Geo& g, LAS unsigned char* l3, int L, const bf16_t* xsrc, const float* nw, int shift_off, int scale_off, bool dry = false) {
    constexpr int NT = PROJ == 1 ? 2 : 3, NBLK = NT * 16, PERW = NBLK / 8;
    constexpr int O_WB = 32768, WBUF = NBLK * 1024;
    const int i2 = L >> 1, lane = g.lane, r16 = lane & 15, q4 = lane >> 4, w = g.wave;
    unsigned char* ws = P.ws;
    const float* mod = (const float*)(ws + WS_MOD);
    const float* ssp = (const float*)(ws + WS_SSP);
    bf16_t* H = (bf16_t*)P.out;
    LAS float* msl = (LAS float*)l3;
    LAS float* shl = (LAS float*)(l3 + 4096);
    LAS float* lgw = (LAS float*)(l3 + 8192 + g.wave * (16 * 48 * 4));
    const bf16_t* WH = PROJ == 1 ? (const bf16_t*)(ws + WS_WDH) + (size_t)i2 * 32 * D : (const bf16_t*)(ws + WS_WRH) + (size_t)L * 48 * D;
    const bf16_t* WL = PROJ == 1 ? (const bf16_t*)(ws + WS_WDL) + (size_t)i2 * 32 * D : (const bf16_t*)(ws + WS_WRL) + (size_t)L * 48 * D;
    for (int blk = g.vcu; blk < T / 128; blk += g.G) {
        const int b = (blk * 128) / SEQ;
        const float* mrow = mod + (size_t)(L * NB + b) * 6144;
        __syncthreads();
        for (int k = g.tid; k < D; k += 512) { msl[k] = nw[k] * (1.f + mrow[scale_off + k]); shl[k] = mrow[shift_off + k]; }
        const int m0 = blk * 128 + w * 16;
        const bf16_t* xr = xsrc + (size_t)(m0 + r16) * D + 8 * q4;
        u32x4 xq[8];
#pragma unroll
        for (int sl = 0; sl < 8; ++sl) xq[sl] = *(const u32x4*)(xr + 32 * sl);
        float ss; { const f32x4 p4 = *(const f32x4*)(ssp + (size_t)(m0 + r16) * 16 + 4 * q4); ss = (p4[0] + p4[1]) + (p4[2] + p4[3]); }
        ss = xhalf_sum(x16_sum(ss));
        const float rstd = rsqrtf(ss * (1.f / D) + EPS);
        u32x4 wreg[PERW];
#define N16_LOADW(CH) do { _Pragma("unroll") for (int i = 0; i < PERW; ++i) { const int j = PERW * w + i, lo = j >= NT * 8, jj = lo ? j - NT * 8 : j, ct = jj >> 3, sl = jj & 7; \
            wreg[i] = *(const u32x4*)((lo ? WL : WH) + (size_t)(ct * 32 + 8 * (CH) + sl) * 512 + lane * 8); } } while (0)
#define N16_STOREW(BUF) do { _Pragma("unroll") for (int i = 0; i < PERW; ++i) *(LAS u32x4*)(l3 + O_WB + (BUF) * WBUF + (PERW * w + i) * 1024 + lane * 16) = wreg[i]; } while (0)
        N16_LOADW(0); N16_STOREW(0);
        __syncthreads();
        f32x4 acc[NT];
#pragma unroll
        for (int ct = 0; ct < NT; ++ct) acc[ct] = (f32x4){0.f, 0.f, 0.f, 0.f};
        bf16_t* hrow = H + (size_t)(m0 + r16) * D + 8 * q4;
#pragma unroll 1
        for (int ch = 0; ch < 4; ++ch) {
            if (ch < 3) N16_LOADW(ch + 1);
            u32x4 xn[8];
#pragma unroll
            for (int sl = 0; sl < 8; ++sl) xn[sl] = xq[sl];
            if (ch < 3) {
#pragma unroll
                for (int sl = 0; sl < 8; ++sl) xn[sl] = *(const u32x4*)(xr + 32 * (8 * (ch + 1) + sl)); }
            const LAS unsigned char* wb = l3 + O_WB + (ch & 1) * WBUF + lane * 16;
#pragma unroll
            for (int sl = 0; sl < 8; ++sl) {
                const int s = 8 * ch + sl;
                const u32x4 x8 = xq[sl];
                f32x4 a, c; a.x = bf2f(x8.x & 0xffffu); a.y = bf2f(x8.x >> 16); a.z = bf2f(x8.y & 0xffffu); a.w = bf2f(x8.y >> 16); c.x = bf2f(x8.z & 0xffffu); c.y = bf2f(x8.z >> 16); c.z = bf2f(x8.w & 0xffffu); c.w = bf2f(x8.w >> 16);
                const f32x4 m0v = *(const LAS f32x4*)(msl + 32 * s + 8 * q4), m1v = *(const LAS f32x4*)(msl + 32 * s + 8 * q4 + 4);
                const f32x4 s0v = *(const LAS f32x4*)(shl + 32 * s + 8 * q4), s1v = *(const LAS f32x4*)(shl + 32 * s + 8 * q4 + 4);
                const f32x4 h0 = a * rstd * m0v + s0v, h1 = c * rstd * m1v + s1v;
                u32x4 hi; hi.x = pk2(h0.x, h0.y); hi.y = pk2(h0.z, h0.w); hi.z = pk2(h1.x, h1.y); hi.w = pk2(h1.z, h1.w);
                *(u32x4*)(hrow + 32 * s) = hi;
                u32x4 lo;
                lo.x = pk2(h0.x - bf2f(hi.x & 0xffffu), h0.y - bf2f(hi.x >> 16)); lo.y = pk2(h0.z - bf2f(hi.y & 0xffffu), h0.w - bf2f(hi.y >> 16));
                lo.z = pk2(h1.x - bf2f(hi.z & 0xffffu), h1.y - bf2f(hi.z >> 16)); lo.w = pk2(h1.z - bf2f(hi.w & 0xffffu), h1.w - bf2f(hi.w >> 16));
                const bf16x8 ahi = __builtin_bit_cast(bf16x8, hi), alo = __builtin_bit_cast(bf16x8, lo);
#pragma unroll
                for (int ct = 0; ct < NT; ++ct) { const bf16x8 bh = *(const LAS bf16x8*)(wb + (ct * 8 + sl) * 1024), bl = *(const LAS bf16x8*)(wb + (NT * 8 + ct * 8 + sl) * 1024);
                    acc[ct] = __builtin_amdgcn_mfma_f32_16x16x32_bf16(ahi, bh, acc[ct], 0, 0, 0);
                    acc[ct] = __builtin_amdgcn_mfma_f32_16x16x32_bf16(ahi, bl, acc[ct], 0, 0, 0);
                    acc[ct] = __builtin_amdgcn_mfma_f32_16x16x32_bf16(alo, bh, acc[ct], 0, 0, 0); }
            }
            if (ch < 3) N16_STOREW((ch + 1) & 1);
            asm volatile("s_waitcnt lgkmcnt(0)" ::: "memory"); __builtin_amdgcn_s_barrier(); asm volatile("" ::: "memory");
#pragma unroll
            for (int sl = 0; sl < 8; ++sl) xq[sl] = xn[sl];
        }
#undef N16_LOADW
#undef N16_STOREW
        if (PROJ == 1) {
            float* DT = (float*)(ws + WS_DT); const float* dtb = P.in[I_DTB] + i2 * SSM_H;
#pragma unroll
            for (int ct = 0; ct < NT; ++ct) { const float bias = dtb[16 * ct + r16];
#pragma unroll
                for (int r = 0; r < 4; ++r) DT[(size_t)(m0 + 4 * q4 + r) * 32 + 16 * ct + r16] = softplus_f(acc[ct][r] + bias); }
        } else {
#pragma unroll
            for (int ct = 0; ct < NT; ++ct)
#pragma unroll
                for (int r = 0; r < 4; ++r) lgw[(4 * q4 + r) * 48 + 16 * ct + r16] = acc[ct][r];
            asm volatile("s_waitcnt lgkmcnt(0)" ::: "memory");
            if (lane < 16) {
                const LAS float* lg = lgw + lane * 48; const int m = m0 + lane;
                const float* bg = P.in[I_BG] + L * 4; const float* be = P.in[I_BE] + L * 32;
                float gl[4]; float gm = -3.0e38f; int gi = 0;
#pragma unroll
                for (int q = 0; q < 4; ++q) { gl[q] = lg[q] + bg[q]; if (gl[q] > gm) { gm = gl[q]; gi = q; } }
                float gs = 0.f;
#pragma unroll
                for (int q = 0; q < 4; ++q) gs += __expf(gl[q] - gm);
                const float gval = 1.f / gs;
                float el[8];
#pragma unroll
                for (int e = 0; e < 8; ++e) el[e] = lg[4 + gi * 8 + e] + be[gi * 8 + e];
                float mx0 = -3.0e38f; int i0 = 0;
#pragma unroll
                for (int e = 0; e < 8; ++e) if (el[e] > mx0) { mx0 = el[e]; i0 = e; }
                float mx1 = -3.0e38f; int i1 = 0;
#pragma unroll
                for (int e = 0; e < 8; ++e) if (e != i0 && el[e] > mx1) { mx1 = el[e]; i1 = e; }
                float es = 0.f;
#pragma unroll
                for (int e = 0; e < 8; ++e) es += __expf(el[e] - mx0);
                const float p0 = 1.f / es, p1 = __expf(mx1 - mx0) / es;
                const float w0 = gval * (p0 / (p0 + p1)), w1 = gval * (p1 / (p0 + p1));
                const int lo = i0 < i1 ? i0 : i1, hi = i0 < i1 ? i1 : i0;
                const float wlo = i0 < i1 ? w0 : w1, whi = i0 < i1 ? w1 : w0;
                const int bucket = gi * 28 + 7 * lo - (lo * (lo - 1)) / 2 + (hi - lo - 1);
                ((int2*)(ws + WS_TOKE))[m] = make_int2(gi * 8 + lo, gi * 8 + hi);
                ((float2*)(ws + WS_TOKW))[m] = make_float2(wlo, whi);
                if (!dry) {
                    unsigned* cnt = (unsigned*)(ws + WS_CTL) + CW_CNT + (L * 128 + bucket) * 16;
                    const unsigned rank = atomicAdd(cnt, 1u);
                    ((int*)(ws + WS_LIST))[(size_t)bucket * T + rank] = m;
                }
            }
        }
    }
}

__device__ __forceinline__ void phase_gate(const Params& P, const Geo& g, bool dry = false) {
    bf16_t* XS = (bf16_t*)(P.ws + WS_XS); const bf16_t* Z = (const bf16_t*)(P.ws + WS_BC);
    const int gw = g.vcu * 8 + g.wave, NGW = g.G * 8;
    for (int m = gw; m < T; m += NGW) {
        u32x4* yp = (u32x4*)(XS + (size_t)m * SSM_DI + 32 * g.lane);
        const u32x4* zp = (const u32x4*)(Z + (size_t)m * SSM_DI + 32 * g.lane);
        float gv[32]; float ss = 0.f;
#pragma unroll
        for (int j = 0; j < 4; ++j) {
            const u32x4 y4 = yp[j], z4 = zp[j];
#pragma unroll
            for (int e = 0; e < 4; ++e) {
                const unsigned yy = y4[e], zz = z4[e];
                const float y0 = bf2f(yy & 0xffffu), y1 = bf2f(yy >> 16), z0 = bf2f(zz & 0xffffu), z1 = bf2f(zz >> 16);
                const float g0 = y0 * silu_f(z0), g1 = y1 * silu_f(z1);
                gv[j * 8 + e * 2] = g0; gv[j * 8 + e * 2 + 1] = g1; ss += g0 * g0 + g1 * g1;
            }
        }
        ss += __shfl_xor(ss, 1); ss += __shfl_xor(ss, 2); ss += __shfl_xor(ss, 4);
        const float rs = rsqrtf(ss * (1.f / 256.f) + EPS);
#pragma unroll
        for (int j = 0; j < 4; ++j) { u32x4 o;
#pragma unroll
            for (int e = 0; e < 4; ++e) o[e] = pk2(gv[j * 8 + e * 2] * rs, gv[j * 8 + e * 2 + 1] * rs);
            if (!dry) yp[j] = o; else asm volatile("" :: "v"(o)); }
    }
}

__device__ __forceinline__ void phase_final(const Params& P, const Geo& g, bool dry = false) {
    const float* nw = P.in[I_FNW];
    const bf16_t* XB = (const bf16_t*)(P.ws + WS_XB);
    const int gw = g.vcu * 8 + g.wave, NGW = g.G * 8;
    for (int m = gw; m < T; m += NGW) {
        const u32x2* xr2 = (const u32x2*)(XB + (size_t)m * D) + g.lane;
        f32x4* orow = (f32x4*)(P.out + (size_t)m * D) + g.lane;
        f32x4 v[4]; float ss = 0.f;
#pragma unroll
        for (int j = 0; j < 4; ++j) { const u32x2 t2 = xr2[64 * j]; v[j].x = bf2f(t2.x & 0xffffu); v[j].y = bf2f(t2.x >> 16); v[j].z = bf2f(t2.y & 0xffffu); v[j].w = bf2f(t2.y >> 16);
            ss += v[j].x * v[j].x + v[j].y * v[j].y + v[j].z * v[j].z + v[j].w * v[j].w; }
        const float rstd = rsqrtf(wave_sum(ss) * (1.f / D) + EPS);
#pragma unroll
        for (int j = 0; j < 4; ++j) { const f32x4 w4 = *(const f32x4*)(nw + 4 * g.lane + 256 * j); orow[64 * j] = v[j] * rstd * w4; }
    }
}

namespace pg8 {
#define PG8_LAS __attribute__((address_space(3)))
typedef unsigned short bf16_t;
typedef short bf16x8 __attribute__((ext_vector_type(8)));
typedef float f32x4 __attribute__((ext_vector_type(4)));
typedef unsigned u32x4 __attribute__((ext_vector_type(4)));
constexpr int BM = 256, BK = 64, HALF = 128, HTB = HALF * BK * 2  , STAGE_BYTES = 8 * HTB, NXCD = 8, WGM = 8;

__host__ __device__ __forceinline__ int lds_byte(int r, int c) { const int st = (r >> 4) * 2 + (c >> 5), rr = r & 15, cc = c & 31, ob = rr * 64 + cc * 2; return st * 1024 + (ob ^ (((ob >> 9) & 1) << 5)); }
__host__ __device__ __forceinline__ void stage_rc(int b, int& R, int& C) { const int st = b / 1024, sb = b % 1024, swz = sb ^ (((sb >> 9) & 1) << 5); R = (st >> 1) * 16 + swz / 64; C = (st & 1) * 32 + (swz % 64) / 2; }
__host__ __device__ __forceinline__ int perm32(int rho) { const int n = rho >> 4, i = rho & 15; return 8 * (i >> 2) + 4 * n + (i & 3); }

struct Unit { int pm, pn; };
struct Gemm { const bf16_t* A; const bf16_t* Bt; int M, N, K; };

struct StaticOrder {
    int nM, nN, nwg, G, c;
    __host__ __device__ void init(int M, int N, int G_, int c_) { nM = M / BM; nN = N / BM; nwg = nM * nN; G = G_; c = c_; }
    __host__ __device__ bool next(int i, Unit& u) const {
        const long L = (long)i * G + c; if (L >= nwg) return false;
        int wgid = (int)L; { const int q = nwg / NXCD, r = nwg % NXCD, xcd = wgid % NXCD, off = wgid / NXCD; wgid = (xcd < r ? xcd * (q + 1) : r * (q + 1) + (xcd - r) * q) + off; }
        const int nig = WGM * nN, gid = wgid / nig, fm = gid * WGM, gsz = (nM - fm) < WGM ? (nM - fm) : WGM;
        u.pm = fm + ((wgid % nig) % gsz); u.pn = (wgid % nig) / gsz; return true;
    }
    __device__ __forceinline__ void a_ready(const Unit&) const {}
    __device__ __forceinline__ void done(const Unit&) const {}
};
template <class Epi, class Sched, bool ALIGN_EPI = false, bool SP2 = false>
__device__ __forceinline__ void gemm_phase(PG8_LAS unsigned char* lds, const Gemm g, const Sched& S, const Epi& E) {
    const int tid = threadIdx.x, wid = __builtin_amdgcn_readfirstlane(tid >> 6), lane = tid & 63, wr = wid >> 2, wc = wid & 3, fr = lane & 15, fq = lane >> 4;
    const int K = g.K, nt = K / BK;
    unsigned voffA[2], voffB[2];
#pragma unroll
    for (int i = 0; i < 2; ++i) { int R, C; stage_rc(tid * 16 + i * 8192, R, C); const int Rb = Epi::PERM ? ((R & ~31) + perm32(R & 31)) : R;
        voffA[i] = (unsigned)(R * K + C) * 2u; voffB[i] = (unsigned)(Rb * K + C) * 2u; }
    const size_t kstep = (size_t)(BK * 2);
    const size_t hstep = (size_t)HALF * K * 2;
    const size_t tstep = 2 * hstep;
    const unsigned ldsw = (unsigned)wid * 1024u;
    const int aoff = lds_byte(wr * 64 + fr, fq * 8), boff = lds_byte(wc * 32 + fr, fq * 8);
#define PG8_SA(b, h) (((b) * 2 + (h)) * HTB)
#define PG8_SB(b, h) ((4 + (b) * 2 + (h)) * HTB)
#define PG8_STAGE(bufoff, gbase, voff) do { _Pragma("unroll") for (int _i = 0; _i < 2; ++_i) \
        __builtin_amdgcn_global_load_lds((const unsigned*)((const char*)(gbase) + (voff)[_i]), (PG8_LAS unsigned*)(lds + (bufoff) + ldsw + _i * 8192), 16, 0, 0); } while (0)
#define PG8_LDA(dst, b, h) do { _Pragma("unroll") for (int m = 0; m < 4; ++m) _Pragma("unroll") for (int k = 0; k < 2; ++k) dst[m][k] = *(const PG8_LAS bf16x8*)(lds + PG8_SA(b, h) + aoff + m * 2048 + k * 1024); } while (0)
#define PG8_LDB(dst, b, h) do { _Pragma("unroll") for (int n = 0; n < 2; ++n) _Pragma("unroll") for (int k = 0; k < 2; ++k) dst[n][k] = *(const PG8_LAS bf16x8*)(lds + PG8_SB(b, h) + boff + n * 2048 + k * 1024); } while (0)
#define PG8_MMA(ai, bj, At, Bt) do { __builtin_amdgcn_s_setprio(1); _Pragma("unroll") for (int m = 0; m < 4; ++m) _Pragma("unroll") for (int n = 0; n < 2; ++n) _Pragma("unroll") for (int k = 0; k < 2; ++k) \
        acc[ai][bj][m][n] = __builtin_amdgcn_mfma_f32_16x16x32_bf16(Bt[n][k], At[m][k], acc[ai][bj][m][n], 0, 0, 0); __builtin_amdgcn_s_setprio(0); } while (0)
#define PG8_WAIT_V(n) asm volatile("s_waitcnt vmcnt(" #n ")" ::: "memory")
#define PG8_WAIT_L(n) asm volatile("s_waitcnt lgkmcnt(" #n ")" ::: "memory")
#define PG8_BAR __builtin_amdgcn_s_barrier()
#define PG8_SCHED __builtin_amdgcn_sched_barrier(0)
    Unit cur, nxt; int ui = 0;
    if (!S.next(0, cur)) return;
    f32x4 acc[2][2][4][2];
#pragma unroll
    for (int a = 0; a < 2; ++a)
#pragma unroll
        for (int b = 0; b < 2; ++b)
#pragma unroll
            for (int m = 0; m < 4; ++m)
#pragma unroll
                for (int n = 0; n < 2; ++n) acc[a][b][m][n] = (f32x4){0.f, 0.f, 0.f, 0.f};
    bf16x8 At[4][2], B0[2][2], B1[2][2];
    const char* cA = (const char*)g.A + (size_t)cur.pm * tstep; const char* cB = (const char*)g.Bt + (size_t)cur.pn * tstep;
    S.a_ready(cur);
    if constexpr (SP2) {
        PG8_STAGE(PG8_SB(0, 0), cB, voffB); PG8_STAGE(PG8_SB(0, 1), cB + hstep, voffB); PG8_STAGE(PG8_SA(0, 0), cA, voffA); PG8_STAGE(PG8_SA(0, 1), cA + hstep, voffA);
        if (wr == 1) PG8_BAR;
        PG8_WAIT_V(2); PG8_BAR;
        PG8_STAGE(PG8_SB(1, 0), cB + kstep, voffB); PG8_STAGE(PG8_SA(1, 0), cA + kstep, voffA); PG8_STAGE(PG8_SB(1, 1), cB + hstep + kstep, voffB);
        PG8_WAIT_V(6); PG8_BAR;
    } else {
        PG8_STAGE(PG8_SB(0, 0), cB, voffB); PG8_STAGE(PG8_SA(0, 0), cA, voffA); PG8_STAGE(PG8_SB(0, 1), cB + hstep, voffB); PG8_STAGE(PG8_SA(0, 1), cA + hstep, voffA);
        if (wr == 1) PG8_BAR;
        PG8_WAIT_V(4); PG8_BAR;
        PG8_STAGE(PG8_SB(1, 0), cB + kstep, voffB); PG8_STAGE(PG8_SA(1, 0), cA + kstep, voffA); PG8_STAGE(PG8_SB(1, 1), cB + hstep + kstep, voffB);
        PG8_WAIT_V(6); PG8_BAR;
    }
    for (;;) {
        const bool has_next = S.next(ui + 1, nxt);
        const char* nA = has_next ? (const char*)g.A + (size_t)nxt.pm * tstep : cA; const char* nB = has_next ? (const char*)g.Bt + (size_t)nxt.pn * tstep : cB;
        for (int t = 0; t < nt; t += 2) {
            const bool last = (t == nt - 2);
            const char* a1 = cA + (size_t)(t + 1) * kstep;
            const char* a2 = last ? nA : cA + (size_t)(t + 2) * kstep; const char* b2 = last ? nB : cB + (size_t)(t + 2) * kstep;
            const char* a3 = a2 + kstep; const char* b3 = b2 + kstep;
            if (last && has_next) S.a_ready(nxt);
            if constexpr (SP2) {
            PG8_LDB(B0, 0, 0); PG8_LDB(B1, 0, 1); PG8_SCHED; PG8_LDA(At, 0, 0); PG8_STAGE(PG8_SA(1, 1), a1 + hstep, voffA);
            PG8_WAIT_V(8); PG8_WAIT_L(0); PG8_BAR; PG8_MMA(0, 0, At, B0); PG8_MMA(0, 1, At, B1); PG8_BAR; PG8_SCHED;
            PG8_LDA(At, 0, 1); PG8_STAGE(PG8_SB(0, 0), b2, voffB); PG8_STAGE(PG8_SB(0, 1), b2 + hstep, voffB); PG8_STAGE(PG8_SA(0, 0), a2, voffA);
            PG8_WAIT_V(8); PG8_WAIT_L(0); PG8_BAR; PG8_MMA(1, 0, At, B0); PG8_MMA(1, 1, At, B1); PG8_BAR; PG8_SCHED;
            PG8_LDB(B0, 1, 0); PG8_LDB(B1, 1, 1); PG8_SCHED; PG8_LDA(At, 1, 0); PG8_STAGE(PG8_SA(0, 1), a2 + hstep, voffA);
            PG8_WAIT_V(8); PG8_WAIT_L(0); PG8_BAR; PG8_MMA(0, 0, At, B0); PG8_MMA(0, 1, At, B1); PG8_BAR; PG8_SCHED;
            PG8_LDA(At, 1, 1); PG8_STAGE(PG8_SB(1, 0), b3, voffB); PG8_STAGE(PG8_SB(1, 1), b3 + hstep, voffB); PG8_STAGE(PG8_SA(1, 0), a3, voffA);
            PG8_WAIT_V(8); PG8_WAIT_L(0); PG8_BAR; PG8_MMA(1, 0, At, B0); PG8_MMA(1, 1, At, B1); PG8_BAR; PG8_SCHED;
            } else {
            PG8_LDB(B0, 0, 0); PG8_SCHED; PG8_LDA(At, 0, 0); PG8_STAGE(PG8_SA(1, 1), a1 + hstep, voffA);
            PG8_WAIT_L(8); PG8_BAR; PG8_WAIT_L(0); PG8_MMA(0, 0, At, B0); PG8_BAR; PG8_SCHED;
            PG8_LDB(B1, 0, 1); PG8_STAGE(PG8_SB(0, 0), b2, voffB);
            PG8_BAR; PG8_WAIT_L(0); PG8_MMA(0, 1, At, B1); PG8_BAR;
            PG8_LDA(At, 0, 1); PG8_STAGE(PG8_SA(0, 0), a2, voffA);
            PG8_BAR; PG8_WAIT_L(0); PG8_MMA(1, 0, At, B0); PG8_BAR; PG8_SCHED;
            PG8_STAGE(PG8_SB(0, 1), b2 + hstep, voffB);
            PG8_WAIT_V(6); PG8_BAR; PG8_MMA(1, 1, At, B1); PG8_BAR;
            PG8_LDB(B0, 1, 0); PG8_SCHED; PG8_LDA(At, 1, 0); PG8_STAGE(PG8_SA(0, 1), a2 + hstep, voffA);
            PG8_WAIT_L(8); PG8_BAR; PG8_WAIT_L(0); PG8_MMA(0, 0, At, B0); PG8_BAR; PG8_SCHED;
            PG8_LDB(B1, 1, 1); PG8_STAGE(PG8_SB(1, 0), b3, voffB);
            PG8_BAR; PG8_WAIT_L(0); PG8_MMA(0, 1, At, B1); PG8_BAR;
            PG8_LDA(At, 1, 1); PG8_STAGE(PG8_SA(1, 0), a3, voffA);
            PG8_BAR; PG8_WAIT_L(0); PG8_MMA(1, 0, At, B0); PG8_BAR; PG8_SCHED;
            PG8_STAGE(PG8_SB(1, 1), b3 + hstep, voffB);
            PG8_WAIT_V(6); PG8_BAR; PG8_MMA(1, 1, At, B1); PG8_BAR;
            }
        }
        if constexpr (ALIGN_EPI) { if (wr == 0) PG8_BAR; }
        if constexpr (!Epi::AFTER_DRAIN) { E(acc, cur, wr, wc, fr, fq); S.done(cur); }
        if (!has_next) break;
#pragma unroll
        for (int a = 0; a < 2; ++a)
#pragma unroll
            for (int b = 0; b < 2; ++b)
#pragma unroll
                for (int m = 0; m < 4; ++m)
#pragma unroll
                    for (int n = 0; n < 2; ++n) acc[a][b][m][n] = (f32x4){0.f, 0.f, 0.f, 0.f};
        cur = nxt; cA = nA; cB = nB; ++ui;
        if constexpr (ALIGN_EPI) { if (wr == 1) PG8_BAR; }
    }
    PG8_WAIT_V(0);
    if constexpr (!ALIGN_EPI) { if (wr == 0) PG8_BAR; }
    PG8_BAR;
    if constexpr (Epi::AFTER_DRAIN) { E.fused(acc, cur, wr, wc, fr, fq, lds, wid, lane); S.done(cur); }
#undef PG8_SA
#undef PG8_SB
#undef PG8_STAGE
#undef PG8_LDA
#undef PG8_LDB
#undef PG8_MMA
#undef PG8_WAIT_V
#undef PG8_WAIT_L
#undef PG8_BAR
#undef PG8_SCHED
}
}

namespace pg8 {
__device__ __forceinline__ unsigned cvt_pk_bf16(float lo, float hi) { unsigned r; asm volatile("v_cvt_pk_bf16_f32 %0, %1, %2" : "=v"(r) : "v"(lo), "v"(hi)); return r; }
struct EpiE1x {
    static constexpr bool PERM = true, AFTER_DRAIN = false;
    bf16_t *U, *VT;
    __device__ __forceinline__ void operator()(const f32x4 (&acc)[2][2][4][2], const Unit& u, int wr, int wc, int fr, int fq) const {
        const int row0 = u.pm * BM + wr * 64 + fr, type = u.pn >> 1, colt = (u.pn & 1) * 256 + wc * 32 + 8 * fq;
        if (type < 2) {
            bf16_t* base = U + (size_t)type * ((size_t)T * 512);
            const float sc = type == 1 ? QSCALE : 1.f;
#pragma unroll
            for (int ai = 0; ai < 2; ++ai)
#pragma unroll
                for (int m = 0; m < 4; ++m) { bf16_t* rowp = base + (size_t)(row0 + ai * HALF + m * 16) * 512 + colt;
#pragma unroll
                    for (int bj = 0; bj < 2; ++bj) { const f32x4 v0 = acc[ai][bj][m][0] * sc, v1 = acc[ai][bj][m][1] * sc;
                        u32x4 w; w.x = cvt_pk_bf16(v0[0], v0[1]); w.y = cvt_pk_bf16(v0[2], v0[3]); w.z = cvt_pk_bf16(v1[0], v1[1]); w.w = cvt_pk_bf16(v1[2], v1[3]);
                        *(u32x4*)(rowp + bj * HALF) = w; } }
        } else if (type == 2) {
            bf16_t* KT = U + (size_t)2 * ((size_t)T * 512);
#pragma unroll
            for (int ai = 0; ai < 2; ++ai)
#pragma unroll
                for (int m = 0; m < 4; ++m) { const int row = row0 + ai * HALF + m * 16, b = row / SEQ, sq = row % SEQ;
#pragma unroll
                    for (int bj = 0; bj < 2; ++bj) { const int col = colt + bj * HALF, h = col >> 6, d0 = col & 63;
                        const f32x4 v0 = acc[ai][bj][m][0], v1 = acc[ai][bj][m][1];
                        u32x4 w; w.x = cvt_pk_bf16(v0[0], v0[1]); w.y = cvt_pk_bf16(v0[2], v0[3]); w.z = cvt_pk_bf16(v1[0], v1[1]); w.w = cvt_pk_bf16(v1[2], v1[3]);
                        *(u32x4*)(KT + ((((size_t)b * NHEAD + h) * 128 + (sq >> 5)) * 4 + (d0 >> 4)) * 512 + (((d0 >> 3) & 1) * 32 + (sq & 31)) * 8) = w; } }
        } else {
#pragma unroll
            for (int ai = 0; ai < 2; ++ai)
#pragma unroll
                for (int m = 0; m < 4; ++m) { const int row = row0 + ai * HALF + m * 16, b = row / SEQ, sq = row % SEQ, kvl = sq & 31;
                    const int sp = kvl >> 4, r = kvl & 15, hh = (r >> 2) & 1, e = (r & 3) + 4 * (r >> 3);
#pragma unroll
                    for (int bj = 0; bj < 2; ++bj) { const int col = colt + bj * HALF, h = col >> 6, d0 = col & 63;
                        bf16_t* p = VT + (((((size_t)b * NHEAD + h) * 128 + (sq >> 5)) * 2 + (d0 >> 5)) * 2 + sp) * 512 + (hh * 32 + (d0 & 31)) * 8 + e;
                        const f32x4 v0 = acc[ai][bj][m][0], v1 = acc[ai][bj][m][1];
                        const unsigned w0 = cvt_pk_bf16(v0[0], v0[1]), w1 = cvt_pk_bf16(v0[2], v0[3]), w2 = cvt_pk_bf16(v1[0], v1[1]), w3 = cvt_pk_bf16(v1[2], v1[3]);
                        p[0] = (bf16_t)w0; p[8] = (bf16_t)(w0 >> 16); p[16] = (bf16_t)w1; p[24] = (bf16_t)(w1 >> 16);
                        p[32] = (bf16_t)w2; p[40] = (bf16_t)(w2 >> 16); p[48] = (bf16_t)w3; p[56] = (bf16_t)(w3 >> 16); } }
        }
    }
};
struct EpiSplitX {
    static constexpr bool PERM = true, AFTER_DRAIN = false;
    bf16_t *A0;
    unsigned* xhalo;
    __device__ __forceinline__ void operator()(const f32x4 (&acc)[2][2][4][2], const Unit& u, int wr, int wc, int fr, int fq) const {
        const int row0 = u.pm * BM + wr * 64 + fr, colt = (u.pn & 7) * 256 + wc * 32 + 8 * fq;
        bf16_t* base = A0 + (size_t)(u.pn >> 3) * ((size_t)T * 2048);
#pragma unroll
        for (int ai = 0; ai < 2; ++ai)
#pragma unroll
            for (int m = 0; m < 4; ++m) { bf16_t* rowp = base + (size_t)(row0 + ai * HALF + m * 16) * 2048 + colt;
#pragma unroll
                for (int bj = 0; bj < 2; ++bj) { const f32x4 v0 = acc[ai][bj][m][0], v1 = acc[ai][bj][m][1];
                    u32x4 w; w.x = cvt_pk_bf16(v0[0], v0[1]); w.y = cvt_pk_bf16(v0[2], v0[3]); w.z = cvt_pk_bf16(v1[0], v1[1]); w.w = cvt_pk_bf16(v1[2], v1[3]);
                    *(u32x4*)(rowp + bj * HALF) = w;
                    if ((u.pn >> 3) == 0 && (u.pm & 3) == 3 && wr == 1 && ai == 1 && m == 3 && fr >= 13) { const int r = row0 + ai * HALF + m * 16;
                        const int unit = (r >> 12) * 32 + (u.pn & 7) * 4 + ((r >> 10) & 3);
                        *(u32x4*)(xhalo + ((size_t)unit * 3 + (fr - 13)) * 128 + (wc * 32 + 8 * fq + bj * HALF) / 2) = w; } } }
    }
};
struct EpiGateNorm {
    static constexpr bool PERM = true, AFTER_DRAIN = false;
    bf16_t* Y; PG8_LAS float* xch;
    __device__ __forceinline__ void operator()(f32x4 (&acc)[2][2][4][2], const Unit& u, int wr, int wc, int fr, int fq) const {
        const int row0 = u.pm * BM + wr * 64 + fr, colt = (u.pn & 7) * 256 + wc * 32 + 8 * fq;
#pragma unroll
        for (int ai = 0; ai < 2; ++ai)
#pragma unroll
            for (int m = 0; m < 4; ++m) { const bf16_t* rowp = Y + (size_t)(row0 + ai * HALF + m * 16) * 2048 + colt; float sq = 0.f;
#pragma unroll
                for (int bj = 0; bj < 2; ++bj) { const u32x4 y8 = *(const u32x4*)(rowp + bj * HALF);
#pragma unroll
                    for (int n = 0; n < 2; ++n)
#pragma unroll
                        for (int e = 0; e < 4; ++e) { const unsigned yw = y8[2 * n + (e >> 1)]; const float yv = (e & 1) ? __uint_as_float(yw & 0xffff0000u) : __uint_as_float(yw << 16);
                            const float z = acc[ai][bj][m][n][e]; const float gv = yv * z * __builtin_amdgcn_rcpf(1.f + __expf(-z));
                            acc[ai][bj][m][n][e] = gv; sq += gv * gv; } }
                sq = xhalf_sum(x16_sum(sq));
                if (fq == 0) xch[(ai * HALF + wr * 64 + m * 16 + fr) * 4 + wc] = sq; }
        asm volatile("s_waitcnt lgkmcnt(0)" ::: "memory"); __builtin_amdgcn_s_barrier(); asm volatile("" ::: "memory");
#pragma unroll
        for (int ai = 0; ai < 2; ++ai)
#pragma unroll
            for (int m = 0; m < 4; ++m) { const int r = ai * HALF + wr * 64 + m * 16 + fr; const f32x4 p4 = *(const PG8_LAS f32x4*)(xch + r * 4);
                const float rs = __builtin_amdgcn_rsqf(((p4[0] + p4[1]) + (p4[2] + p4[3])) * (1.0f / 256.0f) + 1e-6f);
                bf16_t* rowp = Y + (size_t)(row0 + ai * HALF + m * 16) * 2048 + colt;
#pragma unroll
                for (int bj = 0; bj < 2; ++bj) { const f32x4 v0 = acc[ai][bj][m][0] * rs, v1 = acc[ai][bj][m][1] * rs;
                    u32x4 w; w.x = cvt_pk_bf16(v0[0], v0[1]); w.y = cvt_pk_bf16(v0[2], v0[3]); w.z = cvt_pk_bf16(v1[0], v1[1]); w.w = cvt_pk_bf16(v1[2], v1[3]);
                    *(u32x4*)(rowp + bj * HALF) = w; } }
        asm volatile("s_waitcnt lgkmcnt(0)" ::: "memory"); __builtin_amdgcn_s_barrier(); asm volatile("" ::: "memory");
    }
};
template <bool BASE_F32>
struct EpiResGate {
    static constexpr bool PERM = true, AFTER_DRAIN = false;
    const void* base; bf16_t* out; const float* gate; float* ssp;
    __device__ __forceinline__ void operator()(const f32x4 (&acc)[2][2][4][2], const Unit& u, int wr, int wc, int fr, int fq) const {
        const int row0 = u.pm * BM + wr * 64 + fr, b = (u.pm * BM) / SEQ, col0 = u.pn * BM + wc * 32 + 8 * fq;
        f32x4 gv[2][2];
#pragma unroll
        for (int bj = 0; bj < 2; ++bj)
#pragma unroll
            for (int n = 0; n < 2; ++n) gv[bj][n] = *(const f32x4*)(gate + (size_t)b * 6144 + col0 + bj * HALF + n * 4);
        constexpr int MB = BASE_F32 ? 2 : 4;
#pragma unroll
        for (int ai = 0; ai < 2; ++ai)
#pragma unroll
            for (int m0 = 0; m0 < 4; m0 += MB) {
                f32x4 rf[MB][2][BASE_F32 ? 2 : 1]; u32x4 rx[MB][2];
#pragma unroll
                for (int mm = 0; mm < MB; ++mm) { const size_t off = (size_t)(row0 + ai * HALF + (m0 + mm) * 16) * D + col0;
#pragma unroll
                    for (int bj = 0; bj < 2; ++bj) {
                        if (BASE_F32) { rf[mm][bj][0] = *(const f32x4*)((const float*)base + off + bj * HALF); rf[mm][bj][BASE_F32 ? 1 : 0] = *(const f32x4*)((const float*)base + off + bj * HALF + 4); }
                        else rx[mm][bj] = *(const u32x4*)((const bf16_t*)base + off + bj * HALF); } }
#pragma unroll
                for (int mm = 0; mm < MB; ++mm) { const int m = m0 + mm; const size_t off = (size_t)(row0 + ai * HALF + m * 16) * D + col0; float sq = 0.f;
#pragma unroll
                    for (int bj = 0; bj < 2; ++bj) { f32x4 b0, b1;
                        if (BASE_F32) { b0 = rf[mm][bj][0]; b1 = rf[mm][bj][BASE_F32 ? 1 : 0]; }
                        else { const u32x4 x8 = rx[mm][bj];
                            b0[0] = __uint_as_float(x8.x << 16); b0[1] = __uint_as_float(x8.x & 0xffff0000u); b0[2] = __uint_as_float(x8.y << 16); b0[3] = __uint_as_float(x8.y & 0xffff0000u);
                            b1[0] = __uint_as_float(x8.z << 16); b1[1] = __uint_as_float(x8.z & 0xffff0000u); b1[2] = __uint_as_float(x8.w << 16); b1[3] = __uint_as_float(x8.w & 0xffff0000u); }
                        const f32x4 o0 = b0 + gv[bj][0] * acc[ai][bj][m][0], o1 = b1 + gv[bj][1] * acc[ai][bj][m][1];
                        sq += ((o0[0] * o0[0] + o0[1] * o0[1]) + (o0[2] * o0[2] + o0[3] * o0[3])) + ((o1[0] * o1[0] + o1[1] * o1[1]) + (o1[2] * o1[2] + o1[3] * o1[3]));
                        u32x4 w8; w8.x = cvt_pk_bf16(o0[0], o0[1]); w8.y = cvt_pk_bf16(o0[2], o0[3]); w8.z = cvt_pk_bf16(o1[0], o1[1]); w8.w = cvt_pk_bf16(o1[2], o1[3]);
                        *(u32x4*)(out + off + bj * HALF) = w8; }
                    sq = xhalf_sum(x16_sum(sq));
                    if (fq == 0) ssp[(size_t)(row0 + ai * HALF + m * 16) * 16 + u.pn * 4 + wc] = sq; }
            }
    }
};
}

#define XB_TMO      128
#define XB_XCNT(j)  (256  + 64 * (j))
#define XB_XSUB(j)  (1280 + 64 * (j))
#define XB_XGEN(j)  (2304 + 64 * (j))
#define XB_TOP      3328
#define XB_TOPGEN   3392
#define XCD_BAR_WORDS 3456
#define XB_SPIN_CAP (1u << 18)

__device__ __forceinline__ unsigned xb_ld(unsigned* p)              { return __hip_atomic_load(p, __ATOMIC_RELAXED, __HIP_MEMORY_SCOPE_AGENT); }
__device__ __forceinline__ unsigned xb_add(unsigned* p, unsigned v) { return __hip_atomic_fetch_add(p, v, __ATOMIC_RELAXED, __HIP_MEMORY_SCOPE_AGENT); }
__device__ __forceinline__ unsigned xb_xcc_id() { return (unsigned)__builtin_amdgcn_s_getreg((3 << 11) | 20) & 0xFu; }
#define XB_SPIN(cond, bar) do { unsigned _sp = 0; while (cond) { __builtin_amdgcn_s_sleep(1); \
    if ((++_sp & 255u) == 0u) { if (xb_ld(&(bar)[XB_TMO])) break; if (_sp > XB_SPIN_CAP) { atomicAdd(&(bar)[XB_TMO], 1u); break; } } } } while (0)

struct XcdBarrier {
    unsigned* bar; unsigned x;
    volatile LAS unsigned* st;
};

__device__ __forceinline__ XcdBarrier xcd_barrier_post(unsigned* bar, volatile LAS unsigned* st) {
    XcdBarrier b; b.bar = bar; b.x = xb_xcc_id(); b.st = st;
    if (threadIdx.x == 0) (void)xb_add(&bar[XB_XCNT(b.x)], 1u);
    return b;
}
__device__ __forceinline__ void xcd_barrier_complete(unsigned* bar, unsigned x, unsigned& nloc, unsigned& nx) {
    const unsigned G = gridDim.x * gridDim.y * gridDim.z;
    unsigned sum, cnt, mine, sp = 0u;
    for (;;) {
        sum = 0u; cnt = 0u; mine = 0u;
#pragma unroll
        for (unsigned j = 0; j < 16; ++j) { const unsigned c = xb_ld(&bar[XB_XCNT(j)]); sum += c; cnt += (c > 0u) ? 1u : 0u; mine = (j == x) ? c : mine; }
        if (sum == G) break;
        __builtin_amdgcn_s_sleep(1);
        if ((++sp & 255u) == 0u) { if (xb_ld(&bar[XB_TMO])) break; if (sp > XB_SPIN_CAP) { atomicAdd(&bar[XB_TMO], 1u); break; } }
    }
    nloc = mine > 0u ? mine : 1u; nx = cnt > 0u ? cnt : 1u;
}

__device__ __forceinline__ void xcd_barrier(const XcdBarrier& b) {
    asm volatile("s_waitcnt vmcnt(0)" ::: "memory");
    __syncthreads();
    if (threadIdx.x == 0) {
        unsigned* bar = b.bar;
        __builtin_amdgcn_s_waitcnt(0);
        unsigned nloc = b.st[0], nx = b.st[1];
        if (nloc == 0u) { xcd_barrier_complete(bar, b.x, nloc, nx); b.st[0] = nloc; b.st[1] = nx; }
        const unsigned old = xb_add(&bar[XB_XSUB(b.x)], 1u);
        const unsigned gen = old / nloc;
        if (old + 1u == (gen + 1u) * nloc) {
            __builtin_amdgcn_fence(__ATOMIC_RELEASE, "agent");
            asm volatile("s_waitcnt vmcnt(0)" ::: "memory");
            const unsigned og = xb_add(&bar[XB_TOP], 1u);
            const unsigned tg = og / nx;
            if (og + 1u == (tg + 1u) * nx) xb_add(&bar[XB_TOPGEN], 1u);
            else XB_SPIN(xb_ld(&bar[XB_TOPGEN]) == tg, bar);
            __builtin_amdgcn_fence(__ATOMIC_ACQUIRE, "agent");
            xb_add(&bar[XB_XGEN(b.x)], 1u);
            asm volatile("s_waitcnt vmcnt(0)" ::: "memory");
        } else {
            XB_SPIN(xb_ld(&bar[XB_XGEN(b.x)]) == gen, bar);
            __builtin_amdgcn_fence(__ATOMIC_ACQUIRE, "agent");
            asm volatile("s_waitcnt vmcnt(0)" ::: "memory");
        }
    }
    __syncthreads();
}

#define LDS_WAIT() asm volatile("s_waitcnt lgkmcnt(0)" ::: "memory")
template <int MODE>
__device__ __forceinline__ void transpose_item(const float* W, int ldw, int K, bf16_t* WT, int row_off, float* scr, int kb, int nb, int lane, const float* kscale) {
    const int k0 = 64 * kb, n0 = 32 * nb;
#pragma unroll 32
    for (int i = 0; i < 32; ++i) { const int kk = 2 * i + (lane >> 5); float v = W[(size_t)(k0 + kk) * ldw + n0 + (lane & 31)]; if (kscale) v *= kscale[k0 + kk]; scr[kk * 33 + (lane & 31)] = v; }
    LDS_WAIT(); asm volatile("" ::: "memory");
    const int c = lane & 7;
#pragma unroll
    for (int j = 0; j < 4; ++j) { const int n = (lane >> 3) + 8 * j; const float* s = scr + (8 * c) * 33 + n;
        u32x4 o; o.x = pk2(s[0 * 33], s[1 * 33]); o.y = pk2(s[2 * 33], s[3 * 33]); o.z = pk2(s[4 * 33], s[5 * 33]); o.w = pk2(s[6 * 33], s[7 * 33]);
        const int ng = n0 + n, orow = MODE == 1 ? (row_off + 32 * (ng >> 4) + (ng & 15)) : (row_off + ng);
        if (MODE == 1) {
            const int kk = k0 + 8 * c; const size_t blk = ((size_t)(orow >> 5) * 32 + (kk >> 5)) * 2 + ((orow >> 4) & 1);
            *(u32x4*)(WT + (blk * 64 + ((kk >> 3) & 3) * 16 + (orow & 15)) * 8) = o;
        } else if (MODE == 3) {
            const int kk = k0 + 8 * c, u = orow & 31; const size_t blk = (size_t)(2 * (orow >> 5) + ((u >> 2) & 1)) * (K >> 5) + (kk >> 5);
            *(u32x4*)(WT + (blk * 64 + ((kk >> 3) & 3) * 16 + 4 * (u >> 3) + (u & 3)) * 8) = o;
        } else if (MODE == 2) {
            const int kk = k0 + 8 * c; const size_t blk = (size_t)(orow >> 4) * (K >> 5) + (kk >> 5);
            *(u32x4*)(WT + (blk * 64 + ((kk >> 3) & 3) * 16 + (orow & 15)) * 8) = o;
        } else *(u32x4*)(WT + (size_t)orow * K + k0 + 8 * c) = o; }
    LDS_WAIT(); asm volatile("" ::: "memory");
}
__device__ __forceinline__ void phase_convert(const Params& P, const Geo& g, float* ldsf) {
    float* scr = ldsf + g.wave * (64 * 33);
    const int gw = g.vcu * 8 + g.wave, NGW = g.G * 8;
    unsigned char* ws = P.ws;
    for (int e = gw * 64 + g.lane; e < DEPTH * 48 * D; e += NGW * 64) { const int Lr = e / (48 * D), rem = e % (48 * D), ct = rem / (16 * D), s_ = (rem / 512) & 31, ln = (rem >> 3) & 63, jj = rem & 7;
        const int j = 16 * ct + (ln & 15), k = 32 * s_ + 8 * (ln >> 4) + jj;
        const float v = j < 4 ? P.in[I_WG][((size_t)Lr * D + k) * 4 + j] : (j < 36 ? P.in[I_WE][((size_t)Lr * D + k) * 32 + j - 4] : 0.f);
        const unsigned hi = f2bf(v); ((bf16_t*)(ws + WS_WRH))[e] = (bf16_t)hi; ((bf16_t*)(ws + WS_WRL))[e] = (bf16_t)f2bf(v - bf2f(hi)); }
    for (int e = gw * 64 + g.lane; e < 2 * 32 * D; e += NGW * 64) { const int ir = e / (32 * D), rem = e % (32 * D), ct = rem / (16 * D), s_ = (rem / 512) & 31, ln = (rem >> 3) & 63, jj = rem & 7;
        const int j = 16 * ct + (ln & 15), k = 32 * s_ + 8 * (ln >> 4) + jj;
        const float v = P.in[I_SSMIN][((size_t)ir * D + k) * SSM_IN + 6144 + j];
        const unsigned hi = f2bf(v); ((bf16_t*)(ws + WS_WDH))[e] = (bf16_t)hi; ((bf16_t*)(ws + WS_WDL))[e] = (bf16_t)f2bf(v - bf2f(hi)); }
    constexpr int C0 = 2 * 1024, C1 = C0 + 2 * 512, C2 = C1 + 2 * 2048, C3 = C2 + 2 * 1024, C4 = C3 + 2 * 1024, C5 = C4 + 8 * 8, C6 = C5 + 128 * 64, C7 = C6 + 128 * 64, C8 = C7 + 128 * 64;
    for (int it = gw; it < C8; it += NGW) {
        int r = it;
        if (r < C0) { const int mat = r / 1024, rem = r % 1024;
            transpose_item<0>(P.in[I_MIXIN] + (size_t)mat * D * MIX_IN, MIX_IN, D, (bf16_t*)(ws + WS_WMI) + (size_t)mat * MIX_IN * D, 0, scr, rem / 64, rem % 64, g.lane, nullptr); continue; }
        r -= C0;
        if (r < 2 * 512) { const int mat = r / 512, rem = r % 512;
            transpose_item<0>(P.in[I_MIXOUT] + (size_t)mat * D * D, D, D, (bf16_t*)(ws + WS_WMO) + (size_t)mat * D * D, 0, scr, rem / 32, rem % 32, g.lane, nullptr); continue; }
        r -= 2 * 512;
        if (r < 2 * 2048) { const int mat = r / 2048, rem = r % 2048;
            transpose_item<0>(P.in[I_SSMIN] + (size_t)mat * D * SSM_IN + 2048, SSM_IN, D, (bf16_t*)(ws + WS_WSX) + (size_t)mat * 4096 * D, 0, scr, rem / 128, rem % 128, g.lane, nullptr); continue; }
        r -= 2 * 2048;
        if (r < 2 * 1024) { const int mat = r / 1024, rem = r % 1024;
            transpose_item<0>(P.in[I_SSMIN] + (size_t)mat * D * SSM_IN, SSM_IN, D, (bf16_t*)(ws + WS_WSZ) + (size_t)mat * 2048 * D, 0, scr, rem / 64, rem % 64, g.lane, nullptr); continue; }
        r -= 2 * 1024;
        if (r < 2 * 1024) { const int mat = r / 1024, rem = r % 1024;
            transpose_item<0>(P.in[I_SSMOUT] + (size_t)mat * SSM_DI * D, D, SSM_DI, (bf16_t*)(ws + WS_WSO) + (size_t)mat * D * SSM_DI, 0, scr, rem / 32, rem % 32, g.lane, P.in[I_SSMNW] + mat * SSM_DI); continue; }
        r -= 2 * 1024;
        if (r < 64) { const int mat = r / 8, rem = r % 8;
            transpose_item<0>(P.in[I_POOLW] + (size_t)mat * 128 * 128, 128, 128, (bf16_t*)(ws + WS_WPL) + (size_t)mat * 128 * 128, 0, scr, rem / 4, rem % 4, g.lane, nullptr); continue; }
        r -= 64;
        if (r < 128 * 64) { const int mat = r / 64, rem = r % 64;
            transpose_item<1>(P.in[I_W1] + (size_t)mat * D * MOE_FF, MOE_FF, D, (bf16_t*)(ws + WS_W13) + (size_t)mat * 256 * D, 0, scr, rem / 4, rem % 4, g.lane, nullptr); continue; }
        r -= 128 * 64;
        if (r < 128 * 64) { const int mat = r / 64, rem = r % 64;
            transpose_item<1>(P.in[I_W3] + (size_t)mat * D * MOE_FF, MOE_FF, D, (bf16_t*)(ws + WS_W13) + (size_t)mat * 256 * D, 16, scr, rem / 4, rem % 4, g.lane, nullptr); continue; }
        r -= 128 * 64;
        { const int mat = r / 64, rem = r % 64;
            transpose_item<3>(P.in[I_W2] + (size_t)mat * MOE_FF * D, D, MOE_FF, (bf16_t*)(ws + WS_W2T) + (size_t)mat * D * MOE_FF, 0, scr, rem / 32, rem % 32, g.lane, nullptr); }
    }
}


#define LDS_BARRIER() do { asm volatile("s_waitcnt lgkmcnt(0)" ::: "memory"); __builtin_amdgcn_s_barrier(); asm volatile("" ::: "memory"); } while (0)
template <int NMT>
__device__ __forceinline__ void moe_pass(const Params& P, LAS unsigned char* l3, int L, int w, int lane, int bucket, int off, int nrows, int e0, int e1, bool dry) {
    constexpr int HS = 528, OFF_B1 = 67584, OFF_GT = 67584;
    constexpr int OFF_TOK = 133120, OFF_WLO = OFF_TOK + 512, OFF_WHI = OFF_WLO + 512;
    LAS int* tok = (LAS int*)(l3 + OFF_TOK); LAS float* wlo = (LAS float*)(l3 + OFF_WLO); LAS float* whi = (LAS float*)(l3 + OFF_WHI);
    unsigned char* ws = P.ws;
    const int* list = (const int*)(ws + WS_LIST);
    const float2* tokw = (const float2*)(ws + WS_TOKW);
    const bf16_t* H = (const bf16_t*)P.out;
    const float* gate2 = (const float*)(ws + WS_MOD) + (size_t)L * NB * 6144 + 5120;
    const int j16 = lane & 15, q4 = lane >> 4, tid = w * 64 + lane;
    float2 tww = make_float2(0.f, 0.f);
    if (tid < 128) { const int r = tid; int t = -1;
        if (r < nrows) { t = list[(size_t)bucket * T + off + r]; tww = tokw[t]; }
        tok[r] = t; }
    LDS_BARRIER();
#define MOE_GATHER(KC, BO) do { if (w < NMT) { _Pragma("unroll") for (int i = 0; i < 8; ++i) { int t = tok[16 * w + 2 * i + (lane >> 5)]; t = t < 0 ? 0 : t; \
        const int s = (lane & 31) ^ ((2 * i + (lane >> 5)) & 15); \
        __builtin_amdgcn_global_load_lds((const unsigned*)(H + (size_t)t * D + (KC) * 256 + s * 8), (LAS unsigned*)(l3 + (BO) + (16 * w + 2 * i) * 512), 16, 0, 0); } } } while (0)
    f32x4 gtv[4];
    {
        const char* Wu0 = (const char*)(ws + WS_W13) + ((size_t)(L * MOE_E + e0) * 256 * D + (size_t)w * 32 * 1024) * 2;
        const char* Wu1 = (const char*)(ws + WS_W13) + ((size_t)(L * MOE_E + e1) * 256 * D + (size_t)w * 32 * 1024) * 2;
        const unsigned lo16 = (unsigned)lane * 16u;
#define W13F(U, KS, S) (*(const bf16x8*)((U) + (size_t)(lo16 + (unsigned)(2048 * (KS) + 1024 * (S)))))
        f32x4 acc[2][NMT][2];
#pragma unroll
        for (int es = 0; es < 2; ++es)
#pragma unroll
            for (int mt = 0; mt < NMT; ++mt) { acc[es][mt][0] = (f32x4){0.f, 0.f, 0.f, 0.f}; acc[es][mt][1] = (f32x4){0.f, 0.f, 0.f, 0.f}; }
        MOE_GATHER(0, 0);
        asm volatile("" ::: "memory");
        bf16x8 rb[2][4];
#pragma unroll
        for (int j = 0; j < 2; ++j) { rb[j][0] = W13F(Wu0, j, 0); rb[j][1] = W13F(Wu0, j, 1); rb[j][2] = W13F(Wu1, j, 0); rb[j][3] = W13F(Wu1, j, 1); }
        if (tid < 128) { wlo[tid] = tww.x; whi[tid] = tww.y; }
        asm volatile("s_waitcnt vmcnt(8)" ::: "memory");
        LDS_BARRIER();
#pragma unroll 1
        for (int kc = 0; kc < 4; ++kc) {
            int lk = lane; asm volatile("" : "+v"(lk));
            const int lane = lk, j16 = lane & 15, q4 = lane >> 4; const unsigned lo16 = (unsigned)lane * 16u;
            const int aoff = j16 * 512 + ((q4 ^ j16) << 4);
            const int bo = (kc & 1) ? OFF_B1 : 0;
            if (kc < 3) { if (kc & 1) MOE_GATHER(kc + 1, 0); else MOE_GATHER(kc + 1, OFF_B1); }
            asm volatile("" ::: "memory");
#pragma unroll
            for (int ksl = 0; ksl < 8; ++ksl) {
                const int ks = 8 * kc + ksl;
                const LAS unsigned char* ap = l3 + bo + (aoff ^ (ksl << 6));
#pragma unroll
                for (int mt = 0; mt < NMT; ++mt) { const bf16x8 a = *(const LAS bf16x8*)(ap + mt * 8192);
                    acc[0][mt][0] = __builtin_amdgcn_mfma_f32_16x16x32_bf16(a, rb[ksl & 1][0], acc[0][mt][0], 0, 0, 0);
                    acc[0][mt][1] = __builtin_amdgcn_mfma_f32_16x16x32_bf16(a, rb[ksl & 1][1], acc[0][mt][1], 0, 0, 0); }
                if (kc < 3 || ksl < 6) { rb[ksl & 1][0] = W13F(Wu0, ks + 2, 0); rb[ksl & 1][1] = W13F(Wu0, ks + 2, 1); }
                __builtin_amdgcn_sched_barrier(0);
#pragma unroll
                for (int mt = 0; mt < NMT; ++mt) { const bf16x8 a = *(const LAS bf16x8*)(ap + mt * 8192);
                    acc[1][mt][0] = __builtin_amdgcn_mfma_f32_16x16x32_bf16(a, rb[ksl & 1][2], acc[1][mt][0], 0, 0, 0);
                    acc[1][mt][1] = __builtin_amdgcn_mfma_f32_16x16x32_bf16(a, rb[ksl & 1][3], acc[1][mt][1], 0, 0, 0); }
                if (kc < 3 || ksl < 6) { rb[ksl & 1][2] = W13F(Wu1, ks + 2, 0); rb[ksl & 1][3] = W13F(Wu1, ks + 2, 1); }
                __builtin_amdgcn_sched_barrier(0);
            }
            if (kc < 3) { asm volatile("s_waitcnt vmcnt(8)" ::: "memory"); LDS_BARRIER(); }
        }
        int l2 = lane; asm volatile("" : "+v"(l2));
        { const int lane = l2, j16 = lane & 15, q4 = lane >> 4, tid = w * 64 + lane;
#pragma unroll
        for (int i = 0; i < 4; ++i) { const int e = tid + 512 * i; gtv[i] = *(const f32x4*)(gate2 + (size_t)(e >> 8) * 6144 + (e & 255) * 4); }
#pragma unroll
        for (int es = 0; es < 2; ++es)
#pragma unroll
            for (int mt = 0; mt < NMT; ++mt) { LAS bf16_t* hb = (LAS bf16_t*)(l3 + (16 * mt + 4 * q4) * HS) + 128 * es + 16 * w + j16;
#pragma unroll
                for (int r = 0; r < 4; ++r) { const int l = 16 * mt + 4 * q4 + r; const float wt = es ? whi[l] : wlo[l];
                    hb[r * (HS / 2)] = (bf16_t)f2bf(silu_f(acc[es][mt][0][r]) * acc[es][mt][1][r] * wt); } }
        }
    }
#undef MOE_GATHER
#undef W13F
    int l4 = lane; asm volatile("" : "+v"(l4));
    { const int lane = l4, j16 = lane & 15, q4 = lane >> 4, tid = w * 64 + lane;
    LDS_BARRIER();
#pragma unroll
    for (int i = 0; i < 4; ++i) { const int e = tid + 512 * i; *(LAS f32x4*)(l3 + OFF_GT + (e >> 8) * 4112 + (e & 255) * 16) = gtv[i]; }
    LDS_BARRIER();
#pragma unroll 1
    for (int half = 0; half < 2; ++half) {
        int lh = lane; asm volatile("" : "+v"(lh));
        const int lane = lh, j16 = lane & 15, q4 = lane >> 4;
        const int nb = 128 * w + 64 * half;
        f32x4 acc[NMT][4];
#pragma unroll
        for (int mt = 0; mt < NMT; ++mt)
#pragma unroll
            for (int nt = 0; nt < 4; ++nt) acc[mt][nt] = (f32x4){0.f, 0.f, 0.f, 0.f};
        const char* Vu0 = (const char*)(ws + WS_W2T) + ((size_t)(L * MOE_E + e0) * D * MOE_FF + (size_t)(nb >> 4) * 4 * 512) * 2;
        const char* Vu1 = (const char*)(ws + WS_W2T) + ((size_t)(L * MOE_E + e1) * D * MOE_FF + (size_t)(nb >> 4) * 4 * 512) * 2;
        const unsigned lo16b = (unsigned)lane * 16u;
#define W2F(KS, NT) (*(const bf16x8*)((((KS) >> 2) ? Vu1 : Vu0) + (size_t)(lo16b + (unsigned)(1024 * ((KS) & 3) + 4096 * (NT)))))
#define MOE_XLOAD(MG, BUF) do { _Pragma("unroll") for (int m4 = 0; m4 < 2; ++m4) { int t = tok[16 * (2 * (MG) + m4) + j16]; asm volatile("" : "+v"(t)); tt[BUF][m4] = t; const int tc = t < 0 ? 0 : t; \
            const bf16_t* xr_ = (const bf16_t*)(ws + WS_XB) + (size_t)tc * D + nb + 8 * q4; \
            _Pragma("unroll") for (int np = 0; np < 2; ++np) xin[BUF][m4][np] = *(const u32x4*)(xr_ + 32 * np); } } while (0)
        int tt[2][2]; u32x4 xin[2][2][2];
        bf16x8 bw[2][4];
#pragma unroll
        for (int j = 0; j < 2; ++j)
#pragma unroll
            for (int nt = 0; nt < 4; ++nt) bw[j][nt] = W2F(j, nt);
#pragma unroll
        for (int ks = 0; ks < 8; ++ks) {
            bf16x8 b[4];
#pragma unroll
            for (int nt = 0; nt < 4; ++nt) b[nt] = bw[ks & 1][nt];
            if (ks + 2 < 8) {
#pragma unroll
                for (int nt = 0; nt < 4; ++nt) bw[ks & 1][nt] = W2F(ks + 2, nt); }
            if (ks == 6) MOE_XLOAD(0, 0);
#pragma unroll
            for (int mt = 0; mt < NMT; ++mt) { const bf16x8 a = *(const LAS bf16x8*)(l3 + (16 * mt + j16) * HS + (32 * ks + 8 * q4) * 2);
#pragma unroll
                for (int nt = 0; nt < 4; ++nt) acc[mt][nt] = __builtin_amdgcn_mfma_f32_16x16x32_bf16(b[nt], a, acc[mt][nt], 0, 0, 0); }
            __builtin_amdgcn_sched_barrier(0);
        }
#undef W2F
#pragma unroll
        for (int mg = 0; mg < NMT / 2; ++mg) {
            if (mg + 1 < NMT / 2) MOE_XLOAD(mg + 1, (mg + 1) & 1);
#pragma unroll
            for (int m4 = 0; m4 < 2; ++m4) { const int t = tt[mg & 1][m4], mt = 2 * mg + m4; float sq = 0.f;
                if (t >= 0) { const int b = t / SEQ; bf16_t* xr = (bf16_t*)(ws + WS_XB) + (size_t)t * D + nb + 8 * q4; const LAS float* gr = (const LAS float*)(l3 + OFF_GT) + b * 1028 + nb + 8 * q4;
#pragma unroll
                    for (int np = 0; np < 2; ++np) { const f32x4 g0 = *(const LAS f32x4*)(gr + 32 * np), g1 = *(const LAS f32x4*)(gr + 32 * np + 4);
                        const u32x4 x8 = xin[mg & 1][m4][np];
                        f32x4 x0, x1; x0[0] = bf2f(x8.x & 0xffffu); x0[1] = bf2f(x8.x >> 16); x0[2] = bf2f(x8.y & 0xffffu); x0[3] = bf2f(x8.y >> 16);
                        x1[0] = bf2f(x8.z & 0xffffu); x1[1] = bf2f(x8.z >> 16); x1[2] = bf2f(x8.w & 0xffffu); x1[3] = bf2f(x8.w >> 16);
                        const f32x4 o0 = x0 + g0 * acc[mt][2 * np], o1 = x1 + g1 * acc[mt][2 * np + 1];
                        sq += ((o0[0] * o0[0] + o0[1] * o0[1]) + (o0[2] * o0[2] + o0[3] * o0[3])) + ((o1[0] * o1[0] + o1[1] * o1[1]) + (o1[2] * o1[2] + o1[3] * o1[3]));
                        u32x4 w8; w8.x = pk2(o0[0], o0[1]); w8.y = pk2(o0[2], o0[3]); w8.z = pk2(o1[0], o1[1]); w8.w = pk2(o1[2], o1[3]);
                        if (!dry) *(u32x4*)(xr + 32 * np) = w8; } }
                sq = xhalf_sum(x16_sum(sq));
                if (!dry && t >= 0 && q4 == 0) ((float*)(ws + WS_SSP))[(size_t)t * 16 + 2 * w + half] = sq; }
        }
#undef MOE_XLOAD
    }
    }
    __syncthreads();
}
__device__ __forceinline__ void phase_moe(const Params& P, const Geo& g, LAS unsigned char* l3, int L, bool dry = false) {
    constexpr int HS = 528, OFF_B1 = 67584, OFF_GT = 67584;
    constexpr int OFF_TOK = 133120, OFF_WLO = OFF_TOK + 512, OFF_WHI = OFF_WLO + 512, OFF_PF = OFF_WHI + 512;
    LAS int* tok = (LAS int*)(l3 + OFF_TOK); LAS float* wlo = (LAS float*)(l3 + OFF_WLO); LAS float* whi = (LAS float*)(l3 + OFF_WHI); LAS int* pf = (LAS int*)(l3 + OFF_PF);
    unsigned char* ws = P.ws;
    const unsigned* cnt = (const unsigned*)(ws + WS_CTL) + CW_CNT + L * 128 * 16;
    const int* list = (const int*)(ws + WS_LIST);
    const float2* tokw = (const float2*)(ws + WS_TOKW);
    const bf16_t* H = (const bf16_t*)P.out;
    const float* gate2 = (const float*)(ws + WS_MOD) + (size_t)L * NB * 6144 + 5120;
    const int w = g.wave;
    LAS int* cn = pf + 128;
    if (g.tid < 128) { const int c = g.tid < NBUCKET ? (int)cnt[g.tid * 16] : 0; int sc = c;
#pragma unroll
        for (int o = 1; o < 64; o <<= 1) { const int nbv = __shfl_up(sc, o); sc += (g.lane >= o) ? nbv : 0; }
        pf[g.tid] = sc - c; if (g.tid == 63) cn[0] = sc; }
    __syncthreads();
    if (g.tid >= 64 && g.tid < 128) pf[g.tid] += cn[0];
    __syncthreads();
    const int rows_per = (T + g.G - 1) / g.G;
    int cur = g.vcu * rows_per; const int end = min(T, cur + rows_per);
    int bucket = 0;
    if (cur < end) {
#pragma unroll
        for (int st = 64; st > 0; st >>= 1) if (bucket + st <= NBUCKET - 1 && pf[bucket + st] <= cur) bucket += st; }
    while (cur < end) {
        int lane = g.lane; asm volatile("" : "+v"(lane));
        while (pf[bucket + 1] <= cur) ++bucket;
        const int off = cur - pf[bucket];
        const int nrows = min(min(128, end - cur), pf[bucket + 1] - cur);
        cur += nrows;
        const int nmt = (nrows + 15) >> 4;
        const int g4 = bucket / 28; int rem = bucket % 28, elo = 0;
        while (rem >= 7 - elo) { rem -= 7 - elo; ++elo; }
        const int ehi = elo + 1 + rem;
        const int e0 = g4 * 8 + elo, e1 = g4 * 8 + ehi;
        if (nmt > 6) moe_pass<8>(P, l3, L, w, lane, bucket, off, nrows, e0, e1, dry); else if (nmt > 4) moe_pass<6>(P, l3, L, w, lane, bucket, off, nrows, e0, e1, dry);
        else if (nmt > 2) moe_pass<4>(P, l3, L, w, lane, bucket, off, nrows, e0, e1, dry); else moe_pass<2>(P, l3, L, w, lane, bucket, off, nrows, e0, e1, dry);
    }
}


#define MFMA16(a, b, c) __builtin_amdgcn_mfma_f32_16x16x32_bf16(a, b, c, 0, 0, 0)
constexpr size_t WS_SLOC = WS_LIST;
constexpr size_t WS_ATOT = WS_TOKE;
constexpr size_t WS_XHALO = WS_TOKW;
template <int PASS>
__device__ __forceinline__ void scan_units(const Params& P, const Geo& g, LAS unsigned char* l3, int L, bool dry) {
    constexpr bool FULL = PASS >= 2;
    constexpr int S128 = 272, S64 = 144, SCB = 272;
    constexpr int O_CC = 0, O_BC = 17408, O_BCT = 34816, O_CB = 53248, O_XST = 70656, O_XPT = 107520;
    constexpr int O_ACS = 144384, O_DTV = O_ACS + 2048, O_SCL = O_DTV + 2048, O_EAL = O_SCL + 2048, O_HALO = O_EAL + 2048;
    const int i2 = L >> 1, lane = g.lane, w = g.wave, tid = g.tid;
    unsigned char* ws = P.ws;
    bf16_t* XS = (bf16_t*)(ws + WS_XS); const float* DT = (const float*)(ws + WS_DT);
    for (int u = g.vcu; u < 256; u += g.G) {
        const int b = u >> 5, gq = (u >> 2) & 7, sc = u & 3;
        const size_t tb = (size_t)b * SEQ + (size_t)sc * 1024;
        const int cp = tid & 255, half = tid >> 8;
        const bool act = FULL || (cp < 192);
        const int ch = cp < 128 ? (4 * gq) * 64 + 2 * cp : (cp < 192 ? 2048 + gq * 128 + 2 * (cp - 128) : 3072 + gq * 128 + 2 * (cp - 192));
        const unsigned colb = cp < 128 ? (unsigned)ch * 2u : (unsigned)(WS_BC - WS_XS) + (unsigned)(ch - 2048) * 2u;
        const unsigned voff = colb + (unsigned)half * 32u * 4096u;
        const int hd0 = 4 * gq;
        const float Ah_s0 = -__expf(P.in[I_ALOG][i2 * SSM_H + hd0 + (w & 3)]);
        float Dk[2]; Dk[0] = P.in[I_SSMD][i2 * SSM_H + hd0 + (w >> 2)]; Dk[1] = P.in[I_SSMD][i2 * SSM_H + hd0 + 2 + (w >> 2)];
        f32x4 S0[8], S1[8];
#pragma unroll
        for (int i = 0; i < 8; ++i) { S0[i] = (f32x4){0.f, 0.f, 0.f, 0.f}; S1[i] = (f32x4){0.f, 0.f, 0.f, 0.f}; }
        if (PASS == 2 && sc > 0) {
            const float* AT = (const float*)(ws + WS_ATOT);
#pragma unroll 1
            for (int j = 0; j < sc; ++j) {
                const int uj = (u >> 2) * 3 + j;
                float f0 = 0.f, f1 = 0.f;
                for (int i = j + 1; i < sc; ++i) { f0 += AT[((u & ~3) | i) * 4 + (w >> 2)]; f1 += AT[((u & ~3) | i) * 4 + 2 + (w >> 2)]; }
                f0 = __expf(f0); f1 = __expf(f1);
                const u32x4* sp0 = (const u32x4*)(ws + WS_SLOC) + (((size_t)uj * 2 + 0) * 8 + w) * 256 + lane * 4;
                const u32x4* sp1 = (const u32x4*)(ws + WS_SLOC) + (((size_t)uj * 2 + 1) * 8 + w) * 256 + lane * 4;
#pragma unroll
                for (int i = 0; i < 4; ++i) { const u32x4 a = sp0[i], c = sp1[i];
#pragma unroll
                    for (int e = 0; e < 4; ++e) { const int nt = 2 * i + (e >> 1), r = 2 * (e & 1);
                        S0[nt][r] += f0 * bf2f(a[e] & 0xffffu); S0[nt][r + 1] += f0 * bf2f(a[e] >> 16);
                        S1[nt][r] += f1 * bf2f(c[e] & 0xffffu); S1[nt][r + 1] += f1 * bf2f(c[e] >> 16); } }
            }
        }
        float atot = 0.f;
        unsigned raw[35]; float dt_pf = 0.f;
        {
            const char* rb = (const char*)XS + (tb - 3) * 4096;
#pragma unroll
            for (int i = 0; i < 35; ++i) raw[i] = act ? *(const unsigned*)(rb + (size_t)i * 4096 + voff) : 0u;
            if (half == 0) {
                if (sc == 0) { raw[0] = 0u; raw[1] = 0u; raw[2] = 0u; }
                else if (FULL && cp < 128) {
#pragma unroll
                    for (int i = 0; i < 3; ++i) raw[i] = ((const unsigned*)(ws + WS_XHALO))[((size_t)(u - 1) * 3 + i) * 128 + cp]; }
            }
            if (w < 4) dt_pf = DT[(tb + lane) * 32 + hd0 + w];
        }
        __syncthreads();
#pragma unroll 1
        for (int c = 0; c < 16; ++c) {
            const size_t t0 = tb + (size_t)c * 64;
            const int par = c & 1;
            int lane_o = lane; asm volatile("" : "+v"(lane_o));
            const int j16 = lane_o & 15, q4 = lane_o >> 4;
            LAS float* acs = (LAS float*)(l3 + O_ACS) + par * 256; LAS float* dtv = (LAS float*)(l3 + O_DTV) + par * 256;
            LAS float* scl = (LAS float*)(l3 + O_SCL) + par * 256; LAS float* eal = (LAS float*)(l3 + O_EAL) + par * 256;
            if (w < 4) { const float dt = dt_pf; float a = dt * Ah_s0;
                a = wave_incl_scan(a);
                const float aend = wave_last(a);
                acs[w * 64 + lane] = a; dtv[w * 64 + lane] = dt; scl[w * 64 + lane] = dt * __expf(aend - a); eal[w * 64 + lane] = __expf(a);
                atot += aend;
                if (c + 1 < 16) dt_pf = DT[(t0 + 64 + lane) * 32 + hd0 + w]; }
            __syncthreads();
            if (act) {
                int cpo = cp; asm volatile("" : "+v"(cpo));
                float cw0[5], cw1[5];
                { const int cho = cpo < 128 ? (4 * gq) * 64 + 2 * cpo : (cpo < 192 ? 2048 + gq * 128 + 2 * (cpo - 128) : 3072 + gq * 128 + 2 * (cpo - 192));
                  const float* cwp = P.in[I_CONVW] + (size_t)i2 * 4 * SSM_CONV + cho;
#pragma unroll
                  for (int tp = 0; tp < 4; ++tp) { const f32x2 t2 = *(const f32x2*)(cwp + tp * SSM_CONV); cw0[tp] = t2.x; cw1[tp] = t2.y; }
                  const f32x2 t2 = *(const f32x2*)(P.in[I_CONVB] + (size_t)i2 * SSM_CONV + cho); cw0[4] = t2.x; cw1[4] = t2.y; }
                if (c > 0 && cpo < 128 && half == 0) {
#pragma unroll
                    for (int i = 0; i < 3; ++i) raw[i] = *(const LAS unsigned*)(l3 + O_HALO + (((c - 1) & 1) * 3 + i) * 512 + cpo * 4); }
                if (cpo < 128 && half == 1) {
#pragma unroll
                    for (int i = 0; i < 3; ++i) *(LAS unsigned*)(l3 + O_HALO + ((c & 1) * 3 + i) * 512 + cpo * 4) = raw[32 + i];
                    if (PASS == 1 && c == 15) {
#pragma unroll
                        for (int i = 0; i < 3; ++i) ((unsigned*)(ws + WS_XHALO))[((size_t)u * 3 + i) * 128 + cpo] = raw[32 + i]; }
                }
                const int hq = cpo >> 5;
#pragma unroll
                for (int j = 0; j < 8; ++j) {
                    const int l0 = 32 * half + 4 * j;
                    float v0[4], v1[4];
#pragma unroll
                    for (int o = 0; o < 4; ++o) { float a0 = cw0[4], a1 = cw1[4];
#pragma unroll
                        for (int tp = 0; tp < 4; ++tp) { a0 += cw0[tp] * bf2f(raw[4 * j + o + tp] & 0xffffu); a1 += cw1[tp] * bf2f(raw[4 * j + o + tp] >> 16); }
                        v0[o] = silu_f(a0); v1[o] = silu_f(a1); }
                    if (cpo < 128) {
                        const int p = 2 * (cpo & 31);
                        if (FULL) { u32x2 x0, x1; x0.x = pk2(v0[0], v0[1]); x0.y = pk2(v0[2], v0[3]); x1.x = pk2(v1[0], v1[1]); x1.y = pk2(v1[2], v1[3]);
                            *(LAS u32x2*)(l3 + O_XST + hq * 9216 + p * S64 + l0 * 2) = x0; *(LAS u32x2*)(l3 + O_XST + hq * 9216 + (p + 1) * S64 + l0 * 2) = x1; }
                        const f32x4 s4 = *(const LAS f32x4*)(scl + hq * 64 + l0);
                        u32x2 y0, y1; y0.x = pk2(v0[0] * s4.x, v0[1] * s4.y); y0.y = pk2(v0[2] * s4.z, v0[3] * s4.w); y1.x = pk2(v1[0] * s4.x, v1[1] * s4.y); y1.y = pk2(v1[2] * s4.z, v1[3] * s4.w);
                        *(LAS u32x2*)(l3 + O_XPT + hq * 9216 + p * S64 + l0 * 2) = y0; *(LAS u32x2*)(l3 + O_XPT + hq * 9216 + (p + 1) * S64 + l0 * 2) = y1;
                    } else if (cpo < 192) {
                        const int n = 2 * (cpo - 128);
                        if (FULL) {
#pragma unroll
                            for (int o = 0; o < 4; ++o) *(LAS unsigned*)(l3 + O_BC + (l0 + o) * S128 + n * 2) = pk2(v0[o], v1[o]); }
                        u32x2 x0, x1; x0.x = pk2(v0[0], v0[1]); x0.y = pk2(v0[2], v0[3]); x1.x = pk2(v1[0], v1[1]); x1.y = pk2(v1[2], v1[3]);
                        *(LAS u32x2*)(l3 + O_BCT + n * S64 + l0 * 2) = x0; *(LAS u32x2*)(l3 + O_BCT + (n + 1) * S64 + l0 * 2) = x1;
                    } else {
                        const int n = 2 * (cpo - 192);
#pragma unroll
                        for (int o = 0; o < 4; ++o) *(LAS unsigned*)(l3 + O_CC + (l0 + o) * S128 + n * 2) = pk2(v0[o], v1[o]);
                    }
                }
            }
            __syncthreads();
            if (PASS == 3) {
                const int r_ = tid >> 3, pc_ = tid & 7;
                const u32x4 c0_ = *(const LAS u32x4*)(l3 + O_CC + r_ * S128 + pc_ * 32), c1_ = *(const LAS u32x4*)(l3 + O_CC + r_ * S128 + pc_ * 32 + 16);
                u32x4* dst_ = (u32x4*)((bf16_t*)P.out + (size_t)T * D + (t0 + r_) * 1024 + gq * 128 + pc_ * 16);
                dst_[0] = c0_; dst_[1] = c1_; }
            __builtin_amdgcn_sched_barrier(0);
            if (c + 1 < 16 && act) {
                const char* rb = (const char*)XS + (t0 + 61) * 4096;
#pragma unroll
                for (int i = 0; i < 35; ++i) raw[i] = *(const unsigned*)(rb + (size_t)i * 4096 + voff);
            }
            if (FULL) {
                const int lt = w >> 1;
                bf16x8 cf[4];
#pragma unroll
                for (int ks = 0; ks < 4; ++ks) cf[ks] = *(const LAS bf16x8*)(l3 + O_CC + (16 * lt + j16) * S128 + (32 * ks + 8 * q4) * 2);
#pragma unroll
                for (int si = 0; si < 2; ++si) { const int st = 2 * (w & 1) + si;
                    if (st <= lt) { f32x4 acc = (f32x4){0.f, 0.f, 0.f, 0.f};
#pragma unroll
                        for (int ks = 0; ks < 4; ++ks) { const bf16x8 bfr = *(const LAS bf16x8*)(l3 + O_BC + (16 * st + j16) * S128 + (32 * ks + 8 * q4) * 2); acc = MFMA16(cf[ks], bfr, acc); }
#pragma unroll
                        for (int r = 0; r < 4; ++r) *(LAS float*)(l3 + O_CB + (16 * lt + 4 * q4 + r) * SCB + (16 * st + j16) * 4) = acc[r]; } }
                __syncthreads();
            }
#pragma unroll
            for (int rd = 0; rd < 2; ++rd) {
                const int hq = 2 * rd + (w >> 2), ps = w & 3;
                f32x4 (&S)[8] = rd ? S1 : S0;
                if (FULL) {
                    f32x4 yv[4];
#pragma unroll
                    for (int lt = 0; lt < 4; ++lt) yv[lt] = (f32x4){0.f, 0.f, 0.f, 0.f};
#pragma unroll
                    for (int t = 0; t < 4; ++t) { u32x4 a4; a4.x = pk2(S[2 * t][0], S[2 * t][1]); a4.y = pk2(S[2 * t][2], S[2 * t][3]); a4.z = pk2(S[2 * t + 1][0], S[2 * t + 1][1]); a4.w = pk2(S[2 * t + 1][2], S[2 * t + 1][3]);
                        const bf16x8 af = __builtin_bit_cast(bf16x8, a4);
#pragma unroll
                        for (int lt = 0; lt < 4; ++lt) { const LAS unsigned char* cpz = l3 + O_CC + (16 * lt + j16) * S128 + (32 * t + 4 * q4) * 2;
                            const u32x2 lo = *(const LAS u32x2*)cpz, hi = *(const LAS u32x2*)(cpz + 32);
                            u32x4 b4; b4.x = lo.x; b4.y = lo.y; b4.z = hi.x; b4.w = hi.y;
                            yv[lt] = MFMA16(af, __builtin_bit_cast(bf16x8, b4), yv[lt]); } }
#pragma unroll
                    for (int lt = 0; lt < 4; ++lt) yv[lt] = yv[lt] * eal[hq * 64 + 16 * lt + j16];
                    bf16x8 xf[2];
#pragma unroll
                    for (int ks = 0; ks < 2; ++ks) xf[ks] = *(const LAS bf16x8*)(l3 + O_XST + hq * 9216 + (16 * ps + j16) * S64 + (32 * ks + 8 * q4) * 2);
#pragma unroll
                    for (int lt = 0; lt < 4; ++lt) { const int l = 16 * lt + j16; const float al = acs[hq * 64 + l];
#pragma unroll
                        for (int ks = 0; ks < 2; ++ks) { if (32 * ks <= 16 * lt + 15) {
                                const int s0 = 32 * ks + 8 * q4;
                                const f32x4 c0 = *(const LAS f32x4*)(l3 + O_CB + l * SCB + s0 * 4), c1 = *(const LAS f32x4*)(l3 + O_CB + l * SCB + s0 * 4 + 16);
                                const f32x4 a0 = *(const LAS f32x4*)(acs + hq * 64 + s0), a1 = *(const LAS f32x4*)(acs + hq * 64 + s0 + 4);
                                const f32x4 d0 = *(const LAS f32x4*)(dtv + hq * 64 + s0), d1 = *(const LAS f32x4*)(dtv + hq * 64 + s0 + 4);
                                float m[8];
#pragma unroll
                                for (int e = 0; e < 4; ++e) { m[e] = (s0 + e <= l) ? c0[e] * __expf(al - a0[e]) * d0[e] : 0.f; m[4 + e] = (s0 + 4 + e <= l) ? c1[e] * __expf(al - a1[e]) * d1[e] : 0.f; }
                                u32x4 b4; b4.x = pk2(m[0], m[1]); b4.y = pk2(m[2], m[3]); b4.z = pk2(m[4], m[5]); b4.w = pk2(m[6], m[7]);
                                yv[lt] = MFMA16(xf[ks], __builtin_bit_cast(bf16x8, b4), yv[lt]); } }
                        __builtin_amdgcn_sched_barrier(0); }
#pragma unroll
                    for (int lt = 0; lt < 4; ++lt) { const int l = 16 * lt + j16;
                        float xv[4];
#pragma unroll
                        for (int r = 0; r < 4; ++r) xv[r] = bf2f(*(const LAS bf16_t*)(l3 + O_XST + hq * 9216 + (16 * ps + 4 * q4 + r) * S64 + l * 2));
                        u32x2 o; o.x = pk2(yv[lt][0] + Dk[rd] * xv[0], yv[lt][1] + Dk[rd] * xv[1]); o.y = pk2(yv[lt][2] + Dk[rd] * xv[2], yv[lt][3] + Dk[rd] * xv[3]);
                        const size_t yoff = (t0 + l) * 2048 + (size_t)(hd0 + hq) * 64 + 16 * ps + 4 * q4;
                        bf16_t* yp = dry ? (bf16_t*)(ws + WS_LIST + 12 * MiB) + (yoff & (size_t)(512 * 1024 - 1)) : XS + yoff;
                        *(u32x2*)yp = o; }
                }
                { const float dec = eal[hq * 64 + 63];
                  bf16x8 xp[2];
#pragma unroll
                  for (int ks = 0; ks < 2; ++ks) xp[ks] = *(const LAS bf16x8*)(l3 + O_XPT + hq * 9216 + (16 * ps + j16) * S64 + (32 * ks + 8 * q4) * 2);
#pragma unroll
                  for (int nt = 0; nt < 8; ++nt) { f32x4 acc = S[nt] * dec;
#pragma unroll
                      for (int ks = 0; ks < 2; ++ks) { const bf16x8 bt = *(const LAS bf16x8*)(l3 + O_BCT + (16 * nt + j16) * S64 + (32 * ks + 8 * q4) * 2); acc = MFMA16(bt, xp[ks], acc); }
                      S[nt] = acc; } }
            }
            __syncthreads();
        }
        if (PASS == 1 || PASS == 3) {
            if (w < 4 && lane == 0) ((float*)(ws + WS_ATOT))[u * 4 + w] = atot;
            const int us = (u >> 2) * 3 + (sc < 3 ? sc : 0);
            u32x4* sp0 = (u32x4*)(ws + WS_SLOC) + (((size_t)us * 2 + 0) * 8 + w) * 256 + lane * 4;
            u32x4* sp1 = (u32x4*)(ws + WS_SLOC) + (((size_t)us * 2 + 1) * 8 + w) * 256 + lane * 4;
            if (sc < 3)
#pragma unroll
            for (int i = 0; i < 4; ++i) { u32x4 a, c;
#pragma unroll
                for (int e = 0; e < 4; ++e) { const int nt = 2 * i + (e >> 1), r = 2 * (e & 1); a[e] = pk2(S0[nt][r], S0[nt][r + 1]); c[e] = pk2(S1[nt][r], S1[nt][r + 1]); }
                sp0[i] = a; sp1[i] = c; }
        }
    }
}

__device__ __forceinline__ void scan_fix(const Params& P, const Geo& g, LAS unsigned char* l3, int L) {
    constexpr int S128 = 272, O_CC = 0, CCB = 17408, O_ECL = 2 * CCB;
    const int i2 = L >> 1, w = g.wave; int tid = g.tid; asm volatile("" : "+v"(tid));
    unsigned char* ws = P.ws;
    bf16_t* XS = (bf16_t*)(ws + WS_XS); const float* DT = (const float*)(ws + WS_DT);
    const bf16_t* CCV = (const bf16_t*)P.out + (size_t)T * D;
    const int NITEM = NB * 8 * 3 * 16, per = (NITEM + g.G - 1) / g.G;
    const int gc0 = g.vcu * per, gc1 = min(NITEM, gc0 + per);
    int cur_uu = -1, gq = 0, hd0 = 0; size_t tb = 0; float Ah_s0 = 0.f, atot = 0.f;
    bf16x8 af[2][4];
    u32x4 cr0, cr1; float dt_pf = 0.f;
#define FIX_GEO(GC, TB_, GQ_) const int uu_ = (GC) >> 4, bg_ = uu_ / 3, sc_ = 1 + uu_ % 3; const int GQ_ = bg_ & 7; const size_t TB_ = (size_t)(bg_ >> 3) * SEQ + (size_t)sc_ * 1024 + (size_t)((GC) & 15) * 64;
    if (gc0 < gc1) { FIX_GEO(gc0, t0n, gqn)
        const u32x4* src = (const u32x4*)(CCV + (t0n + (tid >> 3)) * 1024 + gqn * 128 + (tid & 7) * 16); cr0 = src[0]; cr1 = src[1];
        if (w < 4) dt_pf = DT[(t0n + (tid & 63)) * 32 + 4 * gqn + w]; }
    for (int gc = gc0; gc < gc1; ++gc) {
        int lane = tid & 63; asm volatile("" : "+v"(lane));
        const int j16 = lane & 15, q4 = lane >> 4, par = gc & 1;
        const int uu = gc >> 4, c = gc & 15;
        if (uu != cur_uu) {
            cur_uu = uu;
            const int bg = uu / 3, sc = 1 + uu % 3, u = bg * 4 + sc; gq = bg & 7; hd0 = 4 * gq; tb = (size_t)(bg >> 3) * SEQ + (size_t)sc * 1024;
            Ah_s0 = -__expf(P.in[I_ALOG][i2 * SSM_H + hd0 + (w & 3)]);
            f32x4 S0[8], S1[8];
#pragma unroll
            for (int i = 0; i < 8; ++i) { S0[i] = (f32x4){0.f, 0.f, 0.f, 0.f}; S1[i] = (f32x4){0.f, 0.f, 0.f, 0.f}; }
            const float* AT = (const float*)(ws + WS_ATOT);
#pragma unroll 1
            for (int j = 0; j < sc; ++j) {
                const int uj = (u >> 2) * 3 + j;
                float f0 = 0.f, f1 = 0.f;
                for (int i = j + 1; i < sc; ++i) { f0 += AT[((u & ~3) | i) * 4 + (w >> 2)]; f1 += AT[((u & ~3) | i) * 4 + 2 + (w >> 2)]; }
                f0 = __expf(f0); f1 = __expf(f1);
                const u32x4* sp0 = (const u32x4*)(ws + WS_SLOC) + (((size_t)uj * 2 + 0) * 8 + w) * 256 + lane * 4;
                const u32x4* sp1 = (const u32x4*)(ws + WS_SLOC) + (((size_t)uj * 2 + 1) * 8 + w) * 256 + lane * 4;
#pragma unroll
                for (int i = 0; i < 4; ++i) { const u32x4 a = sp0[i], cc = sp1[i];
#pragma unroll
                    for (int e = 0; e < 4; ++e) { const int nt = 2 * i + (e >> 1), r = 2 * (e & 1);
                        S0[nt][r] += f0 * bf2f(a[e] & 0xffffu); S0[nt][r + 1] += f0 * bf2f(a[e] >> 16);
                        S1[nt][r] += f1 * bf2f(cc[e] & 0xffffu); S1[nt][r + 1] += f1 * bf2f(cc[e] >> 16); } }
            }
#pragma unroll
            for (int t = 0; t < 4; ++t) { u32x4 a4;
                a4.x = pk2(S0[2 * t][0], S0[2 * t][1]); a4.y = pk2(S0[2 * t][2], S0[2 * t][3]); a4.z = pk2(S0[2 * t + 1][0], S0[2 * t + 1][1]); a4.w = pk2(S0[2 * t + 1][2], S0[2 * t + 1][3]);
                af[0][t] = __builtin_bit_cast(bf16x8, a4);
                a4.x = pk2(S1[2 * t][0], S1[2 * t][1]); a4.y = pk2(S1[2 * t][2], S1[2 * t][3]); a4.z = pk2(S1[2 * t + 1][0], S1[2 * t + 1][1]); a4.w = pk2(S1[2 * t + 1][2], S1[2 * t + 1][3]);
                af[1][t] = __builtin_bit_cast(bf16x8, a4); }
            atot = 0.f;
            if (w < 4) { float sdt = 0.f;
                for (int j = 0; j < c; ++j) sdt += DT[(tb + (size_t)j * 64 + lane) * 32 + hd0 + w];
                atot = wave_sum(sdt) * Ah_s0; }
        }
        const size_t t0 = tb + (size_t)c * 64;
        LAS float* ecl = (LAS float*)(l3 + O_ECL) + par * 256;
        *(LAS u32x4*)(l3 + O_CC + par * CCB + (tid >> 3) * S128 + (tid & 7) * 32) = cr0; *(LAS u32x4*)(l3 + O_CC + par * CCB + (tid >> 3) * S128 + (tid & 7) * 32 + 16) = cr1;
        if (w < 4) { float a = dt_pf * Ah_s0;
            a = wave_incl_scan(a);
            ecl[w * 64 + lane] = __expf(atot + a);
            atot += wave_last(a); }
        __syncthreads();
        if (gc + 1 < gc1) { FIX_GEO(gc + 1, t0n, gqn)
            const u32x4* src = (const u32x4*)(CCV + (t0n + (tid >> 3)) * 1024 + gqn * 128 + (tid & 7) * 16); cr0 = src[0]; cr1 = src[1];
            if (w < 4) dt_pf = DT[(t0n + lane) * 32 + 4 * gqn + w]; }
        u32x2 yin[2][4];
#pragma unroll
        for (int rd = 0; rd < 2; ++rd)
#pragma unroll
            for (int lt = 0; lt < 4; ++lt) yin[rd][lt] = *(const u32x2*)(XS + (t0 + 16 * lt + j16) * 2048 + (size_t)(hd0 + 2 * rd + (w >> 2)) * 64 + 16 * (w & 3) + 4 * q4);
#pragma unroll
        for (int rd = 0; rd < 2; ++rd) {
            const int hq = 2 * rd + (w >> 2), ps = w & 3;
            f32x4 yv[4];
#pragma unroll
            for (int lt = 0; lt < 4; ++lt) yv[lt] = (f32x4){0.f, 0.f, 0.f, 0.f};
#pragma unroll
            for (int t = 0; t < 4; ++t)
#pragma unroll
                for (int lt = 0; lt < 4; ++lt) { const LAS unsigned char* cpz = l3 + O_CC + par * CCB + (16 * lt + j16) * S128 + (32 * t + 4 * q4) * 2;
                    const u32x2 lo = *(const LAS u32x2*)cpz, hi = *(const LAS u32x2*)(cpz + 32);
                    u32x4 b4; b4.x = lo.x; b4.y = lo.y; b4.z = hi.x; b4.w = hi.y;
                    yv[lt] = MFMA16(af[rd][t], __builtin_bit_cast(bf16x8, b4), yv[lt]); }
#pragma unroll
            for (int lt = 0; lt < 4; ++lt) { const int l = 16 * lt + j16; const float sc_l = ecl[hq * 64 + l];
                u32x2* yp = (u32x2*)(XS + (t0 + l) * 2048 + (size_t)(hd0 + hq) * 64 + 16 * ps + 4 * q4);
                const u32x2 y2 = yin[rd][lt];
                u32x2 o; o.x = pk2(bf2f(y2.x & 0xffffu) + sc_l * yv[lt][0], bf2f(y2.x >> 16) + sc_l * yv[lt][1]); o.y = pk2(bf2f(y2.y & 0xffffu) + sc_l * yv[lt][2], bf2f(y2.y >> 16) + sc_l * yv[lt][3]);
                *yp = o; }
        }
    }
#undef FIX_GEO
}

__device__ __forceinline__ void phase_scan(const Params& P, const Geo& g, LAS unsigned char* l3, int L, bool dry = false) {
    constexpr int S128 = 272, S64 = 144;
    constexpr int O_CC = 0, O_BC = 17408, O_BCT = 34816, O_XST = 53248, O_XPT = 62464, O_MM = 71680, O_SBF = 80896;
    constexpr int O_ACS = 98304, O_DTV = 98560, O_CW = 98816, O_HALO = 105216;
    LAS float* acs = (LAS float*)(l3 + O_ACS); LAS float* dtv = (LAS float*)(l3 + O_DTV);
    LAS f32x2* cwl = (LAS f32x2*)(l3 + O_CW);
    const int i2 = L >> 1, lane = g.lane, w = g.wave, tid = g.tid, j16 = lane & 15, q4 = lane >> 4;
    unsigned char* ws = P.ws;
    bf16_t* XS = (bf16_t*)(ws + WS_XS); const bf16_t* BC = (const bf16_t*)(ws + WS_BC); const float* DT = (const float*)(ws + WS_DT);
    for (int u = g.vcu; u < NB * SSM_H; u += g.G) {
        const int b = u / SSM_H, hd = u % SSM_H, gq = hd >> 2;
        const float Ah = -__expf(P.in[I_ALOG][i2 * SSM_H + hd]), Dk = P.in[I_SSMD][i2 * SSM_H + hd];
        const size_t tb = (size_t)b * SEQ;
        if (tid < 160) { const int cp = tid; const int ch = cp < 32 ? hd * 64 + 2 * cp : (cp < 96 ? 2048 + gq * 128 + 2 * (cp - 32) : 3072 + gq * 128 + 2 * (cp - 96));
            const float* cw = P.in[I_CONVW] + (size_t)i2 * 4 * SSM_CONV + ch;
#pragma unroll
            for (int tp = 0; tp < 4; ++tp) cwl[tp * 160 + cp] = (f32x2){cw[tp * SSM_CONV], cw[tp * SSM_CONV + 1]};
            const float* cb = P.in[I_CONVB] + (size_t)i2 * SSM_CONV + ch; cwl[4 * 160 + cp] = (f32x2){cb[0], cb[1]}; }
        for (int e = tid; e < 17408 / 4; e += 512) ((LAS unsigned*)(l3 + O_SBF))[e] = 0u;
        f32x4 S[4];
#pragma unroll
        for (int i = 0; i < 4; ++i) S[i] = (f32x4){0.f, 0.f, 0.f, 0.f};
        unsigned raw[5][7], voff[5]; float dt_pf = 0.f;
        if (w == 0) dt_pf = DT[(tb + lane) * 32 + hd];
#pragma unroll
        for (int k = 0; k < 5; ++k) {
            const int it = tid + 512 * k, cp = it % 160, strip = it / 160, l0 = 4 * strip;
            const unsigned colb = cp < 32 ? (unsigned)(hd * 64 + 2 * cp) * 2u : (unsigned)(WS_BC - WS_XS) + (unsigned)(cp < 96 ? gq * 128 + 2 * (cp - 32) : 1024 + gq * 128 + 2 * (cp - 96)) * 2u;
            voff[k] = (unsigned)l0 * 4096u + colb;
#pragma unroll
            for (int i = 0; i < 7; ++i) { const int rl = l0 - 3 + i; raw[k][i] = (rl >= 0) ? *(const unsigned*)((const char*)XS + (tb + rl) * 4096 + colb) : 0u; }
        }
        __syncthreads();
#pragma unroll 1
        for (int c = 0; c < NCH; ++c) {
            const size_t t0 = tb + (size_t)c * 64;
            if (w == 0) { const float dt = dt_pf; float a = dt * Ah;
#pragma unroll
                for (int o = 1; o < 64; o <<= 1) { const float nbv = __shfl_up(a, o); a += (lane >= o) ? nbv : 0.f; }
                acs[lane] = a; dtv[lane] = dt; }
            __syncthreads();
            const float aend = acs[63];
            int tA = tid; asm volatile("" : "+v"(tA));
#pragma unroll
            for (int k = 0; k < 5; ++k) {
                const int it = tA + 512 * k, cp = it % 160, strip = it / 160, l0 = 4 * strip;
                if (c > 0 && cp < 32 && strip == 0) {
#pragma unroll
                    for (int i = 0; i < 3; ++i) raw[k][i] = *(const LAS unsigned*)(l3 + O_HALO + (((c - 1) & 1) * 3 + i) * 128 + cp * 4); }
                if (cp < 32 && strip == 15) {
#pragma unroll
                    for (int i = 0; i < 3; ++i) *(LAS unsigned*)(l3 + O_HALO + ((c & 1) * 3 + i) * 128 + cp * 4) = raw[k][4 + i]; }
                float wx[5], wy[5];
#pragma unroll
                for (int tp = 0; tp < 5; ++tp) { const f32x2 ww = cwl[tp * 160 + cp]; wx[tp] = ww.x; wy[tp] = ww.y; }
                float v0[4], v1[4];
#pragma unroll
                for (int o = 0; o < 4; ++o) { float a0 = wx[4], a1 = wy[4];
#pragma unroll
                    for (int tp = 0; tp < 4; ++tp) { a0 += wx[tp] * bf2f(raw[k][o + tp] & 0xffffu); a1 += wy[tp] * bf2f(raw[k][o + tp] >> 16); }
                    v0[o] = silu_f(a0); v1[o] = silu_f(a1); }
                if (cp < 32) {
                    const int p = 2 * cp;
                    u32x2 x0, x1; x0.x = pk2(v0[0], v0[1]); x0.y = pk2(v0[2], v0[3]); x1.x = pk2(v1[0], v1[1]); x1.y = pk2(v1[2], v1[3]);
                    *(LAS u32x2*)(l3 + O_XST + p * S64 + l0 * 2) = x0; *(LAS u32x2*)(l3 + O_XST + (p + 1) * S64 + l0 * 2) = x1;
                    float sc[4];
#pragma unroll
                    for (int o = 0; o < 4; ++o) sc[o] = dtv[l0 + o] * __expf(aend - acs[l0 + o]);
                    x0.x = pk2(v0[0] * sc[0], v0[1] * sc[1]); x0.y = pk2(v0[2] * sc[2], v0[3] * sc[3]); x1.x = pk2(v1[0] * sc[0], v1[1] * sc[1]); x1.y = pk2(v1[2] * sc[2], v1[3] * sc[3]);
                    *(LAS u32x2*)(l3 + O_XPT + p * S64 + l0 * 2) = x0; *(LAS u32x2*)(l3 + O_XPT + (p + 1) * S64 + l0 * 2) = x1;
                } else if (cp < 96) {
                    const int n = 2 * (cp - 32);
#pragma unroll
                    for (int o = 0; o < 4; ++o) *(LAS unsigned*)(l3 + O_BC + (l0 + o) * S128 + n * 2) = pk2(v0[o], v1[o]);
                    u32x2 x0, x1; x0.x = pk2(v0[0], v0[1]); x0.y = pk2(v0[2], v0[3]); x1.x = pk2(v1[0], v1[1]); x1.y = pk2(v1[2], v1[3]);
                    *(LAS u32x2*)(l3 + O_BCT + n * S64 + l0 * 2) = x0; *(LAS u32x2*)(l3 + O_BCT + (n + 1) * S64 + l0 * 2) = x1;
                } else {
                    const int n = 2 * (cp - 96);
#pragma unroll
                    for (int o = 0; o < 4; ++o) *(LAS unsigned*)(l3 + O_CC + (l0 + o) * S128 + n * 2) = pk2(v0[o], v1[o]);
                }
            }
            __syncthreads();
            if (c + 1 < NCH) {
                if (w == 0) dt_pf = DT[(t0 + 64 + lane) * 32 + hd];
                const char* rb = (const char*)XS + (t0 + 61) * 4096;
#pragma unroll
                for (int i = 0; i < 7; ++i)
#pragma unroll
                    for (int k = 0; k < 5; ++k) raw[k][i] = *(const unsigned*)(rb + (size_t)i * 4096 + voff[k]);
            }
            const int lt = w >> 1, h2 = w & 1;
            f32x4 yo[2];
            {
                bf16x8 cf[4];
#pragma unroll
                for (int ks = 0; ks < 4; ++ks) cf[ks] = *(const LAS bf16x8*)(l3 + O_CC + (16 * lt + j16) * S128 + (32 * ks + 8 * q4) * 2);
#pragma unroll
                for (int si = 0; si < 2; ++si) { const int st = 2 * h2 + si;
                    f32x4 acc = (f32x4){0.f, 0.f, 0.f, 0.f};
                    if (st <= lt) {
#pragma unroll
                        for (int ks = 0; ks < 4; ++ks) { const bf16x8 bfr = *(const LAS bf16x8*)(l3 + O_BC + (16 * st + j16) * S128 + (32 * ks + 8 * q4) * 2); acc = MFMA16(cf[ks], bfr, acc); } }
                    const int sidx = 16 * st + j16; const float as = acs[sidx], ds = dtv[sidx];
#pragma unroll
                    for (int r = 0; r < 4; ++r) { const int l = 16 * lt + 4 * q4 + r;
                        const float m = (sidx <= l) ? acc[r] * __expf(acs[l] - as) * ds : 0.f;
                        *(LAS bf16_t*)(l3 + O_MM + l * S64 + sidx * 2) = (bf16_t)f2bf(m); } }
#pragma unroll
                for (int pi = 0; pi < 2; ++pi) { const int pt = 2 * h2 + pi; f32x4 acc = (f32x4){0.f, 0.f, 0.f, 0.f};
#pragma unroll
                    for (int ks = 0; ks < 4; ++ks) { const bf16x8 sf = *(const LAS bf16x8*)(l3 + O_SBF + (16 * pt + j16) * S128 + (32 * ks + 8 * q4) * 2); acc = MFMA16(cf[ks], sf, acc); }
                    yo[pi] = acc; }
            }
            {
                const float dec = __expf(aend);
                bf16x8 xf[2];
#pragma unroll
                for (int ks = 0; ks < 2; ++ks) xf[ks] = *(const LAS bf16x8*)(l3 + O_XPT + (16 * lt + j16) * S64 + (32 * ks + 8 * q4) * 2);
#pragma unroll
                for (int ni = 0; ni < 4; ++ni) { const int nt = 4 * h2 + ni; f32x4 acc = S[ni] * dec;
#pragma unroll
                    for (int ks = 0; ks < 2; ++ks) { const bf16x8 bt = *(const LAS bf16x8*)(l3 + O_BCT + (16 * nt + j16) * S64 + (32 * ks + 8 * q4) * 2); acc = MFMA16(xf[ks], bt, acc); }
                    S[ni] = acc; }
            }
            __syncthreads();
            {
                bf16x8 mf[2];
#pragma unroll
                for (int ks = 0; ks < 2; ++ks) mf[ks] = *(const LAS bf16x8*)(l3 + O_MM + (16 * lt + j16) * S64 + (32 * ks + 8 * q4) * 2);
#pragma unroll
                for (int pi = 0; pi < 2; ++pi) { const int pt = 2 * h2 + pi, p = 16 * pt + j16; f32x4 acc = (f32x4){0.f, 0.f, 0.f, 0.f};
#pragma unroll
                    for (int ks = 0; ks < 2; ++ks) { const bf16x8 xt = *(const LAS bf16x8*)(l3 + O_XST + (16 * pt + j16) * S64 + (32 * ks + 8 * q4) * 2); acc = MFMA16(mf[ks], xt, acc); }
                    const u32x2 xv = *(const LAS u32x2*)(l3 + O_XST + p * S64 + (16 * lt + 4 * q4) * 2);
                    const float xs0 = bf2f(xv.x & 0xffffu), xs1 = bf2f(xv.x >> 16), xs2 = bf2f(xv.y & 0xffffu), xs3 = bf2f(xv.y >> 16);
                    const int lb = 16 * lt + 4 * q4;
                    const size_t yoff = (t0 + lb) * 2048 + hd * 64 + p;
                    bf16_t* yp = dry ? (bf16_t*)(ws + WS_LIST) + (yoff & (size_t)(4 * 1024 * 1024 - 1)) : XS + yoff;
                    yp[0] = (bf16_t)f2bf(acc[0] + __expf(acs[lb]) * yo[pi][0] + Dk * xs0);
                    yp[2048] = (bf16_t)f2bf(acc[1] + __expf(acs[lb + 1]) * yo[pi][1] + Dk * xs1);
                    yp[4096] = (bf16_t)f2bf(acc[2] + __expf(acs[lb + 2]) * yo[pi][2] + Dk * xs2);
                    yp[6144] = (bf16_t)f2bf(acc[3] + __expf(acs[lb + 3]) * yo[pi][3] + Dk * xs3); }
#pragma unroll
                for (int ni = 0; ni < 4; ++ni) { const int n = 16 * (4 * h2 + ni) + j16;
#pragma unroll
                    for (int r = 0; r < 4; ++r) *(LAS bf16_t*)(l3 + O_SBF + (16 * lt + 4 * q4 + r) * S128 + n * 2) = (bf16_t)f2bf(S[ni][r]); }
            }
            __syncthreads();
        }
    }
}


typedef float f32x16 __attribute__((ext_vector_type(16)));
#define MFMA32(a, b, c) __builtin_amdgcn_mfma_f32_32x32x16_bf16(a, b, c, 0, 0, 0)
__device__ __forceinline__ void phase_e2(const Params& P, const Geo& g, LAS unsigned char* l3, int L) {
    const int i2 = L >> 1, lane = g.lane, w = g.wave, tid = g.tid, j16 = lane & 15, q4 = lane >> 4;
    unsigned char* ws = P.ws;
    const bf16_t* U = (const bf16_t*)(ws + WS_U); bf16_t* CAT = (bf16_t*)(ws + WS_CAT);
    {
        constexpr int O_UT = 0, O_PL = 20480, PS = 272;
        u32x4 pre[3];
#define POOL_FETCH(UU) do { const int gi_ = (UU) & 3, t0_ = ((UU) >> 2) * 64, s0_ = t0_ % SEQ; \
            _Pragma("unroll") for (int i = 0; i < 3; ++i) { const int e = tid + 512 * i, r = e >> 4, c16 = e & 15; pre[i] = (u32x4){0u, 0u, 0u, 0u}; \
                if (e < 79 * 16 && s0_ - 15 + r >= 0) pre[i] = *(const u32x4*)(U + (size_t)(t0_ - 15 + r) * 512 + gi_ * 128 + c16 * 8); } } while (0)
        if (g.vcu < (T / 64) * 4) POOL_FETCH(g.vcu);
        for (int u = g.vcu; u < (T / 64) * 4; u += g.G) {
            const int gi = u & 3, t0 = (u >> 2) * 64, s0 = t0 % SEQ, win = 2 << gi;
#pragma unroll
            for (int i = 0; i < 3; ++i) { const int e = tid + 512 * i, r = e >> 4, c16 = e & 15; if (e < 79 * 16) *(LAS u32x4*)(l3 + O_UT + r * 256 + c16 * 16) = pre[i]; }
            const bf16_t* Wb = (const bf16_t*)(ws + WS_WPL) + ((size_t)(i2 * 4 + gi) * 128 + 16 * w + j16) * 128 + 8 * q4;
            bf16x8 bwp[4];
#pragma unroll
            for (int ks = 0; ks < 4; ++ks) bwp[ks] = *(const bf16x8*)(Wb + 32 * ks);
            const f32x4 ps = *(const f32x4*)(P.in[I_POOLS] + i2 * 512 + gi * 128 + 16 * w + 4 * q4);
            __syncthreads();
            if (u + g.G < (T / 64) * 4) POOL_FETCH(u + g.G);
            { const int l = tid >> 3, cb = (tid & 7) * 16, s = s0 + l; const int cnt = (s + 1 < win) ? s + 1 : win;
                float acc[16];
#pragma unroll
                for (int i = 0; i < 16; ++i) acc[i] = 0.f;
                for (int j = 0; j < cnt; ++j) {
                    const u32x4 a = *(const LAS u32x4*)(l3 + O_UT + (l + 15 - j) * 256 + cb * 2), b = *(const LAS u32x4*)(l3 + O_UT + (l + 15 - j) * 256 + cb * 2 + 16);
#pragma unroll
                    for (int i = 0; i < 4; ++i) { acc[2 * i] += bf2f(a[i] & 0xffffu); acc[2 * i + 1] += bf2f(a[i] >> 16); acc[8 + 2 * i] += bf2f(b[i] & 0xffffu); acc[8 + 2 * i + 1] += bf2f(b[i] >> 16); }
                }
                const u32x4 a = *(const LAS u32x4*)(l3 + O_UT + (l + 15) * 256 + cb * 2), b = *(const LAS u32x4*)(l3 + O_UT + (l + 15) * 256 + cb * 2 + 16);
                const float inv = 1.f / (float)cnt;
                u32x4 o0, o1;
#pragma unroll
                for (int i = 0; i < 4; ++i) {
                    o0[i] = pk2(acc[2 * i] * inv - bf2f(a[i] & 0xffffu), acc[2 * i + 1] * inv - bf2f(a[i] >> 16));
                    o1[i] = pk2(acc[8 + 2 * i] * inv - bf2f(b[i] & 0xffffu), acc[8 + 2 * i + 1] * inv - bf2f(b[i] >> 16)); }
                *(LAS u32x4*)(l3 + O_PL + l * PS + cb * 2) = o0; *(LAS u32x4*)(l3 + O_PL + l * PS + cb * 2 + 16) = o1; }
            __syncthreads();
            {
                f32x4 acc[4];
#pragma unroll
                for (int lt = 0; lt < 4; ++lt) acc[lt] = (f32x4){0.f, 0.f, 0.f, 0.f};
#pragma unroll
                for (int ks = 0; ks < 4; ++ks) { const bf16x8 bw = bwp[ks];
#pragma unroll
                    for (int lt = 0; lt < 4; ++lt) { const bf16x8 a = *(const LAS bf16x8*)(l3 + O_PL + (16 * lt + j16) * PS + (32 * ks + 8 * q4) * 2); acc[lt] = MFMA16(bw, a, acc[lt]); } }
#pragma unroll
                for (int lt = 0; lt < 4; ++lt) { const f32x4 v = acc[lt] * ps; u32x2 o; o.x = pk2(v[0], v[1]); o.y = pk2(v[2], v[3]);
                    *(u32x2*)(CAT + (size_t)(t0 + 16 * lt + j16) * D + gi * 128 + 16 * w + 4 * q4) = o; }
            }
        }
#undef POOL_FETCH
        __syncthreads();
    }
    {
        constexpr int O_TB = 0, O_RING = 20480;
        for (int e = tid; e < 8 * 640; e += 512) { const int h = e / 640, i = e % 640; int rel = 575 - i; rel = rel > 256 ? 256 : rel; rel = rel < -256 ? -256 : rel;
            ((LAS float*)(l3 + O_TB))[e] = P.in[I_RELB][((size_t)i2 * NHEAD + h) * 513 + rel + 256] * LOG2E; }
        __syncthreads();
        const bf16_t* Qb = (const bf16_t*)(ws + WS_Q); const unsigned char* Kb = ws + WS_K; const unsigned char* VT = ws + WS_VT;
        const int l31 = lane & 31, hh = lane >> 5;
        for (int u8 = g.vcu; u8 < NB * NHEAD * 8; u8 += g.G) {
            const int cg = u8 & 7, h = (u8 >> 3) & 7, b = u8 >> 6;
            const int c0 = 8 * cg, c = c0 + w;
            const size_t tq0 = (size_t)b * SEQ + (size_t)c * 64;
            const size_t bhb = (((size_t)b * NHEAD + h) * 128) * 4096 + (size_t)tid * 16;
            if (cg > 0) {
#pragma unroll 2
                for (int j = 0; j < 8; ++j) { const size_t o = bhb + (size_t)(c0 - 8 + j) * 8192;
                    const u32x4 kv = *(const u32x4*)(Kb + o), vv = *(const u32x4*)(VT + o);
                    *(LAS u32x4*)(l3 + O_RING + j * 16384 + tid * 16) = kv; *(LAS u32x4*)(l3 + O_RING + j * 16384 + 8192 + tid * 16) = vv; }
            }
            bf16x8 qf[2][4];
#pragma unroll
            for (int qt = 0; qt < 2; ++qt)
#pragma unroll
                for (int ks = 0; ks < 4; ++ks) qf[qt][ks] = *(const bf16x8*)(Qb + (tq0 + 32 * qt + l31) * 512 + h * 64 + 16 * ks + 8 * hh);
            f32x16 ot[2][2];
#pragma unroll
            for (int dt = 0; dt < 2; ++dt)
#pragma unroll
                for (int qt = 0; qt < 2; ++qt)
#pragma unroll
                    for (int r = 0; r < 16; ++r) ot[dt][qt][r] = 0.f;
            float mrow[2] = {-1.0e30f, -1.0e30f}, lrow[2] = {0.f, 0.f};
            __syncthreads();
#define ATT_STEP(CJ, KT) do { \
                const LAS unsigned char* sb_ = l3 + O_RING + ((CJ) & 7) * 16384 + (KT) * 4096 + lane * 16; \
                bf16x8 kf[4], vf[2][2]; \
                _Pragma("unroll") for (int ks = 0; ks < 4; ++ks) kf[ks] = *(const LAS bf16x8*)(sb_ + ks * 1024); \
                _Pragma("unroll") for (int dt = 0; dt < 2; ++dt) _Pragma("unroll") for (int sp = 0; sp < 2; ++sp) vf[dt][sp] = *(const LAS bf16x8*)(sb_ + 8192 + (dt * 2 + sp) * 1024); \
                bf16x8 pf[2][2]; \
                _Pragma("unroll") for (int qt = 0; qt < 2; ++qt) { \
                    const LAS float* tb = (const LAS float*)(l3 + O_TB) + h * 640 + (575 - 64 * (c - (CJ)) - 32 * qt - l31 + 32 * (KT) + 4 * hh); \
                    f32x16 sa; \
                    _Pragma("unroll") for (int r = 0; r < 16; ++r) sa[r] = tb[(r & 3) + 8 * (r >> 2)]; \
                    _Pragma("unroll") for (int ks = 0; ks < 4; ++ks) sa = MFMA32(kf[ks], qf[qt][ks], sa); \
                    float mloc = sa[0]; \
                    _Pragma("unroll") for (int r = 1; r < 16; ++r) mloc = fmaxf(mloc, sa[r]); \
                    mloc = xhalf_max(mloc); \
                    const float mnew = fmaxf(mrow[qt], mloc), alpha = __builtin_amdgcn_exp2f(mrow[qt] - mnew); \
                    float ls = 0.f; \
                    _Pragma("unroll") for (int r = 0; r < 16; ++r) { sa[r] = __builtin_amdgcn_exp2f(sa[r] - mnew); ls += sa[r]; } \
                    ls = xhalf_sum(ls); \
                    lrow[qt] = lrow[qt] * alpha + ls; \
                    if (!__all(mnew == mrow[qt])) { \
                        _Pragma("unroll") for (int dt = 0; dt < 2; ++dt) _Pragma("unroll") for (int r = 0; r < 16; ++r) ot[dt][qt][r] *= alpha; } \
                    mrow[qt] = mnew; \
                    _Pragma("unroll") for (int sp = 0; sp < 2; ++sp) { u32x4 t4; \
                        t4.x = pk2(sa[8 * sp + 0], sa[8 * sp + 1]); t4.y = pk2(sa[8 * sp + 2], sa[8 * sp + 3]); t4.z = pk2(sa[8 * sp + 4], sa[8 * sp + 5]); t4.w = pk2(sa[8 * sp + 6], sa[8 * sp + 7]); \
                        pf[qt][sp] = __builtin_bit_cast(bf16x8, t4); } } \
                _Pragma("unroll") for (int dt = 0; dt < 2; ++dt) _Pragma("unroll") for (int qt = 0; qt < 2; ++qt) _Pragma("unroll") for (int sp = 0; sp < 2; ++sp) ot[dt][qt] = MFMA32(vf[dt][sp], pf[qt][sp], ot[dt][qt]); } while (0)
#pragma unroll 1
            for (int r = 0; r < 9; ++r) {
                u32x4 nk = (u32x4){0u, 0u, 0u, 0u}, nv = (u32x4){0u, 0u, 0u, 0u};
                if (r < 8) { const size_t o = bhb + (size_t)(c0 + r) * 8192; nk = *(const u32x4*)(Kb + o); nv = *(const u32x4*)(VT + o); }
                const int cj = c - 8 + r;
                if (cj >= 0) { ATT_STEP(cj, 0); ATT_STEP(cj, 1); }
                __syncthreads();
                if (r < 8) { *(LAS u32x4*)(l3 + O_RING + r * 16384 + tid * 16) = nk; *(LAS u32x4*)(l3 + O_RING + r * 16384 + 8192 + tid * 16) = nv; __syncthreads(); }
            }
#undef ATT_STEP
#pragma unroll
            for (int qt = 0; qt < 2; ++qt) { const float inv = 1.f / lrow[qt];
                bf16_t* op = CAT + (tq0 + 32 * qt + l31) * D + 512 + h * 64;
#pragma unroll
                for (int dt = 0; dt < 2; ++dt)
#pragma unroll
                    for (int gp = 0; gp < 4; gp += 2) { u32x2 o0, o1;
                        o0.x = pk2(ot[dt][qt][4 * gp] * inv, ot[dt][qt][4 * gp + 1] * inv); o0.y = pk2(ot[dt][qt][4 * gp + 2] * inv, ot[dt][qt][4 * gp + 3] * inv);
                        o1.x = pk2(ot[dt][qt][4 * gp + 4] * inv, ot[dt][qt][4 * gp + 5] * inv); o1.y = pk2(ot[dt][qt][4 * gp + 6] * inv, ot[dt][qt][4 * gp + 7] * inv);
                        const auto sx = __builtin_amdgcn_permlane32_swap(o0.x, o1.x, false, false), sy = __builtin_amdgcn_permlane32_swap(o0.y, o1.y, false, false);
                        u32x4 w4; w4.x = sx[0]; w4.y = sy[0]; w4.z = sx[1]; w4.w = sy[1];
                        *(u32x4*)(op + 32 * dt + 8 * (gp + hh)) = w4; } }
        }
    }
}

constexpr int LDS_BYTES = 160 * 1024, MISC_OFF = 160 * 1024 - 512;
constexpr int NPHASE = 34;
#ifndef PG8_SP2
#define PG8_SP2 true
#endif
#ifndef PG8_ALIGN
#define PG8_ALIGN true
#endif
__global__ void __launch_bounds__(512, 2) mk_fwd(Params P) {
    extern __shared__ __attribute__((aligned(16))) unsigned char lds[];
    LAS unsigned char* l3 = (LAS unsigned char*)lds;
    Geo g; g.tid = threadIdx.x; g.lane = g.tid & 63; g.wave = __builtin_amdgcn_readfirstlane(g.tid >> 6); g.G = gridDim.x;
    { const int bx = blockIdx.x; g.vcu = (g.G % 8 == 0) ? (bx % 8) * (g.G / 8) + bx / 8 : bx; }
    volatile LAS unsigned* MISC = (volatile LAS unsigned*)(l3 + MISC_OFF);
    if (g.tid < 64) MISC[g.tid] = 0u;
    __syncthreads();
    unsigned char* ws = P.ws;
    unsigned* ctl = (unsigned*)(ws + WS_CTL);
    XcdBarrier bar = xcd_barrier_post(ctl + CW_BAR, MISC + 8);
    const int lo = P.ph_lo, hi = P.ph_hi;
#define IN(k) (lo <= (k) && (k) < hi)
#define SEAM(k) do { if ((k) + 1 < hi) xcd_barrier(bar); } while (0)
    const float* mod = (const float*)(ws + WS_MOD);
    bf16_t* Hb = (bf16_t*)P.out; bf16_t* XB = (bf16_t*)(ws + WS_XB);

    if (IN(0)) { for (int rep_ = 0; rep_ < ((PROBE_DUP == 0) ? 2 : 1); ++rep_) { phase_mod(P, g, (float*)lds); phase_convert(P, g, (float*)(lds + 32768))  ; if (rep_ + 1 < ((PROBE_DUP == 0) ? 2 : 1)) xcd_barrier(bar); } SEAM(0); }

#define NREP(ty) ((PROBE_DUP == (ty)) ? 2 : 1)
#define DRYFLAG(ty) bool dry = false; if (PROBE_DUP == (ty)) { int d_ = (rep_ + 1 < NREP(ty)); asm volatile("" : "+s"(d_)); dry = d_ != 0; }
#define DRYBAR() do { if (dry) xcd_barrier(bar); } while (0)
#define G_E1 { pg8::Gemm gm{Hb, (const bf16_t*)(ws + WS_WMI) + (size_t)i2 * MIX_IN * D, T, MIX_IN, D}; pg8::StaticOrder S; S.init(T, MIX_IN, g.G, (int)blockIdx.x); \
                pg8::EpiE1x E{(bf16_t*)(ws + WS_U), (bf16_t*)(ws + WS_VT)}; \
                pg8::gemm_phase<pg8::EpiE1x, pg8::StaticOrder, PG8_ALIGN, PG8_SP2>(l3, gm, S, E); }
#define G_E3(F32B, BASEP) { pg8::Gemm gm{(const bf16_t*)(ws + WS_CAT), (const bf16_t*)(ws + WS_WMO) + (size_t)i2 * D * D, T, D, D}; pg8::StaticOrder S; S.init(T, D, g.G, (int)blockIdx.x); \
                pg8::EpiResGate<F32B> E{BASEP, XB, gate1, (float*)(ws + WS_SSP)}; \
                pg8::gemm_phase<pg8::EpiResGate<F32B>, pg8::StaticOrder, PG8_ALIGN, PG8_SP2>(l3, gm, S, E); }
#define G_O1A { pg8::Gemm gm{Hb, (const bf16_t*)(ws + WS_WSX) + (size_t)i2 * 4096 * D, T, 4096, D}; pg8::StaticOrder S; S.init(T, 4096, g.G, (int)blockIdx.x); \
                pg8::EpiSplitX E{(bf16_t*)(ws + WS_XS), (unsigned*)(ws + WS_XHALO)}; \
                pg8::gemm_phase<pg8::EpiSplitX, pg8::StaticOrder, PG8_ALIGN, PG8_SP2>(l3, gm, S, E); }
#define G_O1B { pg8::Gemm gm{Hb, (const bf16_t*)(ws + WS_WSZ) + (size_t)i2 * 2048 * D, T, 2048, D}; pg8::StaticOrder S; S.init(T, 2048, g.G, (int)blockIdx.x); \
                pg8::EpiGateNorm E{(bf16_t*)(ws + WS_XS), (LAS float*)(l3 + 131072)}; \
                pg8::gemm_phase<pg8::EpiGateNorm, pg8::StaticOrder, true, PG8_SP2>(l3, gm, S, E); }
#define G_O3 { pg8::Gemm gm{(const bf16_t*)(ws + WS_XS), (const bf16_t*)(ws + WS_WSO) + (size_t)i2 * D * SSM_DI, T, D, SSM_DI}; pg8::StaticOrder S; S.init(T, D, g.G, (int)blockIdx.x); \
                pg8::EpiResGate<false> E{XB, XB, gate1, (float*)(ws + WS_SSP)}; \
                pg8::gemm_phase<pg8::EpiResGate<false>, pg8::StaticOrder, PG8_ALIGN, PG8_SP2>(l3, gm, S, E); }
#define GDUP_2(...)
#define GDUP_4(...)
#define GDUP_8(...)
#define GDUP_10(...)
#define GDUP_12(...)
#if PROBE_DUP == 2
#undef GDUP_2
#define GDUP_2(...) __VA_ARGS__ xcd_barrier(bar);
#elif PROBE_DUP == 4
#undef GDUP_4
#define GDUP_4(...) __VA_ARGS__ xcd_barrier(bar);
#elif PROBE_DUP == 8
#undef GDUP_8
#define GDUP_8(...) __VA_ARGS__ xcd_barrier(bar);
#elif PROBE_DUP == 10
#undef GDUP_10
#define GDUP_10(...) __VA_ARGS__ xcd_barrier(bar);
#elif PROBE_DUP == 12
#undef GDUP_12
#define GDUP_12(...) __VA_ARGS__ xcd_barrier(bar);
#endif
#define GDUP(ty, ...) GDUP_##ty(__VA_ARGS__)
#define LAYER_BODY(LL) { const int L = (LL); \
        const int pb = 1 + 8 * L, i2 = L >> 1; \
        const float* gate1 = mod + (size_t)L * NB * 6144 + 2048; \
        if ((L & 1) == 0) { \
            if (IN(pb + 0)) { phase_norm<0>(P, g, (float*)lds, L, P.in[I_X], P.in[I_N1W] + L * D, 0, 1024, false, L == 0 ? (const bf16_t*)nullptr : (const bf16_t*)XB); SEAM(pb + 0); } \
            if (IN(pb + 1)) { G_E1 GDUP(2, G_E1) SEAM(pb + 1); } \
            if (IN(pb + 2)) { for (int rep_ = 0; rep_ < NREP(3); ++rep_) { DRYFLAG(3) phase_e2(P, g, l3, L); DRYBAR(); } SEAM(pb + 2); } \
            if (IN(pb + 3)) { if (L == 0) G_E3(true, P.in[I_X]) else G_E3(false, XB) SEAM(pb + 3); } \
            if (IN(pb + 4)) { for (int rep_ = 0; rep_ < NREP(5); ++rep_) { DRYFLAG(5) phase_norm16<2>(P, g, l3, L, XB, P.in[I_N2W] + L * D, 3072, 4096, dry); DRYBAR(); } SEAM(pb + 4); } \
            if (IN(pb + 5)) { for (int rep_ = 0; rep_ < NREP(6); ++rep_) { DRYFLAG(6) phase_moe(P, g, l3, L, dry); DRYBAR(); } SEAM(pb + 5); } \
        } else { \
            if (IN(pb + 0)) { phase_norm16<1>(P, g, l3, L, XB, P.in[I_N1W] + L * D, 0, 1024, false); SEAM(pb + 0); } \
            if (IN(pb + 1)) { G_O1A GDUP(8, G_O1A) SEAM(pb + 1); } \
            if (IN(pb + 2)) { for (int rep_ = 0; rep_ < NREP(9); ++rep_) { DRYFLAG(9) scan_units<3>(P, g, l3, L, dry); xcd_barrier(bar); scan_fix(P, g, l3, L); DRYBAR(); } SEAM(pb + 2); } \
            if (IN(pb + 3)) { G_O1B GDUP(10, G_O1B) SEAM(pb + 3); } \
            if (IN(pb + 5)) { G_O3 SEAM(pb + 5); } \
            if (IN(pb + 6)) { for (int rep_ = 0; rep_ < NREP(5); ++rep_) { DRYFLAG(5) phase_norm16<2>(P, g, l3, L, XB, P.in[I_N2W] + L * D, 3072, 4096, dry); DRYBAR(); } SEAM(pb + 6); } \
            if (IN(pb + 7)) { for (int rep_ = 0; rep_ < NREP(6); ++rep_) { DRYFLAG(6) phase_moe(P, g, l3, L, dry); DRYBAR(); } SEAM(pb + 7); } \
        } \
    }
    LAYER_BODY(0)
    LAYER_BODY(1)
    LAYER_BODY(2)
    LAYER_BODY(3)
#undef LAYER_BODY
    if (IN(33)) { for (int rep_ = 0; rep_ < NREP(13); ++rep_) { DRYFLAG(13) phase_final(P, g, dry); DRYBAR(); } }
#undef IN
#undef SEAM
}

extern "C" void kernel_launch(void* const* d_in, const int* in_sizes, int n_in, void* d_out, int out_size, void* d_ws, size_t ws_size, hipStream_t stream) {
    static int grid = 0;
    if (grid == 0) {
        if (n_in != 27 || out_size != T * D || ws_size < WS_END) { fprintf(stderr, "kernel_launch: bad shapes n_in %d out %d ws %zu (need %zu)\n", n_in, out_size, ws_size, (size_t)WS_END); grid = -1; return; }
        if (hipFuncSetAttribute((const void*)mk_fwd, hipFuncAttributeMaxDynamicSharedMemorySize, LDS_BYTES) != hipSuccess) { fprintf(stderr, "hipFuncSetAttribute failed\n"); grid = -1; return; }
        int dev = 0, cus = 0, per_cu = 0;
        if (hipGetDevice(&dev) != hipSuccess || hipDeviceGetAttribute(&cus, hipDeviceAttributeMultiprocessorCount, dev) != hipSuccess) { grid = -1; return; }
        if (hipOccupancyMaxActiveBlocksPerMultiprocessor(&per_cu, (const void*)mk_fwd, 512, LDS_BYTES) != hipSuccess || per_cu < 1) fprintf(stderr, "occupancy query says %d\n", per_cu);
        (void)hipGetLastError();
        grid = cus;
    }
    if (grid < 0) return;
    Params P{};
    for (int i = 0; i < 27; ++i) P.in[i] = (const float*)d_in[i];
    P.out = (float*)d_out; P.ws = (unsigned char*)d_ws;
    (void)hipMemsetAsync((unsigned char*)d_ws + WS_CTL, 0, CTL_BYTES, stream);
    const int G = grid;
    auto run = [&](int lo, int hi) { P.ph_lo = lo; P.ph_hi = hi; hipLaunchKernelGGL(mk_fwd, dim3(G), dim3(512), LDS_BYTES, stream, P); };
    run(0, NPHASE);
}
```

```cpp
#include <hip/hip_runtime.h>
#include <cstdio>
#include <cstdint>

#ifndef PROBE_DUP
#define PROBE_DUP -1
#endif
typedef unsigned short bf16_t;
typedef float f32x4 __attribute__((ext_vector_type(4)));
typedef unsigned u32x4 __attribute__((ext_vector_type(4)));
typedef unsigned u32x2 __attribute__((ext_vector_type(2)));
typedef float f32x2 __attribute__((ext_vector_type(2)));

constexpr int D = 1024, NB = 8, SEQ = 4096, DEPTH = 4, T = NB * SEQ;
constexpr int CHUNK = 64, NCH = SEQ / CHUNK;
constexpr float EPS = 1e-6f;
constexpr int POOLW = 512, NHEAD = 8, HD = 64, ATTW = 512, MIX_IN = 2048;
constexpr int SSM_DI = 2048, SSM_H = 32, SSM_G = 8, SSM_N = 128, SSM_P = 64, SSM_CONV = 4096, SSM_IN = 6176;
constexpr int MOE_E = 32, MOE_FF = 128, NBUCKET = 112;
constexpr float QSCALE = 0.125f * 1.4426950408889634f;
constexpr float LOG2E = 1.4426950408889634f;

constexpr size_t MiB = 1u << 20;
constexpr size_t WS_CTL = 0, CTL_BYTES = 1 * MiB;
constexpr size_t WS_MOD = 1 * MiB;
constexpr size_t WS_TOKE = 2 * MiB;
constexpr size_t WS_TOKW = 2 * MiB + 512 * 1024;
constexpr size_t WS_LIST = 3 * MiB;
constexpr size_t WS_WMI = 17 * MiB, WS_WMO = 25 * MiB, WS_WSX = 29 * MiB, WS_WSZ = 45 * MiB, WS_WSO = 53 * MiB, WS_WPL = 61 * MiB;
constexpr size_t WS_W13 = 62 * MiB, WS_W2T = 126 * MiB;
constexpr size_t WS_WRH = 61 * MiB + 256 * 1024, WS_WRL = WS_WRH + 384 * 1024;
constexpr size_t WS_WDH = 1 * MiB + 768 * 1024, WS_WDL = WS_WDH + 128 * 1024;
constexpr size_t WS_XB = 158 * MiB;
constexpr size_t WS_BIG = 222 * MiB;
constexpr size_t WS_U = WS_BIG, WS_Q = WS_BIG + 32 * MiB, WS_K = WS_BIG + 64 * MiB, WS_VT = WS_BIG + 96 * MiB, WS_CAT = WS_BIG + 128 * MiB;
constexpr size_t WS_XS = WS_BIG, WS_BC = WS_BIG + 128 * MiB, WS_DT = WS_BIG + 256 * MiB;
constexpr size_t WS_SSP = WS_BIG + 260 * MiB;
constexpr size_t WS_END = WS_SSP + 2 * MiB;
constexpr int CW_BAR = 4096;
constexpr int CW_CNT = 16384;

struct Params {
    const float* in[27];
    float* out;
    unsigned char* ws;
    int ph_lo, ph_hi;
};
enum { I_X = 0, I_C, I_ADAW, I_ADAB, I_N1W, I_N2W, I_MIXIN, I_POOLW, I_POOLS, I_RELB, I_MIXOUT, I_SSMIN, I_CONVW, I_CONVB, I_DTB, I_ALOG, I_SSMD, I_SSMNW, I_SSMOUT,
       I_WG, I_BG, I_WE, I_BE, I_W1, I_W3, I_W2, I_FNW };

#define LAS __attribute__((address_space(3)))
__device__ __forceinline__ float bf2f(unsigned v) { return __uint_as_float(v << 16); }
typedef __bf16 bf16x2_t __attribute__((ext_vector_type(2)));
__device__ __forceinline__ unsigned pk2(float lo, float hi) { f32x2 v = {lo, hi}; bf16x2_t b = __builtin_convertvector(v, bf16x2_t); return __builtin_bit_cast(unsigned, b); }
__device__ __forceinline__ unsigned f2bf(float f) { return pk2(f, f) & 0xffffu; }
__device__ __forceinline__ float xhalf_max(float x) { const auto r = __builtin_amdgcn_permlane32_swap(__float_as_uint(x), __float_as_uint(x), false, false); return fmaxf(__uint_as_float(r[0]), __uint_as_float(r[1])); }
__device__ __forceinline__ float xhalf_sum(float x) { const auto r = __builtin_amdgcn_permlane32_swap(__float_as_uint(x), __float_as_uint(x), false, false); return __uint_as_float(r[0]) + __uint_as_float(r[1]); }
__device__ __forceinline__ float x16_sum(float x) { const auto r = __builtin_amdgcn_permlane16_swap(__float_as_uint(x), __float_as_uint(x), false, false); return __uint_as_float(r[0]) + __uint_as_float(r[1]); }
#define DPP_F32(SRC, CTRL, RM) __uint_as_float(__builtin_amdgcn_update_dpp(0u, __float_as_uint(SRC), CTRL, RM, 0xf, false))
__device__ __forceinline__ float wave_incl_scan(float x) {
    x += DPP_F32(x, 0x111, 0xf); x += DPP_F32(x, 0x112, 0xf); x += DPP_F32(x, 0x114, 0xf); x += DPP_F32(x, 0x118, 0xf);
    x += DPP_F32(x, 0x142, 0xa); x += DPP_F32(x, 0x143, 0xc);
    return x;
}
__device__ __forceinline__ float wave_last(float x) { return __uint_as_float(__builtin_amdgcn_readlane(__float_as_uint(x), 63)); }
__device__ __forceinline__ float wave_sum(float v) {
#pragma unroll
    for (int o = 1; o < 64; o <<= 1) v += __shfl_xor(v, o);
    return v;
}
__device__ __forceinline__ float silu_f(float x) { return x * __builtin_amdgcn_rcpf(1.f + __expf(-x)); }
__device__ __forceinline__ float softplus_f(float x) { return x > 20.f ? x : log1pf(__expf(x)); }

struct Geo { int tid, lane, wave, vcu, G; };

__device__ __forceinline__ void phase_mod(const Params& P, const Geo& g, float* cs  ) {
    const float* c = P.in[I_C];
    for (int i = g.tid; i < NB * D; i += 512) cs[i] = silu_f(c[i]);
    __syncthreads();
    float* mod = (float*)(P.ws + WS_MOD);
    float* red = cs + 8192 + 8 * (64 * 33);
    for (int u = g.vcu; u < DEPTH * 96; u += g.G) {
        const int L = u / 96, col = (u % 96) * 64 + g.lane;
        const float* w = P.in[I_ADAW] + (size_t)L * D * 6144 + col + (size_t)g.wave * 128 * 6144;
        const float* cw = cs + g.wave * 128;
        float acc[NB];
#pragma unroll
        for (int b = 0; b < NB; ++b) acc[b] = 0.f;
#pragma unroll 32
        for (int k = 0; k < 128; ++k) {
            const float wv = w[(size_t)k * 6144];
#pragma unroll
            for (int b = 0; b < NB; ++b) acc[b] += cw[b * D + k] * wv;
        }
#pragma unroll
        for (int b = 0; b < NB; ++b) red[(g.wave * NB + b) * 64 + g.lane] = acc[b];
        __syncthreads();
        { const int b = g.wave; float sum = P.in[I_ADAB][L * 6144 + col];
#pragma unroll
            for (int ww = 0; ww < 8; ++ww) sum += red[(ww * NB + b) * 64 + g.lane];
            mod[(size_t)(L * NB + b) * 6144 + col] = sum; }
        __syncthreads();
    }
}

template <int PROJ>
__device__ __forceinline__ void phase_norm(const Params& P, const Geo& g, float* wlds, int L, const float* xsrc, const float* nw, int shift_off, int scale_off, bool dry = false, const bf16_t* xb = nullptr  ) {
    constexpr int NPROJ = PROJ == 1 ? 32 : (PROJ == 2 ? 36 : 0);
    const int i2 = L >> 1;
    if (PROJ == 1) {
        const float* w = P.in[I_SSMIN] + (size_t)i2 * D * SSM_IN + 6144;
        for (int e = g.tid; e < 32 * D; e += 512) { const int k = e >> 5, j = e & 31; wlds[j * D + k] = w[(size_t)k * SSM_IN + j]; }
        __syncthreads();
    } else if (PROJ == 2) {
        const float* wg = P.in[I_WG] + (size_t)L * D * 4;
        const float* we = P.in[I_WE] + (size_t)L * D * 32;
        for (int e = g.tid; e < 4 * D; e += 512) { const int k = e >> 2, j = e & 3; wlds[j * D + k] = wg[e]; }
        for (int e = g.tid; e < 32 * D; e += 512) { const int k = e >> 5, j = e & 31; wlds[(4 + j) * D + k] = we[e]; }
        __syncthreads();
    }
    const float* mod = (const float*)(P.ws + WS_MOD);
    bf16_t* H = (bf16_t*)P.out;
    const int gw = g.vcu * 8 + g.wave, NGW = g.G * 8;
    int my_row = -1, my_bucket = 0; int nrows = 0;
    for (int m = gw; m < T; m += NGW) {
        const int b = m / SEQ;
        f32x4 v[4]; float ss = 0.f;
        if (xb) { const u32x2* xr2 = (const u32x2*)(xb + (size_t)m * D) + g.lane;
#pragma unroll
            for (int j = 0; j < 4; ++j) { const u32x2 t2 = xr2[64 * j]; v[j].x = bf2f(t2.x & 0xffffu); v[j].y = bf2f(t2.x >> 16); v[j].z = bf2f(t2.y & 0xffffu); v[j].w = bf2f(t2.y >> 16); } }
        else { const f32x4* xr = (const f32x4*)(xsrc + (size_t)m * D) + g.lane;
#pragma unroll
            for (int j = 0; j < 4; ++j) v[j] = xr[64 * j]; }
#pragma unroll
        for (int j = 0; j < 4; ++j) ss += v[j].x * v[j].x + v[j].y * v[j].y + v[j].z * v[j].z + v[j].w * v[j].w;
        const float rstd = rsqrtf(wave_sum(ss) * (1.f / D) + EPS);
        const float* mrow = mod + (size_t)(L * NB + b) * 6144;
#pragma unroll
        for (int j = 0; j < 4; ++j) {
            const int k = 4 * g.lane + 256 * j;
            const f32x4 w4 = *(const f32x4*)(nw + k), sc = *(const f32x4*)(mrow + scale_off + k), sh = *(const f32x4*)(mrow + shift_off + k);
            v[j] = v[j] * rstd * w4 * (sc + 1.f) + sh;
            u32x2 o; o.x = pk2(v[j].x, v[j].y); o.y = pk2(v[j].z, v[j].w);
            *(u32x2*)(H + (size_t)m * D + k) = o;
        }
        if (NPROJ > 0) {
            float mine = 0.f;
#pragma unroll 2
            for (int q = 0; q < NPROJ; ++q) {
                float a = 0.f;
#pragma unroll
                for (int j = 0; j < 4; ++j) { const f32x4 w4 = *(const f32x4*)(wlds + q * D + 4 * g.lane + 256 * j); a += v[j].x * w4.x + v[j].y * w4.y + v[j].z * w4.z + v[j].w * w4.w; }
                a = wave_sum(a);
                mine = (g.lane == q) ? a : mine;
            }
            if (PROJ == 1) {
                float* DT = (float*)(P.ws + WS_DT);
                const float* dtb = P.in[I_DTB] + i2 * SSM_H;
                if (g.lane < 32) DT[(size_t)m * 32 + g.lane] = softplus_f(mine + dtb[g.lane]);
            } else if (PROJ == 2) {
                const float* bg = P.in[I_BG] + L * 4; const float* be = P.in[I_BE] + L * 32;
                float gl[4]; float gm = -3.0e38f; int gi = 0;
#pragma unroll
                for (int q = 0; q < 4; ++q) { gl[q] = __shfl(mine, q) + bg[q]; if (gl[q] > gm) { gm = gl[q]; gi = q; } }
                float gs = 0.f;
#pragma unroll
                for (int q = 0; q < 4; ++q) gs += __expf(gl[q] - gm);
                const float gval = 1.f / gs;
                float el[8];
#pragma unroll
                for (int e = 0; e < 8; ++e) el[e] = __shfl(mine, 4 + gi * 8 + e) + be[gi * 8 + e];
                float m0 = -3.0e38f; int i0 = 0;
#pragma unroll
                for (int e = 0; e < 8; ++e) if (el[e] > m0) { m0 = el[e]; i0 = e; }
                float m1 = -3.0e38f; int i1 = 0;
#pragma unroll
                for (int e = 0; e < 8; ++e) if (e != i0 && el[e] > m1) { m1 = el[e]; i1 = e; }
                float es = 0.f;
#pragma unroll
                for (int e = 0; e < 8; ++e) es += __expf(el[e] - m0);
                const float p0 = 1.f / es, p1 = __expf(m1 - m0) / es;
                const float w0 = gval * (p0 / (p0 + p1)), w1 = gval * (p1 / (p0 + p1));
                const int lo = i0 < i1 ? i0 : i1, hi = i0 < i1 ? i1 : i0;
                const float wlo = i0 < i1 ? w0 : w1, whi = i0 < i1 ? w1 : w0;
                const int bucket = gi * 28 + 7 * lo - (lo * (lo - 1)) / 2 + (hi - lo - 1);
                if (g.lane == 0) {
                    ((int2*)(P.ws + WS_TOKE))[m] = make_int2(gi * 8 + lo, gi * 8 + hi);
                    ((float2*)(P.ws + WS_TOKW))[m] = make_float2(wlo, whi);
                }
                if (g.lane == (nrows & 63)) { my_row = m; my_bucket = bucket; }
                ++nrows;
                if ((nrows & 63) == 0 && !dry) {
                    unsigned* cnt = (unsigned*)(P.ws + WS_CTL) + CW_CNT + (L * 128 + my_bucket) * 16;
                    const unsigned rank = atomicAdd(cnt, 1u);
                    ((int*)(P.ws + WS_LIST))[(size_t)my_bucket * T + rank] = my_row;
                    my_row = -1;
                }
            }
        }
    }
    if (PROJ == 2) {
        if (my_row >= 0 && !dry) {
            unsigned* cnt = (unsigned*)(P.ws + WS_CTL) + CW_CNT + (L * 128 + my_bucket) * 16;
            const unsigned rank = atomicAdd(cnt, 1u);
            ((int*)(P.ws + WS_LIST))[(size_t)my_bucket * T + rank] = my_row;
        }
    }
}


typedef short bf16x8 __attribute__((ext_vector_type(8)));
template <int PROJ>
__device__ __forceinline__ void phase_norm16(const Params& P, const Geo& g, LAS unsigned char* l3, int L, const bf16_t* xsrc, const float* nw, int shift_off, int scale_off, bool dry = false) {
    constexpr int NT = PROJ == 1 ? 2 : 3, NBLK = NT * 16, PERW = NBLK / 8;
    constexpr int O_WB = 32768, WBUF = NBLK * 1024;
    const int i2 = L >> 1, lane = g.lane, r16 = lane & 15, q4 = lane >> 4, w = g.wave;
    unsigned char* ws = P.ws;
    const float* mod = (const float*)(ws + WS_MOD);
    const float* ssp = (const float*)(ws + WS_SSP);
    bf16_t* H = (bf16_t*)P.out;
    LAS float* msl = (LAS float*)l3;
    LAS float* shl = (LAS float*)(l3 + 4096);
    LAS float* lgw = (LAS float*)(l3 + 8192 + g.wave * (16 * 48 * 4));
    const bf16_t* WH = PROJ == 1 ? (const bf16_t*)(ws + WS_WDH) + (size_t)i2 * 32 * D : (const bf16_t*)(ws + WS_WRH) + (size_t)L * 48 * D;
    const bf16_t* WL = PROJ == 1 ? (const bf16_t*)(ws + WS_WDL) + (size_t)i2 * 32 * D : (const bf16_t*)(ws + WS_WRL) + (size_t)L * 48 * D;
    for (int blk = g.vcu; blk < T / 128; blk += g.G) {
        const int b = (blk * 128) / SEQ;
        const float* mrow = mod + (size_t)(L * NB + b) * 6144;
        __syncthreads();
        for (int k = g.tid; k < D; k += 512) { msl[k] = nw[k] * (1.f + mrow[scale_off + k]); shl[k] = mrow[shift_off + k]; }
        const int m0 = blk * 128 + w * 16;
        const bf16_t* xr = xsrc + (size_t)(m0 + r16) * D + 8 * q4;
        u32x4 xq[8];
#pragma unroll
        for (int sl = 0; sl < 8; ++sl) xq[sl] = *(const u32x4*)(xr + 32 * sl);
        float ss; { const f32x4 p4 = *(const f32x4*)(ssp + (size_t)(m0 + r16) * 16 + 4 * q4); ss = (p4[0] + p4[1]) + (p4[2] + p4[3]); }
        ss = xhalf_sum(x16_sum(ss));
        const float rstd = rsqrtf(ss * (1.f / D) + EPS);
        u32x4 wreg[PERW];
#define N16_LOADW(CH) do { _Pragma("unroll") for (int i = 0; i < PERW; ++i) { const int j = PERW * w + i, lo = j >= NT * 8, jj = lo ? j - NT * 8 : j, ct = jj >> 3, sl = jj & 7; \
            wreg[i] = *(const u32x4*)((lo ? WL : WH) + (size_t)(ct * 32 + 8 * (CH) + sl) * 512 + lane * 8); } } while (0)
#define N16_STOREW(BUF) do { _Pragma("unroll") for (int i = 0; i < PERW; ++i) *(LAS u32x4*)(l3 + O_WB + (BUF) * WBUF + (PERW * w + i) * 1024 + lane * 16) = wreg[i]; } while (0)
        N16_LOADW(0); N16_STOREW(0);
        __syncthreads();
        f32x4 acc[NT];
#pragma unroll
        for (int ct = 0; ct < NT; ++ct) acc[ct] = (f32x4){0.f, 0.f, 0.f, 0.f};
        bf16_t* hrow = H + (size_t)(m0 + r16) * D + 8 * q4;
#pragma unroll 1
        for (int ch = 0; ch < 4; ++ch) {
            if (ch < 3) N16_LOADW(ch + 1);
            u32x4 xn[8];
#pragma unroll
            for (int sl = 0; sl < 8; ++sl) xn[sl] = xq[sl];
            if (ch < 3) {
#pragma unroll
                for (int sl = 0; sl < 8; ++sl) xn[sl] = *(const u32x4*)(xr + 32 * (8 * (ch + 1) + sl)); }
            const LAS unsigned char* wb = l3 + O_WB + (ch & 1) * WBUF + lane * 16;
#pragma unroll
            for (int sl = 0; sl < 8; ++sl) {
                const int s = 8 * ch + sl;
                const u32x4 x8 = xq[sl];
                f32x4 a, c; a.x = bf2f(x8.x & 0xffffu); a.y = bf2f(x8.x >> 16); a.z = bf2f(x8.y & 0xffffu); a.w = bf2f(x8.y >> 16); c.x = bf2f(x8.z & 0xffffu); c.y = bf2f(x8.z >> 16); c.z = bf2f(x8.w & 0xffffu); c.w = bf2f(x8.w >> 16);
                const f32x4 m0v = *(const LAS f32x4*)(msl + 32 * s + 8 * q4), m1v = *(const LAS f32x4*)(msl + 32 * s + 8 * q4 + 4);
                const f32x4 s0v = *(const LAS f32x4*)(shl + 32 * s + 8 * q4), s1v = *(const LAS f32x4*)(shl + 32 * s + 8 * q4 + 4);
                const f32x4 h0 = a * rstd * m0v + s0v, h1 = c * rstd * m1v + s1v;
                u32x4 hi; hi.x = pk2(h0.x, h0.y); hi.y = pk2(h0.z, h0.w); hi.z = pk2(h1.x, h1.y); hi.w = pk2(h1.z, h1.w);
                *(u32x4*)(hrow + 32 * s) = hi;
                u32x4 lo;
                lo.x = pk2(h0.x - bf2f(hi.x & 0xffffu), h0.y - bf2f(hi.x >> 16)); lo.y = pk2(h0.z - bf2f(hi.y & 0xffffu), h0.w - bf2f(hi.y >> 16));
                lo.z = pk2(h1.x - bf2f(hi.z & 0xffffu), h1.y - bf2f(hi.z >> 16)); lo.w = pk2(h1.z - bf2f(hi.w & 0xffffu), h1.w - bf2f(hi.w >> 16));
                const bf16x8 ahi = __builtin_bit_cast(bf16x8, hi), alo = __builtin_bit_cast(bf16x8, lo);
#pragma unroll
                for (int ct = 0; ct < NT; ++ct) { const bf16x8 bh = *(const LAS bf16x8*)(wb + (ct * 8 + sl) * 1024), bl = *(const LAS bf16x8*)(wb + (NT * 8 + ct * 8 + sl) * 1024);
                    acc[ct] = __builtin_amdgcn_mfma_f32_16x16x32_bf16(ahi, bh, acc[ct], 0, 0, 0);
                    acc[ct] = __builtin_amdgcn_mfma_f32_16x16x32_bf16(ahi, bl, acc[ct], 0, 0, 0);
                    acc[ct] = __builtin_amdgcn_mfma_f32_16x16x32_bf16(alo, bh, acc[ct], 0, 0, 0); }
            }
            if (ch < 3) N16_STOREW((ch + 1) & 1);
            asm volatile("s_waitcnt lgkmcnt(0)" ::: "memory"); __builtin_amdgcn_s_barrier(); asm volatile("" ::: "memory");
#pragma unroll
            for (int sl = 0; sl < 8; ++sl) xq[sl] = xn[sl];
        }
#undef N16_LOADW
#undef N16_STOREW
        if (PROJ == 1) {
            float* DT = (float*)(ws + WS_DT); const float* dtb = P.in[I_DTB] + i2 * SSM_H;
#pragma unroll
            for (int ct = 0; ct < NT; ++ct) { const float bias = dtb[16 * ct + r16];
#pragma unroll
                for (int r = 0; r < 4; ++r) DT[(size_t)(m0 + 4 * q4 + r) * 32 + 16 * ct + r16] = softplus_f(acc[ct][r] + bias); }
        } else {
#pragma unroll
            for (int ct = 0; ct < NT; ++ct)
#pragma unroll
                for (int r = 0; r < 4; ++r) lgw[(4 * q4 + r) * 48 + 16 * ct + r16] = acc[ct][r];
            asm volatile("s_waitcnt lgkmcnt(0)" ::: "memory");
            if (lane < 16) {
                const LAS float* lg = lgw + lane * 48; const int m = m0 + lane;
                const float* bg = P.in[I_BG] + L * 4; const float* be = P.in[I_BE] + L * 32;
                float gl[4]; float gm = -3.0e38f; int gi = 0;
#pragma unroll
                for (int q = 0; q < 4; ++q) { gl[q] = lg[q] + bg[q]; if (gl[q] > gm) { gm = gl[q]; gi = q; } }
                float gs = 0.f;
#pragma unroll
                for (int q = 0; q < 4; ++q) gs += __expf(gl[q] - gm);
                const float gval = 1.f / gs;
                float el[8];
#pragma unroll
                for (int e = 0; e < 8; ++e) el[e] = lg[4 + gi * 8 + e] + be[gi * 8 + e];
                float mx0 = -3.0e38f; int i0 = 0;
#pragma unroll
                for (int e = 0; e < 8; ++e) if (el[e] > mx0) { mx0 = el[e]; i0 = e; }
                float mx1 = -3.0e38f; int i1 = 0;
#pragma unroll
                for (int e = 0; e < 8; ++e) if (e != i0 && el[e] > mx1) { mx1 = el[e]; i1 = e; }
                float es = 0.f;
#pragma unroll
                for (int e = 0; e < 8; ++e) es += __expf(el[e] - mx0);
                const float p0 = 1.f / es, p1 = __expf(mx1 - mx0) / es;
                const float w0 = gval * (p0 / (p0 + p1)), w1 = gval * (p1 / (p0 + p1));
                const int lo = i0 < i1 ? i0 : i1, hi = i0 < i1 ? i1 : i0;
                const float wlo = i0 < i1 ? w0 : w1, whi = i0 < i1 ? w1 : w0;
                const int bucket = gi * 28 + 7 * lo - (lo * (lo - 1)) / 2 + (hi - lo - 1);
                ((int2*)(ws + WS_TOKE))[m] = make_int2(gi * 8 + lo, gi * 8 + hi);
                ((float2*)(ws + WS_TOKW))[m] = make_float2(wlo, whi);
                if (!dry) {
                    unsigned* cnt = (unsigned*)(ws + WS_CTL) + CW_CNT + (L * 128 + bucket) * 16;
                    const unsigned rank = atomicAdd(cnt, 1u);
                    ((int*)(ws + WS_LIST))[(size_t)bucket * T + rank] = m;
                }
            }
        }
    }
}

__device__ __forceinline__ void phase_gate(const Params& P, const Geo& g, bool dry = false) {
    bf16_t* XS = (bf16_t*)(P.ws + WS_XS); const bf16_t* Z = (const bf16_t*)(P.ws + WS_BC);
    const int gw = g.vcu * 8 + g.wave, NGW = g.G * 8;
    for (int m = gw; m < T; m += NGW) {
        u32x4* yp = (u32x4*)(XS + (size_t)m * SSM_DI + 32 * g.lane);
        const u32x4* zp = (const u32x4*)(Z + (size_t)m * SSM_DI + 32 * g.lane);
        float gv[32]; float ss = 0.f;
#pragma unroll
        for (int j = 0; j < 4; ++j) {
            const u32x4 y4 = yp[j], z4 = zp[j];
#pragma unroll
            for (int e = 0; e < 4; ++e) {
                const unsigned yy = y4[e], zz = z4[e];
                const float y0 = bf2f(yy & 0xffffu), y1 = bf2f(yy >> 16), z0 = bf2f(zz & 0xffffu), z1 = bf2f(zz >> 16);
                const float g0 = y0 * silu_f(z0), g1 = y1 * silu_f(z1);
                gv[j * 8 + e * 2] = g0; gv[j * 8 + e * 2 + 1] = g1; ss += g0 * g0 + g1 * g1;
            }
        }
        ss += __shfl_xor(ss, 1); ss += __shfl_xor(ss, 2); ss += __shfl_xor(ss, 4);
        const float rs = rsqrtf(ss * (1.f / 256.f) + EPS);
#pragma unroll
        for (int j = 0; j < 4; ++j) { u32x4 o;
#pragma unroll
            for (int e = 0; e < 4; ++e) o[e] = pk2(gv[j * 8 + e * 2] * rs, gv[j * 8 + e * 2 + 1] * rs);
            if (!dry) yp[j] = o; else asm volatile("" :: "v"(o)); }
    }
}

__device__ __forceinline__ void phase_final(const Params& P, const Geo& g, bool dry = false) {
    const float* nw = P.in[I_FNW];
    const bf16_t* XB = (const bf16_t*)(P.ws + WS_XB);
    const int gw = g.vcu * 8 + g.wave, NGW = g.G * 8;
    for (int m = gw; m < T; m += NGW) {
        const u32x2* xr2 = (const u32x2*)(XB + (size_t)m * D) + g.lane;
        f32x4* orow = (f32x4*)(P.out + (size_t)m * D) + g.lane;
        f32x4 v[4]; float ss = 0.f;
#pragma unroll
        for (int j = 0; j < 4; ++j) { const u32x2 t2 = xr2[64 * j]; v[j].x = bf2f(t2.x & 0xffffu); v[j].y = bf2f(t2.x >> 16); v[j].z = bf2f(t2.y & 0xffffu); v[j].w = bf2f(t2.y >> 16);
            ss += v[j].x * v[j].x + v[j].y * v[j].y + v[j].z * v[j].z + v[j].w * v[j].w; }
        const float rstd = rsqrtf(wave_sum(ss) * (1.f / D) + EPS);
#pragma unroll
        for (int j = 0; j < 4; ++j) { const f32x4 w4 = *(const f32x4*)(nw + 4 * g.lane + 256 * j); orow[64 * j] = v[j] * rstd * w4; }
    }
}

namespace pg8 {
#define PG8_LAS __attribute__((address_space(3)))
typedef unsigned short bf16_t;
typedef short bf16x8 __attribute__((ext_vector_type(8)));
typedef float f32x4 __attribute__((ext_vector_type(4)));
typedef unsigned u32x4 __attribute__((ext_vector_type(4)));
constexpr int BM = 256, BK = 64, HALF = 128, HTB = HALF * BK * 2  , STAGE_BYTES = 8 * HTB, NXCD = 8, WGM = 8;

__host__ __device__ __forceinline__ int lds_byte(int r, int c) { const int st = (r >> 4) * 2 + (c >> 5), rr = r & 15, cc = c & 31, ob = rr * 64 + cc * 2; return st * 1024 + (ob ^ (((ob >> 9) & 1) << 5)); }
__host__ __device__ __forceinline__ void stage_rc(int b, int& R, int& C) { const int st = b / 1024, sb = b % 1024, swz = sb ^ (((sb >> 9) & 1) << 5); R = (st >> 1) * 16 + swz / 64; C = (st & 1) * 32 + (swz % 64) / 2; }
__host__ __device__ __forceinline__ int perm32(int rho) { const int n = rho >> 4, i = rho & 15; return 8 * (i >> 2) + 4 * n + (i & 3); }

struct Unit { int pm, pn; };
struct Gemm { const bf16_t* A; const bf16_t* Bt; int M, N, K; };

struct StaticOrder {
    int nM, nN, nwg, G, c;
    __host__ __device__ void init(int M, int N, int G_, int c_) { nM = M / BM; nN = N / BM; nwg = nM * nN; G = G_; c = c_; }
    __host__ __device__ bool next(int i, Unit& u) const {
        const long L = (long)i * G + c; if (L >= nwg) return false;
        int wgid = (int)L; { const int q = nwg / NXCD, r = nwg % NXCD, xcd = wgid % NXCD, off = wgid / NXCD; wgid = (xcd < r ? xcd * (q + 1) : r * (q + 1) + (xcd - r) * q) + off; }
        const int nig = WGM * nN, gid = wgid / nig, fm = gid * WGM, gsz = (nM - fm) < WGM ? (nM - fm) : WGM;
        u.pm = fm + ((wgid % nig) % gsz); u.pn = (wgid % nig) / gsz; return true;
    }
    __device__ __forceinline__ void a_ready(const Unit&) const {}
    __device__ __forceinline__ void done(const Unit&) const {}
};
template <class Epi, class Sched, bool ALIGN_EPI = false, bool SP2 = false>
__device__ __forceinline__ void gemm_phase(PG8_LAS unsigned char* lds, const Gemm g, const Sched& S, const Epi& E) {
    const int tid = threadIdx.x, wid = __builtin_amdgcn_readfirstlane(tid >> 6), lane = tid & 63, wr = wid >> 2, wc = wid & 3, fr = lane & 15, fq = lane >> 4;
    const int K = g.K, nt = K / BK;
    unsigned voffA[2], voffB[2];
#pragma unroll
    for (int i = 0; i < 2; ++i) { int R, C; stage_rc(tid * 16 + i * 8192, R, C); const int Rb = Epi::PERM ? ((R & ~31) + perm32(R & 31)) : R;
        voffA[i] = (unsigned)(R * K + C) * 2u; voffB[i] = (unsigned)(Rb * K + C) * 2u; }
    const size_t kstep = (size_t)(BK * 2);
    const size_t hstep = (size_t)HALF * K * 2;
    const size_t tstep = 2 * hstep;
    const unsigned ldsw = (unsigned)wid * 1024u;
    const int aoff = lds_byte(wr * 64 + fr, fq * 8), boff = lds_byte(wc * 32 + fr, fq * 8);
#define PG8_SA(b, h) (((b) * 2 + (h)) * HTB)
#define PG8_SB(b, h) ((4 + (b) * 2 + (h)) * HTB)
#define PG8_STAGE(bufoff, gbase, voff) do { _Pragma("unroll") for (int _i = 0; _i < 2; ++_i) \
        __builtin_amdgcn_global_load_lds((const unsigned*)((const char*)(gbase) + (voff)[_i]), (PG8_LAS unsigned*)(lds + (bufoff) + ldsw + _i * 8192), 16, 0, 0); } while (0)
#define PG8_LDA(dst, b, h) do { _Pragma("unroll") for (int m = 0; m < 4; ++m) _Pragma("unroll") for (int k = 0; k < 2; ++k) dst[m][k] = *(const PG8_LAS bf16x8*)(lds + PG8_SA(b, h) + aoff + m * 2048 + k * 1024); } while (0)
#define PG8_LDB(dst, b, h) do { _Pragma("unroll") for (int n = 0; n < 2; ++n) _Pragma("unroll") for (int k = 0; k < 2; ++k) dst[n][k] = *(const PG8_LAS bf16x8*)(lds + PG8_SB(b, h) + boff + n * 2048 + k * 1024); } while (0)
#define PG8_MMA(ai, bj, At, Bt) do { __builtin_amdgcn_s_setprio(1); _Pragma("unroll") for (int m = 0; m < 4; ++m) _Pragma("unroll") for (int n = 0; n < 2; ++n) _Pragma("unroll") for (int k = 0; k < 2; ++k) \
        acc[ai][bj][m][n] = __builtin_amdgcn_mfma_f32_16x16x32_bf16(Bt[n][k], At[m][k], acc[ai][bj][m][n], 0, 0, 0); __builtin_amdgcn_s_setprio(0); } while (0)
#define PG8_WAIT_V(n) asm volatile("s_waitcnt vmcnt(" #n ")" ::: "memory")
#define PG8_WAIT_L(n) asm volatile("s_waitcnt lgkmcnt(" #n ")" ::: "memory")
#define PG8_BAR __builtin_amdgcn_s_barrier()
#define PG8_SCHED __builtin_amdgcn_sched_barrier(0)
    Unit cur, nxt; int ui = 0;
    if (!S.next(0, cur)) return;
    f32x4 acc[2][2][4][2];
#pragma unroll
    for (int a = 0; a < 2; ++a)
#pragma unroll
        for (int b = 0; b < 2; ++b)
#pragma unroll
            for (int m = 0; m < 4; ++m)
#pragma unroll
                for (int n = 0; n < 2; ++n) acc[a][b][m][n] = (f32x4){0.f, 0.f, 0.f, 0.f};
    bf16x8 At[4][2], B0[2][2], B1[2][2];
    const char* cA = (const char*)g.A + (size_t)cur.pm * tstep; const char* cB = (const char*)g.Bt + (size_t)cur.pn * tstep;
    S.a_ready(cur);
    if constexpr (SP2) {
        PG8_STAGE(PG8_SB(0, 0), cB, voffB); PG8_STAGE(PG8_SB(0, 1), cB + hstep, voffB); PG8_STAGE(PG8_SA(0, 0), cA, voffA); PG8_STAGE(PG8_SA(0, 1), cA + hstep, voffA);
        if (wr == 1) PG8_BAR;
        PG8_WAIT_V(2); PG8_BAR;
        PG8_STAGE(PG8_SB(1, 0), cB + kstep, voffB); PG8_STAGE(PG8_SA(1, 0), cA + kstep, voffA); PG8_STAGE(PG8_SB(1, 1), cB + hstep + kstep, voffB);
        PG8_WAIT_V(6); PG8_BAR;
    } else {
        PG8_STAGE(PG8_SB(0, 0), cB, voffB); PG8_STAGE(PG8_SA(0, 0), cA, voffA); PG8_STAGE(PG8_SB(0, 1), cB + hstep, voffB); PG8_STAGE(PG8_SA(0, 1), cA + hstep, voffA);
        if (wr == 1) PG8_BAR;
        PG8_WAIT_V(4); PG8_BAR;
        PG8_STAGE(PG8_SB(1, 0), cB + kstep, voffB); PG8_STAGE(PG8_SA(1, 0), cA + kstep, voffA); PG8_STAGE(PG8_SB(1, 1), cB + hstep + kstep, voffB);
        PG8_WAIT_V(6); PG8_BAR;
    }
    for (;;) {
        const bool has_next = S.next(ui + 1, nxt);
        const char* nA = has_next ? (const char*)g.A + (size_t)nxt.pm * tstep : cA; const char* nB = has_next ? (const char*)g.Bt + (size_t)nxt.pn * tstep : cB;
        for (int t = 0; t < nt; t += 2) {
            const bool last = (t == nt - 2);
            const char* a1 = cA + (size_t)(t + 1) * kstep;
            const char* a2 = last ? nA : cA + (size_t)(t + 2) * kstep; const char* b2 = last ? nB : cB + (size_t)(t + 2) * kstep;
            const char* a3 = a2 + kstep; const char* b3 = b2 + kstep;
            if (last && has_next) S.a_ready(nxt);
            if constexpr (SP2) {
            PG8_LDB(B0, 0, 0); PG8_LDB(B1, 0, 1); PG8_SCHED; PG8_LDA(At, 0, 0); PG8_STAGE(PG8_SA(1, 1), a1 + hstep, voffA);
            PG8_WAIT_V(8); PG8_WAIT_L(0); PG8_BAR; PG8_MMA(0, 0, At, B0); PG8_MMA(0, 1, At, B1); PG8_BAR; PG8_SCHED;
            PG8_LDA(At, 0, 1); PG8_STAGE(PG8_SB(0, 0), b2, voffB); PG8_STAGE(PG8_SB(0, 1), b2 + hstep, voffB); PG8_STAGE(PG8_SA(0, 0), a2, voffA);
            PG8_WAIT_V(8); PG8_WAIT_L(0); PG8_BAR; PG8_MMA(1, 0, At, B0); PG8_MMA(1, 1, At, B1); PG8_BAR; PG8_SCHED;
            PG8_LDB(B0, 1, 0); PG8_LDB(B1, 1, 1); PG8_SCHED; PG8_LDA(At, 1, 0); PG8_STAGE(PG8_SA(0, 1), a2 + hstep, voffA);
            PG8_WAIT_V(8); PG8_WAIT_L(0); PG8_BAR; PG8_MMA(0, 0, At, B0); PG8_MMA(0, 1, At, B1); PG8_BAR; PG8_SCHED;
            PG8_LDA(At, 1, 1); PG8_STAGE(PG8_SB(1, 0), b3, voffB); PG8_STAGE(PG8_SB(1, 1), b3 + hstep, voffB); PG8_STAGE(PG8_SA(1, 0), a3, voffA);
            PG8_WAIT_V(8); PG8_WAIT_L(0); PG8_BAR; PG8_MMA(1, 0, At, B0); PG8_MMA(1, 1, At, B1); PG8_BAR; PG8_SCHED;
            } else {
            PG8_LDB(B0, 0, 0); PG8_SCHED; PG8_LDA(At, 0, 0); PG8_STAGE(PG8_SA(1, 1), a1 + hstep, voffA);
            PG8_WAIT_L(8); PG8_BAR; PG8_WAIT_L(0); PG8_MMA(0, 0, At, B0); PG8_BAR; PG8_SCHED;
            PG8_LDB(B1, 0, 1); PG8_STAGE(PG8_SB(0, 0), b2, voffB);
            PG8_BAR; PG8_WAIT_L(0); PG8_MMA(0, 1, At, B1); PG8_BAR;
            PG8_LDA(At, 0, 1); PG8_STAGE(PG8_SA(0, 0), a2, voffA);
            PG8_BAR; PG8_WAIT_L(0); PG8_MMA(1, 0, At, B0); PG8_BAR; PG8_SCHED;
            PG8_STAGE(PG8_SB(0, 1), b2 + hstep, voffB);
            PG8_WAIT_V(6); PG8_BAR; PG8_MMA(1, 1, At, B1); PG8_BAR;
            PG8_LDB(B0, 1, 0); PG8_SCHED; PG8_LDA(At, 1, 0); PG8_STAGE(PG8_SA(0, 1), a2 + hstep, voffA);
            PG8_WAIT_L(8); PG8_BAR; PG8_WAIT_L(0); PG8_MMA(0, 0, At, B0); PG8_BAR; PG8_SCHED;
            PG8_LDB(B1, 1, 1); PG8_STAGE(PG8_SB(1, 0), b3, voffB);
            PG8_BAR; PG8_WAIT_L(0); PG8_MMA(0, 1, At, B1); PG8_BAR;
            PG8_LDA(At, 1, 1); PG8_STAGE(PG8_SA(1, 0), a3, voffA);
            PG8_BAR; PG8_WAIT_L(0); PG8_MMA(1, 0, At, B0); PG8_BAR; PG8_SCHED;
            PG8_STAGE(PG8_SB(1, 1), b3 + hstep, voffB);
            PG8_WAIT_V(6); PG8_BAR; PG8_MMA(1, 1, At, B1); PG8_BAR;
            }
        }
        if constexpr (ALIGN_EPI) { if (wr == 0) PG8_BAR; }
        if constexpr (!Epi::AFTER_DRAIN) { E(acc, cur, wr, wc, fr, fq); S.done(cur); }
        if (!has_next) break;
#pragma unroll
        for (int a = 0; a < 2; ++a)
#pragma unroll
            for (int b = 0; b < 2; ++b)
#pragma unroll
                for (int m = 0; m < 4; ++m)
#pragma unroll
                    for (int n = 0; n < 2; ++n) acc[a][b][m][n] = (f32x4){0.f, 0.f, 0.f, 0.f};
        cur = nxt; cA = nA; cB = nB; ++ui;
        if constexpr (ALIGN_EPI) { if (wr == 1) PG8_BAR; }
    }
    PG8_WAIT_V(0);
    if constexpr (!ALIGN_EPI) { if (wr == 0) PG8_BAR; }
    PG8_BAR;
    if constexpr (Epi::AFTER_DRAIN) { E.fused(acc, cur, wr, wc, fr, fq, lds, wid, lane); S.done(cur); }
#undef PG8_SA
#undef PG8_SB
#undef PG8_STAGE
#undef PG8_LDA
#undef PG8_LDB
#undef PG8_MMA
#undef PG8_WAIT_V
#undef PG8_WAIT_L
#undef PG8_BAR
#undef PG8_SCHED
}
}

namespace pg8 {
__device__ __forceinline__ unsigned cvt_pk_bf16(float lo, float hi) { unsigned r; asm volatile("v_cvt_pk_bf16_f32 %0, %1, %2" : "=v"(r) : "v"(lo), "v"(hi)); return r; }
struct EpiE1x {
    static constexpr bool PERM = true, AFTER_DRAIN = false;
    bf16_t *U, *VT;
    __device__ __forceinline__ void operator()(const f32x4 (&acc)[2][2][4][2], const Unit& u, int wr, int wc, int fr, int fq) const {
        const int row0 = u.pm * BM + wr * 64 + fr, type = u.pn >> 1, colt = (u.pn & 1) * 256 + wc * 32 + 8 * fq;
        if (type < 2) {
            bf16_t* base = U + (size_t)type * ((size_t)T * 512);
            const float sc = type == 1 ? QSCALE : 1.f;
#pragma unroll
            for (int ai = 0; ai < 2; ++ai)
#pragma unroll
                for (int m = 0; m < 4; ++m) { bf16_t* rowp = base + (size_t)(row0 + ai * HALF + m * 16) * 512 + colt;
#pragma unroll
                    for (int bj = 0; bj < 2; ++bj) { const f32x4 v0 = acc[ai][bj][m][0] * sc, v1 = acc[ai][bj][m][1] * sc;
                        u32x4 w; w.x = cvt_pk_bf16(v0[0], v0[1]); w.y = cvt_pk_bf16(v0[2], v0[3]); w.z = cvt_pk_bf16(v1[0], v1[1]); w.w = cvt_pk_bf16(v1[2], v1[3]);
                        *(u32x4*)(rowp + bj * HALF) = w; } }
        } else if (type == 2) {
            bf16_t* KT = U + (size_t)2 * ((size_t)T * 512);
#pragma unroll
            for (int ai = 0; ai < 2; ++ai)
#pragma unroll
                for (int m = 0; m < 4; ++m) { const int row = row0 + ai * HALF + m * 16, b = row / SEQ, sq = row % SEQ;
#pragma unroll
                    for (int bj = 0; bj < 2; ++bj) { const int col = colt + bj * HALF, h = col >> 6, d0 = col & 63;
                        const f32x4 v0 = acc[ai][bj][m][0], v1 = acc[ai][bj][m][1];
                        u32x4 w; w.x = cvt_pk_bf16(v0[0], v0[1]); w.y = cvt_pk_bf16(v0[2], v0[3]); w.z = cvt_pk_bf16(v1[0], v1[1]); w.w = cvt_pk_bf16(v1[2], v1[3]);
                        *(u32x4*)(KT + ((((size_t)b * NHEAD + h) * 128 + (sq >> 5)) * 4 + (d0 >> 4)) * 512 + (((d0 >> 3) & 1) * 32 + (sq & 31)) * 8) = w; } }
        } else {
#pragma unroll
            for (int ai = 0; ai < 2; ++ai)
#pragma unroll
                for (int m = 0; m < 4; ++m) { const int row = row0 + ai * HALF + m * 16, b = row / SEQ, sq = row % SEQ, kvl = sq & 31;
                    const int sp = kvl >> 4, r = kvl & 15, hh = (r >> 2) & 1, e = (r & 3) + 4 * (r >> 3);
#pragma unroll
                    for (int bj = 0; bj < 2; ++bj) { const int col = colt + bj * HALF, h = col >> 6, d0 = col & 63;
                        bf16_t* p = VT + (((((size_t)b * NHEAD + h) * 128 + (sq >> 5)) * 2 + (d0 >> 5)) * 2 + sp) * 512 + (hh * 32 + (d0 & 31)) * 8 + e;
                        const f32x4 v0 = acc[ai][bj][m][0], v1 = acc[ai][bj][m][1];
                        const unsigned w0 = cvt_pk_bf16(v0[0], v0[1]), w1 = cvt_pk_bf16(v0[2], v0[3]), w2 = cvt_pk_bf16(v1[0], v1[1]), w3 = cvt_pk_bf16(v1[2], v1[3]);
                        p[0] = (bf16_t)w0; p[8] = (bf16_t)(w0 >> 16); p[16] = (bf16_t)w1; p[24] = (bf16_t)(w1 >> 16);
                        p[32] = (bf16_t)w2; p[40] = (bf16_t)(w2 >> 16); p[48] = (bf16_t)w3; p[56] = (bf16_t)(w3 >> 16); } }
        }
    }
};
struct EpiSplitX {
    static constexpr bool PERM = true, AFTER_DRAIN = false;
    bf16_t *A0;
    unsigned* xhalo;
    __device__ __forceinline__ void operator()(const f32x4 (&acc)[2][2][4][2], const Unit& u, int wr, int wc, int fr, int fq) const {
        const int row0 = u.pm * BM + wr * 64 + fr, colt = (u.pn & 7) * 256 + wc * 32 + 8 * fq;
        bf16_t* base = A0 + (size_t)(u.pn >> 3) * ((size_t)T * 2048);
#pragma unroll
        for (int ai = 0; ai < 2; ++ai)
#pragma unroll
            for (int m = 0; m < 4; ++m) { bf16_t* rowp = base + (size_t)(row0 + ai * HALF + m * 16) * 2048 + colt;
#pragma unroll
                for (int bj = 0; bj < 2; ++bj) { const f32x4 v0 = acc[ai][bj][m][0], v1 = acc[ai][bj][m][1];
                    u32x4 w; w.x = cvt_pk_bf16(v0[0], v0[1]); w.y = cvt_pk_bf16(v0[2], v0[3]); w.z = cvt_pk_bf16(v1[0], v1[1]); w.w = cvt_pk_bf16(v1[2], v1[3]);
                    *(u32x4*)(rowp + bj * HALF) = w;
                    if ((u.pn >> 3) == 0 && (u.pm & 3) == 3 && wr == 1 && ai == 1 && m == 3 && fr >= 13) { const int r = row0 + ai * HALF + m * 16;
                        const int unit = (r >> 12) * 32 + (u.pn & 7) * 4 + ((r >> 10) & 3);
                        *(u32x4*)(xhalo + ((size_t)unit * 3 + (fr - 13)) * 128 + (wc * 32 + 8 * fq + bj * HALF) / 2) = w; } } }
    }
};
struct EpiGateNorm {
    static constexpr bool PERM = true, AFTER_DRAIN = false;
    bf16_t* Y; PG8_LAS float* xch;
    __device__ __forceinline__ void operator()(f32x4 (&acc)[2][2][4][2], const Unit& u, int wr, int wc, int fr, int fq) const {
        const int row0 = u.pm * BM + wr * 64 + fr, colt = (u.pn & 7) * 256 + wc * 32 + 8 * fq;
#pragma unroll
        for (int ai = 0; ai < 2; ++ai)
#pragma unroll
            for (int m = 0; m < 4; ++m) { const bf16_t* rowp = Y + (size_t)(row0 + ai * HALF + m * 16) * 2048 + colt; float sq = 0.f;
#pragma unroll
                for (int bj = 0; bj < 2; ++bj) { const u32x4 y8 = *(const u32x4*)(rowp + bj * HALF);
#pragma unroll
                    for (int n = 0; n < 2; ++n)
#pragma unroll
                        for (int e = 0; e < 4; ++e) { const unsigned yw = y8[2 * n + (e >> 1)]; const float yv = (e & 1) ? __uint_as_float(yw & 0xffff0000u) : __uint_as_float(yw << 16);
                            const float z = acc[ai][bj][m][n][e]; const float gv = yv * z * __builtin_amdgcn_rcpf(1.f + __expf(-z));
                            acc[ai][bj][m][n][e] = gv; sq += gv * gv; } }
                sq = xhalf_sum(x16_sum(sq));
                if (fq == 0) xch[(ai * HALF + wr * 64 + m * 16 + fr) * 4 + wc] = sq; }
        asm volatile("s_waitcnt lgkmcnt(0)" ::: "memory"); __builtin_amdgcn_s_barrier(); asm volatile("" ::: "memory");
#pragma unroll
        for (int ai = 0; ai < 2; ++ai)
#pragma unroll
            for (int m = 0; m < 4; ++m) { const int r = ai * HALF + wr * 64 + m * 16 + fr; const f32x4 p4 = *(const PG8_LAS f32x4*)(xch + r * 4);
                const float rs = __builtin_amdgcn_rsqf(((p4[0] + p4[1]) + (p4[2] + p4[3])) * (1.0f / 256.0f) + 1e-6f);
                bf16_t* rowp = Y + (size_t)(row0 + ai * HALF + m * 16) * 2048 + colt;
#pragma unroll
                for (int bj = 0; bj < 2; ++bj) { const f32x4 v0 = acc[ai][bj][m][0] * rs, v1 = acc[ai][bj][m][1] * rs;
                    u32x4 w; w.x = cvt_pk_bf16(v0[0], v0[1]); w.y = cvt_pk_bf16(v0[2], v0[3]); w.z = cvt_pk_bf16(v1[0], v1[1]); w.w = cvt_pk_bf16(v1[2], v1[3]);
                    *(u32x4*)(rowp + bj * HALF) = w; } }
        asm volatile("s_waitcnt lgkmcnt(0)" ::: "memory"); __builtin_amdgcn_s_barrier(); asm volatile("" ::: "memory");
    }
};
template <bool BASE_F32>
struct EpiResGate {
    static constexpr bool PERM = true, AFTER_DRAIN = false;
    const void* base; bf16_t* out; const float* gate; float* ssp;
    __device__ __forceinline__ void operator()(const f32x4 (&acc)[2][2][4][2], const Unit& u, int wr, int wc, int fr, int fq) const {
        const int row0 = u.pm * BM + wr * 64 + fr, b = (u.pm * BM) / SEQ, col0 = u.pn * BM + wc * 32 + 8 * fq;
        f32x4 gv[2][2];
#pragma unroll
        for (int bj = 0; bj < 2; ++bj)
#pragma unroll
            for (int n = 0; n < 2; ++n) gv[bj][n] = *(const f32x4*)(gate + (size_t)b * 6144 + col0 + bj * HALF + n * 4);
        constexpr int MB = BASE_F32 ? 2 : 4;
#pragma unroll
        for (int ai = 0; ai < 2; ++ai)
#pragma unroll
            for (int m0 = 0; m0 < 4; m0 += MB) {
                f32x4 rf[MB][2][BASE_F32 ? 2 : 1]; u32x4 rx[MB][2];
#pragma unroll
                for (int mm = 0; mm < MB; ++mm) { const size_t off = (size_t)(row0 + ai * HALF + (m0 + mm) * 16) * D + col0;
#pragma unroll
                    for (int bj = 0; bj < 2; ++bj) {
                        if (BASE_F32) { rf[mm][bj][0] = *(const f32x4*)((const float*)base + off + bj * HALF); rf[mm][bj][BASE_F32 ? 1 : 0] = *(const f32x4*)((const float*)base + off + bj * HALF + 4); }
                        else rx[mm][bj] = *(const u32x4*)((const bf16_t*)base + off + bj * HALF); } }
#pragma unroll
                for (int mm = 0; mm < MB; ++mm) { const int m = m0 + mm; const size_t off = (size_t)(row0 + ai * HALF + m * 16) * D + col0; float sq = 0.f;
#pragma unroll
                    for (int bj = 0; bj < 2; ++bj) { f32x4 b0, b1;
                        if (BASE_F32) { b0 = rf[mm][bj][0]; b1 = rf[mm][bj][BASE_F32 ? 1 : 0]; }
                        else { const u32x4 x8 = rx[mm][bj];
                            b0[0] = __uint_as_float(x8.x << 16); b0[1] = __uint_as_float(x8.x & 0xffff0000u); b0[2] = __uint_as_float(x8.y << 16); b0[3] = __uint_as_float(x8.y & 0xffff0000u);
                            b1[0] = __uint_as_float(x8.z << 16); b1[1] = __uint_as_float(x8.z & 0xffff0000u); b1[2] = __uint_as_float(x8.w << 16); b1[3] = __uint_as_float(x8.w & 0xffff0000u); }
                        const f32x4 o0 = b0 + gv[bj][0] * acc[ai][bj][m][0], o1 = b1 + gv[bj][1] * acc[ai][bj][m][1];
                        sq += ((o0[0] * o0[0] + o0[1] * o0[1]) + (o0[2] * o0[2] + o0[3] * o0[3])) + ((o1[0] * o1[0] + o1[1] * o1[1]) + (o1[2] * o1[2] + o1[3] * o1[3]));
                        u32x4 w8; w8.x = cvt_pk_bf16(o0[0], o0[1]); w8.y = cvt_pk_bf16(o0[2], o0[3]); w8.z = cvt_pk_bf16(o1[0], o1[1]); w8.w = cvt_pk_bf16(o1[2], o1[3]);
                        *(u32x4*)(out + off + bj * HALF) = w8; }
                    sq = xhalf_sum(x16_sum(sq));
                    if (fq == 0) ssp[(size_t)(row0 + ai * HALF + m * 16) * 16 + u.pn * 4 + wc] = sq; }
            }
    }
};
}

#define XB_TMO      128
#define XB_XCNT(j)  (256  + 64 * (j))
#define XB_XSUB(j)  (1280 + 64 * (j))
#define XB_XGEN(j)  (2304 + 64 * (j))
#define XB_TOP      3328
#define XB_TOPGEN   3392
#define XCD_BAR_WORDS 3456
#define XB_SPIN_CAP (1u << 18)

__device__ __forceinline__ unsigned xb_ld(unsigned* p)              { return __hip_atomic_load(p, __ATOMIC_RELAXED, __HIP_MEMORY_SCOPE_AGENT); }
__device__ __forceinline__ unsigned xb_add(unsigned* p, unsigned v) { return __hip_atomic_fetch_add(p, v, __ATOMIC_RELAXED, __HIP_MEMORY_SCOPE_AGENT); }
__device__ __forceinline__ unsigned xb_xcc_id() { return (unsigned)__builtin_amdgcn_s_getreg((3 << 11) | 20) & 0xFu; }
#define XB_SPIN(cond, bar) do { unsigned _sp = 0; while (cond) { __builtin_amdgcn_s_sleep(1); \
    if ((++_sp & 255u) == 0u) { if (xb_ld(&(bar)[XB_TMO])) break; if (_sp > XB_SPIN_CAP) { atomicAdd(&(bar)[XB_TMO], 1u); break; } } } } while (0)

struct XcdBarrier {
    unsigned* bar; unsigned x;
    volatile LAS unsigned* st;
};

__device__ __forceinline__ XcdBarrier xcd_barrier_post(unsigned* bar, volatile LAS unsigned* st) {
    XcdBarrier b; b.bar = bar; b.x = xb_xcc_id(); b.st = st;
    if (threadIdx.x == 0) (void)xb_add(&bar[XB_XCNT(b.x)], 1u);
    return b;
}
__device__ __forceinline__ void xcd_barrier_complete(unsigned* bar, unsigned x, unsigned& nloc, unsigned& nx) {
    const unsigned G = gridDim.x * gridDim.y * gridDim.z;
    unsigned sum, cnt, mine, sp = 0u;
    for (;;) {
        sum = 0u; cnt = 0u; mine = 0u;
#pragma unroll
        for (unsigned j = 0; j < 16; ++j) { const unsigned c = xb_ld(&bar[XB_XCNT(j)]); sum += c; cnt += (c > 0u) ? 1u : 0u; mine = (j == x) ? c : mine; }
        if (sum == G) break;
        __builtin_amdgcn_s_sleep(1);
        if ((++sp & 255u) == 0u) { if (xb_ld(&bar[XB_TMO])) break; if (sp > XB_SPIN_CAP) { atomicAdd(&bar[XB_TMO], 1u); break; } }
    }
    nloc = mine > 0u ? mine : 1u; nx = cnt > 0u ? cnt : 1u;
}

__device__ __forceinline__ void xcd_barrier(const XcdBarrier& b) {
    asm volatile("s_waitcnt vmcnt(0)" ::: "memory");
    __syncthreads();
    if (threadIdx.x == 0) {
        unsigned* bar = b.bar;
        __builtin_amdgcn_s_waitcnt(0);
        unsigned nloc = b.st[0], nx = b.st[1];
        if (nloc == 0u) { xcd_barrier_complete(bar, b.x, nloc, nx); b.st[0] = nloc; b.st[1] = nx; }
        const unsigned old = xb_add(&bar[XB_XSUB(b.x)], 1u);
        const unsigned gen = old / nloc;
        if (old + 1u == (gen + 1u) * nloc) {
            __builtin_amdgcn_fence(__ATOMIC_RELEASE, "agent");
            asm volatile("s_waitcnt vmcnt(0)" ::: "memory");
            const unsigned og = xb_add(&bar[XB_TOP], 1u);
            const unsigned tg = og / nx;
            if (og + 1u == (tg + 1u) * nx) xb_add(&bar[XB_TOPGEN], 1u);
            else XB_SPIN(xb_ld(&bar[XB_TOPGEN]) == tg, bar);
            __builtin_amdgcn_fence(__ATOMIC_ACQUIRE, "agent");
            xb_add(&bar[XB_XGEN(b.x)], 1u);
            asm volatile("s_waitcnt vmcnt(0)" ::: "memory");
        } else {
            XB_SPIN(xb_ld(&bar[XB_XGEN(b.x)]) == gen, bar);
            __builtin_amdgcn_fence(__ATOMIC_ACQUIRE, "agent");
            asm volatile("s_waitcnt vmcnt(0)" ::: "memory");
        }
    }
    __syncthreads();
}

#define LDS_WAIT() asm volatile("s_waitcnt lgkmcnt(0)" ::: "memory")
template <int MODE>
__device__ __forceinline__ void transpose_item(const float* W, int ldw, int K, bf16_t* WT, int row_off, float* scr, int kb, int nb, int lane, const float* kscale) {
    const int k0 = 64 * kb, n0 = 32 * nb;
#pragma unroll 32
    for (int i = 0; i < 32; ++i) { const int kk = 2 * i + (lane >> 5); float v = W[(size_t)(k0 + kk) * ldw + n0 + (lane & 31)]; if (kscale) v *= kscale[k0 + kk]; scr[kk * 33 + (lane & 31)] = v; }
    LDS_WAIT(); asm volatile("" ::: "memory");
    const int c = lane & 7;
#pragma unroll
    for (int j = 0; j < 4; ++j) { const int n = (lane >> 3) + 8 * j; const float* s = scr + (8 * c) * 33 + n;
        u32x4 o; o.x = pk2(s[0 * 33], s[1 * 33]); o.y = pk2(s[2 * 33], s[3 * 33]); o.z = pk2(s[4 * 33], s[5 * 33]); o.w = pk2(s[6 * 33], s[7 * 33]);
        const int ng = n0 + n, orow = MODE == 1 ? (row_off + 32 * (ng >> 4) + (ng & 15)) : (row_off + ng);
        if (MODE == 1) {
            const int kk = k0 + 8 * c; const size_t blk = ((size_t)(orow >> 5) * 32 + (kk >> 5)) * 2 + ((orow >> 4) & 1);
            *(u32x4*)(WT + (blk * 64 + ((kk >> 3) & 3) * 16 + (orow & 15)) * 8) = o;
        } else if (MODE == 3) {
            const int kk = k0 + 8 * c, u = orow & 31; const size_t blk = (size_t)(2 * (orow >> 5) + ((u >> 2) & 1)) * (K >> 5) + (kk >> 5);
            *(u32x4*)(WT + (blk * 64 + ((kk >> 3) & 3) * 16 + 4 * (u >> 3) + (u & 3)) * 8) = o;
        } else if (MODE == 2) {
            const int kk = k0 + 8 * c; const size_t blk = (size_t)(orow >> 4) * (K >> 5) + (kk >> 5);
            *(u32x4*)(WT + (blk * 64 + ((kk >> 3) & 3) * 16 + (orow & 15)) * 8) = o;
        } else *(u32x4*)(WT + (size_t)orow * K + k0 + 8 * c) = o; }
    LDS_WAIT(); asm volatile("" ::: "memory");
}
__device__ __forceinline__ void phase_convert(const Params& P, const Geo& g, float* ldsf) {
    float* scr = ldsf + g.wave * (64 * 33);
    const int gw = g.vcu * 8 + g.wave, NGW = g.G * 8;
    unsigned char* ws = P.ws;
    for (int e = gw * 64 + g.lane; e < DEPTH * 48 * D; e += NGW * 64) { const int Lr = e / (48 * D), rem = e % (48 * D), ct = rem / (16 * D), s_ = (rem / 512) & 31, ln = (rem >> 3) & 63, jj = rem & 7;
        const int j = 16 * ct + (ln & 15), k = 32 * s_ + 8 * (ln >> 4) + jj;
        const float v = j < 4 ? P.in[I_WG][((size_t)Lr * D + k) * 4 + j] : (j < 36 ? P.in[I_WE][((size_t)Lr * D + k) * 32 + j - 4] : 0.f);
        const unsigned hi = f2bf(v); ((bf16_t*)(ws + WS_WRH))[e] = (bf16_t)hi; ((bf16_t*)(ws + WS_WRL))[e] = (bf16_t)f2bf(v - bf2f(hi)); }
    for (int e = gw * 64 + g.lane; e < 2 * 32 * D; e += NGW * 64) { const int ir = e / (32 * D), rem = e % (32 * D), ct = rem / (16 * D), s_ = (rem / 512) & 31, ln = (rem >> 3) & 63, jj = rem & 7;
        const int j = 16 * ct + (ln & 15), k = 32 * s_ + 8 * (ln >> 4) + jj;
        const float v = P.in[I_SSMIN][((size_t)ir * D + k) * SSM_IN + 6144 + j];
        const unsigned hi = f2bf(v); ((bf16_t*)(ws + WS_WDH))[e] = (bf16_t)hi; ((bf16_t*)(ws + WS_WDL))[e] = (bf16_t)f2bf(v - bf2f(hi)); }
    constexpr int C0 = 2 * 1024, C1 = C0 + 2 * 512, C2 = C1 + 2 * 2048, C3 = C2 + 2 * 1024, C4 = C3 + 2 * 1024, C5 = C4 + 8 * 8, C6 = C5 + 128 * 64, C7 = C6 + 128 * 64, C8 = C7 + 128 * 64;
    for (int it = gw; it < C8; it += NGW) {
        int r = it;
        if (r < C0) { const int mat = r / 1024, rem = r % 1024;
            transpose_item<0>(P.in[I_MIXIN] + (size_t)mat * D * MIX_IN, MIX_IN, D, (bf16_t*)(ws + WS_WMI) + (size_t)mat * MIX_IN * D, 0, scr, rem / 64, rem % 64, g.lane, nullptr); continue; }
        r -= C0;
        if (r < 2 * 512) { const int mat = r / 512, rem = r % 512;
            transpose_item<0>(P.in[I_MIXOUT] + (size_t)mat * D * D, D, D, (bf16_t*)(ws + WS_WMO) + (size_t)mat * D * D, 0, scr, rem / 32, rem % 32, g.lane, nullptr); continue; }
        r -= 2 * 512;
        if (r < 2 * 2048) { const int mat = r / 2048, rem = r % 2048;
            transpose_item<0>(P.in[I_SSMIN] + (size_t)mat * D * SSM_IN + 2048, SSM_IN, D, (bf16_t*)(ws + WS_WSX) + (size_t)mat * 4096 * D, 0, scr, rem / 128, rem % 128, g.lane, nullptr); continue; }
        r -= 2 * 2048;
        if (r < 2 * 1024) { const int mat = r / 1024, rem = r % 1024;
            transpose_item<0>(P.in[I_SSMIN] + (size_t)mat * D * SSM_IN, SSM_IN, D, (bf16_t*)(ws + WS_WSZ) + (size_t)mat * 2048 * D, 0, scr, rem / 64, rem % 64, g.lane, nullptr); continue; }
        r -= 2 * 1024;
        if (r < 2 * 1024) { const int mat = r / 1024, rem = r % 1024;
            transpose_item<0>(P.in[I_SSMOUT] + (size_t)mat * SSM_DI * D, D, SSM_DI, (bf16_t*)(ws + WS_WSO) + (size_t)mat * D * SSM_DI, 0, scr, rem / 32, rem % 32, g.lane, P.in[I_SSMNW] + mat * SSM_DI); continue; }
        r -= 2 * 1024;
        if (r < 64) { const int mat = r / 8, rem = r % 8;
            transpose_item<0>(P.in[I_POOLW] + (size_t)mat * 128 * 128, 128, 128, (bf16_t*)(ws + WS_WPL) + (size_t)mat * 128 * 128, 0, scr, rem / 4, rem % 4, g.lane, nullptr); continue; }
        r -= 64;
        if (r < 128 * 64) { const int mat = r / 64, rem = r % 64;
            transpose_item<1>(P.in[I_W1] + (size_t)mat * D * MOE_FF, MOE_FF, D, (bf16_t*)(ws + WS_W13) + (size_t)mat * 256 * D, 0, scr, rem / 4, rem % 4, g.lane, nullptr); continue; }
        r -= 128 * 64;
        if (r < 128 * 64) { const int mat = r / 64, rem = r % 64;
            transpose_item<1>(P.in[I_W3] + (size_t)mat * D * MOE_FF, MOE_FF, D, (bf16_t*)(ws + WS_W13) + (size_t)mat * 256 * D, 16, scr, rem / 4, rem % 4, g.lane, nullptr); continue; }
        r -= 128 * 64;
        { const int mat = r / 64, rem = r % 64;
            transpose_item<3>(P.in[I_W2] + (size_t)mat * MOE_FF * D, D, MOE_FF, (bf16_t*)(ws + WS_W2T) + (size_t)mat * D * MOE_FF, 0, scr, rem / 32, rem % 32, g.lane, nullptr); }
    }
}


#define LDS_BARRIER() do { asm volatile("s_waitcnt lgkmcnt(0)" ::: "memory"); __builtin_amdgcn_s_barrier(); asm volatile("" ::: "memory"); } while (0)
template <int NMT>
__device__ __forceinline__ void moe_pass(const Params& P, LAS unsigned char* l3, int L, int w, int lane, int bucket, int off, int nrows, int e0, int e1, bool dry) {
    constexpr int HS = 528, OFF_B1 = 67584, OFF_GT = 67584;
    constexpr int OFF_TOK = 133120, OFF_WLO = OFF_TOK + 512, OFF_WHI = OFF_WLO + 512;
    LAS int* tok = (LAS int*)(l3 + OFF_TOK); LAS float* wlo = (LAS float*)(l3 + OFF_WLO); LAS float* whi = (LAS float*)(l3 + OFF_WHI);
    unsigned char* ws = P.ws;
    const int* list = (const int*)(ws + WS_LIST);
    const float2* tokw = (const float2*)(ws + WS_TOKW);
    const bf16_t* H = (const bf16_t*)P.out;
    const float* gate2 = (const float*)(ws + WS_MOD) + (size_t)L * NB * 6144 + 5120;
    const int j16 = lane & 15, q4 = lane >> 4, tid = w * 64 + lane;
    float2 tww = make_float2(0.f, 0.f);
    if (tid < 128) { const int r = tid; int t = -1;
        if (r < nrows) { t = list[(size_t)bucket * T + off + r]; tww = tokw[t]; }
        tok[r] = t; }
    LDS_BARRIER();
#define MOE_GATHER(KC, BO) do { if (w < NMT) { _Pragma("unroll") for (int i = 0; i < 8; ++i) { int t = tok[16 * w + 2 * i + (lane >> 5)]; t = t < 0 ? 0 : t; \
        const int s = (lane & 31) ^ ((2 * i + (lane >> 5)) & 15); \
        __builtin_amdgcn_global_load_lds((const unsigned*)(H + (size_t)t * D + (KC) * 256 + s * 8), (LAS unsigned*)(l3 + (BO) + (16 * w + 2 * i) * 512), 16, 0, 0); } } } while (0)
    f32x4 gtv[4];
    {
        const char* Wu0 = (const char*)(ws + WS_W13) + ((size_t)(L * MOE_E + e0) * 256 * D + (size_t)w * 32 * 1024) * 2;
        const char* Wu1 = (const char*)(ws + WS_W13) + ((size_t)(L * MOE_E + e1) * 256 * D + (size_t)w * 32 * 1024) * 2;
        const unsigned lo16 = (unsigned)lane * 16u;
#define W13F(U, KS, S) (*(const bf16x8*)((U) + (size_t)(lo16 + (unsigned)(2048 * (KS) + 1024 * (S)))))
        f32x4 acc[2][NMT][2];
#pragma unroll
        for (int es = 0; es < 2; ++es)
#pragma unroll
            for (int mt = 0; mt < NMT; ++mt) { acc[es][mt][0] = (f32x4){0.f, 0.f, 0.f, 0.f}; acc[es][mt][1] = (f32x4){0.f, 0.f, 0.f, 0.f}; }
        MOE_GATHER(0, 0);
        asm volatile("" ::: "memory");
        bf16x8 rb[2][4];
#pragma unroll
        for (int j = 0; j < 2; ++j) { rb[j][0] = W13F(Wu0, j, 0); rb[j][1] = W13F(Wu0, j, 1); rb[j][2] = W13F(Wu1, j, 0); rb[j][3] = W13F(Wu1, j, 1); }
        if (tid < 128) { wlo[tid] = tww.x; whi[tid] = tww.y; }
        asm volatile("s_waitcnt vmcnt(8)" ::: "memory");
        LDS_BARRIER();
#pragma unroll 1
        for (int kc = 0; kc < 4; ++kc) {
            int lk = lane; asm volatile("" : "+v"(lk));
            const int lane = lk, j16 = lane & 15, q4 = lane >> 4; const unsigned lo16 = (unsigned)lane * 16u;
            const int aoff = j16 * 512 + ((q4 ^ j16) << 4);
            const int bo = (kc & 1) ? OFF_B1 : 0;
            if (kc < 3) { if (kc & 1) MOE_GATHER(kc + 1, 0); else MOE_GATHER(kc + 1, OFF_B1); }
            asm volatile("" ::: "memory");
#pragma unroll
            for (int ksl = 0; ksl < 8; ++ksl) {
                const int ks = 8 * kc + ksl;
                const LAS unsigned char* ap = l3 + bo + (aoff ^ (ksl << 6));
#pragma unroll
                for (int mt = 0; mt < NMT; ++mt) { const bf16x8 a = *(const LAS bf16x8*)(ap + mt * 8192);
                    acc[0][mt][0] = __builtin_amdgcn_mfma_f32_16x16x32_bf16(a, rb[ksl & 1][0], acc[0][mt][0], 0, 0, 0);
                    acc[0][mt][1] = __builtin_amdgcn_mfma_f32_16x16x32_bf16(a, rb[ksl & 1][1], acc[0][mt][1], 0, 0, 0); }
                if (kc < 3 || ksl < 6) { rb[ksl & 1][0] = W13F(Wu0, ks + 2, 0); rb[ksl & 1][1] = W13F(Wu0, ks + 2, 1); }
                __builtin_amdgcn_sched_barrier(0);
#pragma unroll
                for (int mt = 0; mt < NMT; ++mt) { const bf16x8 a = *(const LAS bf16x8*)(ap + mt * 8192);
                    acc[1][mt][0] = __builtin_amdgcn_mfma_f32_16x16x32_bf16(a, rb[ksl & 1][2], acc[1][mt][0], 0, 0, 0);
                    acc[1][mt][1] = __builtin_amdgcn_mfma_f32_16x16x32_bf16(a, rb[ksl & 1][3], acc[1][mt][1], 0, 0, 0); }
                if (kc < 3 || ksl < 6) { rb[ksl & 1][2] = W13F(Wu1, ks + 2, 0); rb[ksl & 1][3] = W13F(Wu1, ks + 2, 1); }
                __builtin_amdgcn_sched_barrier(0);
            }
            if (kc < 3) { asm volatile("s_waitcnt vmcnt(8)" ::: "memory"); LDS_BARRIER(); }
        }
        int l2 = lane; asm volatile("" : "+v"(l2));
        { const int lane = l2, j16 = lane & 15, q4 = lane >> 4, tid = w * 64 + lane;
#pragma unroll
        for (int i = 0; i < 4; ++i) { const int e = tid + 512 * i; gtv[i] = *(const f32x4*)(gate2 + (size_t)(e >> 8) * 6144 + (e & 255) * 4); }
#pragma unroll
        for (int es = 0; es < 2; ++es)
#pragma unroll
            for (int mt = 0; mt < NMT; ++mt) { LAS bf16_t* hb = (LAS bf16_t*)(l3 + (16 * mt + 4 * q4) * HS) + 128 * es + 16 * w + j16;
#pragma unroll
                for (int r = 0; r < 4; ++r) { const int l = 16 * mt + 4 * q4 + r; const float wt = es ? whi[l] : wlo[l];
                    hb[r * (HS / 2)] = (bf16_t)f2bf(silu_f(acc[es][mt][0][r]) * acc[es][mt][1][r] * wt); } }
        }
    }
#undef MOE_GATHER
#undef W13F
    int l4 = lane; asm volatile("" : "+v"(l4));
    { const int lane = l4, j16 = lane & 15, q4 = lane >> 4, tid = w * 64 + lane;
    LDS_BARRIER();
#pragma unroll
    for (int i = 0; i < 4; ++i) { const int e = tid + 512 * i; *(LAS f32x4*)(l3 + OFF_GT + (e >> 8) * 4112 + (e & 255) * 16) = gtv[i]; }
    LDS_BARRIER();
#pragma unroll 1
    for (int half = 0; half < 2; ++half) {
        int lh = lane; asm volatile("" : "+v"(lh));
        const int lane = lh, j16 = lane & 15, q4 = lane >> 4;
        const int nb = 128 * w + 64 * half;
        f32x4 acc[NMT][4];
#pragma unroll
        for (int mt = 0; mt < NMT; ++mt)
#pragma unroll
            for (int nt = 0; nt < 4; ++nt) acc[mt][nt] = (f32x4){0.f, 0.f, 0.f, 0.f};
        const char* Vu0 = (const char*)(ws + WS_W2T) + ((size_t)(L * MOE_E + e0) * D * MOE_FF + (size_t)(nb >> 4) * 4 * 512) * 2;
        const char* Vu1 = (const char*)(ws + WS_W2T) + ((size_t)(L * MOE_E + e1) * D * MOE_FF + (size_t)(nb >> 4) * 4 * 512) * 2;
        const unsigned lo16b = (unsigned)lane * 16u;
#define W2F(KS, NT) (*(const bf16x8*)((((KS) >> 2) ? Vu1 : Vu0) + (size_t)(lo16b + (unsigned)(1024 * ((KS) & 3) + 4096 * (NT)))))
#define MOE_XLOAD(MG, BUF) do { _Pragma("unroll") for (int m4 = 0; m4 < 2; ++m4) { int t = tok[16 * (2 * (MG) + m4) + j16]; asm volatile("" : "+v"(t)); tt[BUF][m4] = t; const int tc = t < 0 ? 0 : t; \
            const bf16_t* xr_ = (const bf16_t*)(ws + WS_XB) + (size_t)tc * D + nb + 8 * q4; \
            _Pragma("unroll") for (int np = 0; np < 2; ++np) xin[BUF][m4][np] = *(const u32x4*)(xr_ + 32 * np); } } while (0)
        int tt[2][2]; u32x4 xin[2][2][2];
        bf16x8 bw[2][4];
#pragma unroll
        for (int j = 0; j < 2; ++j)
#pragma unroll
            for (int nt = 0; nt < 4; ++nt) bw[j][nt] = W2F(j, nt);
#pragma unroll
        for (int ks = 0; ks < 8; ++ks) {
            bf16x8 b[4];
#pragma unroll
            for (int nt = 0; nt < 4; ++nt) b[nt] = bw[ks & 1][nt];
            if (ks + 2 < 8) {
#pragma unroll
                for (int nt = 0; nt < 4; ++nt) bw[ks & 1][nt] = W2F(ks + 2, nt); }
            if (ks == 6) MOE_XLOAD(0, 0);
#pragma unroll
            for (int mt = 0; mt < NMT; ++mt) { const bf16x8 a = *(const LAS bf16x8*)(l3 + (16 * mt + j16) * HS + (32 * ks + 8 * q4) * 2);
#pragma unroll
                for (int nt = 0; nt < 4; ++nt) acc[mt][nt] = __builtin_amdgcn_mfma_f32_16x16x32_bf16(b[nt], a, acc[mt][nt], 0, 0, 0); }
            __builtin_amdgcn_sched_barrier(0);
        }
#undef W2F
#pragma unroll
        for (int mg = 0; mg < NMT / 2; ++mg) {
            if (mg + 1 < NMT / 2) MOE_XLOAD(mg + 1, (mg + 1) & 1);
#pragma unroll
            for (int m4 = 0; m4 < 2; ++m4) { const int t = tt[mg & 1][m4], mt = 2 * mg + m4; float sq = 0.f;
                if (t >= 0) { const int b = t / SEQ; bf16_t* xr = (bf16_t*)(ws + WS_XB) + (size_t)t * D + nb + 8 * q4; const LAS float* gr = (const LAS float*)(l3 + OFF_GT) + b * 1028 + nb + 8 * q4;
#pragma unroll
                    for (int np = 0; np < 2; ++np) { const f32x4 g0 = *(const LAS f32x4*)(gr + 32 * np), g1 = *(const LAS f32x4*)(gr + 32 * np + 4);
                        const u32x4 x8 = xin[mg & 1][m4][np];
                        f32x4 x0, x1; x0[0] = bf2f(x8.x & 0xffffu); x0[1] = bf2f(x8.x >> 16); x0[2] = bf2f(x8.y & 0xffffu); x0[3] = bf2f(x8.y >> 16);
                        x1[0] = bf2f(x8.z & 0xffffu); x1[1] = bf2f(x8.z >> 16); x1[2] = bf2f(x8.w & 0xffffu); x1[3] = bf2f(x8.w >> 16);
                        const f32x4 o0 = x0 + g0 * acc[mt][2 * np], o1 = x1 + g1 * acc[mt][2 * np + 1];
                        sq += ((o0[0] * o0[0] + o0[1] * o0[1]) + (o0[2] * o0[2] + o0[3] * o0[3])) + ((o1[0] * o1[0] + o1[1] * o1[1]) + (o1[2] * o1[2] + o1[3] * o1[3]));
                        u32x4 w8; w8.x = pk2(o0[0], o0[1]); w8.y = pk2(o0[2], o0[3]); w8.z = pk2(o1[0], o1[1]); w8.w = pk2(o1[2], o1[3]);
                        if (!dry) *(u32x4*)(xr + 32 * np) = w8; } }
                sq = xhalf_sum(x16_sum(sq));
                if (!dry && t >= 0 && q4 == 0) ((float*)(ws + WS_SSP))[(size_t)t * 16 + 2 * w + half] = sq; }
        }
#undef MOE_XLOAD
    }
    }
    __syncthreads();
}
__device__ __forceinline__ void phase_moe(const Params& P, const Geo& g, LAS unsigned char* l3, int L, bool dry = false) {
    constexpr int HS = 528, OFF_B1 = 67584, OFF_GT = 67584;
    constexpr int OFF_TOK = 133120, OFF_WLO = OFF_TOK + 512, OFF_WHI = OFF_WLO + 512, OFF_PF = OFF_WHI + 512;
    LAS int* tok = (LAS int*)(l3 + OFF_TOK); LAS float* wlo = (LAS float*)(l3 + OFF_WLO); LAS float* whi = (LAS float*)(l3 + OFF_WHI); LAS int* pf = (LAS int*)(l3 + OFF_PF);
    unsigned char* ws = P.ws;
    const unsigned* cnt = (const unsigned*)(ws + WS_CTL) + CW_CNT + L * 128 * 16;
    const int* list = (const int*)(ws + WS_LIST);
    const float2* tokw = (const float2*)(ws + WS_TOKW);
    const bf16_t* H = (const bf16_t*)P.out;
    const float* gate2 = (const float*)(ws + WS_MOD) + (size_t)L * NB * 6144 + 5120;
    const int w = g.wave;
    LAS int* cn = pf + 128;
    if (g.tid < 128) { const int c = g.tid < NBUCKET ? (int)cnt[g.tid * 16] : 0; int sc = c;
#pragma unroll
        for (int o = 1; o < 64; o <<= 1) { const int nbv = __shfl_up(sc, o); sc += (g.lane >= o) ? nbv : 0; }
        pf[g.tid] = sc - c; if (g.tid == 63) cn[0] = sc; }
    __syncthreads();
    if (g.tid >= 64 && g.tid < 128) pf[g.tid] += cn[0];
    __syncthreads();
    const int rows_per = (T + g.G - 1) / g.G;
    int cur = g.vcu * rows_per; const int end = min(T, cur + rows_per);
    int bucket = 0;
    if (cur < end) {
#pragma unroll
        for (int st = 64; st > 0; st >>= 1) if (bucket + st <= NBUCKET - 1 && pf[bucket + st] <= cur) bucket += st; }
    while (cur < end) {
        int lane = g.lane; asm volatile("" : "+v"(lane));
        while (pf[bucket + 1] <= cur) ++bucket;
        const int off = cur - pf[bucket];
        const int nrows = min(min(128, end - cur), pf[bucket + 1] - cur);
        cur += nrows;
        const int nmt = (nrows + 15) >> 4;
        const int g4 = bucket / 28; int rem = bucket % 28, elo = 0;
        while (rem >= 7 - elo) { rem -= 7 - elo; ++elo; }
        const int ehi = elo + 1 + rem;
        const int e0 = g4 * 8 + elo, e1 = g4 * 8 + ehi;
        if (nmt > 6) moe_pass<8>(P, l3, L, w, lane, bucket, off, nrows, e0, e1, dry); else if (nmt > 4) moe_pass<6>(P, l3, L, w, lane, bucket, off, nrows, e0, e1, dry);
        else if (nmt > 2) moe_pass<4>(P, l3, L, w, lane, bucket, off, nrows, e0, e1, dry); else moe_pass<2>(P, l3, L, w, lane, bucket, off, nrows, e0, e1, dry);
    }
}


#define MFMA16(a, b, c) __builtin_amdgcn_mfma_f32_16x16x32_bf16(a, b, c, 0, 0, 0)
constexpr size_t WS_SLOC = WS_LIST;
constexpr size_t WS_ATOT = WS_TOKE;
constexpr size_t WS_XHALO = WS_TOKW;
template <int PASS>
__device__ __forceinline__ void scan_units(const Params& P, const Geo& g, LAS unsigned char* l3, int L, bool dry) {
    constexpr bool FULL = PASS >= 2;
    constexpr int S128 = 272, S64 = 144, SCB = 272;
    constexpr int O_CC = 0, O_BC = 17408, O_BCT = 34816, O_CB = 53248, O_XST = 70656, O_XPT = 107520;
    constexpr int O_ACS = 144384, O_DTV = O_ACS + 2048, O_SCL = O_DTV + 2048, O_EAL = O_SCL + 2048, O_HALO = O_EAL + 2048;
    const int i2 = L >> 1, lane = g.lane, w = g.wave, tid = g.tid;
    unsigned char* ws = P.ws;
    bf16_t* XS = (bf16_t*)(ws + WS_XS); const float* DT = (const float*)(ws + WS_DT);
    for (int u = g.vcu; u < 256; u += g.G) {
        const int b = u >> 5, gq = (u >> 2) & 7, sc = u & 3;
        const size_t tb = (size_t)b * SEQ + (size_t)sc * 1024;
        const int cp = tid & 255, half = tid >> 8;
        const bool act = FULL || (cp < 192);
        const int ch = cp < 128 ? (4 * gq) * 64 + 2 * cp : (cp < 192 ? 2048 + gq * 128 + 2 * (cp - 128) : 3072 + gq * 128 + 2 * (cp - 192));
        const unsigned colb = cp < 128 ? (unsigned)ch * 2u : (unsigned)(WS_BC - WS_XS) + (unsigned)(ch - 2048) * 2u;
        const unsigned voff = colb + (unsigned)half * 32u * 4096u;
        const int hd0 = 4 * gq;
        const float Ah_s0 = -__expf(P.in[I_ALOG][i2 * SSM_H + hd0 + (w & 3)]);
        float Dk[2]; Dk[0] = P.in[I_SSMD][i2 * SSM_H + hd0 + (w >> 2)]; Dk[1] = P.in[I_SSMD][i2 * SSM_H + hd0 + 2 + (w >> 2)];
        f32x4 S0[8], S1[8];
#pragma unroll
        for (int i = 0; i < 8; ++i) { S0[i] = (f32x4){0.f, 0.f, 0.f, 0.f}; S1[i] = (f32x4){0.f, 0.f, 0.f, 0.f}; }
        if (PASS == 2 && sc > 0) {
            const float* AT = (const float*)(ws + WS_ATOT);
#pragma unroll 1
            for (int j = 0; j < sc; ++j) {
                const int uj = (u >> 2) * 3 + j;
                float f0 = 0.f, f1 = 0.f;
                for (int i = j + 1; i < sc; ++i) { f0 += AT[((u & ~3) | i) * 4 + (w >> 2)]; f1 += AT[((u & ~3) | i) * 4 + 2 + (w >> 2)]; }
                f0 = __expf(f0); f1 = __expf(f1);
                const u32x4* sp0 = (const u32x4*)(ws + WS_SLOC) + (((size_t)uj * 2 + 0) * 8 + w) * 256 + lane * 4;
                const u32x4* sp1 = (const u32x4*)(ws + WS_SLOC) + (((size_t)uj * 2 + 1) * 8 + w) * 256 + lane * 4;
#pragma unroll
                for (int i = 0; i < 4; ++i) { const u32x4 a = sp0[i], c = sp1[i];
#pragma unroll
                    for (int e = 0; e < 4; ++e) { const int nt = 2 * i + (e >> 1), r = 2 * (e & 1);
                        S0[nt][r] += f0 * bf2f(a[e] & 0xffffu); S0[nt][r + 1] += f0 * bf2f(a[e] >> 16);
                        S1[nt][r] += f1 * bf2f(c[e] & 0xffffu); S1[nt][r + 1] += f1 * bf2f(c[e] >> 16); } }
            }
        }
        float atot = 0.f;
        unsigned raw[35]; float dt_pf = 0.f;
        {
            const char* rb = (const char*)XS + (tb - 3) * 4096;
#pragma unroll
            for (int i = 0; i < 35; ++i) raw[i] = act ? *(const unsigned*)(rb + (size_t)i * 4096 + voff) : 0u;
            if (half == 0) {
                if (sc == 0) { raw[0] = 0u; raw[1] = 0u; raw[2] = 0u; }
                else if (FULL && cp < 128) {
#pragma unroll
                    for (int i = 0; i < 3; ++i) raw[i] = ((const unsigned*)(ws + WS_XHALO))[((size_t)(u - 1) * 3 + i) * 128 + cp]; }
            }
            if (w < 4) dt_pf = DT[(tb + lane) * 32 + hd0 + w];
        }
        __syncthreads();
#pragma unroll 1
        for (int c = 0; c < 16; ++c) {
            const size_t t0 = tb + (size_t)c * 64;
            const int par = c & 1;
            int lane_o = lane; asm volatile("" : "+v"(lane_o));
            const int j16 = lane_o & 15, q4 = lane_o >> 4;
            LAS float* acs = (LAS float*)(l3 + O_ACS) + par * 256; LAS float* dtv = (LAS float*)(l3 + O_DTV) + par * 256;
            LAS float* scl = (LAS float*)(l3 + O_SCL) + par * 256; LAS float* eal = (LAS float*)(l3 + O_EAL) + par * 256;
            if (w < 4) { const float dt = dt_pf; float a = dt * Ah_s0;
                a = wave_incl_scan(a);
                const float aend = wave_last(a);
                acs[w * 64 + lane] = a; dtv[w * 64 + lane] = dt; scl[w * 64 + lane] = dt * __expf(aend - a); eal[w * 64 + lane] = __expf(a);
                atot += aend;
                if (c + 1 < 16) dt_pf = DT[(t0 + 64 + lane) * 32 + hd0 + w]; }
            __syncthreads();
            if (act) {
                int cpo = cp; asm volatile("" : "+v"(cpo));
                float cw0[5], cw1[5];
                { const int cho = cpo < 128 ? (4 * gq) * 64 + 2 * cpo : (cpo < 192 ? 2048 + gq * 128 + 2 * (cpo - 128) : 3072 + gq * 128 + 2 * (cpo - 192));
                  const float* cwp = P.in[I_CONVW] + (size_t)i2 * 4 * SSM_CONV + cho;
#pragma unroll
                  for (int tp = 0; tp < 4; ++tp) { const f32x2 t2 = *(const f32x2*)(cwp + tp * SSM_CONV); cw0[tp] = t2.x; cw1[tp] = t2.y; }
                  const f32x2 t2 = *(const f32x2*)(P.in[I_CONVB] + (size_t)i2 * SSM_CONV + cho); cw0[4] = t2.x; cw1[4] = t2.y; }
                if (c > 0 && cpo < 128 && half == 0) {
#pragma unroll
                    for (int i = 0; i < 3; ++i) raw[i] = *(const LAS unsigned*)(l3 + O_HALO + (((c - 1) & 1) * 3 + i) * 512 + cpo * 4); }
                if (cpo < 128 && half == 1) {
#pragma unroll
                    for (int i = 0; i < 3; ++i) *(LAS unsigned*)(l3 + O_HALO + ((c & 1) * 3 + i) * 512 + cpo * 4) = raw[32 + i];
                    if (PASS == 1 && c == 15) {
#pragma unroll
                        for (int i = 0; i < 3; ++i) ((unsigned*)(ws + WS_XHALO))[((size_t)u * 3 + i) * 128 + cpo] = raw[32 + i]; }
                }
                const int hq = cpo >> 5;
#pragma unroll
                for (int j = 0; j < 8; ++j) {
                    const int l0 = 32 * half + 4 * j;
                    float v0[4], v1[4];
#pragma unroll
                    for (int o = 0; o < 4; ++o) { float a0 = cw0[4], a1 = cw1[4];
#pragma unroll
                        for (int tp = 0; tp < 4; ++tp) { a0 += cw0[tp] * bf2f(raw[4 * j + o + tp] & 0xffffu); a1 += cw1[tp] * bf2f(raw[4 * j + o + tp] >> 16); }
                        v0[o] = silu_f(a0); v1[o] = silu_f(a1); }
                    if (cpo < 128) {
                        const int p = 2 * (cpo & 31);
                        if (FULL) { u32x2 x0, x1; x0.x = pk2(v0[0], v0[1]); x0.y = pk2(v0[2], v0[3]); x1.x = pk2(v1[0], v1[1]); x1.y = pk2(v1[2], v1[3]);
                            *(LAS u32x2*)(l3 + O_XST + hq * 9216 + p * S64 + l0 * 2) = x0; *(LAS u32x2*)(l3 + O_XST + hq * 9216 + (p + 1) * S64 + l0 * 2) = x1; }
                        const f32x4 s4 = *(const LAS f32x4*)(scl + hq * 64 + l0);
                        u32x2 y0, y1; y0.x = pk2(v0[0] * s4.x, v0[1] * s4.y); y0.y = pk2(v0[2] * s4.z, v0[3] * s4.w); y1.x = pk2(v1[0] * s4.x, v1[1] * s4.y); y1.y = pk2(v1[2] * s4.z, v1[3] * s4.w);
                        *(LAS u32x2*)(l3 + O_XPT + hq * 9216 + p * S64 + l0 * 2) = y0; *(LAS u32x2*)(l3 + O_XPT + hq * 9216 + (p + 1) * S64 + l0 * 2) = y1;
                    } else if (cpo < 192) {
                        const int n = 2 * (cpo - 128);
                        if (FULL) {
#pragma unroll
                            for (int o = 0; o < 4; ++o) *(LAS unsigned*)(l3 + O_BC + (l0 + o) * S128 + n * 2) = pk2(v0[o], v1[o]); }
                        u32x2 x0, x1; x0.x = pk2(v0[0], v0[1]); x0.y = pk2(v0[2], v0[3]); x1.x = pk2(v1[0], v1[1]); x1.y = pk2(v1[2], v1[3]);
                        *(LAS u32x2*)(l3 + O_BCT + n * S64 + l0 * 2) = x0; *(LAS u32x2*)(l3 + O_BCT + (n + 1) * S64 + l0 * 2) = x1;
                    } else {
                        const int n = 2 * (cpo - 192);
#pragma unroll
                        for (int o = 0; o < 4; ++o) *(LAS unsigned*)(l3 + O_CC + (l0 + o) * S128 + n * 2) = pk2(v0[o], v1[o]);
                    }
                }
            }
            __syncthreads();
            if (PASS == 3) {
                const int r_ = tid >> 3, pc_ = tid & 7;
                const u32x4 c0_ = *(const LAS u32x4*)(l3 + O_CC + r_ * S128 + pc_ * 32), c1_ = *(const LAS u32x4*)(l3 + O_CC + r_ * S128 + pc_ * 32 + 16);
                u32x4* dst_ = (u32x4*)((bf16_t*)P.out + (size_t)T * D + (t0 + r_) * 1024 + gq * 128 + pc_ * 16);
                dst_[0] = c0_; dst_[1] = c1_; }
            __builtin_amdgcn_sched_barrier(0);
            if (c + 1 < 16 && act) {
                const char* rb = (const char*)XS + (t0 + 61) * 4096;
#pragma unroll
                for (int i = 0; i < 35; ++i) raw[i] = *(const unsigned*)(rb + (size_t)i * 4096 + voff);
            }
            if (FULL) {
                const int lt = w >> 1;
                bf16x8 cf[4];
#pragma unroll
                for (int ks = 0; ks < 4; ++ks) cf[ks] = *(const LAS bf16x8*)(l3 + O_CC + (16 * lt + j16) * S128 + (32 * ks + 8 * q4) * 2);
#pragma unroll
                for (int si = 0; si < 2; ++si) { const int st = 2 * (w & 1) + si;
                    if (st <= lt) { f32x4 acc = (f32x4){0.f, 0.f, 0.f, 0.f};
#pragma unroll
                        for (int ks = 0; ks < 4; ++ks) { const bf16x8 bfr = *(const LAS bf16x8*)(l3 + O_BC + (16 * st + j16) * S128 + (32 * ks + 8 * q4) * 2); acc = MFMA16(cf[ks], bfr, acc); }
#pragma unroll
                        for (int r = 0; r < 4; ++r) *(LAS float*)(l3 + O_CB + (16 * lt + 4 * q4 + r) * SCB + (16 * st + j16) * 4) = acc[r]; } }
                __syncthreads();
            }
#pragma unroll
            for (int rd = 0; rd < 2; ++rd) {
                const int hq = 2 * rd + (w >> 2), ps = w & 3;
                f32x4 (&S)[8] = rd ? S1 : S0;
                if (FULL) {
                    f32x4 yv[4];
#pragma unroll
                    for (int lt = 0; lt < 4; ++lt) yv[lt] = (f32x4){0.f, 0.f, 0.f, 0.f};
#pragma unroll
                    for (int t = 0; t < 4; ++t) { u32x4 a4; a4.x = pk2(S[2 * t][0], S[2 * t][1]); a4.y = pk2(S[2 * t][2], S[2 * t][3]); a4.z = pk2(S[2 * t + 1][0], S[2 * t + 1][1]); a4.w = pk2(S[2 * t + 1][2], S[2 * t + 1][3]);
                        const bf16x8 af = __builtin_bit_cast(bf16x8, a4);
#pragma unroll
                        for (int lt = 0; lt < 4; ++lt) { const LAS unsigned char* cpz = l3 + O_CC + (16 * lt + j16) * S128 + (32 * t + 4 * q4) * 2;
                            const u32x2 lo = *(const LAS u32x2*)cpz, hi = *(const LAS u32x2*)(cpz + 32);
                            u32x4 b4; b4.x = lo.x; b4.y = lo.y; b4.z = hi.x; b4.w = hi.y;
                            yv[lt] = MFMA16(af, __builtin_bit_cast(bf16x8, b4), yv[lt]); } }
#pragma unroll
                    for (int lt = 0; lt < 4; ++lt) yv[lt] = yv[lt] * eal[hq * 64 + 16 * lt + j16];
                    bf16x8 xf[2];
#pragma unroll
                    for (int ks = 0; ks < 2; ++ks) xf[ks] = *(const LAS bf16x8*)(l3 + O_XST + hq * 9216 + (16 * ps + j16) * S64 + (32 * ks + 8 * q4) * 2);
#pragma unroll
                    for (int lt = 0; lt < 4; ++lt) { const int l = 16 * lt + j16; const float al = acs[hq * 64 + l];
#pragma unroll
                        for (int ks = 0; ks < 2; ++ks) { if (32 * ks <= 16 * lt + 15) {
                                const int s0 = 32 * ks + 8 * q4;
                                const f32x4 c0 = *(const LAS f32x4*)(l3 + O_CB + l * SCB + s0 * 4), c1 = *(const LAS f32x4*)(l3 + O_CB + l * SCB + s0 * 4 + 16);
                                const f32x4 a0 = *(const LAS f32x4*)(acs + hq * 64 + s0), a1 = *(const LAS f32x4*)(acs + hq * 64 + s0 + 4);
                                const f32x4 d0 = *(const LAS f32x4*)(dtv + hq * 64 + s0), d1 = *(const LAS f32x4*)(dtv + hq * 64 + s0 + 4);
                                float m[8];
#pragma unroll
                                for (int e = 0; e < 4; ++e) { m[e] = (s0 + e <= l) ? c0[e] * __expf(al - a0[e]) * d0[e] : 0.f; m[4 + e] = (s0 + 4 + e <= l) ? c1[e] * __expf(al - a1[e]) * d1[e] : 0.f; }
                                u32x4 b4; b4.x = pk2(m[0], m[1]); b4.y = pk2(m[2], m[3]); b4.z = pk2(m[4], m[5]); b4.w = pk2(m[6], m[7]);
                                yv[lt] = MFMA16(xf[ks], __builtin_bit_cast(bf16x8, b4), yv[lt]); } }
                        __builtin_amdgcn_sched_barrier(0); }
                    u32x2 yo[4];
#pragma unroll
                    for (int lt = 0; lt < 4; ++lt) { const int l = 16 * lt + j16;
                        float xv[4];
#pragma unroll
                        for (int r = 0; r < 4; ++r) xv[r] = bf2f(*(const LAS bf16_t*)(l3 + O_XST + hq * 9216 + (16 * ps + 4 * q4 + r) * S64 + l * 2));
                        yo[lt].x = pk2(yv[lt][0] + Dk[rd] * xv[0], yv[lt][1] + Dk[rd] * xv[1]); yo[lt].y = pk2(yv[lt][2] + Dk[rd] * xv[2], yv[lt][3] + Dk[rd] * xv[3]); }
#pragma unroll
                    for (int lp = 0; lp < 4; lp += 2) {
                        const auto sx = __builtin_amdgcn_permlane16_swap(yo[lp].x, yo[lp + 1].x, false, false), sy = __builtin_amdgcn_permlane16_swap(yo[lp].y, yo[lp + 1].y, false, false);
                        u32x4 w4; w4.x = sx[0]; w4.y = sy[0]; w4.z = sx[1]; w4.w = sy[1];
                        const size_t yoff = (t0 + 16 * (lp + (q4 & 1)) + j16) * 2048 + (size_t)(hd0 + hq) * 64 + 16 * ps + 8 * (q4 >> 1);
                        bf16_t* yp = dry ? (bf16_t*)(ws + WS_LIST + 12 * MiB) + (yoff & (size_t)(512 * 1024 - 1)) : XS + yoff;
                        *(u32x4*)yp = w4; }
                }
                { const float dec = eal[hq * 64 + 63];
                  bf16x8 xp[2];
#pragma unroll
                  for (int ks = 0; ks < 2; ++ks) xp[ks] = *(const LAS bf16x8*)(l3 + O_XPT + hq * 9216 + (16 * ps + j16) * S64 + (32 * ks + 8 * q4) * 2);
#pragma unroll
                  for (int nt = 0; nt < 8; ++nt) { f32x4 acc = S[nt] * dec;
#pragma unroll
                      for (int ks = 0; ks < 2; ++ks) { const bf16x8 bt = *(const LAS bf16x8*)(l3 + O_BCT + (16 * nt + j16) * S64 + (32 * ks + 8 * q4) * 2); acc = MFMA16(bt, xp[ks], acc); }
                      S[nt] = acc; } }
            }
            __syncthreads();
        }
        if (PASS == 1 || PASS == 3) {
            if (w < 4 && lane == 0) ((float*)(ws + WS_ATOT))[u * 4 + w] = atot;
            const int us = (u >> 2) * 3 + (sc < 3 ? sc : 0);
            u32x4* sp0 = (u32x4*)(ws + WS_SLOC) + (((size_t)us * 2 + 0) * 8 + w) * 256 + lane * 4;
            u32x4* sp1 = (u32x4*)(ws + WS_SLOC) + (((size_t)us * 2 + 1) * 8 + w) * 256 + lane * 4;
            if (sc < 3)
#pragma unroll
            for (int i = 0; i < 4; ++i) { u32x4 a, c;
#pragma unroll
                for (int e = 0; e < 4; ++e) { const int nt = 2 * i + (e >> 1), r = 2 * (e & 1); a[e] = pk2(S0[nt][r], S0[nt][r + 1]); c[e] = pk2(S1[nt][r], S1[nt][r + 1]); }
                sp0[i] = a; sp1[i] = c; }
        }
    }
}

__device__ __forceinline__ void scan_fix(const Params& P, const Geo& g, LAS unsigned char* l3, int L) {
    constexpr int S128 = 272, O_CC = 0, CCB = 17408, O_ECL = 2 * CCB;
    const int i2 = L >> 1, w = g.wave; int tid = g.tid; asm volatile("" : "+v"(tid));
    unsigned char* ws = P.ws;
    bf16_t* XS = (bf16_t*)(ws + WS_XS); const float* DT = (const float*)(ws + WS_DT);
    const bf16_t* CCV = (const bf16_t*)P.out + (size_t)T * D;
    const int NITEM = NB * 8 * 3 * 16, per = (NITEM + g.G - 1) / g.G;
    const int gc0 = g.vcu * per, gc1 = min(NITEM, gc0 + per);
    int cur_uu = -1, gq = 0, hd0 = 0; size_t tb = 0; float Ah_s0 = 0.f, atot = 0.f;
    bf16x8 af[2][4];
    u32x4 cr0, cr1; float dt_pf = 0.f;
#define FIX_GEO(GC, TB_, GQ_) const int uu_ = (GC) >> 4, bg_ = uu_ / 3, sc_ = 1 + uu_ % 3; const int GQ_ = bg_ & 7; const size_t TB_ = (size_t)(bg_ >> 3) * SEQ + (size_t)sc_ * 1024 + (size_t)((GC) & 15) * 64;
    if (gc0 < gc1) { FIX_GEO(gc0, t0n, gqn)
        const u32x4* src = (const u32x4*)(CCV + (t0n + (tid >> 3)) * 1024 + gqn * 128 + (tid & 7) * 16); cr0 = src[0]; cr1 = src[1];
        if (w < 4) dt_pf = DT[(t0n + (tid & 63)) * 32 + 4 * gqn + w]; }
    for (int gc = gc0; gc < gc1; ++gc) {
        int lane = tid & 63; asm volatile("" : "+v"(lane));
        const int j16 = lane & 15, q4 = lane >> 4, par = gc & 1;
        const int uu = gc >> 4, c = gc & 15;
        if (uu != cur_uu) {
            cur_uu = uu;
            const int bg = uu / 3, sc = 1 + uu % 3, u = bg * 4 + sc; gq = bg & 7; hd0 = 4 * gq; tb = (size_t)(bg >> 3) * SEQ + (size_t)sc * 1024;
            Ah_s0 = -__expf(P.in[I_ALOG][i2 * SSM_H + hd0 + (w & 3)]);
            f32x4 S0[8], S1[8];
#pragma unroll
            for (int i = 0; i < 8; ++i) { S0[i] = (f32x4){0.f, 0.f, 0.f, 0.f}; S1[i] = (f32x4){0.f, 0.f, 0.f, 0.f}; }
            const float* AT = (const float*)(ws + WS_ATOT);
#pragma unroll 1
            for (int j = 0; j < sc; ++j) {
                const int uj = (u >> 2) * 3 + j;
                float f0 = 0.f, f1 = 0.f;
                for (int i = j + 1; i < sc; ++i) { f0 += AT[((u & ~3) | i) * 4 + (w >> 2)]; f1 += AT[((u & ~3) | i) * 4 + 2 + (w >> 2)]; }
                f0 = __expf(f0); f1 = __expf(f1);
                const u32x4* sp0 = (const u32x4*)(ws + WS_SLOC) + (((size_t)uj * 2 + 0) * 8 + w) * 256 + lane * 4;
                const u32x4* sp1 = (const u32x4*)(ws + WS_SLOC) + (((size_t)uj * 2 + 1) * 8 + w) * 256 + lane * 4;
#pragma unroll
                for (int i = 0; i < 4; ++i) { const u32x4 a = sp0[i], cc = sp1[i];
#pragma unroll
                    for (int e = 0; e < 4; ++e) { const int nt = 2 * i + (e >> 1), r = 2 * (e & 1);
                        S0[nt][r] += f0 * bf2f(a[e] & 0xffffu); S0[nt][r + 1] += f0 * bf2f(a[e] >> 16);
                        S1[nt][r] += f1 * bf2f(cc[e] & 0xffffu); S1[nt][r + 1] += f1 * bf2f(cc[e] >> 16); } }
            }
#pragma unroll
            for (int t = 0; t < 4; ++t) { u32x4 a4;
                a4.x = pk2(S0[2 * t][0], S0[2 * t][1]); a4.y = pk2(S0[2 * t][2], S0[2 * t][3]); a4.z = pk2(S0[2 * t + 1][0], S0[2 * t + 1][1]); a4.w = pk2(S0[2 * t + 1][2], S0[2 * t + 1][3]);
                af[0][t] = __builtin_bit_cast(bf16x8, a4);
                a4.x = pk2(S1[2 * t][0], S1[2 * t][1]); a4.y = pk2(S1[2 * t][2], S1[2 * t][3]); a4.z = pk2(S1[2 * t + 1][0], S1[2 * t + 1][1]); a4.w = pk2(S1[2 * t + 1][2], S1[2 * t + 1][3]);
                af[1][t] = __builtin_bit_cast(bf16x8, a4); }
            atot = 0.f;
            if (w < 4) { float sdt = 0.f;
                for (int j = 0; j < c; ++j) sdt += DT[(tb + (size_t)j * 64 + lane) * 32 + hd0 + w];
                atot = wave_sum(sdt) * Ah_s0; }
        }
        const size_t t0 = tb + (size_t)c * 64;
        LAS float* ecl = (LAS float*)(l3 + O_ECL) + par * 256;
        *(LAS u32x4*)(l3 + O_CC + par * CCB + (tid >> 3) * S128 + (tid & 7) * 32) = cr0; *(LAS u32x4*)(l3 + O_CC + par * CCB + (tid >> 3) * S128 + (tid & 7) * 32 + 16) = cr1;
        if (w < 4) { float a = dt_pf * Ah_s0;
            a = wave_incl_scan(a);
            ecl[w * 64 + lane] = __expf(atot + a);
            atot += wave_last(a); }
        __syncthreads();
        if (gc + 1 < gc1) { FIX_GEO(gc + 1, t0n, gqn)
            const u32x4* src = (const u32x4*)(CCV + (t0n + (tid >> 3)) * 1024 + gqn * 128 + (tid & 7) * 16); cr0 = src[0]; cr1 = src[1];
            if (w < 4) dt_pf = DT[(t0n + lane) * 32 + 4 * gqn + w]; }
        u32x4 yin[2][2];
#pragma unroll
        for (int rd = 0; rd < 2; ++rd)
#pragma unroll
            for (int lp = 0; lp < 2; ++lp) yin[rd][lp] = *(const u32x4*)(XS + (t0 + 16 * (2 * lp + (q4 & 1)) + j16) * 2048 + (size_t)(hd0 + 2 * rd + (w >> 2)) * 64 + 16 * (w & 3) + 8 * (q4 >> 1));
#pragma unroll
        for (int rd = 0; rd < 2; ++rd) {
            const int hq = 2 * rd + (w >> 2), ps = w & 3;
            f32x4 yv[4];
#pragma unroll
            for (int lt = 0; lt < 4; ++lt) yv[lt] = (f32x4){0.f, 0.f, 0.f, 0.f};
#pragma unroll
            for (int t = 0; t < 4; ++t)
#pragma unroll
                for (int lt = 0; lt < 4; ++lt) { const LAS unsigned char* cpz = l3 + O_CC + par * CCB + (16 * lt + j16) * S128 + (32 * t + 4 * q4) * 2;
                    const u32x2 lo = *(const LAS u32x2*)cpz, hi = *(const LAS u32x2*)(cpz + 32);
                    u32x4 b4; b4.x = lo.x; b4.y = lo.y; b4.z = hi.x; b4.w = hi.y;
                    yv[lt] = MFMA16(af[rd][t], __builtin_bit_cast(bf16x8, b4), yv[lt]); }
#pragma unroll
            for (int lp = 0; lp < 4; lp += 2) {
                const u32x4 L4 = yin[rd][lp >> 1];
                const auto ax = __builtin_amdgcn_permlane16_swap(L4.x, L4.z, false, false), ay = __builtin_amdgcn_permlane16_swap(L4.y, L4.w, false, false);
                u32x2 o[2];
#pragma unroll
                for (int i = 0; i < 2; ++i) { const int lt = lp + i; const float sc_l = ecl[hq * 64 + 16 * lt + j16]; const unsigned yx = ax[i], yy = ay[i];
                    o[i].x = pk2(bf2f(yx & 0xffffu) + sc_l * yv[lt][0], bf2f(yx >> 16) + sc_l * yv[lt][1]); o[i].y = pk2(bf2f(yy & 0xffffu) + sc_l * yv[lt][2], bf2f(yy >> 16) + sc_l * yv[lt][3]); }
                const auto sx = __builtin_amdgcn_permlane16_swap(o[0].x, o[1].x, false, false), sy = __builtin_amdgcn_permlane16_swap(o[0].y, o[1].y, false, false);
                u32x4 w4; w4.x = sx[0]; w4.y = sy[0]; w4.z = sx[1]; w4.w = sy[1];
                *(u32x4*)(XS + (t0 + 16 * (lp + (q4 & 1)) + j16) * 2048 + (size_t)(hd0 + hq) * 64 + 16 * ps + 8 * (q4 >> 1)) = w4; }
        }
    }
#undef FIX_GEO
}

__device__ __forceinline__ void phase_scan(const Params& P, const Geo& g, LAS unsigned char* l3, int L, bool dry = false) {
    constexpr int S128 = 272, S64 = 144;
    constexpr int O_CC = 0, O_BC = 17408, O_BCT = 34816, O_XST = 53248, O_XPT = 62464, O_MM = 71680, O_SBF = 80896;
    constexpr int O_ACS = 98304, O_DTV = 98560, O_CW = 98816, O_HALO = 105216;
    LAS float* acs = (LAS float*)(l3 + O_ACS); LAS float* dtv = (LAS float*)(l3 + O_DTV);
    LAS f32x2* cwl = (LAS f32x2*)(l3 + O_CW);
    const int i2 = L >> 1, lane = g.lane, w = g.wave, tid = g.tid, j16 = lane & 15, q4 = lane >> 4;
    unsigned char* ws = P.ws;
    bf16_t* XS = (bf16_t*)(ws + WS_XS); const bf16_t* BC = (const bf16_t*)(ws + WS_BC); const float* DT = (const float*)(ws + WS_DT);
    for (int u = g.vcu; u < NB * SSM_H; u += g.G) {
        const int b = u / SSM_H, hd = u % SSM_H, gq = hd >> 2;
        const float Ah = -__expf(P.in[I_ALOG][i2 * SSM_H + hd]), Dk = P.in[I_SSMD][i2 * SSM_H + hd];
        const size_t tb = (size_t)b * SEQ;
        if (tid < 160) { const int cp = tid; const int ch = cp < 32 ? hd * 64 + 2 * cp : (cp < 96 ? 2048 + gq * 128 + 2 * (cp - 32) : 3072 + gq * 128 + 2 * (cp - 96));
            const float* cw = P.in[I_CONVW] + (size_t)i2 * 4 * SSM_CONV + ch;
#pragma unroll
            for (int tp = 0; tp < 4; ++tp) cwl[tp * 160 + cp] = (f32x2){cw[tp * SSM_CONV], cw[tp * SSM_CONV + 1]};
            const float* cb = P.in[I_CONVB] + (size_t)i2 * SSM_CONV + ch; cwl[4 * 160 + cp] = (f32x2){cb[0], cb[1]}; }
        for (int e = tid; e < 17408 / 4; e += 512) ((LAS unsigned*)(l3 + O_SBF))[e] = 0u;
        f32x4 S[4];
#pragma unroll
        for (int i = 0; i < 4; ++i) S[i] = (f32x4){0.f, 0.f, 0.f, 0.f};
        unsigned raw[5][7], voff[5]; float dt_pf = 0.f;
        if (w == 0) dt_pf = DT[(tb + lane) * 32 + hd];
#pragma unroll
        for (int k = 0; k < 5; ++k) {
            const int it = tid + 512 * k, cp = it % 160, strip = it / 160, l0 = 4 * strip;
            const unsigned colb = cp < 32 ? (unsigned)(hd * 64 + 2 * cp) * 2u : (unsigned)(WS_BC - WS_XS) + (unsigned)(cp < 96 ? gq * 128 + 2 * (cp - 32) : 1024 + gq * 128 + 2 * (cp - 96)) * 2u;
            voff[k] = (unsigned)l0 * 4096u + colb;
#pragma unroll
            for (int i = 0; i < 7; ++i) { const int rl = l0 - 3 + i; raw[k][i] = (rl >= 0) ? *(const unsigned*)((const char*)XS + (tb + rl) * 4096 + colb) : 0u; }
        }
        __syncthreads();
#pragma unroll 1
        for (int c = 0; c < NCH; ++c) {
            const size_t t0 = tb + (size_t)c * 64;
            if (w == 0) { const float dt = dt_pf; float a = dt * Ah;
#pragma unroll
                for (int o = 1; o < 64; o <<= 1) { const float nbv = __shfl_up(a, o); a += (lane >= o) ? nbv : 0.f; }
                acs[lane] = a; dtv[lane] = dt; }
            __syncthreads();
            const float aend = acs[63];
            int tA = tid; asm volatile("" : "+v"(tA));
#pragma unroll
            for (int k = 0; k < 5; ++k) {
                const int it = tA + 512 * k, cp = it % 160, strip = it / 160, l0 = 4 * strip;
                if (c > 0 && cp < 32 && strip == 0) {
#pragma unroll
                    for (int i = 0; i < 3; ++i) raw[k][i] = *(const LAS unsigned*)(l3 + O_HALO + (((c - 1) & 1) * 3 + i) * 128 + cp * 4); }
                if (cp < 32 && strip == 15) {
#pragma unroll
                    for (int i = 0; i < 3; ++i) *(LAS unsigned*)(l3 + O_HALO + ((c & 1) * 3 + i) * 128 + cp * 4) = raw[k][4 + i]; }
                float wx[5], wy[5];
#pragma unroll
                for (int tp = 0; tp < 5; ++tp) { const f32x2 ww = cwl[tp * 160 + cp]; wx[tp] = ww.x; wy[tp] = ww.y; }
                float v0[4], v1[4];
#pragma unroll
                for (int o = 0; o < 4; ++o) { float a0 = wx[4], a1 = wy[4];
#pragma unroll
                    for (int tp = 0; tp < 4; ++tp) { a0 += wx[tp] * bf2f(raw[k][o + tp] & 0xffffu); a1 += wy[tp] * bf2f(raw[k][o + tp] >> 16); }
                    v0[o] = silu_f(a0); v1[o] = silu_f(a1); }
                if (cp < 32) {
                    const int p = 2 * cp;
                    u32x2 x0, x1; x0.x = pk2(v0[0], v0[1]); x0.y = pk2(v0[2], v0[3]); x1.x = pk2(v1[0], v1[1]); x1.y = pk2(v1[2], v1[3]);
                    *(LAS u32x2*)(l3 + O_XST + p * S64 + l0 * 2) = x0; *(LAS u32x2*)(l3 + O_XST + (p + 1) * S64 + l0 * 2) = x1;
                    float sc[4];
#pragma unroll
                    for (int o = 0; o < 4; ++o) sc[o] = dtv[l0 + o] * __expf(aend - acs[l0 + o]);
                    x0.x = pk2(v0[0] * sc[0], v0[1] * sc[1]); x0.y = pk2(v0[2] * sc[2], v0[3] * sc[3]); x1.x = pk2(v1[0] * sc[0], v1[1] * sc[1]); x1.y = pk2(v1[2] * sc[2], v1[3] * sc[3]);
                    *(LAS u32x2*)(l3 + O_XPT + p * S64 + l0 * 2) = x0; *(LAS u32x2*)(l3 + O_XPT + (p + 1) * S64 + l0 * 2) = x1;
                } else if (cp < 96) {
                    const int n = 2 * (cp - 32);
#pragma unroll
                    for (int o = 0; o < 4; ++o) *(LAS unsigned*)(l3 + O_BC + (l0 + o) * S128 + n * 2) = pk2(v0[o], v1[o]);
                    u32x2 x0, x1; x0.x = pk2(v0[0], v0[1]); x0.y = pk2(v0[2], v0[3]); x1.x = pk2(v1[0], v1[1]); x1.y = pk2(v1[2], v1[3]);
                    *(LAS u32x2*)(l3 + O_BCT + n * S64 + l0 * 2) = x0; *(LAS u32x2*)(l3 + O_BCT + (n + 1) * S64 + l0 * 2) = x1;
                } else {
                    const int n = 2 * (cp - 96);
#pragma unroll
                    for (int o = 0; o < 4; ++o) *(LAS unsigned*)(l3 + O_CC + (l0 + o) * S128 + n * 2) = pk2(v0[o], v1[o]);
                }
            }
            __syncthreads();
            if (c + 1 < NCH) {
                if (w == 0) dt_pf = DT[(t0 + 64 + lane) * 32 + hd];
                const char* rb = (const char*)XS + (t0 + 61) * 4096;
#pragma unroll
                for (int i = 0; i < 7; ++i)
#pragma unroll
                    for (int k = 0; k < 5; ++k) raw[k][i] = *(const unsigned*)(rb + (size_t)i * 4096 + voff[k]);
            }
            const int lt = w >> 1, h2 = w & 1;
            f32x4 yo[2];
            {
                bf16x8 cf[4];
#pragma unroll
                for (int ks = 0; ks < 4; ++ks) cf[ks] = *(const LAS bf16x8*)(l3 + O_CC + (16 * lt + j16) * S128 + (32 * ks + 8 * q4) * 2);
#pragma unroll
                for (int si = 0; si < 2; ++si) { const int st = 2 * h2 + si;
                    f32x4 acc = (f32x4){0.f, 0.f, 0.f, 0.f};
                    if (st <= lt) {
#pragma unroll
                        for (int ks = 0; ks < 4; ++ks) { const bf16x8 bfr = *(const LAS bf16x8*)(l3 + O_BC + (16 * st + j16) * S128 + (32 * ks + 8 * q4) * 2); acc = MFMA16(cf[ks], bfr, acc); } }
                    const int sidx = 16 * st + j16; const float as = acs[sidx], ds = dtv[sidx];
#pragma unroll
                    for (int r = 0; r < 4; ++r) { const int l = 16 * lt + 4 * q4 + r;
                        const float m = (sidx <= l) ? acc[r] * __expf(acs[l] - as) * ds : 0.f;
                        *(LAS bf16_t*)(l3 + O_MM + l * S64 + sidx * 2) = (bf16_t)f2bf(m); } }
#pragma unroll
                for (int pi = 0; pi < 2; ++pi) { const int pt = 2 * h2 + pi; f32x4 acc = (f32x4){0.f, 0.f, 0.f, 0.f};
#pragma unroll
                    for (int ks = 0; ks < 4; ++ks) { const bf16x8 sf = *(const LAS bf16x8*)(l3 + O_SBF + (16 * pt + j16) * S128 + (32 * ks + 8 * q4) * 2); acc = MFMA16(cf[ks], sf, acc); }
                    yo[pi] = acc; }
            }
            {
                const float dec = __expf(aend);
                bf16x8 xf[2];
#pragma unroll
                for (int ks = 0; ks < 2; ++ks) xf[ks] = *(const LAS bf16x8*)(l3 + O_XPT + (16 * lt + j16) * S64 + (32 * ks + 8 * q4) * 2);
#pragma unroll
                for (int ni = 0; ni < 4; ++ni) { const int nt = 4 * h2 + ni; f32x4 acc = S[ni] * dec;
#pragma unroll
                    for (int ks = 0; ks < 2; ++ks) { const bf16x8 bt = *(const LAS bf16x8*)(l3 + O_BCT + (16 * nt + j16) * S64 + (32 * ks + 8 * q4) * 2); acc = MFMA16(xf[ks], bt, acc); }
                    S[ni] = acc; }
            }
            __syncthreads();
            {
                bf16x8 mf[2];
#pragma unroll
                for (int ks = 0; ks < 2; ++ks) mf[ks] = *(const LAS bf16x8*)(l3 + O_MM + (16 * lt + j16) * S64 + (32 * ks + 8 * q4) * 2);
#pragma unroll
                for (int pi = 0; pi < 2; ++pi) { const int pt = 2 * h2 + pi, p = 16 * pt + j16; f32x4 acc = (f32x4){0.f, 0.f, 0.f, 0.f};
#pragma unroll
                    for (int ks = 0; ks < 2; ++ks) { const bf16x8 xt = *(const LAS bf16x8*)(l3 + O_XST + (16 * pt + j16) * S64 + (32 * ks + 8 * q4) * 2); acc = MFMA16(mf[ks], xt, acc); }
                    const u32x2 xv = *(const LAS u32x2*)(l3 + O_XST + p * S64 + (16 * lt + 4 * q4) * 2);
                    const float xs0 = bf2f(xv.x & 0xffffu), xs1 = bf2f(xv.x >> 16), xs2 = bf2f(xv.y & 0xffffu), xs3 = bf2f(xv.y >> 16);
                    const int lb = 16 * lt + 4 * q4;
                    const size_t yoff = (t0 + lb) * 2048 + hd * 64 + p;
                    bf16_t* yp = dry ? (bf16_t*)(ws + WS_LIST) + (yoff & (size_t)(4 * 1024 * 1024 - 1)) : XS + yoff;
                    yp[0] = (bf16_t)f2bf(acc[0] + __expf(acs[lb]) * yo[pi][0] + Dk * xs0);
                    yp[2048] = (bf16_t)f2bf(acc[1] + __expf(acs[lb + 1]) * yo[pi][1] + Dk * xs1);
                    yp[4096] = (bf16_t)f2bf(acc[2] + __expf(acs[lb + 2]) * yo[pi][2] + Dk * xs2);
                    yp[6144] = (bf16_t)f2bf(acc[3] + __expf(acs[lb + 3]) * yo[pi][3] + Dk * xs3); }
#pragma unroll
                for (int ni = 0; ni < 4; ++ni) { const int n = 16 * (4 * h2 + ni) + j16;
#pragma unroll
                    for (int r = 0; r < 4; ++r) *(LAS bf16_t*)(l3 + O_SBF + (16 * lt + 4 * q4 + r) * S128 + n * 2) = (bf16_t)f2bf(S[ni][r]); }
            }
            __syncthreads();
        }
    }
}


typedef float f32x16 __attribute__((ext_vector_type(16)));
#define MFMA32(a, b, c) __builtin_amdgcn_mfma_f32_32x32x16_bf16(a, b, c, 0, 0, 0)
__device__ __forceinline__ void phase_e2(const Params& P, const Geo& g, LAS unsigned char* l3, int L) {
    const int i2 = L >> 1, lane = g.lane, w = g.wave, tid = g.tid, j16 = lane & 15, q4 = lane >> 4;
    unsigned char* ws = P.ws;
    const bf16_t* U = (const bf16_t*)(ws + WS_U); bf16_t* CAT = (bf16_t*)(ws + WS_CAT);
    {
        constexpr int O_UT = 0, O_PL = 20480, PS = 272;
        u32x4 pre[3];
#define POOL_FETCH(UU) do { const int gi_ = (UU) & 3, t0_ = ((UU) >> 2) * 64, s0_ = t0_ % SEQ; \
            _Pragma("unroll") for (int i = 0; i < 3; ++i) { const int e = tid + 512 * i, r = e >> 4, c16 = e & 15; pre[i] = (u32x4){0u, 0u, 0u, 0u}; \
                if (e < 79 * 16 && s0_ - 15 + r >= 0) pre[i] = *(const u32x4*)(U + (size_t)(t0_ - 15 + r) * 512 + gi_ * 128 + c16 * 8); } } while (0)
        if (g.vcu < (T / 64) * 4) POOL_FETCH(g.vcu);
        for (int u = g.vcu; u < (T / 64) * 4; u += g.G) {
            const int gi = u & 3, t0 = (u >> 2) * 64, s0 = t0 % SEQ, win = 2 << gi;
#pragma unroll
            for (int i = 0; i < 3; ++i) { const int e = tid + 512 * i, r = e >> 4, c16 = e & 15; if (e < 79 * 16) *(LAS u32x4*)(l3 + O_UT + r * 256 + c16 * 16) = pre[i]; }
            const bf16_t* Wb = (const bf16_t*)(ws + WS_WPL) + ((size_t)(i2 * 4 + gi) * 128 + 16 * w + j16) * 128 + 8 * q4;
            bf16x8 bwp[4];
#pragma unroll
            for (int ks = 0; ks < 4; ++ks) bwp[ks] = *(const bf16x8*)(Wb + 32 * ks);
            const f32x4 ps = *(const f32x4*)(P.in[I_POOLS] + i2 * 512 + gi * 128 + 16 * w + 4 * q4);
            __syncthreads();
            if (u + g.G < (T / 64) * 4) POOL_FETCH(u + g.G);
            { const int l = tid >> 3, cb = (tid & 7) * 16, s = s0 + l; const int cnt = (s + 1 < win) ? s + 1 : win;
                float acc[16];
#pragma unroll
                for (int i = 0; i < 16; ++i) acc[i] = 0.f;
                for (int j = 0; j < cnt; ++j) {
                    const u32x4 a = *(const LAS u32x4*)(l3 + O_UT + (l + 15 - j) * 256 + cb * 2), b = *(const LAS u32x4*)(l3 + O_UT + (l + 15 - j) * 256 + cb * 2 + 16);
#pragma unroll
                    for (int i = 0; i < 4; ++i) { acc[2 * i] += bf2f(a[i] & 0xffffu); acc[2 * i + 1] += bf2f(a[i] >> 16); acc[8 + 2 * i] += bf2f(b[i] & 0xffffu); acc[8 + 2 * i + 1] += bf2f(b[i] >> 16); }
                }
                const u32x4 a = *(const LAS u32x4*)(l3 + O_UT + (l + 15) * 256 + cb * 2), b = *(const LAS u32x4*)(l3 + O_UT + (l + 15) * 256 + cb * 2 + 16);
                const float inv = 1.f / (float)cnt;
                u32x4 o0, o1;
#pragma unroll
                for (int i = 0; i < 4; ++i) {
                    o0[i] = pk2(acc[2 * i] * inv - bf2f(a[i] & 0xffffu), acc[2 * i + 1] * inv - bf2f(a[i] >> 16));
                    o1[i] = pk2(acc[8 + 2 * i] * inv - bf2f(b[i] & 0xffffu), acc[8 + 2 * i + 1] * inv - bf2f(b[i] >> 16)); }
                *(LAS u32x4*)(l3 + O_PL + l * PS + cb * 2) = o0; *(LAS u32x4*)(l3 + O_PL + l * PS + cb * 2 + 16) = o1; }
            __syncthreads();
            {
                f32x4 acc[4];
#pragma unroll
                for (int lt = 0; lt < 4; ++lt) acc[lt] = (f32x4){0.f, 0.f, 0.f, 0.f};
#pragma unroll
                for (int ks = 0; ks < 4; ++ks) { const bf16x8 bw = bwp[ks];
#pragma unroll
                    for (int lt = 0; lt < 4; ++lt) { const bf16x8 a = *(const LAS bf16x8*)(l3 + O_PL + (16 * lt + j16) * PS + (32 * ks + 8 * q4) * 2); acc[lt] = MFMA16(bw, a, acc[lt]); } }
#pragma unroll
                for (int lt = 0; lt < 4; ++lt) { const f32x4 v = acc[lt] * ps; u32x2 o; o.x = pk2(v[0], v[1]); o.y = pk2(v[2], v[3]);
                    *(u32x2*)(CAT + (size_t)(t0 + 16 * lt + j16) * D + gi * 128 + 16 * w + 4 * q4) = o; }
            }
        }
#undef POOL_FETCH
        __syncthreads();
    }
    {
        constexpr int O_TB = 0, O_RING = 20480;
        for (int e = tid; e < 8 * 640; e += 512) { const int h = e / 640, i = e % 640; int rel = 575 - i; rel = rel > 256 ? 256 : rel; rel = rel < -256 ? -256 : rel;
            ((LAS float*)(l3 + O_TB))[e] = P.in[I_RELB][((size_t)i2 * NHEAD + h) * 513 + rel + 256] * LOG2E; }
        __syncthreads();
        const bf16_t* Qb = (const bf16_t*)(ws + WS_Q); const unsigned char* Kb = ws + WS_K; const unsigned char* VT = ws + WS_VT;
        const int l31 = lane & 31, hh = lane >> 5;
        for (int u8 = g.vcu; u8 < NB * NHEAD * 8; u8 += g.G) {
            const int cg = u8 & 7, h = (u8 >> 3) & 7, b = u8 >> 6;
            const int c0 = 8 * cg, c = c0 + w;
            const size_t tq0 = (size_t)b * SEQ + (size_t)c * 64;
            const size_t bhb = (((size_t)b * NHEAD + h) * 128) * 4096 + (size_t)tid * 16;
            if (cg > 0) {
#pragma unroll 2
                for (int j = 0; j < 8; ++j) { const size_t o = bhb + (size_t)(c0 - 8 + j) * 8192;
                    const u32x4 kv = *(const u32x4*)(Kb + o), vv = *(const u32x4*)(VT + o);
                    *(LAS u32x4*)(l3 + O_RING + j * 16384 + tid * 16) = kv; *(LAS u32x4*)(l3 + O_RING + j * 16384 + 8192 + tid * 16) = vv; }
            }
            bf16x8 qf[2][4];
#pragma unroll
            for (int qt = 0; qt < 2; ++qt)
#pragma unroll
                for (int ks = 0; ks < 4; ++ks) qf[qt][ks] = *(const bf16x8*)(Qb + (tq0 + 32 * qt + l31) * 512 + h * 64 + 16 * ks + 8 * hh);
            f32x16 ot[2][2];
#pragma unroll
            for (int dt = 0; dt < 2; ++dt)
#pragma unroll
                for (int qt = 0; qt < 2; ++qt)
#pragma unroll
                    for (int r = 0; r < 16; ++r) ot[dt][qt][r] = 0.f;
            float mrow[2] = {-1.0e30f, -1.0e30f}, lrow[2] = {0.f, 0.f};
            __syncthreads();
#define ATT_STEP(CJ, KT) do { \
                const LAS unsigned char* sb_ = l3 + O_RING + ((CJ) & 7) * 16384 + (KT) * 4096 + lane * 16; \
                bf16x8 kf[4], vf[2][2]; \
                _Pragma("unroll") for (int ks = 0; ks < 4; ++ks) kf[ks] = *(const LAS bf16x8*)(sb_ + ks * 1024); \
                _Pragma("unroll") for (int dt = 0; dt < 2; ++dt) _Pragma("unroll") for (int sp = 0; sp < 2; ++sp) vf[dt][sp] = *(const LAS bf16x8*)(sb_ + 8192 + (dt * 2 + sp) * 1024); \
                bf16x8 pf[2][2]; \
                _Pragma("unroll") for (int qt = 0; qt < 2; ++qt) { \
                    const LAS float* tb = (const LAS float*)(l3 + O_TB) + h * 640 + (575 - 64 * (c - (CJ)) - 32 * qt - l31 + 32 * (KT) + 4 * hh); \
                    f32x16 sa; \
                    _Pragma("unroll") for (int r = 0; r < 16; ++r) sa[r] = tb[(r & 3) + 8 * (r >> 2)]; \
                    _Pragma("unroll") for (int ks = 0; ks < 4; ++ks) sa = MFMA32(kf[ks], qf[qt][ks], sa); \
                    float mloc = sa[0]; \
                    _Pragma("unroll") for (int r = 1; r < 16; ++r) mloc = fmaxf(mloc, sa[r]); \
                    mloc = xhalf_max(mloc); \
                    const float mnew = fmaxf(mrow[qt], mloc), alpha = __builtin_amdgcn_exp2f(mrow[qt] - mnew); \
                    float ls = 0.f; \
                    _Pragma("unroll") for (int r = 0; r < 16; ++r) { sa[r] = __builtin_amdgcn_exp2f(sa[r] - mnew); ls += sa[r]; } \
                    ls = xhalf_sum(ls); \
                    lrow[qt] = lrow[qt] * alpha + ls; \
                    if (!__all(mnew == mrow[qt])) { \
                        _Pragma("unroll") for (int dt = 0; dt < 2; ++dt) _Pragma("unroll") for (int r = 0; r < 16; ++r) ot[dt][qt][r] *= alpha; } \
                    mrow[qt] = mnew; \
                    _Pragma("unroll") for (int sp = 0; sp < 2; ++sp) { u32x4 t4; \
                        t4.x = pk2(sa[8 * sp + 0], sa[8 * sp + 1]); t4.y = pk2(sa[8 * sp + 2], sa[8 * sp + 3]); t4.z = pk2(sa[8 * sp + 4], sa[8 * sp + 5]); t4.w = pk2(sa[8 * sp + 6], sa[8 * sp + 7]); \
                        pf[qt][sp] = __builtin_bit_cast(bf16x8, t4); } } \
                _Pragma("unroll") for (int dt = 0; dt < 2; ++dt) _Pragma("unroll") for (int qt = 0; qt < 2; ++qt) _Pragma("unroll") for (int sp = 0; sp < 2; ++sp) ot[dt][qt] = MFMA32(vf[dt][sp], pf[qt][sp], ot[dt][qt]); } while (0)
#pragma unroll 1
            for (int r = 0; r < 9; ++r) {
                u32x4 nk = (u32x4){0u, 0u, 0u, 0u}, nv = (u32x4){0u, 0u, 0u, 0u};
                if (r < 8) { const size_t o = bhb + (size_t)(c0 + r) * 8192; nk = *(const u32x4*)(Kb + o); nv = *(const u32x4*)(VT + o); }
                const int cj = c - 8 + r;
                if (cj >= 0) { ATT_STEP(cj, 0); ATT_STEP(cj, 1); }
                __syncthreads();
                if (r < 8) { *(LAS u32x4*)(l3 + O_RING + r * 16384 + tid * 16) = nk; *(LAS u32x4*)(l3 + O_RING + r * 16384 + 8192 + tid * 16) = nv; __syncthreads(); }
            }
#undef ATT_STEP
#pragma unroll
            for (int qt = 0; qt < 2; ++qt) { const float inv = 1.f / lrow[qt];
                bf16_t* op = CAT + (tq0 + 32 * qt + l31) * D + 512 + h * 64;
#pragma unroll
                for (int dt = 0; dt < 2; ++dt)
#pragma unroll
                    for (int gp = 0; gp < 4; gp += 2) { u32x2 o0, o1;
                        o0.x = pk2(ot[dt][qt][4 * gp] * inv, ot[dt][qt][4 * gp + 1] * inv); o0.y = pk2(ot[dt][qt][4 * gp + 2] * inv, ot[dt][qt][4 * gp + 3] * inv);
                        o1.x = pk2(ot[dt][qt][4 * gp + 4] * inv, ot[dt][qt][4 * gp + 5] * inv); o1.y = pk2(ot[dt][qt][4 * gp + 6] * inv, ot[dt][qt][4 * gp + 7] * inv);
                        const auto sx = __builtin_amdgcn_permlane32_swap(o0.x, o1.x, false, false), sy = __builtin_amdgcn_permlane32_swap(o0.y, o1.y, false, false);
                        u32x4 w4; w4.x = sx[0]; w4.y = sy[0]; w4.z = sx[1]; w4.w = sy[1];
                        *(u32x4*)(op + 32 * dt + 8 * (gp + hh)) = w4; } }
        }
    }
}

constexpr int LDS_BYTES = 160 * 1024, MISC_OFF = 160 * 1024 - 512;
constexpr int NPHASE = 34;
#ifndef PG8_SP2
#define PG8_SP2 true
#endif
#ifndef PG8_ALIGN
#define PG8_ALIGN true
#endif
__global__ void __launch_bounds__(512, 2) mk_fwd(Params P) {
    extern __shared__ __attribute__((aligned(16))) unsigned char lds[];
    LAS unsigned char* l3 = (LAS unsigned char*)lds;
    Geo g; g.tid = threadIdx.x; g.lane = g.tid & 63; g.wave = __builtin_amdgcn_readfirstlane(g.tid >> 6); g.G = gridDim.x;
    { const int bx = blockIdx.x; g.vcu = (g.G % 8 == 0) ? (bx % 8) * (g.G / 8) + bx / 8 : bx; }
    volatile LAS unsigned* MISC = (volatile LAS unsigned*)(l3 + MISC_OFF);
    if (g.tid < 64) MISC[g.tid] = 0u;
    __syncthreads();
    unsigned char* ws = P.ws;
    unsigned* ctl = (unsigned*)(ws + WS_CTL);
    XcdBarrier bar = xcd_barrier_post(ctl + CW_BAR, MISC + 8);
    const int lo = P.ph_lo, hi = P.ph_hi;
#define IN(k) (lo <= (k) && (k) < hi)
#define SEAM(k) do { if ((k) + 1 < hi) xcd_barrier(bar); } while (0)
    const float* mod = (const float*)(ws + WS_MOD);
    bf16_t* Hb = (bf16_t*)P.out; bf16_t* XB = (bf16_t*)(ws + WS_XB);

    if (IN(0)) { for (int rep_ = 0; rep_ < ((PROBE_DUP == 0) ? 2 : 1); ++rep_) { phase_mod(P, g, (float*)lds); phase_convert(P, g, (float*)(lds + 32768))  ; if (rep_ + 1 < ((PROBE_DUP == 0) ? 2 : 1)) xcd_barrier(bar); } SEAM(0); }

#define NREP(ty) ((PROBE_DUP == (ty)) ? 2 : 1)
#define DRYFLAG(ty) bool dry = false; if (PROBE_DUP == (ty)) { int d_ = (rep_ + 1 < NREP(ty)); asm volatile("" : "+s"(d_)); dry = d_ != 0; }
#define DRYBAR() do { if (dry) xcd_barrier(bar); } while (0)
#define G_E1 { pg8::Gemm gm{Hb, (const bf16_t*)(ws + WS_WMI) + (size_t)i2 * MIX_IN * D, T, MIX_IN, D}; pg8::StaticOrder S; S.init(T, MIX_IN, g.G, (int)blockIdx.x); \
                pg8::EpiE1x E{(bf16_t*)(ws + WS_U), (bf16_t*)(ws + WS_VT)}; \
                pg8::gemm_phase<pg8::EpiE1x, pg8::StaticOrder, PG8_ALIGN, PG8_SP2>(l3, gm, S, E); }
#define G_E3(F32B, BASEP) { pg8::Gemm gm{(const bf16_t*)(ws + WS_CAT), (const bf16_t*)(ws + WS_WMO) + (size_t)i2 * D * D, T, D, D}; pg8::StaticOrder S; S.init(T, D, g.G, (int)blockIdx.x); \
                pg8::EpiResGate<F32B> E{BASEP, XB, gate1, (float*)(ws + WS_SSP)}; \
                pg8::gemm_phase<pg8::EpiResGate<F32B>, pg8::StaticOrder, PG8_ALIGN, PG8_SP2>(l3, gm, S, E); }
#define G_O1A { pg8::Gemm gm{Hb, (const bf16_t*)(ws + WS_WSX) + (size_t)i2 * 4096 * D, T, 4096, D}; pg8::StaticOrder S; S.init(T, 4096, g.G, (int)blockIdx.x); \
                pg8::EpiSplitX E{(bf16_t*)(ws + WS_XS), (unsigned*)(ws + WS_XHALO)}; \
                pg8::gemm_phase<pg8::EpiSplitX, pg8::StaticOrder, PG8_ALIGN, PG8_SP2>(l3, gm, S, E); }
#define G_O1B { pg8::Gemm gm{Hb, (const bf16_t*)(ws + WS_WSZ) + (size_t)i2 * 2048 * D, T, 2048, D}; pg8::StaticOrder S; S.init(T, 2048, g.G, (int)blockIdx.x); \
                pg8::EpiGateNorm E{(bf16_t*)(ws + WS_XS), (LAS float*)(l3 + 131072)}; \
                pg8::gemm_phase<pg8::EpiGateNorm, pg8::StaticOrder, true, PG8_SP2>(l3, gm, S, E); }
#define G_O3 { pg8::Gemm gm{(const bf16_t*)(ws + WS_XS), (const bf16_t*)(ws + WS_WSO) + (size_t)i2 * D * SSM_DI, T, D, SSM_DI}; pg8::StaticOrder S; S.init(T, D, g.G, (int)blockIdx.x); \
                pg8::EpiResGate<false> E{XB, XB, gate1, (float*)(ws + WS_SSP)}; \
                pg8::gemm_phase<pg8::EpiResGate<false>, pg8::StaticOrder, PG8_ALIGN, PG8_SP2>(l3, gm, S, E); }
#define GDUP_2(...)
#define GDUP_4(...)
#define GDUP_8(...)
#define GDUP_10(...)
#define GDUP_12(...)
#if PROBE_DUP == 2
#undef GDUP_2
#define GDUP_2(...) __VA_ARGS__ xcd_barrier(bar);
#elif PROBE_DUP == 4
#undef GDUP_4
#define GDUP_4(...) __VA_ARGS__ xcd_barrier(bar);
#elif PROBE_DUP == 8
#undef GDUP_8
#define GDUP_8(...) __VA_ARGS__ xcd_barrier(bar);
#elif PROBE_DUP == 10
#undef GDUP_10
#define GDUP_10(...) __VA_ARGS__ xcd_barrier(bar);
#elif PROBE_DUP == 12
#undef GDUP_12
#define GDUP_12(...) __VA_ARGS__ xcd_barrier(bar);
#endif
#define GDUP(ty, ...) GDUP_##ty(__VA_ARGS__)
#define LAYER_BODY(LL) { const int L = (LL); \
        const int pb = 1 + 8 * L, i2 = L >> 1; \
        const float* gate1 = mod + (size_t)L * NB * 6144 + 2048; \
        if ((L & 1) == 0) { \
            if (IN(pb + 0)) { phase_norm<0>(P, g, (float*)lds, L, P.in[I_X], P.in[I_N1W] + L * D, 0, 1024, false, L == 0 ? (const bf16_t*)nullptr : (const bf16_t*)XB); SEAM(pb + 0); } \
            if (IN(pb + 1)) { G_E1 GDUP(2, G_E1) SEAM(pb + 1); } \
            if (IN(pb + 2)) { for (int rep_ = 0; rep_ < NREP(3); ++rep_) { DRYFLAG(3) phase_e2(P, g, l3, L); DRYBAR(); } SEAM(pb + 2); } \
            if (IN(pb + 3)) { if (L == 0) G_E3(true, P.in[I_X]) else G_E3(false, XB) SEAM(pb + 3); } \
            if (IN(pb + 4)) { for (int rep_ = 0; rep_ < NREP(5); ++rep_) { DRYFLAG(5) phase_norm16<2>(P, g, l3, L, XB, P.in[I_N2W] + L * D, 3072, 4096, dry); DRYBAR(); } SEAM(pb + 4); } \
            if (IN(pb + 5)) { for (int rep_ = 0; rep_ < NREP(6); ++rep_) { DRYFLAG(6) phase_moe(P, g, l3, L, dry); DRYBAR(); } SEAM(pb + 5); } \
        } else { \
            if (IN(pb + 0)) { phase_norm16<1>(P, g, l3, L, XB, P.in[I_N1W] + L * D, 0, 1024, false); SEAM(pb + 0); } \
            if (IN(pb + 1)) { G_O1A GDUP(8, G_O1A) SEAM(pb + 1); } \
            if (IN(pb + 2)) { for (int rep_ = 0; rep_ < NREP(9); ++rep_) { DRYFLAG(9) scan_units<3>(P, g, l3, L, dry); xcd_barrier(bar); scan_fix(P, g, l3, L); DRYBAR(); } SEAM(pb + 2); } \
            if (IN(pb + 3)) { G_O1B GDUP(10, G_O1B) SEAM(pb + 3); } \
            if (IN(pb + 5)) { G_O3 SEAM(pb + 5); } \
            if (IN(pb + 6)) { for (int rep_ = 0; rep_ < NREP(5); ++rep_) { DRYFLAG(5) phase_norm16<2>(P, g, l3, L, XB, P.in[I_N2W] + L * D, 3072, 4096, dry); DRYBAR(); } SEAM(pb + 6); } \
            if (IN(pb + 7)) { for (int rep_ = 0; rep_ < NREP(6); ++rep_) { DRYFLAG(6) phase_moe(P, g, l3, L, dry); DRYBAR(); } SEAM(pb + 7); } \
        } \
    }
    LAYER_BODY(0)
    LAYER_BODY(1)
    LAYER_BODY(2)
    LAYER_BODY(3)
#undef LAYER_BODY
    if (IN(33)) { for (int rep_ = 0; rep_ < NREP(13); ++rep_) { DRYFLAG(13) phase_final(P, g, dry); DRYBAR(); } }
#undef IN
#undef SEAM
}

extern "C" void kernel_launch(void* const* d_in, const int* in_sizes, int n_in, void* d_out, int out_size, void* d_ws, size_t ws_size, hipStream_t stream) {
    static int grid = 0;
    if (grid == 0) {
        if (n_in != 27 || out_size != T * D || ws_size < WS_END) { fprintf(stderr, "kernel_launch: bad shapes n_in %d out %d ws %zu (need %zu)\n", n_in, out_size, ws_size, (size_t)WS_END); grid = -1; return; }
        if (hipFuncSetAttribute((const void*)mk_fwd, hipFuncAttributeMaxDynamicSharedMemorySize, LDS_BYTES) != hipSuccess) { fprintf(stderr, "hipFuncSetAttribute failed\n"); grid = -1; return; }
        int dev = 0, cus = 0, per_cu = 0;
        if (hipGetDevice(&dev) != hipSuccess || hipDeviceGetAttribute(&cus, hipDeviceAttributeMultiprocessorCount, dev) != hipSuccess) { grid = -1; return; }
        if (hipOccupancyMaxActiveBlocksPerMultiprocessor(&per_cu, (const void*)mk_fwd, 512, LDS_BYTES) != hipSuccess || per_cu < 1) fprintf(stderr, "occupancy query says %d\n", per_cu);
        (void)hipGetLastError();
        grid = cus;
    }
    if (grid < 0) return;
    Params P{};
    for (int i = 0; i < 27; ++i) P.in[i] = (const float*)d_in[i];
    P.out = (float*)d_out; P.ws = (unsigned char*)d_ws;
    (void)hipMemsetAsync((unsigned char*)d_ws + WS_CTL, 0, CTL_BYTES, stream);
    const int G = grid;
    auto run = [&](int lo, int hi) { P.ph_lo = lo; P.ph_hi = hi; hipLaunchKernelGGL(mk_fwd, dim3(G), dim3(512), LDS_BYTES, stream, P); };
    run(0, NPHASE);
}
```

```cpp
#include <hip/hip_runtime.h>
#include <cstdio>
#include <cstdint>

#ifndef PROBE_DUP
#define PROBE_DUP -1
#endif
typedef unsigned short bf16_t;
typedef float f32x4 __attribute__((ext_vector_type(4)));
typedef unsigned u32x4 __attribute__((ext_vector_type(4)));
typedef unsigned u32x2 __attribute__((ext_vector_type(2)));
typedef float f32x2 __attribute__((ext_vector_type(2)));

constexpr int D = 1024, NB = 8, SEQ = 4096, DEPTH = 4, T = NB * SEQ;
constexpr int CHUNK = 64, NCH = SEQ / CHUNK;
constexpr float EPS = 1e-6f;
constexpr int POOLW = 512, NHEAD = 8, HD = 64, ATTW = 512, MIX_IN = 2048;
constexpr int SSM_DI = 2048, SSM_H = 32, SSM_G = 8, SSM_N = 128, SSM_P = 64, SSM_CONV = 4096, SSM_IN = 6176;
constexpr int MOE_E = 32, MOE_FF = 128, NBUCKET = 112;
constexpr float QSCALE = 0.125f * 1.4426950408889634f;
constexpr float LOG2E = 1.4426950408889634f;

constexpr size_t MiB = 1u << 20;
constexpr size_t WS_CTL = 0, CTL_BYTES = 1 * MiB;
constexpr size_t WS_MOD = 1 * MiB;
constexpr size_t WS_TOKE = 2 * MiB;
constexpr size_t WS_TOKW = 2 * MiB + 512 * 1024;
constexpr size_t WS_LIST = 3 * MiB;
constexpr size_t WS_WMI = 17 * MiB, WS_WMO = 25 * MiB, WS_WSX = 29 * MiB, WS_WSZ = 45 * MiB, WS_WSO = 53 * MiB, WS_WPL = 61 * MiB;
constexpr size_t WS_W13 = 62 * MiB, WS_W2T = 126 * MiB;
constexpr size_t WS_WRH = 61 * MiB + 256 * 1024, WS_WRL = WS_WRH + 384 * 1024;
constexpr size_t WS_WDH = 1 * MiB + 768 * 1024, WS_WDL = WS_WDH + 128 * 1024;
constexpr size_t WS_XB = 158 * MiB;
constexpr size_t WS_BIG = 222 * MiB;
constexpr size_t WS_U = WS_BIG, WS_Q = WS_BIG + 32 * MiB, WS_K = WS_BIG + 64 * MiB, WS_VT = WS_BIG + 96 * MiB, WS_CAT = WS_BIG + 128 * MiB;
constexpr size_t WS_XS = WS_BIG, WS_BC = WS_BIG + 128 * MiB, WS_DT = WS_BIG + 256 * MiB;
constexpr size_t WS_SSP = WS_BIG + 260 * MiB;
constexpr size_t WS_END = WS_SSP + 2 * MiB;
constexpr int CW_BAR = 4096;
constexpr int CW_CNT = 16384;

struct Params {
    const float* in[27];
    float* out;
    unsigned char* ws;
    int ph_lo, ph_hi;
};
enum { I_X = 0, I_C, I_ADAW, I_ADAB, I_N1W, I_N2W, I_MIXIN, I_POOLW, I_POOLS, I_RELB, I_MIXOUT, I_SSMIN, I_CONVW, I_CONVB, I_DTB, I_ALOG, I_SSMD, I_SSMNW, I_SSMOUT,
       I_WG, I_BG, I_WE, I_BE, I_W1, I_W3, I_W2, I_FNW };

#define LAS __attribute__((address_space(3)))
__device__ __forceinline__ float bf2f(unsigned v) { return __uint_as_float(v << 16); }
typedef __bf16 bf16x2_t __attribute__((ext_vector_type(2)));
__device__ __forceinline__ unsigned pk2(float lo, float hi) { f32x2 v = {lo, hi}; bf16x2_t b = __builtin_convertvector(v, bf16x2_t); return __builtin_bit_cast(unsigned, b); }
__device__ __forceinline__ unsigned f2bf(float f) { return pk2(f, f) & 0xffffu; }
__device__ __forceinline__ float xhalf_max(float x) { const auto r = __builtin_amdgcn_permlane32_swap(__float_as_uint(x), __float_as_uint(x), false, false); return fmaxf(__uint_as_float(r[0]), __uint_as_float(r[1])); }
__device__ __forceinline__ float xhalf_sum(float x) { const auto r = __builtin_amdgcn_permlane32_swap(__float_as_uint(x), __float_as_uint(x), false, false); return __uint_as_float(r[0]) + __uint_as_float(r[1]); }
__device__ __forceinline__ float x16_sum(float x) { const auto r = __builtin_amdgcn_permlane16_swap(__float_as_uint(x), __float_as_uint(x), false, false); return __uint_as_float(r[0]) + __uint_as_float(r[1]); }
#define DPP_F32(SRC, CTRL, RM) __uint_as_float(__builtin_amdgcn_update_dpp(0u, __float_as_uint(SRC), CTRL, RM, 0xf, false))
__device__ __forceinline__ float wave_incl_scan(float x) {
    x += DPP_F32(x, 0x111, 0xf); x += DPP_F32(x, 0x112, 0xf); x += DPP_F32(x, 0x114, 0xf); x += DPP_F32(x, 0x118, 0xf);
    x += DPP_F32(x, 0x142, 0xa); x += DPP_F32(x, 0x143, 0xc);
    return x;
}
__device__ __forceinline__ float wave_last(float x) { return __uint_as_float(__builtin_amdgcn_readlane(__float_as_uint(x), 63)); }
__device__ __forceinline__ float wave_sum(float v) {
#pragma unroll
    for (int o = 1; o < 64; o <<= 1) v += __shfl_xor(v, o);
    return v;
}
__device__ __forceinline__ float silu_f(float x) { return x * __builtin_amdgcn_rcpf(1.f + __expf(-x)); }
__device__ __forceinline__ float softplus_f(float x) { return x > 20.f ? x : log1pf(__expf(x)); }

struct Geo { int tid, lane, wave, vcu, G; };

__device__ __forceinline__ void phase_mod(const Params& P, const Geo& g, float* cs  ) {
    const float* c = P.in[I_C];
    for (int i = g.tid; i < NB * D; i += 512) cs[i] = silu_f(c[i]);
    __syncthreads();
    float* mod = (float*)(P.ws + WS_MOD);
    float* red = cs + 8192 + 8 * (64 * 33);
    for (int u = g.vcu; u < DEPTH * 96; u += g.G) {
        const int L = u / 96, col = (u % 96) * 64 + g.lane;
        const float* w = P.in[I_ADAW] + (size_t)L * D * 6144 + col + (size_t)g.wave * 128 * 6144;
        const float* cw = cs + g.wave * 128;
        float acc[NB];
#pragma unroll
        for (int b = 0; b < NB; ++b) acc[b] = 0.f;
#pragma unroll 32
        for (int k = 0; k < 128; ++k) {
            const float wv = w[(size_t)k * 6144];
#pragma unroll
            for (int b = 0; b < NB; ++b) acc[b] += cw[b * D + k] * wv;
        }
#pragma unroll
        for (int b = 0; b < NB; ++b) red[(g.wave * NB + b) * 64 + g.lane] = acc[b];
        __syncthreads();
        { const int b = g.wave; float sum = P.in[I_ADAB][L * 6144 + col];
#pragma unroll
            for (int ww = 0; ww < 8; ++ww) sum += red[(ww * NB + b) * 64 + g.lane];
            mod[(size_t)(L * NB + b) * 6144 + col] = sum; }
        __syncthreads();
    }
}

template <int PROJ>
__device__ __forceinline__ void phase_norm(const Params& P, const Geo& g, float* wlds, int L, const float* xsrc, const float* nw, int shift_off, int scale_off, bool dry = false, const bf16_t* xb = nullptr  ) {
    constexpr int NPROJ = PROJ == 1 ? 32 : (PROJ == 2 ? 36 : 0);
    const int i2 = L >> 1;
    if (PROJ == 1) {
        const float* w = P.in[I_SSMIN] + (size_t)i2 * D * SSM_IN + 6144;
        for (int e = g.tid; e < 32 * D; e += 512) { const int k = e >> 5, j = e & 31; wlds[j * D + k] = w[(size_t)k * SSM_IN + j]; }
        __syncthreads();
    } else if (PROJ == 2) {
        const float* wg = P.in[I_WG] + (size_t)L * D * 4;
        const float* we = P.in[I_WE] + (size_t)L * D * 32;
        for (int e = g.tid; e < 4 * D; e += 512) { const int k = e >> 2, j = e & 3; wlds[j * D + k] = wg[e]; }
        for (int e = g.tid; e < 32 * D; e += 512) { const int k = e >> 5, j = e & 31; wlds[(4 + j) * D + k] = we[e]; }
        __syncthreads();
    }
    const float* mod = (const float*)(P.ws + WS_MOD);
    bf16_t* H = (bf16_t*)P.out;
    const int gw = g.vcu * 8 + g.wave, NGW = g.G * 8;
    int my_row = -1, my_bucket = 0; int nrows = 0;
    for (int m = gw; m < T; m += NGW) {
        const int b = m / SEQ;
        f32x4 v[4]; float ss = 0.f;
        if (xb) { const u32x2* xr2 = (const u32x2*)(xb + (size_t)m * D) + g.lane;
#pragma unroll
            for (int j = 0; j < 4; ++j) { const u32x2 t2 = xr2[64 * j]; v[j].x = bf2f(t2.x & 0xffffu); v[j].y = bf2f(t2.x >> 16); v[j].z = bf2f(t2.y & 0xffffu); v[j].w = bf2f(t2.y >> 16); } }
        else { const f32x4* xr = (const f32x4*)(xsrc + (size_t)m * D) + g.lane;
#pragma unroll
            for (int j = 0; j < 4; ++j) v[j] = xr[64 * j]; }
#pragma unroll
        for (int j = 0; j < 4; ++j) ss += v[j].x * v[j].x + v[j].y * v[j].y + v[j].z * v[j].z + v[j].w * v[j].w;
        const float rstd = rsqrtf(wave_sum(ss) * (1.f / D) + EPS);
        const float* mrow = mod + (size_t)(L * NB + b) * 6144;
#pragma unroll
        for (int j = 0; j < 4; ++j) {
            const int k = 4 * g.lane + 256 * j;
            const f32x4 w4 = *(const f32x4*)(nw + k), sc = *(const f32x4*)(mrow + scale_off + k), sh = *(const f32x4*)(mrow + shift_off + k);
            v[j] = v[j] * rstd * w4 * (sc + 1.f) + sh;
            u32x2 o; o.x = pk2(v[j].x, v[j].y); o.y = pk2(v[j].z, v[j].w);
            *(u32x2*)(H + (size_t)m * D + k) = o;
        }
        if (NPROJ > 0) {
            float mine = 0.f;
#pragma unroll 2
            for (int q = 0; q < NPROJ; ++q) {
                float a = 0.f;
#pragma unroll
                for (int j = 0; j < 4; ++j) { const f32x4 w4 = *(const f32x4*)(wlds + q * D + 4 * g.lane + 256 * j); a += v[j].x * w4.x + v[j].y * w4.y + v[j].z * w4.z + v[j].w * w4.w; }
                a = wave_sum(a);
                mine = (g.lane == q) ? a : mine;
            }
            if (PROJ == 1) {
                float* DT = (float*)(P.ws + WS_DT);
                const float* dtb = P.in[I_DTB] + i2 * SSM_H;
                if (g.lane < 32) DT[(size_t)m * 32 + g.lane] = softplus_f(mine + dtb[g.lane]);
            } else if (PROJ == 2) {
                const float* bg = P.in[I_BG] + L * 4; const float* be = P.in[I_BE] + L * 32;
                float gl[4]; float gm = -3.0e38f; int gi = 0;
#pragma unroll
                for (int q = 0; q < 4; ++q) { gl[q] = __shfl(mine, q) + bg[q]; if (gl[q] > gm) { gm = gl[q]; gi = q; } }
                float gs = 0.f;
#pragma unroll
                for (int q = 0; q < 4; ++q) gs += __expf(gl[q] - gm);
                const float gval = 1.f / gs;
                float el[8];
#pragma unroll
                for (int e = 0; e < 8; ++e) el[e] = __shfl(mine, 4 + gi * 8 + e) + be[gi * 8 + e];
                float m0 = -3.0e38f; int i0 = 0;
#pragma unroll
                for (int e = 0; e < 8; ++e) if (el[e] > m0) { m0 = el[e]; i0 = e; }
                float m1 = -3.0e38f; int i1 = 0;
#pragma unroll
                for (int e = 0; e < 8; ++e) if (e != i0 && el[e] > m1) { m1 = el[e]; i1 = e; }
                float es = 0.f;
#pragma unroll
                for (int e = 0; e < 8; ++e) es += __expf(el[e] - m0);
                const float p0 = 1.f / es, p1 = __expf(m1 - m0) / es;
                const float w0 = gval * (p0 / (p0 + p1)), w1 = gval * (p1 / (p0 + p1));
                const int lo = i0 < i1 ? i0 : i1, hi = i0 < i1 ? i1 : i0;
                const float wlo = i0 < i1 ? w0 : w1, whi = i0 < i1 ? w1 : w0;
                const int bucket = gi * 28 + 7 * lo - (lo * (lo - 1)) / 2 + (hi - lo - 1);
                if (g.lane == 0) {
                    ((int2*)(P.ws + WS_TOKE))[m] = make_int2(gi * 8 + lo, gi * 8 + hi);
                    ((float2*)(P.ws + WS_TOKW))[m] = make_float2(wlo, whi);
                }
                if (g.lane == (nrows & 63)) { my_row = m; my_bucket = bucket; }
                ++nrows;
                if ((nrows & 63) == 0 && !dry) {
                    unsigned* cnt = (unsigned*)(P.ws + WS_CTL) + CW_CNT + (L * 128 + my_bucket) * 16;
                    const unsigned rank = atomicAdd(cnt, 1u);
                    ((int*)(P.ws + WS_LIST))[(size_t)my_bucket * T + rank] = my_row;
                    my_row = -1;
                }
            }
        }
    }
    if (PROJ == 2) {
        if (my_row >= 0 && !dry) {
            unsigned* cnt = (unsigned*)(P.ws + WS_CTL) + CW_CNT + (L * 128 + my_bucket) * 16;
            const unsigned rank = atomicAdd(cnt, 1u);
            ((int*)(P.ws + WS_LIST))[(size_t)my_bucket * T + rank] = my_row;
        }
    }
}


typedef short bf16x8 __attribute__((ext_vector_type(8)));
template <int PROJ>
__device__ __forceinline__ void phase_norm16(const Params& P, const Geo& g, LAS unsigned char* l3, int L, const bf16_t* xsrc, const float* nw, int shift_off, int scale_off, bool dry = false) {
    constexpr int NT = PROJ == 1 ? 2 : 3, NBLK = NT * 16, PERW = NBLK / 8;
    constexpr int O_WB = 32768, WBUF = NBLK * 1024;
    const int i2 = L >> 1, lane = g.lane, r16 = lane & 15, q4 = lane >> 4, w = g.wave;
    unsigned char* ws = P.ws;
    const float* mod = (const float*)(ws + WS_MOD);
    const float* ssp = (const float*)(ws + WS_SSP);
    bf16_t* H = (bf16_t*)P.out;
    LAS float* msl = (LAS float*)l3;
    LAS float* shl = (LAS float*)(l3 + 4096);
    LAS float* lgw = (LAS float*)(l3 + 8192 + g.wave * (16 * 48 * 4));
    const bf16_t* WH = PROJ == 1 ? (const bf16_t*)(ws + WS_WDH) + (size_t)i2 * 32 * D : (const bf16_t*)(ws + WS_WRH) + (size_t)L * 48 * D;
    const bf16_t* WL = PROJ == 1 ? (const bf16_t*)(ws + WS_WDL) + (size_t)i2 * 32 * D : (const bf16_t*)(ws + WS_WRL) + (size_t)L * 48 * D;
    for (int blk = g.vcu; blk < T / 128; blk += g.G) {
        const int b = (blk * 128) / SEQ;
        const float* mrow = mod + (size_t)(L * NB + b) * 6144;
        __syncthreads();
        for (int k = g.tid; k < D; k += 512) { msl[k] = nw[k] * (1.f + mrow[scale_off + k]); shl[k] = mrow[shift_off + k]; }
        const int m0 = blk * 128 + w * 16;
        const bf16_t* xr = xsrc + (size_t)(m0 + r16) * D + 8 * q4;
        u32x4 xq[8];
#pragma unroll
        for (int sl = 0; sl < 8; ++sl) xq[sl] = *(const u32x4*)(xr + 32 * sl);
        float ss; { const f32x4 p4 = *(const f32x4*)(ssp + (size_t)(m0 + r16) * 16 + 4 * q4); ss = (p4[0] + p4[1]) + (p4[2] + p4[3]); }
        ss = xhalf_sum(x16_sum(ss));
        const float rstd = rsqrtf(ss * (1.f / D) + EPS);
        u32x4 wreg[PERW];
#define N16_LOADW(CH) do { _Pragma("unroll") for (int i = 0; i < PERW; ++i) { const int j = PERW * w + i, lo = j >= NT * 8, jj = lo ? j - NT * 8 : j, ct = jj >> 3, sl = jj & 7; \
            wreg[i] = *(const u32x4*)((lo ? WL : WH) + (size_t)(ct * 32 + 8 * (CH) + sl) * 512 + lane * 8); } } while (0)
#define N16_STOREW(BUF) do { _Pragma("unroll") for (int i = 0; i < PERW; ++i) *(LAS u32x4*)(l3 + O_WB + (BUF) * WBUF + (PERW * w + i) * 1024 + lane * 16) = wreg[i]; } while (0)
        N16_LOADW(0); N16_STOREW(0);
        __syncthreads();
        f32x4 acc[NT];
#pragma unroll
        for (int ct = 0; ct < NT; ++ct) acc[ct] = (f32x4){0.f, 0.f, 0.f, 0.f};
        bf16_t* hrow = H + (size_t)(m0 + r16) * D + 8 * q4;
#pragma unroll 1
        for (int ch = 0; ch < 4; ++ch) {
            if (ch < 3) N16_LOADW(ch + 1);
            u32x4 xn[8];
#pragma unroll
            for (int sl = 0; sl < 8; ++sl) xn[sl] = xq[sl];
            if (ch < 3) {
#pragma unroll
                for (int sl = 0; sl < 8; ++sl) xn[sl] = *(const u32x4*)(xr + 32 * (8 * (ch + 1) + sl)); }
            const LAS unsigned char* wb = l3 + O_WB + (ch & 1) * WBUF + lane * 16;
#pragma unroll
            for (int sl = 0; sl < 8; ++sl) {
                const int s = 8 * ch + sl;
                const u32x4 x8 = xq[sl];
                f32x4 a, c; a.x = bf2f(x8.x & 0xffffu); a.y = bf2f(x8.x >> 16); a.z = bf2f(x8.y & 0xffffu); a.w = bf2f(x8.y >> 16); c.x = bf2f(x8.z & 0xffffu); c.y = bf2f(x8.z >> 16); c.z = bf2f(x8.w & 0xffffu); c.w = bf2f(x8.w >> 16);
                const f32x4 m0v = *(const LAS f32x4*)(msl + 32 * s + 8 * q4), m1v = *(const LAS f32x4*)(msl + 32 * s + 8 * q4 + 4);
                const f32x4 s0v = *(const LAS f32x4*)(shl + 32 * s + 8 * q4), s1v = *(const LAS f32x4*)(shl + 32 * s + 8 * q4 + 4);
                const f32x4 h0 = a * rstd * m0v + s0v, h1 = c * rstd * m1v + s1v;
                u32x4 hi; hi.x = pk2(h0.x, h0.y); hi.y = pk2(h0.z, h0.w); hi.z = pk2(h1.x, h1.y); hi.w = pk2(h1.z, h1.w);
                *(u32x4*)(hrow + 32 * s) = hi;
                u32x4 lo;
                lo.x = pk2(h0.x - bf2f(hi.x & 0xffffu), h0.y - bf2f(hi.x >> 16)); lo.y = pk2(h0.z - bf2f(hi.y & 0xffffu), h0.w - bf2f(hi.y >> 16));
                lo.z = pk2(h1.x - bf2f(hi.z & 0xffffu), h1.y - bf2f(hi.z >> 16)); lo.w = pk2(h1.z - bf2f(hi.w & 0xffffu), h1.w - bf2f(hi.w >> 16));
                const bf16x8 ahi = __builtin_bit_cast(bf16x8, hi), alo = __builtin_bit_cast(bf16x8, lo);
#pragma unroll
                for (int ct = 0; ct < NT; ++ct) { const bf16x8 bh = *(const LAS bf16x8*)(wb + (ct * 8 + sl) * 1024), bl = *(const LAS bf16x8*)(wb + (NT * 8 + ct * 8 + sl) * 1024);
                    acc[ct] = __builtin_amdgcn_mfma_f32_16x16x32_bf16(ahi, bh, acc[ct], 0, 0, 0);
                    acc[ct] = __builtin_amdgcn_mfma_f32_16x16x32_bf16(ahi, bl, acc[ct], 0, 0, 0);
                    acc[ct] = __builtin_amdgcn_mfma_f32_16x16x32_bf16(alo, bh, acc[ct], 0, 0, 0); }
            }
            if (ch < 3) N16_STOREW((ch + 1) & 1);
            asm volatile("s_waitcnt lgkmcnt(0)" ::: "memory"); __builtin_amdgcn_s_barrier(); asm volatile("" ::: "memory");
#pragma unroll
            for (int sl = 0; sl < 8; ++sl) xq[sl] = xn[sl];
        }
#undef N16_LOADW
#undef N16_STOREW
        if (PROJ == 1) {
            float* DT = (float*)(ws + WS_DT); const float* dtb = P.in[I_DTB] + i2 * SSM_H;
#pragma unroll
            for (int ct = 0; ct < NT; ++ct) { const float bias = dtb[16 * ct + r16];
#pragma unroll
                for (int r = 0; r < 4; ++r) DT[(size_t)(m0 + 4 * q4 + r) * 32 + 16 * ct + r16] = softplus_f(acc[ct][r] + bias); }
        } else {
#pragma unroll
            for (int ct = 0; ct < NT; ++ct)
#pragma unroll
                for (int r = 0; r < 4; ++r) lgw[(4 * q4 + r) * 48 + 16 * ct + r16] = acc[ct][r];
            asm volatile("s_waitcnt lgkmcnt(0)" ::: "memory");
            if (lane < 16) {
                const LAS float* lg = lgw + lane * 48; const int m = m0 + lane;
                const float* bg = P.in[I_BG] + L * 4; const float* be = P.in[I_BE] + L * 32;
                float gl[4]; float gm = -3.0e38f; int gi = 0;
#pragma unroll
                for (int q = 0; q < 4; ++q) { gl[q] = lg[q] + bg[q]; if (gl[q] > gm) { gm = gl[q]; gi = q; } }
                float gs = 0.f;
#pragma unroll
                for (int q = 0; q < 4; ++q) gs += __expf(gl[q] - gm);
                const float gval = 1.f / gs;
                float el[8];
#pragma unroll
                for (int e = 0; e < 8; ++e) el[e] = lg[4 + gi * 8 + e] + be[gi * 8 + e];
                float mx0 = -3.0e38f; int i0 = 0;
#pragma unroll
                for (int e = 0; e < 8; ++e) if (el[e] > mx0) { mx0 = el[e]; i0 = e; }
                float mx1 = -3.0e38f; int i1 = 0;
#pragma unroll
                for (int e = 0; e < 8; ++e) if (e != i0 && el[e] > mx1) { mx1 = el[e]; i1 = e; }
                float es = 0.f;
#pragma unroll
                for (int e = 0; e < 8; ++e) es += __expf(el[e] - mx0);
                const float p0 = 1.f / es, p1 = __expf(mx1 - mx0) / es;
                const float w0 = gval * (p0 / (p0 + p1)), w1 = gval * (p1 / (p0 + p1));
                const int lo = i0 < i1 ? i0 : i1, hi = i0 < i1 ? i1 : i0;
                const float wlo = i0 < i1 ? w0 : w1, whi = i0 < i1 ? w1 : w0;
                const int bucket = gi * 28 + 7 * lo - (lo * (lo - 1)) / 2 + (hi - lo - 1);
                ((int2*)(ws + WS_TOKE))[m] = make_int2(gi * 8 + lo, gi * 8 + hi);
                ((float2*)(ws + WS_TOKW))[m] = make_float2(wlo, whi);
                if (!dry) {
                    unsigned* cnt = (unsigned*)(ws + WS_CTL) + CW_CNT + (L * 128 + bucket) * 16;
                    const unsigned rank = atomicAdd(cnt, 1u);
                    ((int*)(ws + WS_LIST))[(size_t)bucket * T + rank] = m;
                }
            }
        }
    }
}

__device__ __forceinline__ void phase_gate(const Params& P, const Geo& g, bool dry = false) {
    bf16_t* XS = (bf16_t*)(P.ws + WS_XS); const bf16_t* Z = (const bf16_t*)(P.ws + WS_BC);
    const int gw = g.vcu * 8 + g.wave, NGW = g.G * 8;
    for (int m = gw; m < T; m += NGW) {
        u32x4* yp = (u32x4*)(XS + (size_t)m * SSM_DI + 32 * g.lane);
        const u32x4* zp = (const u32x4*)(Z + (size_t)m * SSM_DI + 32 * g.lane);
        float gv[32]; float ss = 0.f;
#pragma unroll
        for (int j = 0; j < 4; ++j) {
            const u32x4 y4 = yp[j], z4 = zp[j];
#pragma unroll
            for (int e = 0; e < 4; ++e) {
                const unsigned yy = y4[e], zz = z4[e];
                const float y0 = bf2f(yy & 0xffffu), y1 = bf2f(yy >> 16), z0 = bf2f(zz & 0xffffu), z1 = bf2f(zz >> 16);
                const float g0 = y0 * silu_f(z0), g1 = y1 * silu_f(z1);
                gv[j * 8 + e * 2] = g0; gv[j * 8 + e * 2 + 1] = g1; ss += g0 * g0 + g1 * g1;
            }
        }
        ss += __shfl_xor(ss, 1); ss += __shfl_xor(ss, 2); ss += __shfl_xor(ss, 4);
        const float rs = rsqrtf(ss * (1.f / 256.f) + EPS);
#pragma unroll
        for (int j = 0; j < 4; ++j) { u32x4 o;
#pragma unroll
            for (int e = 0; e < 4; ++e) o[e] = pk2(gv[j * 8 + e * 2] * rs, gv[j * 8 + e * 2 + 1] * rs);
            if (!dry) yp[j] = o; else asm volatile("" :: "v"(o)); }
    }
}

__device__ __forceinline__ void phase_final(const Params& P, const Geo& g, bool dry = false) {
    const float* nw = P.in[I_FNW];
    const bf16_t* XB = (const bf16_t*)(P.ws + WS_XB);
    const int gw = g.vcu * 8 + g.wave, NGW = g.G * 8;
    for (int m = gw; m < T; m += NGW) {
        const u32x2* xr2 = (const u32x2*)(XB + (size_t)m * D) + g.lane;
        f32x4* orow = (f32x4*)(P.out + (size_t)m * D) + g.lane;
        f32x4 v[4]; float ss = 0.f;
#pragma unroll
        for (int j = 0; j < 4; ++j) { const u32x2 t2 = xr2[64 * j]; v[j].x = bf2f(t2.x & 0xffffu); v[j].y = bf2f(t2.x >> 16); v[j].z = bf2f(t2.y & 0xffffu); v[j].w = bf2f(t2.y >> 16);
            ss += v[j].x * v[j].x + v[j].y * v[j].y + v[j].z * v[j].z + v[j].w * v[j].w; }
        const float rstd = rsqrtf(wave_sum(ss) * (1.f / D) + EPS);
#pragma unroll
        for (int j = 0; j < 4; ++j) { const f32x4 w4 = *(const f32x4*)(nw + 4 * g.lane + 256 * j); orow[64 * j] = v[j] * rstd * w4; }
    }
}

namespace pg8 {
#define PG8_LAS __attribute__((address_space(3)))
typedef unsigned short bf16_t;
typedef short bf16x8 __attribute__((ext_vector_type(8)));
typedef float f32x4 __attribute__((ext_vector_type(4)));
typedef unsigned u32x4 __attribute__((ext_vector_type(4)));
constexpr int BM = 256, BK = 64, HALF = 128, HTB = HALF * BK * 2  , STAGE_BYTES = 8 * HTB, NXCD = 8, WGM = 8;

__host__ __device__ __forceinline__ int lds_byte(int r, int c) { const int st = (r >> 4) * 2 + (c >> 5), rr = r & 15, cc = c & 31, ob = rr * 64 + cc * 2; return st * 1024 + (ob ^ (((ob >> 9) & 1) << 5)); }
__host__ __device__ __forceinline__ void stage_rc(int b, int& R, int& C) { const int st = b / 1024, sb = b % 1024, swz = sb ^ (((sb >> 9) & 1) << 5); R = (st >> 1) * 16 + swz / 64; C = (st & 1) * 32 + (swz % 64) / 2; }
__host__ __device__ __forceinline__ int perm32(int rho) { const int n = rho >> 4, i = rho & 15; return 8 * (i >> 2) + 4 * n + (i & 3); }

struct Unit { int pm, pn; };
struct Gemm { const bf16_t* A; const bf16_t* Bt; int M, N, K; };

struct StaticOrder {
    int nM, nN, nwg, G, c;
    __host__ __device__ void init(int M, int N, int G_, int c_) { nM = M / BM; nN = N / BM; nwg = nM * nN; G = G_; c = c_; }
    __host__ __device__ bool next(int i, Unit& u) const {
        const long L = (long)i * G + c; if (L >= nwg) return false;
        int wgid = (int)L; { const int q = nwg / NXCD, r = nwg % NXCD, xcd = wgid % NXCD, off = wgid / NXCD; wgid = (xcd < r ? xcd * (q + 1) : r * (q + 1) + (xcd - r) * q) + off; }
        const int nig = WGM * nN, gid = wgid / nig, fm = gid * WGM, gsz = (nM - fm) < WGM ? (nM - fm) : WGM;
        u.pm = fm + ((wgid % nig) % gsz); u.pn = (wgid % nig) / gsz; return true;
    }
    __device__ __forceinline__ void a_ready(const Unit&) const {}
    __device__ __forceinline__ void done(const Unit&) const {}
};
template <class Epi, class Sched, bool ALIGN_EPI = false, bool SP2 = false>
__device__ __forceinline__ void gemm_phase(PG8_LAS unsigned char* lds, const Gemm g, const Sched& S, const Epi& E) {
    const int tid = threadIdx.x, wid = __builtin_amdgcn_readfirstlane(tid >> 6), lane = tid & 63, wr = wid >> 2, wc = wid & 3, fr = lane & 15, fq = lane >> 4;
    const int K = g.K, nt = K / BK;
    unsigned voffA[2], voffB[2];
#pragma unroll
    for (int i = 0; i < 2; ++i) { int R, C; stage_rc(tid * 16 + i * 8192, R, C); const int Rb = Epi::PERM ? ((R & ~31) + perm32(R & 31)) : R;
        voffA[i] = (unsigned)(R * K + C) * 2u; voffB[i] = (unsigned)(Rb * K + C) * 2u; }
    const size_t kstep = (size_t)(BK * 2);
    const size_t hstep = (size_t)HALF * K * 2;
    const size_t tstep = 2 * hstep;
    const unsigned ldsw = (unsigned)wid * 1024u;
    const int aoff = lds_byte(wr * 64 + fr, fq * 8), boff = lds_byte(wc * 32 + fr, fq * 8);
#define PG8_SA(b, h) (((b) * 2 + (h)) * HTB)
#define PG8_SB(b, h) ((4 + (b) * 2 + (h)) * HTB)
#define PG8_STAGE(bufoff, gbase, voff) do { _Pragma("unroll") for (int _i = 0; _i < 2; ++_i) \
        __builtin_amdgcn_global_load_lds((const unsigned*)((const char*)(gbase) + (voff)[_i]), (PG8_LAS unsigned*)(lds + (bufoff) + ldsw + _i * 8192), 16, 0, 0); } while (0)
#define PG8_LDA(dst, b, h) do { _Pragma("unroll") for (int m = 0; m < 4; ++m) _Pragma("unroll") for (int k = 0; k < 2; ++k) dst[m][k] = *(const PG8_LAS bf16x8*)(lds + PG8_SA(b, h) + aoff + m * 2048 + k * 1024); } while (0)
#define PG8_LDB(dst, b, h) do { _Pragma("unroll") for (int n = 0; n < 2; ++n) _Pragma("unroll") for (int k = 0; k < 2; ++k) dst[n][k] = *(const PG8_LAS bf16x8*)(lds + PG8_SB(b, h) + boff + n * 2048 + k * 1024); } while (0)
#define PG8_MMA(ai, bj, At, Bt) do { __builtin_amdgcn_s_setprio(1); _Pragma("unroll") for (int m = 0; m < 4; ++m) _Pragma("unroll") for (int n = 0; n < 2; ++n) _Pragma("unroll") for (int k = 0; k < 2; ++k) \
        acc[ai][bj][m][n] = __builtin_amdgcn_mfma_f32_16x16x32_bf16(Bt[n][k], At[m][k], acc[ai][bj][m][n], 0, 0, 0); __builtin_amdgcn_s_setprio(0); } while (0)
#define PG8_WAIT_V(n) asm volatile("s_waitcnt vmcnt(" #n ")" ::: "memory")
#define PG8_WAIT_L(n) asm volatile("s_waitcnt lgkmcnt(" #n ")" ::: "memory")
#define PG8_BAR __builtin_amdgcn_s_barrier()
#define PG8_SCHED __builtin_amdgcn_sched_barrier(0)
    Unit cur, nxt; int ui = 0;
    if (!S.next(0, cur)) return;
    f32x4 acc[2][2][4][2];
#pragma unroll
    for (int a = 0; a < 2; ++a)
#pragma unroll
        for (int b = 0; b < 2; ++b)
#pragma unroll
            for (int m = 0; m < 4; ++m)
#pragma unroll
                for (int n = 0; n < 2; ++n) acc[a][b][m][n] = (f32x4){0.f, 0.f, 0.f, 0.f};
    bf16x8 At[4][2], B0[2][2], B1[2][2];
    const char* cA = (const char*)g.A + (size_t)cur.pm * tstep; const char* cB = (const char*)g.Bt + (size_t)cur.pn * tstep;
    S.a_ready(cur);
    if constexpr (SP2) {
        PG8_STAGE(PG8_SB(0, 0), cB, voffB); PG8_STAGE(PG8_SB(0, 1), cB + hstep, voffB); PG8_STAGE(PG8_SA(0, 0), cA, voffA); PG8_STAGE(PG8_SA(0, 1), cA + hstep, voffA);
        if (wr == 1) PG8_BAR;
        PG8_WAIT_V(2); PG8_BAR;
        PG8_STAGE(PG8_SB(1, 0), cB + kstep, voffB); PG8_STAGE(PG8_SA(1, 0), cA + kstep, voffA); PG8_STAGE(PG8_SB(1, 1), cB + hstep + kstep, voffB);
        PG8_WAIT_V(6); PG8_BAR;
    } else {
        PG8_STAGE(PG8_SB(0, 0), cB, voffB); PG8_STAGE(PG8_SA(0, 0), cA, voffA); PG8_STAGE(PG8_SB(0, 1), cB + hstep, voffB); PG8_STAGE(PG8_SA(0, 1), cA + hstep, voffA);
        if (wr == 1) PG8_BAR;
        PG8_WAIT_V(4); PG8_BAR;
        PG8_STAGE(PG8_SB(1, 0), cB + kstep, voffB); PG8_STAGE(PG8_SA(1, 0), cA + kstep, voffA); PG8_STAGE(PG8_SB(1, 1), cB + hstep + kstep, voffB);
        PG8_WAIT_V(6); PG8_BAR;
    }
    for (;;) {
        const bool has_next = S.next(ui + 1, nxt);
        const char* nA = has_next ? (const char*)g.A + (size_t)nxt.pm * tstep : cA; const char* nB = has_next ? (const char*)g.Bt + (size_t)nxt.pn * tstep : cB;
        for (int t = 0; t < nt; t += 2) {
            const bool last = (t == nt - 2);
            const char* a1 = cA + (size_t)(t + 1) * kstep;
            const char* a2 = last ? nA : cA + (size_t)(t + 2) * kstep; const char* b2 = last ? nB : cB + (size_t)(t + 2) * kstep;
            const char* a3 = a2 + kstep; const char* b3 = b2 + kstep;
            if (last && has_next) S.a_ready(nxt);
            if constexpr (SP2) {
            PG8_LDB(B0, 0, 0); PG8_LDB(B1, 0, 1); PG8_SCHED; PG8_LDA(At, 0, 0); PG8_STAGE(PG8_SA(1, 1), a1 + hstep, voffA);
            PG8_WAIT_V(8); PG8_WAIT_L(0); PG8_BAR; PG8_MMA(0, 0, At, B0); PG8_MMA(0, 1, At, B1); PG8_BAR; PG8_SCHED;
            PG8_LDA(At, 0, 1); PG8_STAGE(PG8_SB(0, 0), b2, voffB); PG8_STAGE(PG8_SB(0, 1), b2 + hstep, voffB); PG8_STAGE(PG8_SA(0, 0), a2, voffA);
            PG8_WAIT_V(8); PG8_WAIT_L(0); PG8_BAR; PG8_MMA(1, 0, At, B0); PG8_MMA(1, 1, At, B1); PG8_BAR; PG8_SCHED;
            PG8_LDB(B0, 1, 0); PG8_LDB(B1, 1, 1); PG8_SCHED; PG8_LDA(At, 1, 0); PG8_STAGE(PG8_SA(0, 1), a2 + hstep, voffA);
            PG8_WAIT_V(8); PG8_WAIT_L(0); PG8_BAR; PG8_MMA(0, 0, At, B0); PG8_MMA(0, 1, At, B1); PG8_BAR; PG8_SCHED;
            PG8_LDA(At, 1, 1); PG8_STAGE(PG8_SB(1, 0), b3, voffB); PG8_STAGE(PG8_SB(1, 1), b3 + hstep, voffB); PG8_STAGE(PG8_SA(1, 0), a3, voffA);
            PG8_WAIT_V(8); PG8_WAIT_L(0); PG8_BAR; PG8_MMA(1, 0, At, B0); PG8_MMA(1, 1, At, B1); PG8_BAR; PG8_SCHED;
            } else {
            PG8_LDB(B0, 0, 0); PG8_SCHED; PG8_LDA(At, 0, 0); PG8_STAGE(PG8_SA(1, 1), a1 + hstep, voffA);
            PG8_WAIT_L(8); PG8_BAR; PG8_WAIT_L(0); PG8_MMA(0, 0, At, B0); PG8_BAR; PG8_SCHED;
            PG8_LDB(B1, 0, 1); PG8_STAGE(PG8_SB(0, 0), b2, voffB);
            PG8_BAR; PG8_WAIT_L(0); PG8_MMA(0, 1, At, B1); PG8_BAR;
            PG8_LDA(At, 0, 1); PG8_STAGE(PG8_SA(0, 0), a2, voffA);
            PG8_BAR; PG8_WAIT_L(0); PG8_MMA(1, 0, At, B0); PG8_BAR; PG8_SCHED;
            PG8_STAGE(PG8_SB(0, 1), b2 + hstep, voffB);
            PG8_WAIT_V(6); PG8_BAR; PG8_MMA(1, 1, At, B1); PG8_BAR;
            PG8_LDB(B0, 1, 0); PG8_SCHED; PG8_LDA(At, 1, 0); PG8_STAGE(PG8_SA(0, 1), a2 + hstep, voffA);
            PG8_WAIT_L(8); PG8_BAR; PG8_WAIT_L(0); PG8_MMA(0, 0, At, B0); PG8_BAR; PG8_SCHED;
            PG8_LDB(B1, 1, 1); PG8_STAGE(PG8_SB(1, 0), b3, voffB);
            PG8_BAR; PG8_WAIT_L(0); PG8_MMA(0, 1, At, B1); PG8_BAR;
            PG8_LDA(At, 1, 1); PG8_STAGE(PG8_SA(1, 0), a3, voffA);
            PG8_BAR; PG8_WAIT_L(0); PG8_MMA(1, 0, At, B0); PG8_BAR; PG8_SCHED;
            PG8_STAGE(PG8_SB(1, 1), b3 + hstep, voffB);
            PG8_WAIT_V(6); PG8_BAR; PG8_MMA(1, 1, At, B1); PG8_BAR;
            }
        }
        if constexpr (ALIGN_EPI) { if (wr == 0) PG8_BAR; }
        if constexpr (!Epi::AFTER_DRAIN) { E(acc, cur, wr, wc, fr, fq); S.done(cur); }
        if (!has_next) break;
#pragma unroll
        for (int a = 0; a < 2; ++a)
#pragma unroll
            for (int b = 0; b < 2; ++b)
#pragma unroll
                for (int m = 0; m < 4; ++m)
#pragma unroll
                    for (int n = 0; n < 2; ++n) acc[a][b][m][n] = (f32x4){0.f, 0.f, 0.f, 0.f};
        cur = nxt; cA = nA; cB = nB; ++ui;
        if constexpr (ALIGN_EPI) { if (wr == 1) PG8_BAR; }
    }
    PG8_WAIT_V(0);
    if constexpr (!ALIGN_EPI) { if (wr == 0) PG8_BAR; }
    PG8_BAR;
    if constexpr (Epi::AFTER_DRAIN) { E.fused(acc, cur, wr, wc, fr, fq, lds, wid, lane); S.done(cur); }
#undef PG8_SA
#undef PG8_SB
#undef PG8_STAGE
#undef PG8_LDA
#undef PG8_LDB
#undef PG8_MMA
#undef PG8_WAIT_V
#undef PG8_WAIT_L
#undef PG8_BAR
#undef PG8_SCHED
}
}

namespace pg8 {
__device__ __forceinline__ unsigned cvt_pk_bf16(float lo, float hi) { unsigned r; asm volatile("v_cvt_pk_bf16_f32 %0, %1, %2" : "=v"(r) : "v"(lo), "v"(hi)); return r; }
struct EpiE1x {
    static constexpr bool PERM = true, AFTER_DRAIN = false;
    bf16_t *U, *VT;
    __device__ __forceinline__ void operator()(const f32x4 (&acc)[2][2][4][2], const Unit& u, int wr, int wc, int fr, int fq) const {
        const int row0 = u.pm * BM + wr * 64 + fr, type = u.pn >> 1, colt = (u.pn & 1) * 256 + wc * 32 + 8 * fq;
        if (type < 2) {
            bf16_t* base = U + (size_t)type * ((size_t)T * 512);
            const float sc = type == 1 ? QSCALE : 1.f;
#pragma unroll
            for (int ai = 0; ai < 2; ++ai)
#pragma unroll
                for (int m = 0; m < 4; ++m) { bf16_t* rowp = base + (size_t)(row0 + ai * HALF + m * 16) * 512 + colt;
#pragma unroll
                    for (int bj = 0; bj < 2; ++bj) { const f32x4 v0 = acc[ai][bj][m][0] * sc, v1 = acc[ai][bj][m][1] * sc;
                        u32x4 w; w.x = cvt_pk_bf16(v0[0], v0[1]); w.y = cvt_pk_bf16(v0[2], v0[3]); w.z = cvt_pk_bf16(v1[0], v1[1]); w.w = cvt_pk_bf16(v1[2], v1[3]);
                        *(u32x4*)(rowp + bj * HALF) = w; } }
        } else if (type == 2) {
            bf16_t* KT = U + (size_t)2 * ((size_t)T * 512);
#pragma unroll
            for (int ai = 0; ai < 2; ++ai)
#pragma unroll
                for (int m = 0; m < 4; ++m) { const int row = row0 + ai * HALF + m * 16, b = row / SEQ, sq = row % SEQ;
#pragma unroll
                    for (int bj = 0; bj < 2; ++bj) { const int col = colt + bj * HALF, h = col >> 6, d0 = col & 63;
                        const f32x4 v0 = acc[ai][bj][m][0], v1 = acc[ai][bj][m][1];
                        u32x4 w; w.x = cvt_pk_bf16(v0[0], v0[1]); w.y = cvt_pk_bf16(v0[2], v0[3]); w.z = cvt_pk_bf16(v1[0], v1[1]); w.w = cvt_pk_bf16(v1[2], v1[3]);
                        *(u32x4*)(KT + ((((size_t)b * NHEAD + h) * 128 + (sq >> 5)) * 4 + (d0 >> 4)) * 512 + (((d0 >> 3) & 1) * 32 + (sq & 31)) * 8) = w; } }
        } else {
#pragma unroll
            for (int ai = 0; ai < 2; ++ai)
#pragma unroll
                for (int m = 0; m < 4; ++m) { const int row = row0 + ai * HALF + m * 16, b = row / SEQ, sq = row % SEQ, kvl = sq & 31;
                    const int sp = kvl >> 4, r = kvl & 15, hh = (r >> 2) & 1, e = (r & 3) + 4 * (r >> 3);
#pragma unroll
                    for (int bj = 0; bj < 2; ++bj) { const int col = colt + bj * HALF, h = col >> 6, d0 = col & 63;
                        bf16_t* p = VT + (((((size_t)b * NHEAD + h) * 128 + (sq >> 5)) * 2 + (d0 >> 5)) * 2 + sp) * 512 + (hh * 32 + (d0 & 31)) * 8 + e;
                        const f32x4 v0 = acc[ai][bj][m][0], v1 = acc[ai][bj][m][1];
                        const unsigned w0 = cvt_pk_bf16(v0[0], v0[1]), w1 = cvt_pk_bf16(v0[2], v0[3]), w2 = cvt_pk_bf16(v1[0], v1[1]), w3 = cvt_pk_bf16(v1[2], v1[3]);
                        p[0] = (bf16_t)w0; p[8] = (bf16_t)(w0 >> 16); p[16] = (bf16_t)w1; p[24] = (bf16_t)(w1 >> 16);
                        p[32] = (bf16_t)w2; p[40] = (bf16_t)(w2 >> 16); p[48] = (bf16_t)w3; p[56] = (bf16_t)(w3 >> 16); } }
        }
    }
};
struct EpiSplitX {
    static constexpr bool PERM = true, AFTER_DRAIN = false;
    bf16_t *A0;
    unsigned* xhalo;
    __device__ __forceinline__ void operator()(const f32x4 (&acc)[2][2][4][2], const Unit& u, int wr, int wc, int fr, int fq) const {
        const int row0 = u.pm * BM + wr * 64 + fr, colt = (u.pn & 7) * 256 + wc * 32 + 8 * fq;
        bf16_t* base = A0 + (size_t)(u.pn >> 3) * ((size_t)T * 2048);
#pragma unroll
        for (int ai = 0; ai < 2; ++ai)
#pragma unroll
            for (int m = 0; m < 4; ++m) { bf16_t* rowp = base + (size_t)(row0 + ai * HALF + m * 16) * 2048 + colt;
#pragma unroll
                for (int bj = 0; bj < 2; ++bj) { const f32x4 v0 = acc[ai][bj][m][0], v1 = acc[ai][bj][m][1];
                    u32x4 w; w.x = cvt_pk_bf16(v0[0], v0[1]); w.y = cvt_pk_bf16(v0[2], v0[3]); w.z = cvt_pk_bf16(v1[0], v1[1]); w.w = cvt_pk_bf16(v1[2], v1[3]);
                    *(u32x4*)(rowp + bj * HALF) = w;
                    if ((u.pn >> 3) == 0 && (u.pm & 3) == 3 && wr == 1 && ai == 1 && m == 3 && fr >= 13) { const int r = row0 + ai * HALF + m * 16;
                        const int unit = (r >> 12) * 32 + (u.pn & 7) * 4 + ((r >> 10) & 3);
                        *(u32x4*)(xhalo + ((size_t)unit * 3 + (fr - 13)) * 128 + (wc * 32 + 8 * fq + bj * HALF) / 2) = w; } } }
    }
};
struct EpiGateNorm {
    static constexpr bool PERM = true, AFTER_DRAIN = false;
    bf16_t* Y; PG8_LAS float* xch;
    __device__ __forceinline__ void operator()(f32x4 (&acc)[2][2][4][2], const Unit& u, int wr, int wc, int fr, int fq) const {
        const int row0 = u.pm * BM + wr * 64 + fr, colt = (u.pn & 7) * 256 + wc * 32 + 8 * fq;
#pragma unroll
        for (int ai = 0; ai < 2; ++ai)
#pragma unroll
            for (int m = 0; m < 4; ++m) { const bf16_t* rowp = Y + (size_t)(row0 + ai * HALF + m * 16) * 2048 + colt; float sq = 0.f;
#pragma unroll
                for (int bj = 0; bj < 2; ++bj) { const u32x4 y8 = *(const u32x4*)(rowp + bj * HALF);
#pragma unroll
                    for (int n = 0; n < 2; ++n)
#pragma unroll
                        for (int e = 0; e < 4; ++e) { const unsigned yw = y8[2 * n + (e >> 1)]; const float yv = (e & 1) ? __uint_as_float(yw & 0xffff0000u) : __uint_as_float(yw << 16);
                            const float z = acc[ai][bj][m][n][e]; const float gv = yv * z * __builtin_amdgcn_rcpf(1.f + __expf(-z));
                            acc[ai][bj][m][n][e] = gv; sq += gv * gv; } }
                sq = xhalf_sum(x16_sum(sq));
                if (fq == 0) xch[(ai * HALF + wr * 64 + m * 16 + fr) * 4 + wc] = sq; }
        asm volatile("s_waitcnt lgkmcnt(0)" ::: "memory"); __builtin_amdgcn_s_barrier(); asm volatile("" ::: "memory");
#pragma unroll
        for (int ai = 0; ai < 2; ++ai)
#pragma unroll
            for (int m = 0; m < 4; ++m) { const int r = ai * HALF + wr * 64 + m * 16 + fr; const f32x4 p4 = *(const PG8_LAS f32x4*)(xch + r * 4);
                const float rs = __builtin_amdgcn_rsqf(((p4[0] + p4[1]) + (p4[2] + p4[3])) * (1.0f / 256.0f) + 1e-6f);
                bf16_t* rowp = Y + (size_t)(row0 + ai * HALF + m * 16) * 2048 + colt;
#pragma unroll
                for (int bj = 0; bj < 2; ++bj) { const f32x4 v0 = acc[ai][bj][m][0] * rs, v1 = acc[ai][bj][m][1] * rs;
                    u32x4 w; w.x = cvt_pk_bf16(v0[0], v0[1]); w.y = cvt_pk_bf16(v0[2], v0[3]); w.z = cvt_pk_bf16(v1[0], v1[1]); w.w = cvt_pk_bf16(v1[2], v1[3]);
                    *(u32x4*)(rowp + bj * HALF) = w; } }
        asm volatile("s_waitcnt lgkmcnt(0)" ::: "memory"); __builtin_amdgcn_s_barrier(); asm volatile("" ::: "memory");
    }
};
template <bool BASE_F32>
struct EpiResGate {
    static constexpr bool PERM = true, AFTER_DRAIN = false;
    const void* base; bf16_t* out; const float* gate; float* ssp;
    __device__ __forceinline__ void operator()(const f32x4 (&acc)[2][2][4][2], const Unit& u, int wr, int wc, int fr, int fq) const {
        const int row0 = u.pm * BM + wr * 64 + fr, b = (u.pm * BM) / SEQ, col0 = u.pn * BM + wc * 32 + 8 * fq;
        f32x4 gv[2][2];
#pragma unroll
        for (int bj = 0; bj < 2; ++bj)
#pragma unroll
            for (int n = 0; n < 2; ++n) gv[bj][n] = *(const f32x4*)(gate + (size_t)b * 6144 + col0 + bj * HALF + n * 4);
        constexpr int MB = BASE_F32 ? 2 : 4;
#pragma unroll
        for (int ai = 0; ai < 2; ++ai)
#pragma unroll
            for (int m0 = 0; m0 < 4; m0 += MB) {
                f32x4 rf[MB][2][BASE_F32 ? 2 : 1]; u32x4 rx[MB][2];
#pragma unroll
                for (int mm = 0; mm < MB; ++mm) { const size_t off = (size_t)(row0 + ai * HALF + (m0 + mm) * 16) * D + col0;
#pragma unroll
                    for (int bj = 0; bj < 2; ++bj) {
                        if (BASE_F32) { rf[mm][bj][0] = *(const f32x4*)((const float*)base + off + bj * HALF); rf[mm][bj][BASE_F32 ? 1 : 0] = *(const f32x4*)((const float*)base + off + bj * HALF + 4); }
                        else rx[mm][bj] = *(const u32x4*)((const bf16_t*)base + off + bj * HALF); } }
#pragma unroll
                for (int mm = 0; mm < MB; ++mm) { const int m = m0 + mm; const size_t off = (size_t)(row0 + ai * HALF + m * 16) * D + col0; float sq = 0.f;
#pragma unroll
                    for (int bj = 0; bj < 2; ++bj) { f32x4 b0, b1;
                        if (BASE_F32) { b0 = rf[mm][bj][0]; b1 = rf[mm][bj][BASE_F32 ? 1 : 0]; }
                        else { const u32x4 x8 = rx[mm][bj];
                            b0[0] = __uint_as_float(x8.x << 16); b0[1] = __uint_as_float(x8.x & 0xffff0000u); b0[2] = __uint_as_float(x8.y << 16); b0[3] = __uint_as_float(x8.y & 0xffff0000u);
                            b1[0] = __uint_as_float(x8.z << 16); b1[1] = __uint_as_float(x8.z & 0xffff0000u); b1[2] = __uint_as_float(x8.w << 16); b1[3] = __uint_as_float(x8.w & 0xffff0000u); }
                        const f32x4 o0 = b0 + gv[bj][0] * acc[ai][bj][m][0], o1 = b1 + gv[bj][1] * acc[ai][bj][m][1];
                        sq += ((o0[0] * o0[0] + o0[1] * o0[1]) + (o0[2] * o0[2] + o0[3] * o0[3])) + ((o1[0] * o1[0] + o1[1] * o1[1]) + (o1[2] * o1[2] + o1[3] * o1[3]));
                        u32x4 w8; w8.x = cvt_pk_bf16(o0[0], o0[1]); w8.y = cvt_pk_bf16(o0[2], o0[3]); w8.z = cvt_pk_bf16(o1[0], o1[1]); w8.w = cvt_pk_bf16(o1[2], o1[3]);
                        *(u32x4*)(out + off + bj * HALF) = w8; }
                    sq = xhalf_sum(x16_sum(sq));
                    if (fq == 0) ssp[(size_t)(row0 + ai * HALF + m * 16) * 16 + u.pn * 4 + wc] = sq; }
            }
    }
};
}

#define XB_TMO      128
#define XB_XCNT(j)  (256  + 64 * (j))
#define XB_XSUB(j)  (1280 + 64 * (j))
#define XB_XGEN(j)  (2304 + 64 * (j))
#define XB_TOP      3328
#define XB_TOPGEN   3392
#define XCD_BAR_WORDS 3456
#define XB_SPIN_CAP (1u << 18)

__device__ __forceinline__ unsigned xb_ld(unsigned* p)              { return __hip_atomic_load(p, __ATOMIC_RELAXED, __HIP_MEMORY_SCOPE_AGENT); }
__device__ __forceinline__ unsigned xb_add(unsigned* p, unsigned v) { return __hip_atomic_fetch_add(p, v, __ATOMIC_RELAXED, __HIP_MEMORY_SCOPE_AGENT); }
__device__ __forceinline__ unsigned xb_xcc_id() { return (unsigned)__builtin_amdgcn_s_getreg((3 << 11) | 20) & 0xFu; }
#define XB_SPIN(cond, bar) do { unsigned _sp = 0; while (cond) { __builtin_amdgcn_s_sleep(1); \
    if ((++_sp & 255u) == 0u) { if (xb_ld(&(bar)[XB_TMO])) break; if (_sp > XB_SPIN_CAP) { atomicAdd(&(bar)[XB_TMO], 1u); break; } } } } while (0)

struct XcdBarrier {
    unsigned* bar; unsigned x;
    volatile LAS unsigned* st;
};

__device__ __forceinline__ XcdBarrier xcd_barrier_post(unsigned* bar, volatile LAS unsigned* st) {
    XcdBarrier b; b.bar = bar; b.x = xb_xcc_id(); b.st = st;
    if (threadIdx.x == 0) (void)xb_add(&bar[XB_XCNT(b.x)], 1u);
    return b;
}
__device__ __forceinline__ void xcd_barrier_complete(unsigned* bar, unsigned x, unsigned& nloc, unsigned& nx) {
    const unsigned G = gridDim.x * gridDim.y * gridDim.z;
    unsigned sum, cnt, mine, sp = 0u;
    for (;;) {
        sum = 0u; cnt = 0u; mine = 0u;
#pragma unroll
        for (unsigned j = 0; j < 16; ++j) { const unsigned c = xb_ld(&bar[XB_XCNT(j)]); sum += c; cnt += (c > 0u) ? 1u : 0u; mine = (j == x) ? c : mine; }
        if (sum == G) break;
        __builtin_amdgcn_s_sleep(1);
        if ((++sp & 255u) == 0u) { if (xb_ld(&bar[XB_TMO])) break; if (sp > XB_SPIN_CAP) { atomicAdd(&bar[XB_TMO], 1u); break; } }
    }
    nloc = mine > 0u ? mine : 1u; nx = cnt > 0u ? cnt : 1u;
}

__device__ __forceinline__ void xcd_barrier(const XcdBarrier& b) {
    asm volatile("s_waitcnt vmcnt(0)" ::: "memory");
    __syncthreads();
    if (threadIdx.x == 0) {
        unsigned* bar = b.bar;
        __builtin_amdgcn_s_waitcnt(0);
        unsigned nloc = b.st[0], nx = b.st[1];
        if (nloc == 0u) { xcd_barrier_complete(bar, b.x, nloc, nx); b.st[0] = nloc; b.st[1] = nx; }
        const unsigned old = xb_add(&bar[XB_XSUB(b.x)], 1u);
        const unsigned gen = old / nloc;
        if (old + 1u == (gen + 1u) * nloc) {
            __builtin_amdgcn_fence(__ATOMIC_RELEASE, "agent");
            asm volatile("s_waitcnt vmcnt(0)" ::: "memory");
            const unsigned og = xb_add(&bar[XB_TOP], 1u);
            const unsigned tg = og / nx;
            if (og + 1u == (tg + 1u) * nx) xb_add(&bar[XB_TOPGEN], 1u);
            else XB_SPIN(xb_ld(&bar[XB_TOPGEN]) == tg, bar);
            __builtin_amdgcn_fence(__ATOMIC_ACQUIRE, "agent");
            xb_add(&bar[XB_XGEN(b.x)], 1u);
            asm volatile("s_waitcnt vmcnt(0)" ::: "memory");
        } else {
            XB_SPIN(xb_ld(&bar[XB_XGEN(b.x)]) == gen, bar);
            __builtin_amdgcn_fence(__ATOMIC_ACQUIRE, "agent");
            asm volatile("s_waitcnt vmcnt(0)" ::: "memory");
        }
    }
    __syncthreads();
}

#define LDS_WAIT() asm volatile("s_waitcnt lgkmcnt(0)" ::: "memory")
template <int MODE>
__device__ __forceinline__ void transpose_item(const float* W, int ldw, int K, bf16_t* WT, int row_off, float* scr, int kb, int nb, int lane, const float* kscale) {
    const int k0 = 64 * kb, n0 = 32 * nb;
#pragma unroll 32
    for (int i = 0; i < 32; ++i) { const int kk = 2 * i + (lane >> 5); float v = W[(size_t)(k0 + kk) * ldw + n0 + (lane & 31)]; if (kscale) v *= kscale[k0 + kk]; scr[kk * 33 + (lane & 31)] = v; }
    LDS_WAIT(); asm volatile("" ::: "memory");
    const int c = lane & 7;
#pragma unroll
    for (int j = 0; j < 4; ++j) { const int n = (lane >> 3) + 8 * j; const float* s = scr + (8 * c) * 33 + n;
        u32x4 o; o.x = pk2(s[0 * 33], s[1 * 33]); o.y = pk2(s[2 * 33], s[3 * 33]); o.z = pk2(s[4 * 33], s[5 * 33]); o.w = pk2(s[6 * 33], s[7 * 33]);
        const int ng = n0 + n, orow = MODE == 1 ? (row_off + 32 * (ng >> 4) + (ng & 15)) : (row_off + ng);
        if (MODE == 1) {
            const int kk = k0 + 8 * c; const size_t blk = ((size_t)(orow >> 5) * 32 + (kk >> 5)) * 2 + ((orow >> 4) & 1);
            *(u32x4*)(WT + (blk * 64 + ((kk >> 3) & 3) * 16 + (orow & 15)) * 8) = o;
        } else if (MODE == 3) {
            const int kk = k0 + 8 * c, u = orow & 31; const size_t blk = (size_t)(2 * (orow >> 5) + ((u >> 2) & 1)) * (K >> 5) + (kk >> 5);
            *(u32x4*)(WT + (blk * 64 + ((kk >> 3) & 3) * 16 + 4 * (u >> 3) + (u & 3)) * 8) = o;
        } else if (MODE == 2) {
            const int kk = k0 + 8 * c; const size_t blk = (size_t)(orow >> 4) * (K >> 5) + (kk >> 5);
            *(u32x4*)(WT + (blk * 64 + ((kk >> 3) & 3) * 16 + (orow & 15)) * 8) = o;
        } else *(u32x4*)(WT + (size_t)orow * K + k0 + 8 * c) = o; }
    LDS_WAIT(); asm volatile("" ::: "memory");
}
__device__ __forceinline__ void phase_convert(const Params& P, const Geo& g, float* ldsf) {
    float* scr = ldsf + g.wave * (64 * 33);
    const int gw = g.vcu * 8 + g.wave, NGW = g.G * 8;
    unsigned char* ws = P.ws;
    for (int e = gw * 64 + g.lane; e < DEPTH * 48 * D; e += NGW * 64) { const int Lr = e / (48 * D), rem = e % (48 * D), ct = rem / (16 * D), s_ = (rem / 512) & 31, ln = (rem >> 3) & 63, jj = rem & 7;
        const int j = 16 * ct + (ln & 15), k = 32 * s_ + 8 * (ln >> 4) + jj;
        const float v = j < 4 ? P.in[I_WG][((size_t)Lr * D + k) * 4 + j] : (j < 36 ? P.in[I_WE][((size_t)Lr * D + k) * 32 + j - 4] : 0.f);
        const unsigned hi = f2bf(v); ((bf16_t*)(ws + WS_WRH))[e] = (bf16_t)hi; ((bf16_t*)(ws + WS_WRL))[e] = (bf16_t)f2bf(v - bf2f(hi)); }
    for (int e = gw * 64 + g.lane; e < 2 * 32 * D; e += NGW * 64) { const int ir = e / (32 * D), rem = e % (32 * D), ct = rem / (16 * D), s_ = (rem / 512) & 31, ln = (rem >> 3) & 63, jj = rem & 7;
        const int j = 16 * ct + (ln & 15), k = 32 * s_ + 8 * (ln >> 4) + jj;
        const float v = P.in[I_SSMIN][((size_t)ir * D + k) * SSM_IN + 6144 + j];
        const unsigned hi = f2bf(v); ((bf16_t*)(ws + WS_WDH))[e] = (bf16_t)hi; ((bf16_t*)(ws + WS_WDL))[e] = (bf16_t)f2bf(v - bf2f(hi)); }
    constexpr int C0 = 2 * 1024, C1 = C0 + 2 * 512, C2 = C1 + 2 * 2048, C3 = C2 + 2 * 1024, C4 = C3 + 2 * 1024, C5 = C4 + 8 * 8, C6 = C5 + 128 * 64, C7 = C6 + 128 * 64, C8 = C7 + 128 * 64;
    for (int it = gw; it < C8; it += NGW) {
        int r = it;
        if (r < C0) { const int mat = r / 1024, rem = r % 1024;
            transpose_item<0>(P.in[I_MIXIN] + (size_t)mat * D * MIX_IN, MIX_IN, D, (bf16_t*)(ws + WS_WMI) + (size_t)mat * MIX_IN * D, 0, scr, rem / 64, rem % 64, g.lane, nullptr); continue; }
        r -= C0;
        if (r < 2 * 512) { const int mat = r / 512, rem = r % 512;
            transpose_item<0>(P.in[I_MIXOUT] + (size_t)mat * D * D, D, D, (bf16_t*)(ws + WS_WMO) + (size_t)mat * D * D, 0, scr, rem / 32, rem % 32, g.lane, nullptr); continue; }
        r -= 2 * 512;
        if (r < 2 * 2048) { const int mat = r / 2048, rem = r % 2048;
            transpose_item<0>(P.in[I_SSMIN] + (size_t)mat * D * SSM_IN + 2048, SSM_IN, D, (bf16_t*)(ws + WS_WSX) + (size_t)mat * 4096 * D, 0, scr, rem / 128, rem % 128, g.lane, nullptr); continue; }
        r -= 2 * 2048;
        if (r < 2 * 1024) { const int mat = r / 1024, rem = r % 1024;
            transpose_item<0>(P.in[I_SSMIN] + (size_t)mat * D * SSM_IN, SSM_IN, D, (bf16_t*)(ws + WS_WSZ) + (size_t)mat * 2048 * D, 0, scr, rem / 64, rem % 64, g.lane, nullptr); continue; }
        r -= 2 * 1024;
        if (r < 2 * 1024) { const int mat = r / 1024, rem = r % 1024;
            transpose_item<0>(P.in[I_SSMOUT] + (size_t)mat * SSM_DI * D, D, SSM_DI, (bf16_t*)(ws + WS_WSO) + (size_t)mat * D * SSM_DI, 0, scr, rem / 32, rem % 32, g.lane, P.in[I_SSMNW] + mat * SSM_DI); continue; }
        r -= 2 * 1024;
        if (r < 64) { const int mat = r / 8, rem = r % 8;
            transpose_item<0>(P.in[I_POOLW] + (size_t)mat * 128 * 128, 128, 128, (bf16_t*)(ws + WS_WPL) + (size_t)mat * 128 * 128, 0, scr, rem / 4, rem % 4, g.lane, nullptr); continue; }
        r -= 64;
        if (r < 128 * 64) { const int mat = r / 64, rem = r % 64;
            transpose_item<1>(P.in[I_W1] + (size_t)mat * D * MOE_FF, MOE_FF, D, (bf16_t*)(ws + WS_W13) + (size_t)mat * 256 * D, 0, scr, rem / 4, rem % 4, g.lane, nullptr); continue; }
        r -= 128 * 64;
        if (r < 128 * 64) { const int mat = r / 64, rem = r % 64;
            transpose_item<1>(P.in[I_W3] + (size_t)mat * D * MOE_FF, MOE_FF, D, (bf16_t*)(ws + WS_W13) + (size_t)mat * 256 * D, 16, scr, rem / 4, rem % 4, g.lane, nullptr); continue; }
        r -= 128 * 64;
        { const int mat = r / 64, rem = r % 64;
            transpose_item<3>(P.in[I_W2] + (size_t)mat * MOE_FF * D, D, MOE_FF, (bf16_t*)(ws + WS_W2T) + (size_t)mat * D * MOE_FF, 0, scr, rem / 32, rem % 32, g.lane, nullptr); }
    }
}


#define LDS_BARRIER() do { asm volatile("s_waitcnt lgkmcnt(0)" ::: "memory"); __builtin_amdgcn_s_barrier(); asm volatile("" ::: "memory"); } while (0)
template <int NMT>
__device__ __forceinline__ void moe_pass(const Params& P, LAS unsigned char* l3, int L, int w, int lane, int bucket, int off, int nrows, int e0, int e1, bool dry) {
    constexpr int HS = 528, OFF_B1 = 67584, OFF_GT = 67584;
    constexpr int OFF_TOK = 133120, OFF_WLO = OFF_TOK + 512, OFF_WHI = OFF_WLO + 512;
    LAS int* tok = (LAS int*)(l3 + OFF_TOK); LAS float* wlo = (LAS float*)(l3 + OFF_WLO); LAS float* whi = (LAS float*)(l3 + OFF_WHI);
    unsigned char* ws = P.ws;
    const int* list = (const int*)(ws + WS_LIST);
    const float2* tokw = (const float2*)(ws + WS_TOKW);
    const bf16_t* H = (const bf16_t*)P.out;
    const float* gate2 = (const float*)(ws + WS_MOD) + (size_t)L * NB * 6144 + 5120;
    const int j16 = lane & 15, q4 = lane >> 4, tid = w * 64 + lane;
    float2 tww = make_float2(0.f, 0.f);
    if (tid < 128) { const int r = tid; int t = -1;
        if (r < nrows) { t = list[(size_t)bucket * T + off + r]; tww = tokw[t]; }
        tok[r] = t; }
    LDS_BARRIER();
#define MOE_GATHER(KC, BO) do { if (w < NMT) { _Pragma("unroll") for (int i = 0; i < 8; ++i) { int t = tok[16 * w + 2 * i + (lane >> 5)]; t = t < 0 ? 0 : t; \
        const int s = (lane & 31) ^ ((2 * i + (lane >> 5)) & 15); \
        __builtin_amdgcn_global_load_lds((const unsigned*)(H + (size_t)t * D + (KC) * 256 + s * 8), (LAS unsigned*)(l3 + (BO) + (16 * w + 2 * i) * 512), 16, 0, 0); } } } while (0)
    f32x4 gtv[4];
    {
        const char* Wu0 = (const char*)(ws + WS_W13) + ((size_t)(L * MOE_E + e0) * 256 * D + (size_t)w * 32 * 1024) * 2;
        const char* Wu1 = (const char*)(ws + WS_W13) + ((size_t)(L * MOE_E + e1) * 256 * D + (size_t)w * 32 * 1024) * 2;
        const unsigned lo16 = (unsigned)lane * 16u;
#define W13F(U, KS, S) (*(const bf16x8*)((U) + (size_t)(lo16 + (unsigned)(2048 * (KS) + 1024 * (S)))))
        f32x4 acc[2][NMT][2];
#pragma unroll
        for (int es = 0; es < 2; ++es)
#pragma unroll
            for (int mt = 0; mt < NMT; ++mt) { acc[es][mt][0] = (f32x4){0.f, 0.f, 0.f, 0.f}; acc[es][mt][1] = (f32x4){0.f, 0.f, 0.f, 0.f}; }
        MOE_GATHER(0, 0);
        asm volatile("" ::: "memory");
        bf16x8 rb[2][4];
#pragma unroll
        for (int j = 0; j < 2; ++j) { rb[j][0] = W13F(Wu0, j, 0); rb[j][1] = W13F(Wu0, j, 1); rb[j][2] = W13F(Wu1, j, 0); rb[j][3] = W13F(Wu1, j, 1); }
        if (tid < 128) { wlo[tid] = tww.x; whi[tid] = tww.y; }
        asm volatile("s_waitcnt vmcnt(8)" ::: "memory");
        LDS_BARRIER();
#pragma unroll 1
        for (int kc = 0; kc < 4; ++kc) {
            int lk = lane; asm volatile("" : "+v"(lk));
            const int lane = lk, j16 = lane & 15, q4 = lane >> 4; const unsigned lo16 = (unsigned)lane * 16u;
            const int aoff = j16 * 512 + ((q4 ^ j16) << 4);
            const int bo = (kc & 1) ? OFF_B1 : 0;
            if (kc < 3) { if (kc & 1) MOE_GATHER(kc + 1, 0); else MOE_GATHER(kc + 1, OFF_B1); }
            asm volatile("" ::: "memory");
#pragma unroll
            for (int ksl = 0; ksl < 8; ++ksl) {
                const int ks = 8 * kc + ksl;
                const LAS unsigned char* ap = l3 + bo + (aoff ^ (ksl << 6));
#pragma unroll
                for (int mt = 0; mt < NMT; ++mt) { const bf16x8 a = *(const LAS bf16x8*)(ap + mt * 8192);
                    acc[0][mt][0] = __builtin_amdgcn_mfma_f32_16x16x32_bf16(a, rb[ksl & 1][0], acc[0][mt][0], 0, 0, 0);
                    acc[0][mt][1] = __builtin_amdgcn_mfma_f32_16x16x32_bf16(a, rb[ksl & 1][1], acc[0][mt][1], 0, 0, 0); }
                if (kc < 3 || ksl < 6) { rb[ksl & 1][0] = W13F(Wu0, ks + 2, 0); rb[ksl & 1][1] = W13F(Wu0, ks + 2, 1); }
                __builtin_amdgcn_sched_barrier(0);
#pragma unroll
                for (int mt = 0; mt < NMT; ++mt) { const bf16x8 a = *(const LAS bf16x8*)(ap + mt * 8192);
                    acc[1][mt][0] = __builtin_amdgcn_mfma_f32_16x16x32_bf16(a, rb[ksl & 1][2], acc[1][mt][0], 0, 0, 0);
                    acc[1][mt][1] = __builtin_amdgcn_mfma_f32_16x16x32_bf16(a, rb[ksl & 1][3], acc[1][mt][1], 0, 0, 0); }
                if (kc < 3 || ksl < 6) { rb[ksl & 1][2] = W13F(Wu1, ks + 2, 0); rb[ksl & 1][3] = W13F(Wu1, ks + 2, 1); }
                __builtin_amdgcn_sched_barrier(0);
            }
            if (kc < 3) { asm volatile("s_waitcnt vmcnt(8)" ::: "memory"); LDS_BARRIER(); }
        }
        int l2 = lane; asm volatile("" : "+v"(l2));
        { const int lane = l2, j16 = lane & 15, q4 = lane >> 4, tid = w * 64 + lane;
#pragma unroll
        for (int i = 0; i < 4; ++i) { const int e = tid + 512 * i; gtv[i] = *(const f32x4*)(gate2 + (size_t)(e >> 8) * 6144 + (e & 255) * 4); }
#pragma unroll
        for (int es = 0; es < 2; ++es)
#pragma unroll
            for (int mt = 0; mt < NMT; ++mt) { LAS bf16_t* hb = (LAS bf16_t*)(l3 + (16 * mt + 4 * q4) * HS) + 128 * es + 16 * w + j16;
#pragma unroll
                for (int r = 0; r < 4; ++r) { const int l = 16 * mt + 4 * q4 + r; const float wt = es ? whi[l] : wlo[l];
                    hb[r * (HS / 2)] = (bf16_t)f2bf(silu_f(acc[es][mt][0][r]) * acc[es][mt][1][r] * wt); } }
        }
    }
#undef MOE_GATHER
#undef W13F
    int l4 = lane; asm volatile("" : "+v"(l4));
    { const int lane = l4, j16 = lane & 15, q4 = lane >> 4, tid = w * 64 + lane;
    LDS_BARRIER();
#pragma unroll
    for (int i = 0; i < 4; ++i) { const int e = tid + 512 * i; *(LAS f32x4*)(l3 + OFF_GT + (e >> 8) * 4112 + (e & 255) * 16) = gtv[i]; }
    LDS_BARRIER();
#pragma unroll 1
    for (int half = 0; half < 2; ++half) {
        int lh = lane; asm volatile("" : "+v"(lh));
        const int lane = lh, j16 = lane & 15, q4 = lane >> 4;
        const int nb = 128 * w + 64 * half;
        f32x4 acc[NMT][4];
#pragma unroll
        for (int mt = 0; mt < NMT; ++mt)
#pragma unroll
            for (int nt = 0; nt < 4; ++nt) acc[mt][nt] = (f32x4){0.f, 0.f, 0.f, 0.f};
        const char* Vu0 = (const char*)(ws + WS_W2T) + ((size_t)(L * MOE_E + e0) * D * MOE_FF + (size_t)(nb >> 4) * 4 * 512) * 2;
        const char* Vu1 = (const char*)(ws + WS_W2T) + ((size_t)(L * MOE_E + e1) * D * MOE_FF + (size_t)(nb >> 4) * 4 * 512) * 2;
        const unsigned lo16b = (unsigned)lane * 16u;
#define W2F(KS, NT) (*(const bf16x8*)((((KS) >> 2) ? Vu1 : Vu0) + (size_t)(lo16b + (unsigned)(1024 * ((KS) & 3) + 4096 * (NT)))))
#define MOE_XLOAD(MG, BUF) do { _Pragma("unroll") for (int m4 = 0; m4 < 2; ++m4) { int t = tok[16 * (2 * (MG) + m4) + j16]; asm volatile("" : "+v"(t)); tt[BUF][m4] = t; const int tc = t < 0 ? 0 : t; \
            const bf16_t* xr_ = (const bf16_t*)(ws + WS_XB) + (size_t)tc * D + nb + 8 * q4; \
            _Pragma("unroll") for (int np = 0; np < 2; ++np) xin[BUF][m4][np] = *(const u32x4*)(xr_ + 32 * np); } } while (0)
        int tt[2][2]; u32x4 xin[2][2][2];
        bf16x8 bw[2][4];
#pragma unroll
        for (int j = 0; j < 2; ++j)
#pragma unroll
            for (int nt = 0; nt < 4; ++nt) bw[j][nt] = W2F(j, nt);
#pragma unroll
        for (int ks = 0; ks < 8; ++ks) {
            bf16x8 b[4];
#pragma unroll
            for (int nt = 0; nt < 4; ++nt) b[nt] = bw[ks & 1][nt];
            if (ks + 2 < 8) {
#pragma unroll
                for (int nt = 0; nt < 4; ++nt) bw[ks & 1][nt] = W2F(ks + 2, nt); }
            if (ks == 6) MOE_XLOAD(0, 0);
#pragma unroll
            for (int mt = 0; mt < NMT; ++mt) { const bf16x8 a = *(const LAS bf16x8*)(l3 + (16 * mt + j16) * HS + (32 * ks + 8 * q4) * 2);
#pragma unroll
                for (int nt = 0; nt < 4; ++nt) acc[mt][nt] = __builtin_amdgcn_mfma_f32_16x16x32_bf16(b[nt], a, acc[mt][nt], 0, 0, 0); }
            __builtin_amdgcn_sched_barrier(0);
        }
#undef W2F
#pragma unroll
        for (int mg = 0; mg < NMT / 2; ++mg) {
            if (mg + 1 < NMT / 2) MOE_XLOAD(mg + 1, (mg + 1) & 1);
#pragma unroll
            for (int m4 = 0; m4 < 2; ++m4) { const int t = tt[mg & 1][m4], mt = 2 * mg + m4; float sq = 0.f;
                if (t >= 0) { const int b = t / SEQ; bf16_t* xr = (bf16_t*)(ws + WS_XB) + (size_t)t * D + nb + 8 * q4; const LAS float* gr = (const LAS float*)(l3 + OFF_GT) + b * 1028 + nb + 8 * q4;
#pragma unroll
                    for (int np = 0; np < 2; ++np) { const f32x4 g0 = *(const LAS f32x4*)(gr + 32 * np), g1 = *(const LAS f32x4*)(gr + 32 * np + 4);
                        const u32x4 x8 = xin[mg & 1][m4][np];
                        f32x4 x0, x1; x0[0] = bf2f(x8.x & 0xffffu); x0[1] = bf2f(x8.x >> 16); x0[2] = bf2f(x8.y & 0xffffu); x0[3] = bf2f(x8.y >> 16);
                        x1[0] = bf2f(x8.z & 0xffffu); x1[1] = bf2f(x8.z >> 16); x1[2] = bf2f(x8.w & 0xffffu); x1[3] = bf2f(x8.w >> 16);
                        const f32x4 o0 = x0 + g0 * acc[mt][2 * np], o1 = x1 + g1 * acc[mt][2 * np + 1];
                        sq += ((o0[0] * o0[0] + o0[1] * o0[1]) + (o0[2] * o0[2] + o0[3] * o0[3])) + ((o1[0] * o1[0] + o1[1] * o1[1]) + (o1[2] * o1[2] + o1[3] * o1[3]));
                        u32x4 w8; w8.x = pk2(o0[0], o0[1]); w8.y = pk2(o0[2], o0[3]); w8.z = pk2(o1[0], o1[1]); w8.w = pk2(o1[2], o1[3]);
                        if (!dry) *(u32x4*)(xr + 32 * np) = w8; } }
                sq = xhalf_sum(x16_sum(sq));
                if (!dry && t >= 0 && q4 == 0) ((float*)(ws + WS_SSP))[(size_t)t * 16 + 2 * w + half] = sq; }
        }
#undef MOE_XLOAD
    }
    }
    __syncthreads();
}
__device__ __forceinline__ void phase_moe(const Params& P, const Geo& g, LAS unsigned char* l3, int L, bool dry = false) {
    constexpr int HS = 528, OFF_B1 = 67584, OFF_GT = 67584;
    constexpr int OFF_TOK = 133120, OFF_WLO = OFF_TOK + 512, OFF_WHI = OFF_WLO + 512, OFF_PF = OFF_WHI + 512;
    LAS int* tok = (LAS int*)(l3 + OFF_TOK); LAS float* wlo = (LAS float*)(l3 + OFF_WLO); LAS float* whi = (LAS float*)(l3 + OFF_WHI); LAS int* pf = (LAS int*)(l3 + OFF_PF);
    unsigned char* ws = P.ws;
    const unsigned* cnt = (const unsigned*)(ws + WS_CTL) + CW_CNT + L * 128 * 16;
    const int* list = (const int*)(ws + WS_LIST);
    const float2* tokw = (const float2*)(ws + WS_TOKW);
    const bf16_t* H = (const bf16_t*)P.out;
    const float* gate2 = (const float*)(ws + WS_MOD) + (size_t)L * NB * 6144 + 5120;
    const int w = g.wave;
    LAS int* cn = pf + 128;
    if (g.tid < 128) { const int c = g.tid < NBUCKET ? (int)cnt[g.tid * 16] : 0; int sc = c;
#pragma unroll
        for (int o = 1; o < 64; o <<= 1) { const int nbv = __shfl_up(sc, o); sc += (g.lane >= o) ? nbv : 0; }
        pf[g.tid] = sc - c; if (g.tid == 63) cn[0] = sc; }
    __syncthreads();
    if (g.tid >= 64 && g.tid < 128) pf[g.tid] += cn[0];
    __syncthreads();
    const int rows_per = (T + g.G - 1) / g.G;
    int cur = g.vcu * rows_per; const int end = min(T, cur + rows_per);
    int bucket = 0;
    if (cur < end) {
#pragma unroll
        for (int st = 64; st > 0; st >>= 1) if (bucket + st <= NBUCKET - 1 && pf[bucket + st] <= cur) bucket += st; }
    while (cur < end) {
        int lane = g.lane; asm volatile("" : "+v"(lane));
        while (pf[bucket + 1] <= cur) ++bucket;
        const int off = cur - pf[bucket];
        const int nrows = min(min(128, end - cur), pf[bucket + 1] - cur);
        cur += nrows;
        const int nmt = (nrows + 15) >> 4;
        const int g4 = bucket / 28; int rem = bucket % 28, elo = 0;
        while (rem >= 7 - elo) { rem -= 7 - elo; ++elo; }
        const int ehi = elo + 1 + rem;
        const int e0 = g4 * 8 + elo, e1 = g4 * 8 + ehi;
        if (nmt > 6) moe_pass<8>(P, l3, L, w, lane, bucket, off, nrows, e0, e1, dry); else if (nmt > 4) moe_pass<6>(P, l3, L, w, lane, bucket, off, nrows, e0, e1, dry);
        else if (nmt > 2) moe_pass<4>(P, l3, L, w, lane, bucket, off, nrows, e0, e1, dry); else moe_pass<2>(P, l3, L, w, lane, bucket, off, nrows, e0, e1, dry);
    }
}


#define MFMA16(a, b, c) __builtin_amdgcn_mfma_f32_16x16x32_bf16(a, b, c, 0, 0, 0)
constexpr size_t WS_SLOC = WS_LIST;
constexpr size_t WS_ATOT = WS_TOKE;
constexpr size_t WS_XHALO = WS_TOKW;
template <int PASS>
__device__ __forceinline__ void scan_units(const Params& P, const Geo& g, LAS unsigned char* l3, int L, bool dry) {
    constexpr bool FULL = PASS >= 2;
    constexpr int S128 = 272, S64 = 144, SCB = 272;
    constexpr int O_CC = 0, O_BC = 17408, O_BCT = 34816, O_CB = 53248, O_XST = 70656, O_XPT = 107520;
    constexpr int O_ACS = 144384, O_DTV = O_ACS + 2048, O_SCL = O_DTV + 2048, O_EAL = O_SCL + 2048, O_HALO = O_EAL + 2048;
    const int i2 = L >> 1, lane = g.lane, w = g.wave, tid = g.tid;
    unsigned char* ws = P.ws;
    bf16_t* XS = (bf16_t*)(ws + WS_XS); const float* DT = (const float*)(ws + WS_DT);
    for (int u = g.vcu; u < 256; u += g.G) {
        const int b = u >> 5, gq = (u >> 2) & 7, sc = u & 3;
        const size_t tb = (size_t)b * SEQ + (size_t)sc * 1024;
        const int cp = tid & 255, half = tid >> 8;
        const bool act = FULL || (cp < 192);
        const int ch = cp < 128 ? (4 * gq) * 64 + 2 * cp : (cp < 192 ? 2048 + gq * 128 + 2 * (cp - 128) : 3072 + gq * 128 + 2 * (cp - 192));
        const unsigned colb = cp < 128 ? (unsigned)ch * 2u : (unsigned)(WS_BC - WS_XS) + (unsigned)(ch - 2048) * 2u;
        const unsigned voff = colb + (unsigned)half * 32u * 4096u;
        const int hd0 = 4 * gq;
        const float Ah_s0 = -__expf(P.in[I_ALOG][i2 * SSM_H + hd0 + (w & 3)]);
        float Dk[2]; Dk[0] = P.in[I_SSMD][i2 * SSM_H + hd0 + (w >> 2)]; Dk[1] = P.in[I_SSMD][i2 * SSM_H + hd0 + 2 + (w >> 2)];
        f32x4 S0[8], S1[8];
#pragma unroll
        for (int i = 0; i < 8; ++i) { S0[i] = (f32x4){0.f, 0.f, 0.f, 0.f}; S1[i] = (f32x4){0.f, 0.f, 0.f, 0.f}; }
        if (PASS == 2 && sc > 0) {
            const float* AT = (const float*)(ws + WS_ATOT);
#pragma unroll 1
            for (int j = 0; j < sc; ++j) {
                const int uj = (u >> 2) * 3 + j;
                float f0 = 0.f, f1 = 0.f;
                for (int i = j + 1; i < sc; ++i) { f0 += AT[((u & ~3) | i) * 4 + (w >> 2)]; f1 += AT[((u & ~3) | i) * 4 + 2 + (w >> 2)]; }
                f0 = __expf(f0); f1 = __expf(f1);
                const u32x4* sp0 = (const u32x4*)(ws + WS_SLOC) + (((size_t)uj * 2 + 0) * 8 + w) * 256 + lane * 4;
                const u32x4* sp1 = (const u32x4*)(ws + WS_SLOC) + (((size_t)uj * 2 + 1) * 8 + w) * 256 + lane * 4;
#pragma unroll
                for (int i = 0; i < 4; ++i) { const u32x4 a = sp0[i], c = sp1[i];
#pragma unroll
                    for (int e = 0; e < 4; ++e) { const int nt = 2 * i + (e >> 1), r = 2 * (e & 1);
                        S0[nt][r] += f0 * bf2f(a[e] & 0xffffu); S0[nt][r + 1] += f0 * bf2f(a[e] >> 16);
                        S1[nt][r] += f1 * bf2f(c[e] & 0xffffu); S1[nt][r + 1] += f1 * bf2f(c[e] >> 16); } }
            }
        }
        float atot = 0.f;
        unsigned raw[35]; float dt_pf = 0.f;
        {
            const char* rb = (const char*)XS + (tb - 3) * 4096;
#pragma unroll
            for (int i = 0; i < 35; ++i) raw[i] = act ? *(const unsigned*)(rb + (size_t)i * 4096 + voff) : 0u;
            if (half == 0) {
                if (sc == 0) { raw[0] = 0u; raw[1] = 0u; raw[2] = 0u; }
                else if (FULL && cp < 128) {
#pragma unroll
                    for (int i = 0; i < 3; ++i) raw[i] = ((const unsigned*)(ws + WS_XHALO))[((size_t)(u - 1) * 3 + i) * 128 + cp]; }
            }
            if (w < 4) dt_pf = DT[(tb + lane) * 32 + hd0 + w];
        }
#define SCAN_STEP0(CN) do { if (w < 4) { const int pn_ = (CN) & 1; const float dt = dt_pf; float a = dt * Ah_s0; \
            a = wave_incl_scan(a); const float aend = wave_last(a); \
            ((LAS float*)(l3 + O_ACS))[pn_ * 256 + w * 64 + lane] = a; ((LAS float*)(l3 + O_DTV))[pn_ * 256 + w * 64 + lane] = dt; \
            ((LAS float*)(l3 + O_SCL))[pn_ * 256 + w * 64 + lane] = dt * __expf(aend - a); ((LAS float*)(l3 + O_EAL))[pn_ * 256 + w * 64 + lane] = __expf(a); \
            atot += aend; \
            if ((CN) + 1 < 16) dt_pf = DT[(tb + (size_t)((CN) + 1) * 64 + lane) * 32 + hd0 + w]; } } while (0)
        SCAN_STEP0(0);
        __syncthreads();
#pragma unroll 1
        for (int c = 0; c < 16; ++c) {
            const size_t t0 = tb + (size_t)c * 64;
            const int par = c & 1;
            int lane_o = lane; asm volatile("" : "+v"(lane_o));
            const int j16 = lane_o & 15, q4 = lane_o >> 4;
            LAS float* acs = (LAS float*)(l3 + O_ACS) + par * 256; LAS float* dtv = (LAS float*)(l3 + O_DTV) + par * 256;
            LAS float* scl = (LAS float*)(l3 + O_SCL) + par * 256; LAS float* eal = (LAS float*)(l3 + O_EAL) + par * 256;
            if (act) {
                int cpo = cp; asm volatile("" : "+v"(cpo));
                float cw0[5], cw1[5];
                { const int cho = cpo < 128 ? (4 * gq) * 64 + 2 * cpo : (cpo < 192 ? 2048 + gq * 128 + 2 * (cpo - 128) : 3072 + gq * 128 + 2 * (cpo - 192));
                  const float* cwp = P.in[I_CONVW] + (size_t)i2 * 4 * SSM_CONV + cho;
#pragma unroll
                  for (int tp = 0; tp < 4; ++tp) { const f32x2 t2 = *(const f32x2*)(cwp + tp * SSM_CONV); cw0[tp] = t2.x; cw1[tp] = t2.y; }
                  const f32x2 t2 = *(const f32x2*)(P.in[I_CONVB] + (size_t)i2 * SSM_CONV + cho); cw0[4] = t2.x; cw1[4] = t2.y; }
                if (c > 0 && cpo < 128 && half == 0) {
#pragma unroll
                    for (int i = 0; i < 3; ++i) raw[i] = *(const LAS unsigned*)(l3 + O_HALO + (((c - 1) & 1) * 3 + i) * 512 + cpo * 4); }
                if (cpo < 128 && half == 1) {
#pragma unroll
                    for (int i = 0; i < 3; ++i) *(LAS unsigned*)(l3 + O_HALO + ((c & 1) * 3 + i) * 512 + cpo * 4) = raw[32 + i];
                    if (PASS == 1 && c == 15) {
#pragma unroll
                        for (int i = 0; i < 3; ++i) ((unsigned*)(ws + WS_XHALO))[((size_t)u * 3 + i) * 128 + cpo] = raw[32 + i]; }
                }
                const int hq = cpo >> 5;
#pragma unroll
                for (int j = 0; j < 8; ++j) {
                    const int l0 = 32 * half + 4 * j;
                    float v0[4], v1[4];
#pragma unroll
                    for (int o = 0; o < 4; ++o) { float a0 = cw0[4], a1 = cw1[4];
#pragma unroll
                        for (int tp = 0; tp < 4; ++tp) { a0 += cw0[tp] * bf2f(raw[4 * j + o + tp] & 0xffffu); a1 += cw1[tp] * bf2f(raw[4 * j + o + tp] >> 16); }
                        v0[o] = silu_f(a0); v1[o] = silu_f(a1); }
                    if (cpo < 128) {
                        const int p = 2 * (cpo & 31);
                        if (FULL) { u32x2 x0, x1; x0.x = pk2(v0[0], v0[1]); x0.y = pk2(v0[2], v0[3]); x1.x = pk2(v1[0], v1[1]); x1.y = pk2(v1[2], v1[3]);
                            *(LAS u32x2*)(l3 + O_XST + hq * 9216 + p * S64 + l0 * 2) = x0; *(LAS u32x2*)(l3 + O_XST + hq * 9216 + (p + 1) * S64 + l0 * 2) = x1; }
                        const f32x4 s4 = *(const LAS f32x4*)(scl + hq * 64 + l0);
                        u32x2 y0, y1; y0.x = pk2(v0[0] * s4.x, v0[1] * s4.y); y0.y = pk2(v0[2] * s4.z, v0[3] * s4.w); y1.x = pk2(v1[0] * s4.x, v1[1] * s4.y); y1.y = pk2(v1[2] * s4.z, v1[3] * s4.w);
                        *(LAS u32x2*)(l3 + O_XPT + hq * 9216 + p * S64 + l0 * 2) = y0; *(LAS u32x2*)(l3 + O_XPT + hq * 9216 + (p + 1) * S64 + l0 * 2) = y1;
                    } else if (cpo < 192) {
                        const int n = 2 * (cpo - 128);
                        if (FULL) {
#pragma unroll
                            for (int o = 0; o < 4; ++o) *(LAS unsigned*)(l3 + O_BC + (l0 + o) * S128 + n * 2) = pk2(v0[o], v1[o]); }
                        u32x2 x0, x1; x0.x = pk2(v0[0], v0[1]); x0.y = pk2(v0[2], v0[3]); x1.x = pk2(v1[0], v1[1]); x1.y = pk2(v1[2], v1[3]);
                        *(LAS u32x2*)(l3 + O_BCT + n * S64 + l0 * 2) = x0; *(LAS u32x2*)(l3 + O_BCT + (n + 1) * S64 + l0 * 2) = x1;
                    } else {
                        const int n = 2 * (cpo - 192);
#pragma unroll
                        for (int o = 0; o < 4; ++o) *(LAS unsigned*)(l3 + O_CC + (l0 + o) * S128 + n * 2) = pk2(v0[o], v1[o]);
                    }
                }
            }
            __syncthreads();
            if (PASS == 3) {
                const int r_ = tid >> 3, pc_ = tid & 7;
                const u32x4 c0_ = *(const LAS u32x4*)(l3 + O_CC + r_ * S128 + pc_ * 32), c1_ = *(const LAS u32x4*)(l3 + O_CC + r_ * S128 + pc_ * 32 + 16);
                u32x4* dst_ = (u32x4*)((bf16_t*)P.out + (size_t)T * D + (t0 + r_) * 1024 + gq * 128 + pc_ * 16);
                dst_[0] = c0_; dst_[1] = c1_; }
            __builtin_amdgcn_sched_barrier(0);
            if (c + 1 < 16 && act) {
                const char* rb = (const char*)XS + (t0 + 61) * 4096;
#pragma unroll
                for (int i = 0; i < 35; ++i) raw[i] = *(const unsigned*)(rb + (size_t)i * 4096 + voff);
            }
            if (FULL) {
                const int lt = w >> 1;
                bf16x8 cf[4];
#pragma unroll
                for (int ks = 0; ks < 4; ++ks) cf[ks] = *(const LAS bf16x8*)(l3 + O_CC + (16 * lt + j16) * S128 + (32 * ks + 8 * q4) * 2);
#pragma unroll
                for (int si = 0; si < 2; ++si) { const int st = 2 * (w & 1) + si;
                    if (st <= lt) { f32x4 acc = (f32x4){0.f, 0.f, 0.f, 0.f};
#pragma unroll
                        for (int ks = 0; ks < 4; ++ks) { const bf16x8 bfr = *(const LAS bf16x8*)(l3 + O_BC + (16 * st + j16) * S128 + (32 * ks + 8 * q4) * 2); acc = MFMA16(cf[ks], bfr, acc); }
#pragma unroll
                        for (int r = 0; r < 4; ++r) *(LAS float*)(l3 + O_CB + (16 * lt + 4 * q4 + r) * SCB + (16 * st + j16) * 4) = acc[r]; } }
                __syncthreads();
            }
#pragma unroll
            for (int rd = 0; rd < 2; ++rd) {
                const int hq = 2 * rd + (w >> 2), ps = w & 3;
                f32x4 (&S)[8] = rd ? S1 : S0;
                if (FULL) {
                    f32x4 yv[4];
#pragma unroll
                    for (int lt = 0; lt < 4; ++lt) yv[lt] = (f32x4){0.f, 0.f, 0.f, 0.f};
#pragma unroll
                    for (int t = 0; t < 4; ++t) { u32x4 a4; a4.x = pk2(S[2 * t][0], S[2 * t][1]); a4.y = pk2(S[2 * t][2], S[2 * t][3]); a4.z = pk2(S[2 * t + 1][0], S[2 * t + 1][1]); a4.w = pk2(S[2 * t + 1][2], S[2 * t + 1][3]);
                        const bf16x8 af = __builtin_bit_cast(bf16x8, a4);
#pragma unroll
                        for (int lt = 0; lt < 4; ++lt) { const LAS unsigned char* cpz = l3 + O_CC + (16 * lt + j16) * S128 + (32 * t + 4 * q4) * 2;
                            const u32x2 lo = *(const LAS u32x2*)cpz, hi = *(const LAS u32x2*)(cpz + 32);
                            u32x4 b4; b4.x = lo.x; b4.y = lo.y; b4.z = hi.x; b4.w = hi.y;
                            yv[lt] = MFMA16(af, __builtin_bit_cast(bf16x8, b4), yv[lt]); } }
#pragma unroll
                    for (int lt = 0; lt < 4; ++lt) yv[lt] = yv[lt] * eal[hq * 64 + 16 * lt + j16];
                    bf16x8 xf[2];
#pragma unroll
                    for (int ks = 0; ks < 2; ++ks) xf[ks] = *(const LAS bf16x8*)(l3 + O_XST + hq * 9216 + (16 * ps + j16) * S64 + (32 * ks + 8 * q4) * 2);
#pragma unroll
                    for (int lt = 0; lt < 4; ++lt) { const int l = 16 * lt + j16; const float al = acs[hq * 64 + l];
#pragma unroll
                        for (int ks = 0; ks < 2; ++ks) { if (32 * ks <= 16 * lt + 15) {
                                const int s0 = 32 * ks + 8 * q4;
                                const f32x4 c0 = *(const LAS f32x4*)(l3 + O_CB + l * SCB + s0 * 4), c1 = *(const LAS f32x4*)(l3 + O_CB + l * SCB + s0 * 4 + 16);
                                const f32x4 a0 = *(const LAS f32x4*)(acs + hq * 64 + s0), a1 = *(const LAS f32x4*)(acs + hq * 64 + s0 + 4);
                                const f32x4 d0 = *(const LAS f32x4*)(dtv + hq * 64 + s0), d1 = *(const LAS f32x4*)(dtv + hq * 64 + s0 + 4);
                                float m[8];
#pragma unroll
                                for (int e = 0; e < 4; ++e) { m[e] = (s0 + e <= l) ? c0[e] * __expf(al - a0[e]) * d0[e] : 0.f; m[4 + e] = (s0 + 4 + e <= l) ? c1[e] * __expf(al - a1[e]) * d1[e] : 0.f; }
                                u32x4 b4; b4.x = pk2(m[0], m[1]); b4.y = pk2(m[2], m[3]); b4.z = pk2(m[4], m[5]); b4.w = pk2(m[6], m[7]);
                                yv[lt] = MFMA16(xf[ks], __builtin_bit_cast(bf16x8, b4), yv[lt]); } }
                        __builtin_amdgcn_sched_barrier(0); }
                    u32x2 yo[4];
#pragma unroll
                    for (int lt = 0; lt < 4; ++lt) { const int l = 16 * lt + j16;
                        float xv[4];
#pragma unroll
                        for (int r = 0; r < 4; ++r) xv[r] = bf2f(*(const LAS bf16_t*)(l3 + O_XST + hq * 9216 + (16 * ps + 4 * q4 + r) * S64 + l * 2));
                        yo[lt].x = pk2(yv[lt][0] + Dk[rd] * xv[0], yv[lt][1] + Dk[rd] * xv[1]); yo[lt].y = pk2(yv[lt][2] + Dk[rd] * xv[2], yv[lt][3] + Dk[rd] * xv[3]); }
#pragma unroll
                    for (int lp = 0; lp < 4; lp += 2) {
                        const auto sx = __builtin_amdgcn_permlane16_swap(yo[lp].x, yo[lp + 1].x, false, false), sy = __builtin_amdgcn_permlane16_swap(yo[lp].y, yo[lp + 1].y, false, false);
                        u32x4 w4; w4.x = sx[0]; w4.y = sy[0]; w4.z = sx[1]; w4.w = sy[1];
                        const size_t yoff = (t0 + 16 * (lp + (q4 & 1)) + j16) * 2048 + (size_t)(hd0 + hq) * 64 + 16 * ps + 8 * (q4 >> 1);
                        bf16_t* yp = dry ? (bf16_t*)(ws + WS_LIST + 12 * MiB) + (yoff & (size_t)(512 * 1024 - 1)) : XS + yoff;
                        *(u32x4*)yp = w4; }
                }
                { const float dec = eal[hq * 64 + 63];
                  bf16x8 xp[2];
#pragma unroll
                  for (int ks = 0; ks < 2; ++ks) xp[ks] = *(const LAS bf16x8*)(l3 + O_XPT + hq * 9216 + (16 * ps + j16) * S64 + (32 * ks + 8 * q4) * 2);
#pragma unroll
                  for (int nt = 0; nt < 8; ++nt) { f32x4 acc = S[nt] * dec;
#pragma unroll
                      for (int ks = 0; ks < 2; ++ks) { const bf16x8 bt = *(const LAS bf16x8*)(l3 + O_BCT + (16 * nt + j16) * S64 + (32 * ks + 8 * q4) * 2); acc = MFMA16(bt, xp[ks], acc); }
                      S[nt] = acc; } }
            }
            if (c + 1 < 16) SCAN_STEP0(c + 1);
            __syncthreads();
        }
#undef SCAN_STEP0
        if (PASS == 1 || PASS == 3) {
            if (w < 4 && lane == 0) ((float*)(ws + WS_ATOT))[u * 4 + w] = atot;
            const int us = (u >> 2) * 3 + (sc < 3 ? sc : 0);
            u32x4* sp0 = (u32x4*)(ws + WS_SLOC) + (((size_t)us * 2 + 0) * 8 + w) * 256 + lane * 4;
            u32x4* sp1 = (u32x4*)(ws + WS_SLOC) + (((size_t)us * 2 + 1) * 8 + w) * 256 + lane * 4;
            if (sc < 3)
#pragma unroll
            for (int i = 0; i < 4; ++i) { u32x4 a, c;
#pragma unroll
                for (int e = 0; e < 4; ++e) { const int nt = 2 * i + (e >> 1), r = 2 * (e & 1); a[e] = pk2(S0[nt][r], S0[nt][r + 1]); c[e] = pk2(S1[nt][r], S1[nt][r + 1]); }
                sp0[i] = a; sp1[i] = c; }
        }
    }
}

__device__ __forceinline__ void scan_fix(const Params& P, const Geo& g, LAS unsigned char* l3, int L) {
    constexpr int S128 = 272, O_CC = 0, CCB = 17408, O_ECL = 2 * CCB;
    const int i2 = L >> 1, w = g.wave; int tid = g.tid; asm volatile("" : "+v"(tid));
    unsigned char* ws = P.ws;
    bf16_t* XS = (bf16_t*)(ws + WS_XS); const float* DT = (const float*)(ws + WS_DT);
    const bf16_t* CCV = (const bf16_t*)P.out + (size_t)T * D;
    const int NITEM = NB * 8 * 3 * 16, per = (NITEM + g.G - 1) / g.G;
    const int gc0 = g.vcu * per, gc1 = min(NITEM, gc0 + per);
    int cur_uu = -1, gq = 0, hd0 = 0; size_t tb = 0; float Ah_s0 = 0.f, atot = 0.f;
    bf16x8 af[2][4];
    u32x4 cr0, cr1; float dt_pf = 0.f;
#define FIX_GEO(GC, TB_, GQ_) const int uu_ = (GC) >> 4, bg_ = uu_ / 3, sc_ = 1 + uu_ % 3; const int GQ_ = bg_ & 7; const size_t TB_ = (size_t)(bg_ >> 3) * SEQ + (size_t)sc_ * 1024 + (size_t)((GC) & 15) * 64;
    if (gc0 < gc1) { FIX_GEO(gc0, t0n, gqn)
        const u32x4* src = (const u32x4*)(CCV + (t0n + (tid >> 3)) * 1024 + gqn * 128 + (tid & 7) * 16); cr0 = src[0]; cr1 = src[1];
        if (w < 4) dt_pf = DT[(t0n + (tid & 63)) * 32 + 4 * gqn + w]; }
    for (int gc = gc0; gc < gc1; ++gc) {
        int lane = tid & 63; asm volatile("" : "+v"(lane));
        const int j16 = lane & 15, q4 = lane >> 4, par = gc & 1;
        const int uu = gc >> 4, c = gc & 15;
        if (uu != cur_uu) {
            cur_uu = uu;
            const int bg = uu / 3, sc = 1 + uu % 3, u = bg * 4 + sc; gq = bg & 7; hd0 = 4 * gq; tb = (size_t)(bg >> 3) * SEQ + (size_t)sc * 1024;
            Ah_s0 = -__expf(P.in[I_ALOG][i2 * SSM_H + hd0 + (w & 3)]);
            f32x4 S0[8], S1[8];
#pragma unroll
            for (int i = 0; i < 8; ++i) { S0[i] = (f32x4){0.f, 0.f, 0.f, 0.f}; S1[i] = (f32x4){0.f, 0.f, 0.f, 0.f}; }
            const float* AT = (const float*)(ws + WS_ATOT);
#pragma unroll 1
            for (int j = 0; j < sc; ++j) {
                const int uj = (u >> 2) * 3 + j;
                float f0 = 0.f, f1 = 0.f;
                for (int i = j + 1; i < sc; ++i) { f0 += AT[((u & ~3) | i) * 4 + (w >> 2)]; f1 += AT[((u & ~3) | i) * 4 + 2 + (w >> 2)]; }
                f0 = __expf(f0); f1 = __expf(f1);
                const u32x4* sp0 = (const u32x4*)(ws + WS_SLOC) + (((size_t)uj * 2 + 0) * 8 + w) * 256 + lane * 4;
                const u32x4* sp1 = (const u32x4*)(ws + WS_SLOC) + (((size_t)uj * 2 + 1) * 8 + w) * 256 + lane * 4;
#pragma unroll
                for (int i = 0; i < 4; ++i) { const u32x4 a = sp0[i], cc = sp1[i];
#pragma unroll
                    for (int e = 0; e < 4; ++e) { const int nt = 2 * i + (e >> 1), r = 2 * (e & 1);
                        S0[nt][r] += f0 * bf2f(a[e] & 0xffffu); S0[nt][r + 1] += f0 * bf2f(a[e] >> 16);
                        S1[nt][r] += f1 * bf2f(cc[e] & 0xffffu); S1[nt][r + 1] += f1 * bf2f(cc[e] >> 16); } }
            }
#pragma unroll
            for (int t = 0; t < 4; ++t) { u32x4 a4;
                a4.x = pk2(S0[2 * t][0], S0[2 * t][1]); a4.y = pk2(S0[2 * t][2], S0[2 * t][3]); a4.z = pk2(S0[2 * t + 1][0], S0[2 * t + 1][1]); a4.w = pk2(S0[2 * t + 1][2], S0[2 * t + 1][3]);
                af[0][t] = __builtin_bit_cast(bf16x8, a4);
                a4.x = pk2(S1[2 * t][0], S1[2 * t][1]); a4.y = pk2(S1[2 * t][2], S1[2 * t][3]); a4.z = pk2(S1[2 * t + 1][0], S1[2 * t + 1][1]); a4.w = pk2(S1[2 * t + 1][2], S1[2 * t + 1][3]);
                af[1][t] = __builtin_bit_cast(bf16x8, a4); }
            atot = 0.f;
            if (w < 4) { float sdt = 0.f;
                for (int j = 0; j < c; ++j) sdt += DT[(tb + (size_t)j * 64 + lane) * 32 + hd0 + w];
                atot = wave_sum(sdt) * Ah_s0; }
        }
        const size_t t0 = tb + (size_t)c * 64;
        LAS float* ecl = (LAS float*)(l3 + O_ECL) + par * 256;
        *(LAS u32x4*)(l3 + O_CC + par * CCB + (tid >> 3) * S128 + (tid & 7) * 32) = cr0; *(LAS u32x4*)(l3 + O_CC + par * CCB + (tid >> 3) * S128 + (tid & 7) * 32 + 16) = cr1;
        if (w < 4) { float a = dt_pf * Ah_s0;
            a = wave_incl_scan(a);
            ecl[w * 64 + lane] = __expf(atot + a);
            atot += wave_last(a); }
        __syncthreads();
        if (gc + 1 < gc1) { FIX_GEO(gc + 1, t0n, gqn)
            const u32x4* src = (const u32x4*)(CCV + (t0n + (tid >> 3)) * 1024 + gqn * 128 + (tid & 7) * 16); cr0 = src[0]; cr1 = src[1];
            if (w < 4) dt_pf = DT[(t0n + lane) * 32 + 4 * gqn + w]; }
        u32x4 yin[2][2];
#pragma unroll
        for (int rd = 0; rd < 2; ++rd)
#pragma unroll
            for (int lp = 0; lp < 2; ++lp) yin[rd][lp] = *(const u32x4*)(XS + (t0 + 16 * (2 * lp + (q4 & 1)) + j16) * 2048 + (size_t)(hd0 + 2 * rd + (w >> 2)) * 64 + 16 * (w & 3) + 8 * (q4 >> 1));
#pragma unroll
        for (int rd = 0; rd < 2; ++rd) {
            const int hq = 2 * rd + (w >> 2), ps = w & 3;
            f32x4 yv[4];
#pragma unroll
            for (int lt = 0; lt < 4; ++lt) yv[lt] = (f32x4){0.f, 0.f, 0.f, 0.f};
#pragma unroll
            for (int t = 0; t < 4; ++t)
#pragma unroll
                for (int lt = 0; lt < 4; ++lt) { const LAS unsigned char* cpz = l3 + O_CC + par * CCB + (16 * lt + j16) * S128 + (32 * t + 4 * q4) * 2;
                    const u32x2 lo = *(const LAS u32x2*)cpz, hi = *(const LAS u32x2*)(cpz + 32);
                    u32x4 b4; b4.x = lo.x; b4.y = lo.y; b4.z = hi.x; b4.w = hi.y;
                    yv[lt] = MFMA16(af[rd][t], __builtin_bit_cast(bf16x8, b4), yv[lt]); }
#pragma unroll
            for (int lp = 0; lp < 4; lp += 2) {
                const u32x4 L4 = yin[rd][lp >> 1];
                const auto ax = __builtin_amdgcn_permlane16_swap(L4.x, L4.z, false, false), ay = __builtin_amdgcn_permlane16_swap(L4.y, L4.w, false, false);
                u32x2 o[2];
#pragma unroll
                for (int i = 0; i < 2; ++i) { const int lt = lp + i; const float sc_l = ecl[hq * 64 + 16 * lt + j16]; const unsigned yx = ax[i], yy = ay[i];
                    o[i].x = pk2(bf2f(yx & 0xffffu) + sc_l * yv[lt][0], bf2f(yx >> 16) + sc_l * yv[lt][1]); o[i].y = pk2(bf2f(yy & 0xffffu) + sc_l * yv[lt][2], bf2f(yy >> 16) + sc_l * yv[lt][3]); }
                const auto sx = __builtin_amdgcn_permlane16_swap(o[0].x, o[1].x, false, false), sy = __builtin_amdgcn_permlane16_swap(o[0].y, o[1].y, false, false);
                u32x4 w4; w4.x = sx[0]; w4.y = sy[0]; w4.z = sx[1]; w4.w = sy[1];
                *(u32x4*)(XS + (t0 + 16 * (lp + (q4 & 1)) + j16) * 2048 + (size_t)(hd0 + hq) * 64 + 16 * ps + 8 * (q4 >> 1)) = w4; }
        }
    }
#undef FIX_GEO
}

__device__ __forceinline__ void phase_scan(const Params& P, const Geo& g, LAS unsigned char* l3, int L, bool dry = false) {
    constexpr int S128 = 272, S64 = 144;
    constexpr int O_CC = 0, O_BC = 17408, O_BCT = 34816, O_XST = 53248, O_XPT = 62464, O_MM = 71680, O_SBF = 80896;
    constexpr int O_ACS = 98304, O_DTV = 98560, O_CW = 98816, O_HALO = 105216;
    LAS float* acs = (LAS float*)(l3 + O_ACS); LAS float* dtv = (LAS float*)(l3 + O_DTV);
    LAS f32x2* cwl = (LAS f32x2*)(l3 + O_CW);
    const int i2 = L >> 1, lane = g.lane, w = g.wave, tid = g.tid, j16 = lane & 15, q4 = lane >> 4;
    unsigned char* ws = P.ws;
    bf16_t* XS = (bf16_t*)(ws + WS_XS); const bf16_t* BC = (const bf16_t*)(ws + WS_BC); const float* DT = (const float*)(ws + WS_DT);
    for (int u = g.vcu; u < NB * SSM_H; u += g.G) {
        const int b = u / SSM_H, hd = u % SSM_H, gq = hd >> 2;
        const float Ah = -__expf(P.in[I_ALOG][i2 * SSM_H + hd]), Dk = P.in[I_SSMD][i2 * SSM_H + hd];
        const size_t tb = (size_t)b * SEQ;
        if (tid < 160) { const int cp = tid; const int ch = cp < 32 ? hd * 64 + 2 * cp : (cp < 96 ? 2048 + gq * 128 + 2 * (cp - 32) : 3072 + gq * 128 + 2 * (cp - 96));
            const float* cw = P.in[I_CONVW] + (size_t)i2 * 4 * SSM_CONV + ch;
#pragma unroll
            for (int tp = 0; tp < 4; ++tp) cwl[tp * 160 + cp] = (f32x2){cw[tp * SSM_CONV], cw[tp * SSM_CONV + 1]};
            const float* cb = P.in[I_CONVB] + (size_t)i2 * SSM_CONV + ch; cwl[4 * 160 + cp] = (f32x2){cb[0], cb[1]}; }
        for (int e = tid; e < 17408 / 4; e += 512) ((LAS unsigned*)(l3 + O_SBF))[e] = 0u;
        f32x4 S[4];
#pragma unroll
        for (int i = 0; i < 4; ++i) S[i] = (f32x4){0.f, 0.f, 0.f, 0.f};
        unsigned raw[5][7], voff[5]; float dt_pf = 0.f;
        if (w == 0) dt_pf = DT[(tb + lane) * 32 + hd];
#pragma unroll
        for (int k = 0; k < 5; ++k) {
            const int it = tid + 512 * k, cp = it % 160, strip = it / 160, l0 = 4 * strip;
            const unsigned colb = cp < 32 ? (unsigned)(hd * 64 + 2 * cp) * 2u : (unsigned)(WS_BC - WS_XS) + (unsigned)(cp < 96 ? gq * 128 + 2 * (cp - 32) : 1024 + gq * 128 + 2 * (cp - 96)) * 2u;
            voff[k] = (unsigned)l0 * 4096u + colb;
#pragma unroll
            for (int i = 0; i < 7; ++i) { const int rl = l0 - 3 + i; raw[k][i] = (rl >= 0) ? *(const unsigned*)((const char*)XS + (tb + rl) * 4096 + colb) : 0u; }
        }
        __syncthreads();
#pragma unroll 1
        for (int c = 0; c < NCH; ++c) {
            const size_t t0 = tb + (size_t)c * 64;
            if (w == 0) { const float dt = dt_pf; float a = dt * Ah;
#pragma unroll
                for (int o = 1; o < 64; o <<= 1) { const float nbv = __shfl_up(a, o); a += (lane >= o) ? nbv : 0.f; }
                acs[lane] = a; dtv[lane] = dt; }
            __syncthreads();
            const float aend = acs[63];
            int tA = tid; asm volatile("" : "+v"(tA));
#pragma unroll
            for (int k = 0; k < 5; ++k) {
                const int it = tA + 512 * k, cp = it % 160, strip = it / 160, l0 = 4 * strip;
                if (c > 0 && cp < 32 && strip == 0) {
#pragma unroll
                    for (int i = 0; i < 3; ++i) raw[k][i] = *(const LAS unsigned*)(l3 + O_HALO + (((c - 1) & 1) * 3 + i) * 128 + cp * 4); }
                if (cp < 32 && strip == 15) {
#pragma unroll
                    for (int i = 0; i < 3; ++i) *(LAS unsigned*)(l3 + O_HALO + ((c & 1) * 3 + i) * 128 + cp * 4) = raw[k][4 + i]; }
                float wx[5], wy[5];
#pragma unroll
                for (int tp = 0; tp < 5; ++tp) { const f32x2 ww = cwl[tp * 160 + cp]; wx[tp] = ww.x; wy[tp] = ww.y; }
                float v0[4], v1[4];
#pragma unroll
                for (int o = 0; o < 4; ++o) { float a0 = wx[4], a1 = wy[4];
#pragma unroll
                    for (int tp = 0; tp < 4; ++tp) { a0 += wx[tp] * bf2f(raw[k][o + tp] & 0xffffu); a1 += wy[tp] * bf2f(raw[k][o + tp] >> 16); }
                    v0[o] = silu_f(a0); v1[o] = silu_f(a1); }
                if (cp < 32) {
                    const int p = 2 * cp;
                    u32x2 x0, x1; x0.x = pk2(v0[0], v0[1]); x0.y = pk2(v0[2], v0[3]); x1.x = pk2(v1[0], v1[1]); x1.y = pk2(v1[2], v1[3]);
                    *(LAS u32x2*)(l3 + O_XST + p * S64 + l0 * 2) = x0; *(LAS u32x2*)(l3 + O_XST + (p + 1) * S64 + l0 * 2) = x1;
                    float sc[4];
#pragma unroll
                    for (int o = 0; o < 4; ++o) sc[o] = dtv[l0 + o] * __expf(aend - acs[l0 + o]);
                    x0.x = pk2(v0[0] * sc[0], v0[1] * sc[1]); x0.y = pk2(v0[2] * sc[2], v0[3] * sc[3]); x1.x = pk2(v1[0] * sc[0], v1[1] * sc[1]); x1.y = pk2(v1[2] * sc[2], v1[3] * sc[3]);
                    *(LAS u32x2*)(l3 + O_XPT + p * S64 + l0 * 2) = x0; *(LAS u32x2*)(l3 + O_XPT + (p + 1) * S64 + l0 * 2) = x1;
                } else if (cp < 96) {
                    const int n = 2 * (cp - 32);
#pragma unroll
                    for (int o = 0; o < 4; ++o) *(LAS unsigned*)(l3 + O_BC + (l0 + o) * S128 + n * 2) = pk2(v0[o], v1[o]);
                    u32x2 x0, x1; x0.x = pk2(v0[0], v0[1]); x0.y = pk2(v0[2], v0[3]); x1.x = pk2(v1[0], v1[1]); x1.y = pk2(v1[2], v1[3]);
                    *(LAS u32x2*)(l3 + O_BCT + n * S64 + l0 * 2) = x0; *(LAS u32x2*)(l3 + O_BCT + (n + 1) * S64 + l0 * 2) = x1;
                } else {
                    const int n = 2 * (cp - 96);
#pragma unroll
                    for (int o = 0; o < 4; ++o) *(LAS unsigned*)(l3 + O_CC + (l0 + o) * S128 + n * 2) = pk2(v0[o], v1[o]);
                }
            }
            __syncthreads();
            if (c + 1 < NCH) {
                if (w == 0) dt_pf = DT[(t0 + 64 + lane) * 32 + hd];
                const char* rb = (const char*)XS + (t0 + 61) * 4096;
#pragma unroll
                for (int i = 0; i < 7; ++i)
#pragma unroll
                    for (int k = 0; k < 5; ++k) raw[k][i] = *(const unsigned*)(rb + (size_t)i * 4096 + voff[k]);
            }
            const int lt = w >> 1, h2 = w & 1;
            f32x4 yo[2];
            {
                bf16x8 cf[4];
#pragma unroll
                for (int ks = 0; ks < 4; ++ks) cf[ks] = *(const LAS bf16x8*)(l3 + O_CC + (16 * lt + j16) * S128 + (32 * ks + 8 * q4) * 2);
#pragma unroll
                for (int si = 0; si < 2; ++si) { const int st = 2 * h2 + si;
                    f32x4 acc = (f32x4){0.f, 0.f, 0.f, 0.f};
                    if (st <= lt) {
#pragma unroll
                        for (int ks = 0; ks < 4; ++ks) { const bf16x8 bfr = *(const LAS bf16x8*)(l3 + O_BC + (16 * st + j16) * S128 + (32 * ks + 8 * q4) * 2); acc = MFMA16(cf[ks], bfr, acc); } }
                    const int sidx = 16 * st + j16; const float as = acs[sidx], ds = dtv[sidx];
#pragma unroll
                    for (int r = 0; r < 4; ++r) { const int l = 16 * lt + 4 * q4 + r;
                        const float m = (sidx <= l) ? acc[r] * __expf(acs[l] - as) * ds : 0.f;
                        *(LAS bf16_t*)(l3 + O_MM + l * S64 + sidx * 2) = (bf16_t)f2bf(m); } }
#pragma unroll
                for (int pi = 0; pi < 2; ++pi) { const int pt = 2 * h2 + pi; f32x4 acc = (f32x4){0.f, 0.f, 0.f, 0.f};
#pragma unroll
                    for (int ks = 0; ks < 4; ++ks) { const bf16x8 sf = *(const LAS bf16x8*)(l3 + O_SBF + (16 * pt + j16) * S128 + (32 * ks + 8 * q4) * 2); acc = MFMA16(cf[ks], sf, acc); }
                    yo[pi] = acc; }
            }
            {
                const float dec = __expf(aend);
                bf16x8 xf[2];
#pragma unroll
                for (int ks = 0; ks < 2; ++ks) xf[ks] = *(const LAS bf16x8*)(l3 + O_XPT + (16 * lt + j16) * S64 + (32 * ks + 8 * q4) * 2);
#pragma unroll
                for (int ni = 0; ni < 4; ++ni) { const int nt = 4 * h2 + ni; f32x4 acc = S[ni] * dec;
#pragma unroll
                    for (int ks = 0; ks < 2; ++ks) { const bf16x8 bt = *(const LAS bf16x8*)(l3 + O_BCT + (16 * nt + j16) * S64 + (32 * ks + 8 * q4) * 2); acc = MFMA16(xf[ks], bt, acc); }
                    S[ni] = acc; }
            }
            __syncthreads();
            {
                bf16x8 mf[2];
#pragma unroll
                for (int ks = 0; ks < 2; ++ks) mf[ks] = *(const LAS bf16x8*)(l3 + O_MM + (16 * lt + j16) * S64 + (32 * ks + 8 * q4) * 2);
#pragma unroll
                for (int pi = 0; pi < 2; ++pi) { const int pt = 2 * h2 + pi, p = 16 * pt + j16; f32x4 acc = (f32x4){0.f, 0.f, 0.f, 0.f};
#pragma unroll
                    for (int ks = 0; ks < 2; ++ks) { const bf16x8 xt = *(const LAS bf16x8*)(l3 + O_XST + (16 * pt + j16) * S64 + (32 * ks + 8 * q4) * 2); acc = MFMA16(mf[ks], xt, acc); }
                    const u32x2 xv = *(const LAS u32x2*)(l3 + O_XST + p * S64 + (16 * lt + 4 * q4) * 2);
                    const float xs0 = bf2f(xv.x & 0xffffu), xs1 = bf2f(xv.x >> 16), xs2 = bf2f(xv.y & 0xffffu), xs3 = bf2f(xv.y >> 16);
                    const int lb = 16 * lt + 4 * q4;
                    const size_t yoff = (t0 + lb) * 2048 + hd * 64 + p;
                    bf16_t* yp = dry ? (bf16_t*)(ws + WS_LIST) + (yoff & (size_t)(4 * 1024 * 1024 - 1)) : XS + yoff;
                    yp[0] = (bf16_t)f2bf(acc[0] + __expf(acs[lb]) * yo[pi][0] + Dk * xs0);
                    yp[2048] = (bf16_t)f2bf(acc[1] + __expf(acs[lb + 1]) * yo[pi][1] + Dk * xs1);
                    yp[4096] = (bf16_t)f2bf(acc[2] + __expf(acs[lb + 2]) * yo[pi][2] + Dk * xs2);
                    yp[6144] = (bf16_t)f2bf(acc[3] + __expf(acs[lb + 3]) * yo[pi][3] + Dk * xs3); }
#pragma unroll
                for (int ni = 0; ni < 4; ++ni) { const int n = 16 * (4 * h2 + ni) + j16;
#pragma unroll
                    for (int r = 0; r < 4; ++r) *(LAS bf16_t*)(l3 + O_SBF + (16 * lt + 4 * q4 + r) * S128 + n * 2) = (bf16_t)f2bf(S[ni][r]); }
            }
            __syncthreads();
        }
    }
}


typedef float f32x16 __attribute__((ext_vector_type(16)));
#define MFMA32(a, b, c) __builtin_amdgcn_mfma_f32_32x32x16_bf16(a, b, c, 0, 0, 0)
__device__ __forceinline__ void phase_e2(const Params& P, const Geo& g, LAS unsigned char* l3, int L) {
    const int i2 = L >> 1, lane = g.lane, w = g.wave, tid = g.tid, j16 = lane & 15, q4 = lane >> 4;
    unsigned char* ws = P.ws;
    const bf16_t* U = (const bf16_t*)(ws + WS_U); bf16_t* CAT = (bf16_t*)(ws + WS_CAT);
    {
        constexpr int O_UT = 0, O_PL = 20480, PS = 272;
        u32x4 pre[3];
#define POOL_FETCH(UU) do { const int gi_ = (UU) & 3, t0_ = ((UU) >> 2) * 64, s0_ = t0_ % SEQ; \
            _Pragma("unroll") for (int i = 0; i < 3; ++i) { const int e = tid + 512 * i, r = e >> 4, c16 = e & 15; pre[i] = (u32x4){0u, 0u, 0u, 0u}; \
                if (e < 79 * 16 && s0_ - 15 + r >= 0) pre[i] = *(const u32x4*)(U + (size_t)(t0_ - 15 + r) * 512 + gi_ * 128 + c16 * 8); } } while (0)
        if (g.vcu < (T / 64) * 4) POOL_FETCH(g.vcu);
        for (int u = g.vcu; u < (T / 64) * 4; u += g.G) {
            const int gi = u & 3, t0 = (u >> 2) * 64, s0 = t0 % SEQ, win = 2 << gi;
#pragma unroll
            for (int i = 0; i < 3; ++i) { const int e = tid + 512 * i, r = e >> 4, c16 = e & 15; if (e < 79 * 16) *(LAS u32x4*)(l3 + O_UT + r * 256 + c16 * 16) = pre[i]; }
            const bf16_t* Wb = (const bf16_t*)(ws + WS_WPL) + ((size_t)(i2 * 4 + gi) * 128 + 16 * w + j16) * 128 + 8 * q4;
            bf16x8 bwp[4];
#pragma unroll
            for (int ks = 0; ks < 4; ++ks) bwp[ks] = *(const bf16x8*)(Wb + 32 * ks);
            const f32x4 ps = *(const f32x4*)(P.in[I_POOLS] + i2 * 512 + gi * 128 + 16 * w + 4 * q4);
            __syncthreads();
            if (u + g.G < (T / 64) * 4) POOL_FETCH(u + g.G);
            { const int l = tid >> 3, cb = (tid & 7) * 16, s = s0 + l; const int cnt = (s + 1 < win) ? s + 1 : win;
                float acc[16];
#pragma unroll
                for (int i = 0; i < 16; ++i) acc[i] = 0.f;
                for (int j = 0; j < cnt; ++j) {
                    const u32x4 a = *(const LAS u32x4*)(l3 + O_UT + (l + 15 - j) * 256 + cb * 2), b = *(const LAS u32x4*)(l3 + O_UT + (l + 15 - j) * 256 + cb * 2 + 16);
#pragma unroll
                    for (int i = 0; i < 4; ++i) { acc[2 * i] += bf2f(a[i] & 0xffffu); acc[2 * i + 1] += bf2f(a[i] >> 16); acc[8 + 2 * i] += bf2f(b[i] & 0xffffu); acc[8 + 2 * i + 1] += bf2f(b[i] >> 16); }
                }
                const u32x4 a = *(const LAS u32x4*)(l3 + O_UT + (l + 15) * 256 + cb * 2), b = *(const LAS u32x4*)(l3 + O_UT + (l + 15) * 256 + cb * 2 + 16);
                const float inv = 1.f / (float)cnt;
                u32x4 o0, o1;
#pragma unroll
                for (int i = 0; i < 4; ++i) {
                    o0[i] = pk2(acc[2 * i] * inv - bf2f(a[i] & 0xffffu), acc[2 * i + 1] * inv - bf2f(a[i] >> 16));
                    o1[i] = pk2(acc[8 + 2 * i] * inv - bf2f(b[i] & 0xffffu), acc[8 + 2 * i + 1] * inv - bf2f(b[i] >> 16)); }
                *(LAS u32x4*)(l3 + O_PL + l * PS + cb * 2) = o0; *(LAS u32x4*)(l3 + O_PL + l * PS + cb * 2 + 16) = o1; }
            __syncthreads();
            {
                f32x4 acc[4];
#pragma unroll
                for (int lt = 0; lt < 4; ++lt) acc[lt] = (f32x4){0.f, 0.f, 0.f, 0.f};
#pragma unroll
                for (int ks = 0; ks < 4; ++ks) { const bf16x8 bw = bwp[ks];
#pragma unroll
                    for (int lt = 0; lt < 4; ++lt) { const bf16x8 a = *(const LAS bf16x8*)(l3 + O_PL + (16 * lt + j16) * PS + (32 * ks + 8 * q4) * 2); acc[lt] = MFMA16(bw, a, acc[lt]); } }
#pragma unroll
                for (int lt = 0; lt < 4; ++lt) { const f32x4 v = acc[lt] * ps; u32x2 o; o.x = pk2(v[0], v[1]); o.y = pk2(v[2], v[3]);
                    *(u32x2*)(CAT + (size_t)(t0 + 16 * lt + j16) * D + gi * 128 + 16 * w + 4 * q4) = o; }
            }
        }
#undef POOL_FETCH
        __syncthreads();
    }
    {
        constexpr int O_TB = 0, O_RING = 20480;
        for (int e = tid; e < 8 * 640; e += 512) { const int h = e / 640, i = e % 640; int rel = 575 - i; rel = rel > 256 ? 256 : rel; rel = rel < -256 ? -256 : rel;
            ((LAS float*)(l3 + O_TB))[e] = P.in[I_RELB][((size_t)i2 * NHEAD + h) * 513 + rel + 256] * LOG2E; }
        __syncthreads();
        const bf16_t* Qb = (const bf16_t*)(ws + WS_Q); const unsigned char* Kb = ws + WS_K; const unsigned char* VT = ws + WS_VT;
        const int l31 = lane & 31, hh = lane >> 5;
        for (int u8 = g.vcu; u8 < NB * NHEAD * 8; u8 += g.G) {
            const int cg = u8 & 7, h = (u8 >> 3) & 7, b = u8 >> 6;
            const int c0 = 8 * cg, c = c0 + w;
            const size_t tq0 = (size_t)b * SEQ + (size_t)c * 64;
            const size_t bhb = (((size_t)b * NHEAD + h) * 128) * 4096 + (size_t)tid * 16;
            if (cg > 0) {
#pragma unroll 2
                for (int j = 0; j < 8; ++j) { const size_t o = bhb + (size_t)(c0 - 8 + j) * 8192;
                    const u32x4 kv = *(const u32x4*)(Kb + o), vv = *(const u32x4*)(VT + o);
                    *(LAS u32x4*)(l3 + O_RING + j * 16384 + tid * 16) = kv; *(LAS u32x4*)(l3 + O_RING + j * 16384 + 8192 + tid * 16) = vv; }
            }
            bf16x8 qf[2][4];
#pragma unroll
            for (int qt = 0; qt < 2; ++qt)
#pragma unroll
                for (int ks = 0; ks < 4; ++ks) qf[qt][ks] = *(const bf16x8*)(Qb + (tq0 + 32 * qt + l31) * 512 + h * 64 + 16 * ks + 8 * hh);
            f32x16 ot[2][2];
#pragma unroll
            for (int dt = 0; dt < 2; ++dt)
#pragma unroll
                for (int qt = 0; qt < 2; ++qt)
#pragma unroll
                    for (int r = 0; r < 16; ++r) ot[dt][qt][r] = 0.f;
            float mrow[2] = {-1.0e30f, -1.0e30f}, lrow[2] = {0.f, 0.f};
            __syncthreads();
#define ATT_STEP(CJ, KT) do { \
                const LAS unsigned char* sb_ = l3 + O_RING + ((CJ) & 7) * 16384 + (KT) * 4096 + lane * 16; \
                bf16x8 kf[4], vf[2][2]; \
                _Pragma("unroll") for (int ks = 0; ks < 4; ++ks) kf[ks] = *(const LAS bf16x8*)(sb_ + ks * 1024); \
                _Pragma("unroll") for (int dt = 0; dt < 2; ++dt) _Pragma("unroll") for (int sp = 0; sp < 2; ++sp) vf[dt][sp] = *(const LAS bf16x8*)(sb_ + 8192 + (dt * 2 + sp) * 1024); \
                bf16x8 pf[2][2]; \
                _Pragma("unroll") for (int qt = 0; qt < 2; ++qt) { \
                    const LAS float* tb = (const LAS float*)(l3 + O_TB) + h * 640 + (575 - 64 * (c - (CJ)) - 32 * qt - l31 + 32 * (KT) + 4 * hh); \
                    f32x16 sa; \
                    _Pragma("unroll") for (int r = 0; r < 16; ++r) sa[r] = tb[(r & 3) + 8 * (r >> 2)]; \
                    _Pragma("unroll") for (int ks = 0; ks < 4; ++ks) sa = MFMA32(kf[ks], qf[qt][ks], sa); \
                    float mloc = sa[0]; \
                    _Pragma("unroll") for (int r = 1; r < 16; ++r) mloc = fmaxf(mloc, sa[r]); \
                    mloc = xhalf_max(mloc); \
                    const float mnew = fmaxf(mrow[qt], mloc), alpha = __builtin_amdgcn_exp2f(mrow[qt] - mnew); \
                    float ls = 0.f; \
                    _Pragma("unroll") for (int r = 0; r < 16; ++r) { sa[r] = __builtin_amdgcn_exp2f(sa[r] - mnew); ls += sa[r]; } \
                    ls = xhalf_sum(ls); \
                    lrow[qt] = lrow[qt] * alpha + ls; \
                    if (!__all(mnew == mrow[qt])) { \
                        _Pragma("unroll") for (int dt = 0; dt < 2; ++dt) _Pragma("unroll") for (int r = 0; r < 16; ++r) ot[dt][qt][r] *= alpha; } \
                    mrow[qt] = mnew; \
                    _Pragma("unroll") for (int sp = 0; sp < 2; ++sp) { u32x4 t4; \
                        t4.x = pk2(sa[8 * sp + 0], sa[8 * sp + 1]); t4.y = pk2(sa[8 * sp + 2], sa[8 * sp + 3]); t4.z = pk2(sa[8 * sp + 4], sa[8 * sp + 5]); t4.w = pk2(sa[8 * sp + 6], sa[8 * sp + 7]); \
                        pf[qt][sp] = __builtin_bit_cast(bf16x8, t4); } } \
                _Pragma("unroll") for (int dt = 0; dt < 2; ++dt) _Pragma("unroll") for (int qt = 0; qt < 2; ++qt) _Pragma("unroll") for (int sp = 0; sp < 2; ++sp) ot[dt][qt] = MFMA32(vf[dt][sp], pf[qt][sp], ot[dt][qt]); } while (0)
#pragma unroll 1
            for (int r = 0; r < 9; ++r) {
                u32x4 nk = (u32x4){0u, 0u, 0u, 0u}, nv = (u32x4){0u, 0u, 0u, 0u};
                if (r < 8) { const size_t o = bhb + (size_t)(c0 + r) * 8192; nk = *(const u32x4*)(Kb + o); nv = *(const u32x4*)(VT + o); }
                const int cj = c - 8 + r;
                if (cj >= 0) { ATT_STEP(cj, 0); ATT_STEP(cj, 1); }
                __syncthreads();
                if (r < 8) { *(LAS u32x4*)(l3 + O_RING + r * 16384 + tid * 16) = nk; *(LAS u32x4*)(l3 + O_RING + r * 16384 + 8192 + tid * 16) = nv; __syncthreads(); }
            }
#undef ATT_STEP
#pragma unroll
            for (int qt = 0; qt < 2; ++qt) { const float inv = 1.f / lrow[qt];
                bf16_t* op = CAT + (tq0 + 32 * qt + l31) * D + 512 + h * 64;
#pragma unroll
                for (int dt = 0; dt < 2; ++dt)
#pragma unroll
                    for (int gp = 0; gp < 4; gp += 2) { u32x2 o0, o1;
                        o0.x = pk2(ot[dt][qt][4 * gp] * inv, ot[dt][qt][4 * gp + 1] * inv); o0.y = pk2(ot[dt][qt][4 * gp + 2] * inv, ot[dt][qt][4 * gp + 3] * inv);
                        o1.x = pk2(ot[dt][qt][4 * gp + 4] * inv, ot[dt][qt][4 * gp + 5] * inv); o1.y = pk2(ot[dt][qt][4 * gp + 6] * inv, ot[dt][qt][4 * gp + 7] * inv);
                        const auto sx = __builtin_amdgcn_permlane32_swap(o0.x, o1.x, false, false), sy = __builtin_amdgcn_permlane32_swap(o0.y, o1.y, false, false);
                        u32x4 w4; w4.x = sx[0]; w4.y = sy[0]; w4.z = sx[1]; w4.w = sy[1];
                        *(u32x4*)(op + 32 * dt + 8 * (gp + hh)) = w4; } }
        }
    }
}

constexpr int LDS_BYTES = 160 * 1024, MISC_OFF = 160 * 1024 - 512;
constexpr int NPHASE = 34;
#ifndef PG8_SP2
#define PG8_SP2 true
#endif
#ifndef PG8_ALIGN
#define PG8_ALIGN true
#endif
__global__ void __launch_bounds__(512, 2) mk_fwd(Params P) {
    extern __shared__ __attribute__((aligned(16))) unsigned char lds[];
    LAS unsigned char* l3 = (LAS unsigned char*)lds;
    Geo g; g.tid = threadIdx.x; g.lane = g.tid & 63; g.wave = __builtin_amdgcn_readfirstlane(g.tid >> 6); g.G = gridDim.x;
    { const int bx = blockIdx.x; g.vcu = (g.G % 8 == 0) ? (bx % 8) * (g.G / 8) + bx / 8 : bx; }
    volatile LAS unsigned* MISC = (volatile LAS unsigned*)(l3 + MISC_OFF);
    if (g.tid < 64) MISC[g.tid] = 0u;
    __syncthreads();
    unsigned char* ws = P.ws;
    unsigned* ctl = (unsigned*)(ws + WS_CTL);
    XcdBarrier bar = xcd_barrier_post(ctl + CW_BAR, MISC + 8);
    const int lo = P.ph_lo, hi = P.ph_hi;
#define IN(k) (lo <= (k) && (k) < hi)
#define SEAM(k) do { if ((k) + 1 < hi) xcd_barrier(bar); } while (0)
    const float* mod = (const float*)(ws + WS_MOD);
    bf16_t* Hb = (bf16_t*)P.out; bf16_t* XB = (bf16_t*)(ws + WS_XB);

    if (IN(0)) { for (int rep_ = 0; rep_ < ((PROBE_DUP == 0) ? 2 : 1); ++rep_) { phase_mod(P, g, (float*)lds); phase_convert(P, g, (float*)(lds + 32768))  ; if (rep_ + 1 < ((PROBE_DUP == 0) ? 2 : 1)) xcd_barrier(bar); } SEAM(0); }

#define NREP(ty) ((PROBE_DUP == (ty)) ? 2 : 1)
#define DRYFLAG(ty) bool dry = false; if (PROBE_DUP == (ty)) { int d_ = (rep_ + 1 < NREP(ty)); asm volatile("" : "+s"(d_)); dry = d_ != 0; }
#define DRYBAR() do { if (dry) xcd_barrier(bar); } while (0)
#define G_E1 { pg8::Gemm gm{Hb, (const bf16_t*)(ws + WS_WMI) + (size_t)i2 * MIX_IN * D, T, MIX_IN, D}; pg8::StaticOrder S; S.init(T, MIX_IN, g.G, (int)blockIdx.x); \
                pg8::EpiE1x E{(bf16_t*)(ws + WS_U), (bf16_t*)(ws + WS_VT)}; \
                pg8::gemm_phase<pg8::EpiE1x, pg8::StaticOrder, PG8_ALIGN, PG8_SP2>(l3, gm, S, E); }
#define G_E3(F32B, BASEP) { pg8::Gemm gm{(const bf16_t*)(ws + WS_CAT), (const bf16_t*)(ws + WS_WMO) + (size_t)i2 * D * D, T, D, D}; pg8::StaticOrder S; S.init(T, D, g.G, (int)blockIdx.x); \
                pg8::EpiResGate<F32B> E{BASEP, XB, gate1, (float*)(ws + WS_SSP)}; \
                pg8::gemm_phase<pg8::EpiResGate<F32B>, pg8::StaticOrder, PG8_ALIGN, PG8_SP2>(l3, gm, S, E); }
#define G_O1A { pg8::Gemm gm{Hb, (const bf16_t*)(ws + WS_WSX) + (size_t)i2 * 4096 * D, T, 4096, D}; pg8::StaticOrder S; S.init(T, 4096, g.G, (int)blockIdx.x); \
                pg8::EpiSplitX E{(bf16_t*)(ws + WS_XS), (unsigned*)(ws + WS_XHALO)}; \
                pg8::gemm_phase<pg8::EpiSplitX, pg8::StaticOrder, PG8_ALIGN, PG8_SP2>(l3, gm, S, E); }
#define G_O1B { pg8::Gemm gm{Hb, (const bf16_t*)(ws + WS_WSZ) + (size_t)i2 * 2048 * D, T, 2048, D}; pg8::StaticOrder S; S.init(T, 2048, g.G, (int)blockIdx.x); \
                pg8::EpiGateNorm E{(bf16_t*)(ws + WS_XS), (LAS float*)(l3 + 131072)}; \
                pg8::gemm_phase<pg8::EpiGateNorm, pg8::StaticOrder, true, PG8_SP2>(l3, gm, S, E); }
#define G_O3 { pg8::Gemm gm{(const bf16_t*)(ws + WS_XS), (const bf16_t*)(ws + WS_WSO) + (size_t)i2 * D * SSM_DI, T, D, SSM_DI}; pg8::StaticOrder S; S.init(T, D, g.G, (int)blockIdx.x); \
                pg8::EpiResGate<false> E{XB, XB, gate1, (float*)(ws + WS_SSP)}; \
                pg8::gemm_phase<pg8::EpiResGate<false>, pg8::StaticOrder, PG8_ALIGN, PG8_SP2>(l3, gm, S, E); }
#define GDUP_2(...)
#define GDUP_4(...)
#define GDUP_8(...)
#define GDUP_10(...)
#define GDUP_12(...)
#if PROBE_DUP == 2
#undef GDUP_2
#define GDUP_2(...) __VA_ARGS__ xcd_barrier(bar);
#elif PROBE_DUP == 4
#undef GDUP_4
#define GDUP_4(...) __VA_ARGS__ xcd_barrier(bar);
#elif PROBE_DUP == 8
#undef GDUP_8
#define GDUP_8(...) __VA_ARGS__ xcd_barrier(bar);
#elif PROBE_DUP == 10
#undef GDUP_10
#define GDUP_10(...) __VA_ARGS__ xcd_barrier(bar);
#elif PROBE_DUP == 12
#undef GDUP_12
#define GDUP_12(...) __VA_ARGS__ xcd_barrier(bar);
#endif
#define GDUP(ty, ...) GDUP_##ty(__VA_ARGS__)
#define LAYER_BODY(LL) { const int L = (LL); \
        const int pb = 1 + 8 * L, i2 = L >> 1; \
        const float* gate1 = mod + (size_t)L * NB * 6144 + 2048; \
        if ((L & 1) == 0) { \
            if (IN(pb + 0)) { phase_norm<0>(P, g, (float*)lds, L, P.in[I_X], P.in[I_N1W] + L * D, 0, 1024, false, L == 0 ? (const bf16_t*)nullptr : (const bf16_t*)XB); SEAM(pb + 0); } \
            if (IN(pb + 1)) { G_E1 GDUP(2, G_E1) SEAM(pb + 1); } \
            if (IN(pb + 2)) { for (int rep_ = 0; rep_ < NREP(3); ++rep_) { DRYFLAG(3) phase_e2(P, g, l3, L); DRYBAR(); } SEAM(pb + 2); } \
            if (IN(pb + 3)) { if (L == 0) G_E3(true, P.in[I_X]) else G_E3(false, XB) SEAM(pb + 3); } \
            if (IN(pb + 4)) { for (int rep_ = 0; rep_ < NREP(5); ++rep_) { DRYFLAG(5) phase_norm16<2>(P, g, l3, L, XB, P.in[I_N2W] + L * D, 3072, 4096, dry); DRYBAR(); } SEAM(pb + 4); } \
            if (IN(pb + 5)) { for (int rep_ = 0; rep_ < NREP(6); ++rep_) { DRYFLAG(6) phase_moe(P, g, l3, L, dry); DRYBAR(); } SEAM(pb + 5); } \
        } else { \
            if (IN(pb + 0)) { phase_norm16<1>(P, g, l3, L, XB, P.in[I_N1W] + L * D, 0, 1024, false); SEAM(pb + 0); } \
            if (IN(pb + 1)) { G_O1A GDUP(8, G_O1A) SEAM(pb + 1); } \
            if (IN(pb + 2)) { for (int rep_ = 0; rep_ < NREP(9); ++rep_) { DRYFLAG(9) scan_units<3>(P, g, l3, L, dry); xcd_barrier(bar); scan_fix(P, g, l3, L); DRYBAR(); } SEAM(pb + 2); } \
            if (IN(pb + 3)) { G_O1B GDUP(10, G_O1B) SEAM(pb + 3); } \
            if (IN(pb + 5)) { G_O3 SEAM(pb + 5); } \
            if (IN(pb + 6)) { for (int rep_ = 0; rep_ < NREP(5); ++rep_) { DRYFLAG(5) phase_norm16<2>(P, g, l3, L, XB, P.in[I_N2W] + L * D, 3072, 4096, dry); DRYBAR(); } SEAM(pb + 6); } \
            if (IN(pb + 7)) { for (int rep_ = 0; rep_ < NREP(6); ++rep_) { DRYFLAG(6) phase_moe(P, g, l3, L, dry); DRYBAR(); } SEAM(pb + 7); } \
        } \
    }
    LAYER_BODY(0)
    LAYER_BODY(1)
    LAYER_BODY(2)
    LAYER_BODY(3)
#undef LAYER_BODY
    if (IN(33)) { for (int rep_ = 0; rep_ < NREP(13); ++rep_) { DRYFLAG(13) phase_final(P, g, dry); DRYBAR(); } }
#undef IN
#undef SEAM
}

extern "C" void kernel_launch(void* const* d_in, const int* in_sizes, int n_in, void* d_out, int out_size, void* d_ws, size_t ws_size, hipStream_t stream) {
    static int grid = 0;
    if (grid == 0) {
        if (n_in != 27 || out_size != T * D || ws_size < WS_END) { fprintf(stderr, "kernel_launch: bad shapes n_in %d out %d ws %zu (need %zu)\n", n_in, out_size, ws_size, (size_t)WS_END); grid = -1; return; }
        if (hipFuncSetAttribute((const void*)mk_fwd, hipFuncAttributeMaxDynamicSharedMemorySize, LDS_BYTES) != hipSuccess) { fprintf(stderr, "hipFuncSetAttribute failed\n"); grid = -1; return; }
        int dev = 0, cus = 0, per_cu = 0;
        if (hipGetDevice(&dev) != hipSuccess || hipDeviceGetAttribute(&cus, hipDeviceAttributeMultiprocessorCount, dev) != hipSuccess) { grid = -1; return; }
        if (hipOccupancyMaxActiveBlocksPerMultiprocessor(&per_cu, (const void*)mk_fwd, 512, LDS_BYTES) != hipSuccess || per_cu < 1) fprintf(stderr, "occupancy query says %d\n", per_cu);
        (void)hipGetLastError();
        grid = cus;
    }
    if (grid < 0) return;
    Params P{};
    for (int i = 0; i < 27; ++i) P.in[i] = (const float*)d_in[i];
    P.out = (float*)d_out; P.ws = (unsigned char*)d_ws;
    (void)hipMemsetAsync((unsigned char*)d_ws + WS_CTL, 0, CTL_BYTES, stream);
    const int G = grid;
    auto run = [&](int lo, int hi) { P.ph_lo = lo; P.ph_hi = hi; hipLaunchKernelGGL(mk_fwd, dim3(G), dim3(512), LDS_BYTES, stream, P); };
    run(0, NPHASE);
}
```

```cpp
#include <hip/hip_runtime.h>
#include <cstdio>
#include <cstdint>

#ifndef PROBE_DUP
#define PROBE_DUP -1
#endif
typedef unsigned short bf16_t;
typedef float f32x4 __attribute__((ext_vector_type(4)));
typedef unsigned u32x4 __attribute__((ext_vector_type(4)));
typedef unsigned u32x2 __attribute__((ext_vector_type(2)));
typedef float f32x2 __attribute__((ext_vector_type(2)));

constexpr int D = 1024, NB = 8, SEQ = 4096, DEPTH = 4, T = NB * SEQ;
constexpr int CHUNK = 64, NCH = SEQ / CHUNK;
constexpr float EPS = 1e-6f;
constexpr int POOLW = 512, NHEAD = 8, HD = 64, ATTW = 512, MIX_IN = 2048;
constexpr int SSM_DI = 2048, SSM_H = 32, SSM_G = 8, SSM_N = 128, SSM_P = 64, SSM_CONV = 4096, SSM_IN = 6176;
constexpr int MOE_E = 32, MOE_FF = 128, NBUCKET = 112;
constexpr float QSCALE = 0.125f * 1.4426950408889634f;
constexpr float LOG2E = 1.4426950408889634f;

constexpr size_t MiB = 1u << 20;
constexpr size_t WS_CTL = 0, CTL_BYTES = 1 * MiB;
constexpr size_t WS_MOD = 1 * MiB;
constexpr size_t WS_TOKE = 2 * MiB;
constexpr size_t WS_TOKW = 2 * MiB + 512 * 1024;
constexpr size_t WS_LIST = 3 * MiB;
constexpr size_t WS_WMI = 17 * MiB, WS_WMO = 25 * MiB, WS_WSX = 29 * MiB, WS_WSZ = 45 * MiB, WS_WSO = 53 * MiB, WS_WPL = 61 * MiB;
constexpr size_t WS_W13 = 62 * MiB, WS_W2T = 126 * MiB;
constexpr size_t WS_WRH = 61 * MiB + 256 * 1024, WS_WRL = WS_WRH + 384 * 1024;
constexpr size_t WS_WDH = 1 * MiB + 768 * 1024, WS_WDL = WS_WDH + 128 * 1024;
constexpr size_t WS_XB = 158 * MiB;
constexpr size_t WS_BIG = 222 * MiB;
constexpr size_t WS_U = WS_BIG, WS_Q = WS_BIG + 32 * MiB, WS_K = WS_BIG + 64 * MiB, WS_VT = WS_BIG + 96 * MiB, WS_CAT = WS_BIG + 128 * MiB;
constexpr size_t WS_XS = WS_BIG, WS_BC = WS_BIG + 128 * MiB, WS_DT = WS_BIG + 256 * MiB;
constexpr size_t WS_SSP = WS_BIG + 260 * MiB;
constexpr size_t WS_END = WS_SSP + 2 * MiB;
constexpr int CW_BAR = 4096;
constexpr int CW_CNT = 16384;

struct Params {
    const float* in[27];
    float* out;
    unsigned char* ws;
    int ph_lo, ph_hi;
};
enum { I_X = 0, I_C, I_ADAW, I_ADAB, I_N1W, I_N2W, I_MIXIN, I_POOLW, I_POOLS, I_RELB, I_MIXOUT, I_SSMIN, I_CONVW, I_CONVB, I_DTB, I_ALOG, I_SSMD, I_SSMNW, I_SSMOUT,
       I_WG, I_BG, I_WE, I_BE, I_W1, I_W3, I_W2, I_FNW };

#define LAS __attribute__((address_space(3)))
__device__ __forceinline__ float bf2f(unsigned v) { return __uint_as_float(v << 16); }
typedef __bf16 bf16x2_t __attribute__((ext_vector_type(2)));
__device__ __forceinline__ unsigned pk2(float lo, float hi) { f32x2 v = {lo, hi}; bf16x2_t b = __builtin_convertvector(v, bf16x2_t); return __builtin_bit_cast(unsigned, b); }
__device__ __forceinline__ unsigned f2bf(float f) { return pk2(f, f) & 0xffffu; }
__device__ __forceinline__ float xhalf_max(float x) { const auto r = __builtin_amdgcn_permlane32_swap(__float_as_uint(x), __float_as_uint(x), false, false); return fmaxf(__uint_as_float(r[0]), __uint_as_float(r[1])); }
__device__ __forceinline__ float xhalf_sum(float x) { const auto r = __builtin_amdgcn_permlane32_swap(__float_as_uint(x), __float_as_uint(x), false, false); return __uint_as_float(r[0]) + __uint_as_float(r[1]); }
__device__ __forceinline__ float x16_sum(float x) { const auto r = __builtin_amdgcn_permlane16_swap(__float_as_uint(x), __float_as_uint(x), false, false); return __uint_as_float(r[0]) + __uint_as_float(r[1]); }
#define DPP_F32(SRC, CTRL, RM) __uint_as_float(__builtin_amdgcn_update_dpp(0u, __float_as_uint(SRC), CTRL, RM, 0xf, false))
__device__ __forceinline__ float wave_incl_scan(float x) {
    x += DPP_F32(x, 0x111, 0xf); x += DPP_F32(x, 0x112, 0xf); x += DPP_F32(x, 0x114, 0xf); x += DPP_F32(x, 0x118, 0xf);
    x += DPP_F32(x, 0x142, 0xa); x += DPP_F32(x, 0x143, 0xc);
    return x;
}
__device__ __forceinline__ float wave_last(float x) { return __uint_as_float(__builtin_amdgcn_readlane(__float_as_uint(x), 63)); }
__device__ __forceinline__ float wave_sum(float v) {
#pragma unroll
    for (int o = 1; o < 64; o <<= 1) v += __shfl_xor(v, o);
    return v;
}
__device__ __forceinline__ float silu_f(float x) { return x * __builtin_amdgcn_rcpf(1.f + __expf(-x)); }
__device__ __forceinline__ float softplus_f(float x) { return x > 20.f ? x : log1pf(__expf(x)); }

struct Geo { int tid, lane, wave, vcu, G; };

__device__ __forceinline__ void phase_mod(const Params& P, const Geo& g, float* cs  ) {
    const float* c = P.in[I_C];
    for (int i = g.tid; i < NB * D; i += 512) cs[i] = silu_f(c[i]);
    __syncthreads();
    float* mod = (float*)(P.ws + WS_MOD);
    float* red = cs + 8192 + 8 * (64 * 33);
    for (int u = g.vcu; u < DEPTH * 96; u += g.G) {
        const int L = u / 96, col = (u % 96) * 64 + g.lane;
        const float* w = P.in[I_ADAW] + (size_t)L * D * 6144 + col + (size_t)g.wave * 128 * 6144;
        const float* cw = cs + g.wave * 128;
        float acc[NB];
#pragma unroll
        for (int b = 0; b < NB; ++b) acc[b] = 0.f;
#pragma unroll 32
        for (int k = 0; k < 128; ++k) {
            const float wv = w[(size_t)k * 6144];
#pragma unroll
            for (int b = 0; b < NB; ++b) acc[b] += cw[b * D + k] * wv;
        }
#pragma unroll
        for (int b = 0; b < NB; ++b) red[(g.wave * NB + b) * 64 + g.lane] = acc[b];
        __syncthreads();
        { const int b = g.wave; float sum = P.in[I_ADAB][L * 6144 + col];
#pragma unroll
            for (int ww = 0; ww < 8; ++ww) sum += red[(ww * NB + b) * 64 + g.lane];
            mod[(size_t)(L * NB + b) * 6144 + col] = sum; }
        __syncthreads();
    }
}

template <int PROJ>
__device__ __forceinline__ void phase_norm(const Params& P, const Geo& g, float* wlds, int L, const float* xsrc, const float* nw, int shift_off, int scale_off, bool dry = false, const bf16_t* xb = nullptr  ) {
    constexpr int NPROJ = PROJ == 1 ? 32 : (PROJ == 2 ? 36 : 0);
    const int i2 = L >> 1;
    if (PROJ == 1) {
        const float* w = P.in[I_SSMIN] + (size_t)i2 * D * SSM_IN + 6144;
        for (int e = g.tid; e < 32 * D; e += 512) { const int k = e >> 5, j = e & 31; wlds[j * D + k] = w[(size_t)k * SSM_IN + j]; }
        __syncthreads();
    } else if (PROJ == 2) {
        const float* wg = P.in[I_WG] + (size_t)L * D * 4;
        const float* we = P.in[I_WE] + (size_t)L * D * 32;
        for (int e = g.tid; e < 4 * D; e += 512) { const int k = e >> 2, j = e & 3; wlds[j * D + k] = wg[e]; }
        for (int e = g.tid; e < 32 * D; e += 512) { const int k = e >> 5, j = e & 31; wlds[(4 + j) * D + k] = we[e]; }
        __syncthreads();
    }
    const float* mod = (const float*)(P.ws + WS_MOD);
    bf16_t* H = (bf16_t*)P.out;
    const int gw = g.vcu * 8 + g.wave, NGW = g.G * 8;
    int my_row = -1, my_bucket = 0; int nrows = 0;
    for (int m = gw; m < T; m += NGW) {
        const int b = m / SEQ;
        f32x4 v[4]; float ss = 0.f;
        if (xb) { const u32x2* xr2 = (const u32x2*)(xb + (size_t)m * D) + g.lane;
#pragma unroll
            for (int j = 0; j < 4; ++j) { const u32x2 t2 = xr2[64 * j]; v[j].x = bf2f(t2.x & 0xffffu); v[j].y = bf2f(t2.x >> 16); v[j].z = bf2f(t2.y & 0xffffu); v[j].w = bf2f(t2.y >> 16); } }
        else { const f32x4* xr = (const f32x4*)(xsrc + (size_t)m * D) + g.lane;
#pragma unroll
            for (int j = 0; j < 4; ++j) v[j] = xr[64 * j]; }
#pragma unroll
        for (int j = 0; j < 4; ++j) ss += v[j].x * v[j].x + v[j].y * v[j].y + v[j].z * v[j].z + v[j].w * v[j].w;
        const float rstd = rsqrtf(wave_sum(ss) * (1.f / D) + EPS);
        const float* mrow = mod + (size_t)(L * NB + b) * 6144;
#pragma unroll
        for (int j = 0; j < 4; ++j) {
            const int k = 4 * g.lane + 256 * j;
            const f32x4 w4 = *(const f32x4*)(nw + k), sc = *(const f32x4*)(mrow + scale_off + k), sh = *(const f32x4*)(mrow + shift_off + k);
            v[j] = v[j] * rstd * w4 * (sc + 1.f) + sh;
            u32x2 o; o.x = pk2(v[j].x, v[j].y); o.y = pk2(v[j].z, v[j].w);
            *(u32x2*)(H + (size_t)m * D + k) = o;
        }
        if (NPROJ > 0) {
            float mine = 0.f;
#pragma unroll 2
            for (int q = 0; q < NPROJ; ++q) {
                float a = 0.f;
#pragma unroll
                for (int j = 0; j < 4; ++j) { const f32x4 w4 = *(const f32x4*)(wlds + q * D + 4 * g.lane + 256 * j); a += v[j].x * w4.x + v[j].y * w4.y + v[j].z * w4.z + v[j].w * w4.w; }
                a = wave_sum(a);
                mine = (g.lane == q) ? a : mine;
            }
            if (PROJ == 1) {
                float* DT = (float*)(P.ws + WS_DT);
                const float* dtb = P.in[I_DTB] + i2 * SSM_H;
                if (g.lane < 32) DT[(size_t)m * 32 + g.lane] = softplus_f(mine + dtb[g.lane]);
            } else if (PROJ == 2) {
                const float* bg = P.in[I_BG] + L * 4; const float* be = P.in[I_BE] + L * 32;
                float gl[4]; float gm = -3.0e38f; int gi = 0;
#pragma unroll
                for (int q = 0; q < 4; ++q) { gl[q] = __shfl(mine, q) + bg[q]; if (gl[q] > gm) { gm = gl[q]; gi = q; } }
                float gs = 0.f;
#pragma unroll
                for (int q = 0; q < 4; ++q) gs += __expf(gl[q] - gm);
                const float gval = 1.f / gs;
                float el[8];
#pragma unroll
                for (int e = 0; e < 8; ++e) el[e] = __shfl(mine, 4 + gi * 8 + e) + be[gi * 8 + e];
                float m0 = -3.0e38f; int i0 = 0;
#pragma unroll
                for (int e = 0; e < 8; ++e) if (el[e] > m0) { m0 = el[e]; i0 = e; }
                float m1 = -3.0e38f; int i1 = 0;
#pragma unroll
                for (int e = 0; e < 8; ++e) if (e != i0 && el[e] > m1) { m1 = el[e]; i1 = e; }
                float es = 0.f;
#pragma unroll
                for (int e = 0; e < 8; ++e) es += __expf(el[e] - m0);
                const float p0 = 1.f / es, p1 = __expf(m1 - m0) / es;
                const float w0 = gval * (p0 / (p0 + p1)), w1 = gval * (p1 / (p0 + p1));
                const int lo = i0 < i1 ? i0 : i1, hi = i0 < i1 ? i1 : i0;
                const float wlo = i0 < i1 ? w0 : w1, whi = i0 < i1 ? w1 : w0;
                const int bucket = gi * 28 + 7 * lo - (lo * (lo - 1)) / 2 + (hi - lo - 1);
                if (g.lane == 0) {
                    ((int2*)(P.ws + WS_TOKE))[m] = make_int2(gi * 8 + lo, gi * 8 + hi);
                    ((float2*)(P.ws + WS_TOKW))[m] = make_float2(wlo, whi);
                }
                if (g.lane == (nrows & 63)) { my_row = m; my_bucket = bucket; }
                ++nrows;
                if ((nrows & 63) == 0 && !dry) {
                    unsigned* cnt = (unsigned*)(P.ws + WS_CTL) + CW_CNT + (L * 128 + my_bucket) * 16;
                    const unsigned rank = atomicAdd(cnt, 1u);
                    ((int*)(P.ws + WS_LIST))[(size_t)my_bucket * T + rank] = my_row;
                    my_row = -1;
                }
            }
        }
    }
    if (PROJ == 2) {
        if (my_row >= 0 && !dry) {
            unsigned* cnt = (unsigned*)(P.ws + WS_CTL) + CW_CNT + (L * 128 + my_bucket) * 16;
            const unsigned rank = atomicAdd(cnt, 1u);
            ((int*)(P.ws + WS_LIST))[(size_t)my_bucket * T + rank] = my_row;
        }
    }
}


typedef short bf16x8 __attribute__((ext_vector_type(8)));
template <int PROJ>
__device__ __forceinline__ void phase_norm16(const Params& P, const Geo& g, LAS unsigned char* l3, int L, const bf16_t* xsrc, const float* nw, int shift_off, int scale_off, bool dry = false) {
    constexpr int NT = PROJ == 1 ? 2 : 3, NBLK = NT * 16, PERW = NBLK / 8;
    constexpr int O_WB = 32768, WBUF = NBLK * 1024;
    const int i2 = L >> 1, lane = g.lane, r16 = lane & 15, q4 = lane >> 4, w = g.wave;
    unsigned char* ws = P.ws;
    const float* mod = (const float*)(ws + WS_MOD);
    const float* ssp = (const float*)(ws + WS_SSP);
    bf16_t* H = (bf16_t*)P.out;
    LAS float* msl = (LAS float*)l3;
    LAS float* shl = (LAS float*)(l3 + 4096);
    LAS float* lgw = (LAS float*)(l3 + 8192 + g.wave * (16 * 48 * 4));
    const bf16_t* WH = PROJ == 1 ? (const bf16_t*)(ws + WS_WDH) + (size_t)i2 * 32 * D : (const bf16_t*)(ws + WS_WRH) + (size_t)L * 48 * D;
    const bf16_t* WL = PROJ == 1 ? (const bf16_t*)(ws + WS_WDL) + (size_t)i2 * 32 * D : (const bf16_t*)(ws + WS_WRL) + (size_t)L * 48 * D;
    for (int blk = g.vcu; blk < T / 128; blk += g.G) {
        const int b = (blk * 128) / SEQ;
        const float* mrow = mod + (size_t)(L * NB + b) * 6144;
        __syncthreads();
        for (int k = g.tid; k < D; k += 512) { msl[k] = nw[k] * (1.f + mrow[scale_off + k]); shl[k] = mrow[shift_off + k]; }
        const int m0 = blk * 128 + w * 16;
        const bf16_t* xr = xsrc + (size_t)(m0 + r16) * D + 8 * q4;
        u32x4 xq[8];
#pragma unroll
        for (int sl = 0; sl < 8; ++sl) xq[sl] = *(const u32x4*)(xr + 32 * sl);
        float ss; { const f32x4 p4 = *(const f32x4*)(ssp + (size_t)(m0 + r16) * 16 + 4 * q4); ss = (p4[0] + p4[1]) + (p4[2] + p4[3]); }
        ss = xhalf_sum(x16_sum(ss));
        const float rstd = rsqrtf(ss * (1.f / D) + EPS);
        u32x4 wreg[PERW];
#define N16_LOADW(CH) do { _Pragma("unroll") for (int i = 0; i < PERW; ++i) { const int j = PERW * w + i, lo = j >= NT * 8, jj = lo ? j - NT * 8 : j, ct = jj >> 3, sl = jj & 7; \
            wreg[i] = *(const u32x4*)((lo ? WL : WH) + (size_t)(ct * 32 + 8 * (CH) + sl) * 512 + lane * 8); } } while (0)
#define N16_STOREW(BUF) do { _Pragma("unroll") for (int i = 0; i < PERW; ++i) *(LAS u32x4*)(l3 + O_WB + (BUF) * WBUF + (PERW * w + i) * 1024 + lane * 16) = wreg[i]; } while (0)
        N16_LOADW(0); N16_STOREW(0);
        __syncthreads();
        f32x4 acc[NT];
#pragma unroll
        for (int ct = 0; ct < NT; ++ct) acc[ct] = (f32x4){0.f, 0.f, 0.f, 0.f};
        bf16_t* hrow = H + (size_t)(m0 + r16) * D + 8 * q4;
#pragma unroll 1
        for (int ch = 0; ch < 4; ++ch) {
            if (ch < 3) N16_LOADW(ch + 1);
            u32x4 xn[8];
#pragma unroll
            for (int sl = 0; sl < 8; ++sl) xn[sl] = xq[sl];
            if (ch < 3) {
#pragma unroll
                for (int sl = 0; sl < 8; ++sl) xn[sl] = *(const u32x4*)(xr + 32 * (8 * (ch + 1) + sl)); }
            const LAS unsigned char* wb = l3 + O_WB + (ch & 1) * WBUF + lane * 16;
#pragma unroll
            for (int sl = 0; sl < 8; ++sl) {
                const int s = 8 * ch + sl;
                const u32x4 x8 = xq[sl];
                f32x4 a, c; a.x = bf2f(x8.x & 0xffffu); a.y = bf2f(x8.x >> 16); a.z = bf2f(x8.y & 0xffffu); a.w = bf2f(x8.y >> 16); c.x = bf2f(x8.z & 0xffffu); c.y = bf2f(x8.z >> 16); c.z = bf2f(x8.w & 0xffffu); c.w = bf2f(x8.w >> 16);
                const f32x4 m0v = *(const LAS f32x4*)(msl + 32 * s + 8 * q4), m1v = *(const LAS f32x4*)(msl + 32 * s + 8 * q4 + 4);
                const f32x4 s0v = *(const LAS f32x4*)(shl + 32 * s + 8 * q4), s1v = *(const LAS f32x4*)(shl + 32 * s + 8 * q4 + 4);
                const f32x4 h0 = a * rstd * m0v + s0v, h1 = c * rstd * m1v + s1v;
                u32x4 hi; hi.x = pk2(h0.x, h0.y); hi.y = pk2(h0.z, h0.w); hi.z = pk2(h1.x, h1.y); hi.w = pk2(h1.z, h1.w);
                *(u32x4*)(hrow + 32 * s) = hi;
                u32x4 lo;
                lo.x = pk2(h0.x - bf2f(hi.x & 0xffffu), h0.y - bf2f(hi.x >> 16)); lo.y = pk2(h0.z - bf2f(hi.y & 0xffffu), h0.w - bf2f(hi.y >> 16));
                lo.z = pk2(h1.x - bf2f(hi.z & 0xffffu), h1.y - bf2f(hi.z >> 16)); lo.w = pk2(h1.z - bf2f(hi.w & 0xffffu), h1.w - bf2f(hi.w >> 16));
                const bf16x8 ahi = __builtin_bit_cast(bf16x8, hi), alo = __builtin_bit_cast(bf16x8, lo);
#pragma unroll
                for (int ct = 0; ct < NT; ++ct) { const bf16x8 bh = *(const LAS bf16x8*)(wb + (ct * 8 + sl) * 1024), bl = *(const LAS bf16x8*)(wb + (NT * 8 + ct * 8 + sl) * 1024);
                    acc[ct] = __builtin_amdgcn_mfma_f32_16x16x32_bf16(ahi, bh, acc[ct], 0, 0, 0);
                    acc[ct] = __builtin_amdgcn_mfma_f32_16x16x32_bf16(ahi, bl, acc[ct], 0, 0, 0);
                    acc[ct] = __builtin_amdgcn_mfma_f32_16x16x32_bf16(alo, bh, acc[ct], 0, 0, 0); }
            }
            if (ch < 3) N16_STOREW((ch + 1) & 1);
            asm volatile("s_waitcnt lgkmcnt(0)" ::: "memory"); __builtin_amdgcn_s_barrier(); asm volatile("" ::: "memory");
#pragma unroll
            for (int sl = 0; sl < 8; ++sl) xq[sl] = xn[sl];
        }
#undef N16_LOADW
#undef N16_STOREW
        if (PROJ == 1) {
            float* DT = (float*)(ws + WS_DT); const float* dtb = P.in[I_DTB] + i2 * SSM_H;
#pragma unroll
            for (int ct = 0; ct < NT; ++ct) { const float bias = dtb[16 * ct + r16];
#pragma unroll
                for (int r = 0; r < 4; ++r) DT[(size_t)(m0 + 4 * q4 + r) * 32 + 16 * ct + r16] = softplus_f(acc[ct][r] + bias); }
        } else {
#pragma unroll
            for (int ct = 0; ct < NT; ++ct)
#pragma unroll
                for (int r = 0; r < 4; ++r) lgw[(4 * q4 + r) * 48 + 16 * ct + r16] = acc[ct][r];
            asm volatile("s_waitcnt lgkmcnt(0)" ::: "memory");
            if (lane < 16) {
                const LAS float* lg = lgw + lane * 48; const int m = m0 + lane;
                const float* bg = P.in[I_BG] + L * 4; const float* be = P.in[I_BE] + L * 32;
                float gl[4]; float gm = -3.0e38f; int gi = 0;
#pragma unroll
                for (int q = 0; q < 4; ++q) { gl[q] = lg[q] + bg[q]; if (gl[q] > gm) { gm = gl[q]; gi = q; } }
                float gs = 0.f;
#pragma unroll
                for (int q = 0; q < 4; ++q) gs += __expf(gl[q] - gm);
                const float gval = 1.f / gs;
                float el[8];
#pragma unroll
                for (int e = 0; e < 8; ++e) el[e] = lg[4 + gi * 8 + e] + be[gi * 8 + e];
                float mx0 = -3.0e38f; int i0 = 0;
#pragma unroll
                for (int e = 0; e < 8; ++e) if (el[e] > mx0) { mx0 = el[e]; i0 = e; }
                float mx1 = -3.0e38f; int i1 = 0;
#pragma unroll
                for (int e = 0; e < 8; ++e) if (e != i0 && el[e] > mx1) { mx1 = el[e]; i1 = e; }
                float es = 0.f;
#pragma unroll
                for (int e = 0; e < 8; ++e) es += __expf(el[e] - mx0);
                const float p0 = 1.f / es, p1 = __expf(mx1 - mx0) / es;
                const float w0 = gval * (p0 / (p0 + p1)), w1 = gval * (p1 / (p0 + p1));
                const int lo = i0 < i1 ? i0 : i1, hi = i0 < i1 ? i1 : i0;
                const float wlo = i0 < i1 ? w0 : w1, whi = i0 < i1 ? w1 : w0;
                const int bucket = gi * 28 + 7 * lo - (lo * (lo - 1)) / 2 + (hi - lo - 1);
                ((int2*)(ws + WS_TOKE))[m] = make_int2(gi * 8 + lo, gi * 8 + hi);
                ((float2*)(ws + WS_TOKW))[m] = make_float2(wlo, whi);
                if (!dry) {
                    unsigned* cnt = (unsigned*)(ws + WS_CTL) + CW_CNT + (L * 128 + bucket) * 16;
                    const unsigned rank = atomicAdd(cnt, 1u);
                    ((int*)(ws + WS_LIST))[(size_t)bucket * T + rank] = m;
                }
            }
        }
    }
}

__device__ __forceinline__ void phase_gate(const Params& P, const Geo& g, bool dry = false) {
    bf16_t* XS = (bf16_t*)(P.ws + WS_XS); const bf16_t* Z = (const bf16_t*)(P.ws + WS_BC);
    const int gw = g.vcu * 8 + g.wave, NGW = g.G * 8;
    for (int m = gw; m < T; m += NGW) {
        u32x4* yp = (u32x4*)(XS + (size_t)m * SSM_DI + 32 * g.lane);
        const u32x4* zp = (const u32x4*)(Z + (size_t)m * SSM_DI + 32 * g.lane);
        float gv[32]; float ss = 0.f;
#pragma unroll
        for (int j = 0; j < 4; ++j) {
            const u32x4 y4 = yp[j], z4 = zp[j];
#pragma unroll
            for (int e = 0; e < 4; ++e) {
                const unsigned yy = y4[e], zz = z4[e];
                const float y0 = bf2f(yy & 0xffffu), y1 = bf2f(yy >> 16), z0 = bf2f(zz & 0xffffu), z1 = bf2f(zz >> 16);
                const float g0 = y0 * silu_f(z0), g1 = y1 * silu_f(z1);
                gv[j * 8 + e * 2] = g0; gv[j * 8 + e * 2 + 1] = g1; ss += g0 * g0 + g1 * g1;
            }
        }
        ss += __shfl_xor(ss, 1); ss += __shfl_xor(ss, 2); ss += __shfl_xor(ss, 4);
        const float rs = rsqrtf(ss * (1.f / 256.f) + EPS);
#pragma unroll
        for (int j = 0; j < 4; ++j) { u32x4 o;
#pragma unroll
            for (int e = 0; e < 4; ++e) o[e] = pk2(gv[j * 8 + e * 2] * rs, gv[j * 8 + e * 2 + 1] * rs);
            if (!dry) yp[j] = o; else asm volatile("" :: "v"(o)); }
    }
}

__device__ __forceinline__ void phase_final(const Params& P, const Geo& g, bool dry = false) {
    const float* nw = P.in[I_FNW];
    const bf16_t* XB = (const bf16_t*)(P.ws + WS_XB);
    const int gw = g.vcu * 8 + g.wave, NGW = g.G * 8;
    for (int m = gw; m < T; m += NGW) {
        const u32x2* xr2 = (const u32x2*)(XB + (size_t)m * D) + g.lane;
        f32x4* orow = (f32x4*)(P.out + (size_t)m * D) + g.lane;
        f32x4 v[4]; float ss = 0.f;
#pragma unroll
        for (int j = 0; j < 4; ++j) { const u32x2 t2 = xr2[64 * j]; v[j].x = bf2f(t2.x & 0xffffu); v[j].y = bf2f(t2.x >> 16); v[j].z = bf2f(t2.y & 0xffffu); v[j].w = bf2f(t2.y >> 16);
            ss += v[j].x * v[j].x + v[j].y * v[j].y + v[j].z * v[j].z + v[j].w * v[j].w; }
        const float rstd = rsqrtf(wave_sum(ss) * (1.f / D) + EPS);
#pragma unroll
        for (int j = 0; j < 4; ++j) { const f32x4 w4 = *(const f32x4*)(nw + 4 * g.lane + 256 * j); orow[64 * j] = v[j] * rstd * w4; }
    }
}

namespace pg8 {
#define PG8_LAS __attribute__((address_space(3)))
typedef unsigned short bf16_t;
typedef short bf16x8 __attribute__((ext_vector_type(8)));
typedef float f32x4 __attribute__((ext_vector_type(4)));
typedef unsigned u32x4 __attribute__((ext_vector_type(4)));
constexpr int BM = 256, BK = 64, HALF = 128, HTB = HALF * BK * 2  , STAGE_BYTES = 8 * HTB, NXCD = 8, WGM = 8;

__host__ __device__ __forceinline__ int lds_byte(int r, int c) { const int st = (r >> 4) * 2 + (c >> 5), rr = r & 15, cc = c & 31, ob = rr * 64 + cc * 2; return st * 1024 + (ob ^ (((ob >> 9) & 1) << 5)); }
__host__ __device__ __forceinline__ void stage_rc(int b, int& R, int& C) { const int st = b / 1024, sb = b % 1024, swz = sb ^ (((sb >> 9) & 1) << 5); R = (st >> 1) * 16 + swz / 64; C = (st & 1) * 32 + (swz % 64) / 2; }
__host__ __device__ __forceinline__ int perm32(int rho) { const int n = rho >> 4, i = rho & 15; return 8 * (i >> 2) + 4 * n + (i & 3); }

struct Unit { int pm, pn; };
struct Gemm { const bf16_t* A; const bf16_t* Bt; int M, N, K; };

struct StaticOrder {
    int nM, nN, nwg, G, c;
    __host__ __device__ void init(int M, int N, int G_, int c_) { nM = M / BM; nN = N / BM; nwg = nM * nN; G = G_; c = c_; }
    __host__ __device__ bool next(int i, Unit& u) const {
        const long L = (long)i * G + c; if (L >= nwg) return false;
        int wgid = (int)L; { const int q = nwg / NXCD, r = nwg % NXCD, xcd = wgid % NXCD, off = wgid / NXCD; wgid = (xcd < r ? xcd * (q + 1) : r * (q + 1) + (xcd - r) * q) + off; }
        const int nig = WGM * nN, gid = wgid / nig, fm = gid * WGM, gsz = (nM - fm) < WGM ? (nM - fm) : WGM;
        u.pm = fm + ((wgid % nig) % gsz); u.pn = (wgid % nig) / gsz; return true;
    }
    __device__ __forceinline__ void a_ready(const Unit&) const {}
    __device__ __forceinline__ void done(const Unit&) const {}
};
template <class Epi, class Sched, bool ALIGN_EPI = false, bool SP2 = false>
__device__ __forceinline__ void gemm_phase(PG8_LAS unsigned char* lds, const Gemm g, const Sched& S, const Epi& E) {
    const int tid = threadIdx.x, wid = __builtin_amdgcn_readfirstlane(tid >> 6), lane = tid & 63, wr = wid >> 2, wc = wid & 3, fr = lane & 15, fq = lane >> 4;
    const int K = g.K, nt = K / BK;
    unsigned voffA[2], voffB[2];
#pragma unroll
    for (int i = 0; i < 2; ++i) { int R, C; stage_rc(tid * 16 + i * 8192, R, C); const int Rb = Epi::PERM ? ((R & ~31) + perm32(R & 31)) : R;
        voffA[i] = (unsigned)(R * K + C) * 2u; voffB[i] = (unsigned)(Rb * K + C) * 2u; }
    const size_t kstep = (size_t)(BK * 2);
    const size_t hstep = (size_t)HALF * K * 2;
    const size_t tstep = 2 * hstep;
    const unsigned ldsw = (unsigned)wid * 1024u;
    const int aoff = lds_byte(wr * 64 + fr, fq * 8), boff = lds_byte(wc * 32 + fr, fq * 8);
#define PG8_SA(b, h) (((b) * 2 + (h)) * HTB)
#define PG8_SB(b, h) ((4 + (b) * 2 + (h)) * HTB)
#define PG8_STAGE(bufoff, gbase, voff) do { _Pragma("unroll") for (int _i = 0; _i < 2; ++_i) \
        __builtin_amdgcn_global_load_lds((const unsigned*)((const char*)(gbase) + (voff)[_i]), (PG8_LAS unsigned*)(lds + (bufoff) + ldsw + _i * 8192), 16, 0, 0); } while (0)
#define PG8_LDA(dst, b, h) do { _Pragma("unroll") for (int m = 0; m < 4; ++m) _Pragma("unroll") for (int k = 0; k < 2; ++k) dst[m][k] = *(const PG8_LAS bf16x8*)(lds + PG8_SA(b, h) + aoff + m * 2048 + k * 1024); } while (0)
#define PG8_LDB(dst, b, h) do { _Pragma("unroll") for (int n = 0; n < 2; ++n) _Pragma("unroll") for (int k = 0; k < 2; ++k) dst[n][k] = *(const PG8_LAS bf16x8*)(lds + PG8_SB(b, h) + boff + n * 2048 + k * 1024); } while (0)
#define PG8_MMA(ai, bj, At, Bt) do { __builtin_amdgcn_s_setprio(1); _Pragma("unroll") for (int m = 0; m < 4; ++m) _Pragma("unroll") for (int n = 0; n < 2; ++n) _Pragma("unroll") for (int k = 0; k < 2; ++k) \
        acc[ai][bj][m][n] = __builtin_amdgcn_mfma_f32_16x16x32_bf16(Bt[n][k], At[m][k], acc[ai][bj][m][n], 0, 0, 0); __builtin_amdgcn_s_setprio(0); } while (0)
#define PG8_WAIT_V(n) asm volatile("s_waitcnt vmcnt(" #n ")" ::: "memory")
#define PG8_WAIT_L(n) asm volatile("s_waitcnt lgkmcnt(" #n ")" ::: "memory")
#define PG8_BAR __builtin_amdgcn_s_barrier()
#define PG8_SCHED __builtin_amdgcn_sched_barrier(0)
    Unit cur, nxt; int ui = 0;
    if (!S.next(0, cur)) return;
    f32x4 acc[2][2][4][2];
#pragma unroll
    for (int a = 0; a < 2; ++a)
#pragma unroll
        for (int b = 0; b < 2; ++b)
#pragma unroll
            for (int m = 0; m < 4; ++m)
#pragma unroll
                for (int n = 0; n < 2; ++n) acc[a][b][m][n] = (f32x4){0.f, 0.f, 0.f, 0.f};
    bf16x8 At[4][2], B0[2][2], B1[2][2];
    const char* cA = (const char*)g.A + (size_t)cur.pm * tstep; const char* cB = (const char*)g.Bt + (size_t)cur.pn * tstep;
    S.a_ready(cur);
    if constexpr (SP2) {
        PG8_STAGE(PG8_SB(0, 0), cB, voffB); PG8_STAGE(PG8_SB(0, 1), cB + hstep, voffB); PG8_STAGE(PG8_SA(0, 0), cA, voffA); PG8_STAGE(PG8_SA(0, 1), cA + hstep, voffA);
        if (wr == 1) PG8_BAR;
        PG8_WAIT_V(2); PG8_BAR;
        PG8_STAGE(PG8_SB(1, 0), cB + kstep, voffB); PG8_STAGE(PG8_SA(1, 0), cA + kstep, voffA); PG8_STAGE(PG8_SB(1, 1), cB + hstep + kstep, voffB);
        PG8_WAIT_V(6); PG8_BAR;
    } else {
        PG8_STAGE(PG8_SB(0, 0), cB, voffB); PG8_STAGE(PG8_SA(0, 0), cA, voffA); PG8_STAGE(PG8_SB(0, 1), cB + hstep, voffB); PG8_STAGE(PG8_SA(0, 1), cA + hstep, voffA);
        if (wr == 1) PG8_BAR;
        PG8_WAIT_V(4); PG8_BAR;
        PG8_STAGE(PG8_SB(1, 0), cB + kstep, voffB); PG8_STAGE(PG8_SA(1, 0), cA + kstep, voffA); PG8_STAGE(PG8_SB(1, 1), cB + hstep + kstep, voffB);
        PG8_WAIT_V(6); PG8_BAR;
    }
    for (;;) {
        const bool has_next = S.next(ui + 1, nxt);
        const char* nA = has_next ? (const char*)g.A + (size_t)nxt.pm * tstep : cA; const char* nB = has_next ? (const char*)g.Bt + (size_t)nxt.pn * tstep : cB;
        for (int t = 0; t < nt; t += 2) {
            const bool last = (t == nt - 2);
            const char* a1 = cA + (size_t)(t + 1) * kstep;
            const char* a2 = last ? nA : cA + (size_t)(t + 2) * kstep; const char* b2 = last ? nB : cB + (size_t)(t + 2) * kstep;
            const char* a3 = a2 + kstep; const char* b3 = b2 + kstep;
            if (last && has_next) S.a_ready(nxt);
            if constexpr (SP2) {
            PG8_LDB(B0, 0, 0); PG8_LDB(B1, 0, 1); PG8_SCHED; PG8_LDA(At, 0, 0); PG8_STAGE(PG8_SA(1, 1), a1 + hstep, voffA);
            PG8_WAIT_V(8); PG8_WAIT_L(0); PG8_BAR; PG8_MMA(0, 0, At, B0); PG8_MMA(0, 1, At, B1); PG8_BAR; PG8_SCHED;
            PG8_LDA(At, 0, 1); PG8_STAGE(PG8_SB(0, 0), b2, voffB); PG8_STAGE(PG8_SB(0, 1), b2 + hstep, voffB); PG8_STAGE(PG8_SA(0, 0), a2, voffA);
            PG8_WAIT_V(8); PG8_WAIT_L(0); PG8_BAR; PG8_MMA(1, 0, At, B0); PG8_MMA(1, 1, At, B1); PG8_BAR; PG8_SCHED;
            PG8_LDB(B0, 1, 0); PG8_LDB(B1, 1, 1); PG8_SCHED; PG8_LDA(At, 1, 0); PG8_STAGE(PG8_SA(0, 1), a2 + hstep, voffA);
            PG8_WAIT_V(8); PG8_WAIT_L(0); PG8_BAR; PG8_MMA(0, 0, At, B0); PG8_MMA(0, 1, At, B1); PG8_BAR; PG8_SCHED;
            PG8_LDA(At, 1, 1); PG8_STAGE(PG8_SB(1, 0), b3, voffB); PG8_STAGE(PG8_SB(1, 1), b3 + hstep, voffB); PG8_STAGE(PG8_SA(1, 0), a3, voffA);
            PG8_WAIT_V(8); PG8_WAIT_L(0); PG8_BAR; PG8_MMA(1, 0, At, B0); PG8_MMA(1, 1, At, B1); PG8_BAR; PG8_SCHED;
            } else {
            PG8_LDB(B0, 0, 0); PG8_SCHED; PG8_LDA(At, 0, 0); PG8_STAGE(PG8_SA(1, 1), a1 + hstep, voffA);
            PG8_WAIT_L(8); PG8_BAR; PG8_WAIT_L(0); PG8_MMA(0, 0, At, B0); PG8_BAR; PG8_SCHED;
            PG8_LDB(B1, 0, 1); PG8_STAGE(PG8_SB(0, 0), b2, voffB);
            PG8_BAR; PG8_WAIT_L(0); PG8_MMA(0, 1, At, B1); PG8_BAR;
            PG8_LDA(At, 0, 1); PG8_STAGE(PG8_SA(0, 0), a2, voffA);
            PG8_BAR; PG8_WAIT_L(0); PG8_MMA(1, 0, At, B0); PG8_BAR; PG8_SCHED;
            PG8_STAGE(PG8_SB(0, 1), b2 + hstep, voffB);
            PG8_WAIT_V(6); PG8_BAR; PG8_MMA(1, 1, At, B1); PG8_BAR;
            PG8_LDB(B0, 1, 0); PG8_SCHED; PG8_LDA(At, 1, 0); PG8_STAGE(PG8_SA(0, 1), a2 + hstep, voffA);
            PG8_WAIT_L(8); PG8_BAR; PG8_WAIT_L(0); PG8_MMA(0, 0, At, B0); PG8_BAR; PG8_SCHED;
            PG8_LDB(B1, 1, 1); PG8_STAGE(PG8_SB(1, 0), b3, voffB);
            PG8_BAR; PG8_WAIT_L(0); PG8_MMA(0, 1, At, B1); PG8_BAR;
            PG8_LDA(At, 1, 1); PG8_STAGE(PG8_SA(1, 0), a3, voffA);
            PG8_BAR; PG8_WAIT_L(0); PG8_MMA(1, 0, At, B0); PG8_BAR; PG8_SCHED;
            PG8_STAGE(PG8_SB(1, 1), b3 + hstep, voffB);
            PG8_WAIT_V(6); PG8_BAR; PG8_MMA(1, 1, At, B1); PG8_BAR;
            }
        }
        if constexpr (ALIGN_EPI) { if (wr == 0) PG8_BAR; }
        if constexpr (!Epi::AFTER_DRAIN) { E(acc, cur, wr, wc, fr, fq); S.done(cur); }
        if (!has_next) break;
#pragma unroll
        for (int a = 0; a < 2; ++a)
#pragma unroll
            for (int b = 0; b < 2; ++b)
#pragma unroll
                for (int m = 0; m < 4; ++m)
#pragma unroll
                    for (int n = 0; n < 2; ++n) acc[a][b][m][n] = (f32x4){0.f, 0.f, 0.f, 0.f};
        cur = nxt; cA = nA; cB = nB; ++ui;
        if constexpr (ALIGN_EPI) { if (wr == 1) PG8_BAR; }
    }
    PG8_WAIT_V(0);
    if constexpr (!ALIGN_EPI) { if (wr == 0) PG8_BAR; }
    PG8_BAR;
    if constexpr (Epi::AFTER_DRAIN) { E.fused(acc, cur, wr, wc, fr, fq, lds, wid, lane); S.done(cur); }
#undef PG8_SA
#undef PG8_SB
#undef PG8_STAGE
#undef PG8_LDA
#undef PG8_LDB
#undef PG8_MMA
#undef PG8_WAIT_V
#undef PG8_WAIT_L
#undef PG8_BAR
#undef PG8_SCHED
}
}

namespace pg8 {
__device__ __forceinline__ unsigned cvt_pk_bf16(float lo, float hi) { unsigned r; asm volatile("v_cvt_pk_bf16_f32 %0, %1, %2" : "=v"(r) : "v"(lo), "v"(hi)); return r; }
struct EpiE1x {
    static constexpr bool PERM = true, AFTER_DRAIN = false;
    bf16_t *U, *VT;
    __device__ __forceinline__ void operator()(const f32x4 (&acc)[2][2][4][2], const Unit& u, int wr, int wc, int fr, int fq) const {
        const int row0 = u.pm * BM + wr * 64 + fr, type = u.pn >> 1, colt = (u.pn & 1) * 256 + wc * 32 + 8 * fq;
        if (type < 2) {
            bf16_t* base = U + (size_t)type * ((size_t)T * 512);
            const float sc = type == 1 ? QSCALE : 1.f;
#pragma unroll
            for (int ai = 0; ai < 2; ++ai)
#pragma unroll
                for (int m = 0; m < 4; ++m) { bf16_t* rowp = base + (size_t)(row0 + ai * HALF + m * 16) * 512 + colt;
#pragma unroll
                    for (int bj = 0; bj < 2; ++bj) { const f32x4 v0 = acc[ai][bj][m][0] * sc, v1 = acc[ai][bj][m][1] * sc;
                        u32x4 w; w.x = cvt_pk_bf16(v0[0], v0[1]); w.y = cvt_pk_bf16(v0[2], v0[3]); w.z = cvt_pk_bf16(v1[0], v1[1]); w.w = cvt_pk_bf16(v1[2], v1[3]);
                        *(u32x4*)(rowp + bj * HALF) = w; } }
        } else if (type == 2) {
            bf16_t* KT = U + (size_t)2 * ((size_t)T * 512);
#pragma unroll
            for (int ai = 0; ai < 2; ++ai)
#pragma unroll
                for (int m = 0; m < 4; ++m) { const int row = row0 + ai * HALF + m * 16, b = row / SEQ, sq = row % SEQ;
#pragma unroll
                    for (int bj = 0; bj < 2; ++bj) { const int col = colt + bj * HALF, h = col >> 6, d0 = col & 63;
                        const f32x4 v0 = acc[ai][bj][m][0], v1 = acc[ai][bj][m][1];
                        u32x4 w; w.x = cvt_pk_bf16(v0[0], v0[1]); w.y = cvt_pk_bf16(v0[2], v0[3]); w.z = cvt_pk_bf16(v1[0], v1[1]); w.w = cvt_pk_bf16(v1[2], v1[3]);
                        *(u32x4*)(KT + ((((size_t)b * NHEAD + h) * 128 + (sq >> 5)) * 4 + (d0 >> 4)) * 512 + (((d0 >> 3) & 1) * 32 + (sq & 31)) * 8) = w; } }
        } else {
#pragma unroll
            for (int ai = 0; ai < 2; ++ai)
#pragma unroll
                for (int m = 0; m < 4; ++m) { const int row = row0 + ai * HALF + m * 16, b = row / SEQ, sq = row % SEQ, kvl = sq & 31;
                    const int sp = kvl >> 4, r = kvl & 15, hh = (r >> 2) & 1, e = (r & 3) + 4 * (r >> 3);
#pragma unroll
                    for (int bj = 0; bj < 2; ++bj) { const int col = colt + bj * HALF, h = col >> 6, d0 = col & 63;
                        bf16_t* p = VT + (((((size_t)b * NHEAD + h) * 128 + (sq >> 5)) * 2 + (d0 >> 5)) * 2 + sp) * 512 + (hh * 32 + (d0 & 31)) * 8 + e;
                        const f32x4 v0 = acc[ai][bj][m][0], v1 = acc[ai][bj][m][1];
                        const unsigned w0 = cvt_pk_bf16(v0[0], v0[1]), w1 = cvt_pk_bf16(v0[2], v0[3]), w2 = cvt_pk_bf16(v1[0], v1[1]), w3 = cvt_pk_bf16(v1[2], v1[3]);
                        p[0] = (bf16_t)w0; p[8] = (bf16_t)(w0 >> 16); p[16] = (bf16_t)w1; p[24] = (bf16_t)(w1 >> 16);
                        p[32] = (bf16_t)w2; p[40] = (bf16_t)(w2 >> 16); p[48] = (bf16_t)w3; p[56] = (bf16_t)(w3 >> 16); } }
        }
    }
};
struct EpiSplitX {
    static constexpr bool PERM = true, AFTER_DRAIN = false;
    bf16_t *A0;
    unsigned* xhalo;
    __device__ __forceinline__ void operator()(const f32x4 (&acc)[2][2][4][2], const Unit& u, int wr, int wc, int fr, int fq) const {
        const int row0 = u.pm * BM + wr * 64 + fr, colt = (u.pn & 7) * 256 + wc * 32 + 8 * fq;
        bf16_t* base = A0 + (size_t)(u.pn >> 3) * ((size_t)T * 2048);
#pragma unroll
        for (int ai = 0; ai < 2; ++ai)
#pragma unroll
            for (int m = 0; m < 4; ++m) { bf16_t* rowp = base + (size_t)(row0 + ai * HALF + m * 16) * 2048 + colt;
#pragma unroll
                for (int bj = 0; bj < 2; ++bj) { const f32x4 v0 = acc[ai][bj][m][0], v1 = acc[ai][bj][m][1];
                    u32x4 w; w.x = cvt_pk_bf16(v0[0], v0[1]); w.y = cvt_pk_bf16(v0[2], v0[3]); w.z = cvt_pk_bf16(v1[0], v1[1]); w.w = cvt_pk_bf16(v1[2], v1[3]);
                    *(u32x4*)(rowp + bj * HALF) = w;
                    if ((u.pn >> 3) == 0 && (u.pm & 3) == 3 && wr == 1 && ai == 1 && m == 3 && fr >= 13) { const int r = row0 + ai * HALF + m * 16;
                        const int unit = (r >> 12) * 32 + (u.pn & 7) * 4 + ((r >> 10) & 3);
                        *(u32x4*)(xhalo + ((size_t)unit * 3 + (fr - 13)) * 128 + (wc * 32 + 8 * fq + bj * HALF) / 2) = w; } } }
    }
};
struct EpiGateNorm {
    static constexpr bool PERM = true, AFTER_DRAIN = false;
    bf16_t* Y; PG8_LAS float* xch;
    __device__ __forceinline__ void operator()(f32x4 (&acc)[2][2][4][2], const Unit& u, int wr, int wc, int fr, int fq) const {
        const int row0 = u.pm * BM + wr * 64 + fr, colt = (u.pn & 7) * 256 + wc * 32 + 8 * fq;
#pragma unroll
        for (int ai = 0; ai < 2; ++ai)
#pragma unroll
            for (int m = 0; m < 4; ++m) { const bf16_t* rowp = Y + (size_t)(row0 + ai * HALF + m * 16) * 2048 + colt; float sq = 0.f;
#pragma unroll
                for (int bj = 0; bj < 2; ++bj) { const u32x4 y8 = *(const u32x4*)(rowp + bj * HALF);
#pragma unroll
                    for (int n = 0; n < 2; ++n)
#pragma unroll
                        for (int e = 0; e < 4; ++e) { const unsigned yw = y8[2 * n + (e >> 1)]; const float yv = (e & 1) ? __uint_as_float(yw & 0xffff0000u) : __uint_as_float(yw << 16);
                            const float z = acc[ai][bj][m][n][e]; const float gv = yv * z * __builtin_amdgcn_rcpf(1.f + __expf(-z));
                            acc[ai][bj][m][n][e] = gv; sq += gv * gv; } }
                sq = xhalf_sum(x16_sum(sq));
                if (fq == 0) xch[(ai * HALF + wr * 64 + m * 16 + fr) * 4 + wc] = sq; }
        asm volatile("s_waitcnt lgkmcnt(0)" ::: "memory"); __builtin_amdgcn_s_barrier(); asm volatile("" ::: "memory");
#pragma unroll
        for (int ai = 0; ai < 2; ++ai)
#pragma unroll
            for (int m = 0; m < 4; ++m) { const int r = ai * HALF + wr * 64 + m * 16 + fr; const f32x4 p4 = *(const PG8_LAS f32x4*)(xch + r * 4);
                const float rs = __builtin_amdgcn_rsqf(((p4[0] + p4[1]) + (p4[2] + p4[3])) * (1.0f / 256.0f) + 1e-6f);
                bf16_t* rowp = Y + (size_t)(row0 + ai * HALF + m * 16) * 2048 + colt;
#pragma unroll
                for (int bj = 0; bj < 2; ++bj) { const f32x4 v0 = acc[ai][bj][m][0] * rs, v1 = acc[ai][bj][m][1] * rs;
                    u32x4 w; w.x = cvt_pk_bf16(v0[0], v0[1]); w.y = cvt_pk_bf16(v0[2], v0[3]); w.z = cvt_pk_bf16(v1[0], v1[1]); w.w = cvt_pk_bf16(v1[2], v1[3]);
                    *(u32x4*)(rowp + bj * HALF) = w; } }
        asm volatile("s_waitcnt lgkmcnt(0)" ::: "memory"); __builtin_amdgcn_s_barrier(); asm volatile("" ::: "memory");
    }
};
template <bool BASE_F32>
struct EpiResGate {
    static constexpr bool PERM = true, AFTER_DRAIN = false;
    const void* base; bf16_t* out; const float* gate; float* ssp;
    __device__ __forceinline__ void operator()(const f32x4 (&acc)[2][2][4][2], const Unit& u, int wr, int wc, int fr, int fq) const {
        const int row0 = u.pm * BM + wr * 64 + fr, b = (u.pm * BM) / SEQ, col0 = u.pn * BM + wc * 32 + 8 * fq;
        f32x4 gv[2][2];
#pragma unroll
        for (int bj = 0; bj < 2; ++bj)
#pragma unroll
            for (int n = 0; n < 2; ++n) gv[bj][n] = *(const f32x4*)(gate + (size_t)b * 6144 + col0 + bj * HALF + n * 4);
        constexpr int MB = BASE_F32 ? 2 : 4;
#pragma unroll
        for (int ai = 0; ai < 2; ++ai)
#pragma unroll
            for (int m0 = 0; m0 < 4; m0 += MB) {
                f32x4 rf[MB][2][BASE_F32 ? 2 : 1]; u32x4 rx[MB][2];
#pragma unroll
                for (int mm = 0; mm < MB; ++mm) { const size_t off = (size_t)(row0 + ai * HALF + (m0 + mm) * 16) * D + col0;
#pragma unroll
                    for (int bj = 0; bj < 2; ++bj) {
                        if (BASE_F32) { rf[mm][bj][0] = *(const f32x4*)((const float*)base + off + bj * HALF); rf[mm][bj][BASE_F32 ? 1 : 0] = *(const f32x4*)((const float*)base + off + bj * HALF + 4); }
                        else rx[mm][bj] = *(const u32x4*)((const bf16_t*)base + off + bj * HALF); } }
#pragma unroll
                for (int mm = 0; mm < MB; ++mm) { const int m = m0 + mm; const size_t off = (size_t)(row0 + ai * HALF + m * 16) * D + col0; float sq = 0.f;
#pragma unroll
                    for (int bj = 0; bj < 2; ++bj) { f32x4 b0, b1;
                        if (BASE_F32) { b0 = rf[mm][bj][0]; b1 = rf[mm][bj][BASE_F32 ? 1 : 0]; }
                        else { const u32x4 x8 = rx[mm][bj];
                            b0[0] = __uint_as_float(x8.x << 16); b0[1] = __uint_as_float(x8.x & 0xffff0000u); b0[2] = __uint_as_float(x8.y << 16); b0[3] = __uint_as_float(x8.y & 0xffff0000u);
                            b1[0] = __uint_as_float(x8.z << 16); b1[1] = __uint_as_float(x8.z & 0xffff0000u); b1[2] = __uint_as_float(x8.w << 16); b1[3] = __uint_as_float(x8.w & 0xffff0000u); }
                        const f32x4 o0 = b0 + gv[bj][0] * acc[ai][bj][m][0], o1 = b1 + gv[bj][1] * acc[ai][bj][m][1];
                        sq += ((o0[0] * o0[0] + o0[1] * o0[1]) + (o0[2] * o0[2] + o0[3] * o0[3])) + ((o1[0] * o1[0] + o1[1] * o1[1]) + (o1[2] * o1[2] + o1[3] * o1[3]));
                        u32x4 w8; w8.x = cvt_pk_bf16(o0[0], o0[1]); w8.y = cvt_pk_bf16(o0[2], o0[3]); w8.z = cvt_pk_bf16(o1[0], o1[1]); w8.w = cvt_pk_bf16(o1[2], o1[3]);
                        *(u32x4*)(out + off + bj * HALF) = w8; }
                    sq = xhalf_sum(x16_sum(sq));
                    if (fq == 0) ssp[(size_t)(row0 + ai * HALF + m * 16) * 16 + u.pn * 4 + wc] = sq; }
            }
    }
};
}

#define XB_TMO      128
#define XB_XCNT(j)  (256  + 64 * (j))
#define XB_XSUB(j)  (1280 + 64 * (j))
#define XB_XGEN(j)  (2304 + 64 * (j))
#define XB_TOP      3328
#define XB_TOPGEN   3392
#define XCD_BAR_WORDS 3456
#define XB_SPIN_CAP (1u << 18)

__device__ __forceinline__ unsigned xb_ld(unsigned* p)              { return __hip_atomic_load(p, __ATOMIC_RELAXED, __HIP_MEMORY_SCOPE_AGENT); }
__device__ __forceinline__ unsigned xb_add(unsigned* p, unsigned v) { return __hip_atomic_fetch_add(p, v, __ATOMIC_RELAXED, __HIP_MEMORY_SCOPE_AGENT); }
__device__ __forceinline__ unsigned xb_xcc_id() { return (unsigned)__builtin_amdgcn_s_getreg((3 << 11) | 20) & 0xFu; }
#define XB_SPIN(cond, bar) do { unsigned _sp = 0; while (cond) { __builtin_amdgcn_s_sleep(1); \
    if ((++_sp & 255u) == 0u) { if (xb_ld(&(bar)[XB_TMO])) break; if (_sp > XB_SPIN_CAP) { atomicAdd(&(bar)[XB_TMO], 1u); break; } } } } while (0)

struct XcdBarrier {
    unsigned* bar; unsigned x;
    volatile LAS unsigned* st;
};

__device__ __forceinline__ XcdBarrier xcd_barrier_post(unsigned* bar, volatile LAS unsigned* st) {
    XcdBarrier b; b.bar = bar; b.x = xb_xcc_id(); b.st = st;
    if (threadIdx.x == 0) (void)xb_add(&bar[XB_XCNT(b.x)], 1u);
    return b;
}
__device__ __forceinline__ void xcd_barrier_complete(unsigned* bar, unsigned x, unsigned& nloc, unsigned& nx) {
    const unsigned G = gridDim.x * gridDim.y * gridDim.z;
    unsigned sum, cnt, mine, sp = 0u;
    for (;;) {
        sum = 0u; cnt = 0u; mine = 0u;
#pragma unroll
        for (unsigned j = 0; j < 16; ++j) { const unsigned c = xb_ld(&bar[XB_XCNT(j)]); sum += c; cnt += (c > 0u) ? 1u : 0u; mine = (j == x) ? c : mine; }
        if (sum == G) break;
        __builtin_amdgcn_s_sleep(1);
        if ((++sp & 255u) == 0u) { if (xb_ld(&bar[XB_TMO])) break; if (sp > XB_SPIN_CAP) { atomicAdd(&bar[XB_TMO], 1u); break; } }
    }
    nloc = mine > 0u ? mine : 1u; nx = cnt > 0u ? cnt : 1u;
}

__device__ __forceinline__ void xcd_barrier(const XcdBarrier& b) {
    asm volatile("s_waitcnt vmcnt(0)" ::: "memory");
    __syncthreads();
    if (threadIdx.x == 0) {
        unsigned* bar = b.bar;
        __builtin_amdgcn_s_waitcnt(0);
        unsigned nloc = b.st[0], nx = b.st[1];
        if (nloc == 0u) { xcd_barrier_complete(bar, b.x, nloc, nx); b.st[0] = nloc; b.st[1] = nx; }
        const unsigned old = xb_add(&bar[XB_XSUB(b.x)], 1u);
        const unsigned gen = old / nloc;
        if (old + 1u == (gen + 1u) * nloc) {
            __builtin_amdgcn_fence(__ATOMIC_RELEASE, "agent");
            asm volatile("s_waitcnt vmcnt(0)" ::: "memory");
            const unsigned og = xb_add(&bar[XB_TOP], 1u);
            const unsigned tg = og / nx;
            if (og + 1u == (tg + 1u) * nx) xb_add(&bar[XB_TOPGEN], 1u);
            else XB_SPIN(xb_ld(&bar[XB_TOPGEN]) == tg, bar);
            __builtin_amdgcn_fence(__ATOMIC_ACQUIRE, "agent");
            xb_add(&bar[XB_XGEN(b.x)], 1u);
            asm volatile("s_waitcnt vmcnt(0)" ::: "memory");
        } else {
            XB_SPIN(xb_ld(&bar[XB_XGEN(b.x)]) == gen, bar);
            __builtin_amdgcn_fence(__ATOMIC_ACQUIRE, "agent");
            asm volatile("s_waitcnt vmcnt(0)" ::: "memory");
        }
    }
    __syncthreads();
}

#define LDS_WAIT() asm volatile("s_waitcnt lgkmcnt(0)" ::: "memory")
template <int MODE>
__device__ __forceinline__ void transpose_item(const float* W, int ldw, int K, bf16_t* WT, int row_off, float* scr, int kb, int nb, int lane, const float* kscale) {
    const int k0 = 64 * kb, n0 = 32 * nb;
#pragma unroll 32
    for (int i = 0; i < 32; ++i) { const int kk = 2 * i + (lane >> 5); float v = W[(size_t)(k0 + kk) * ldw + n0 + (lane & 31)]; if (kscale) v *= kscale[k0 + kk]; scr[kk * 33 + (lane & 31)] = v; }
    LDS_WAIT(); asm volatile("" ::: "memory");
    const int c = lane & 7;
#pragma unroll
    for (int j = 0; j < 4; ++j) { const int n = (lane >> 3) + 8 * j; const float* s = scr + (8 * c) * 33 + n;
        u32x4 o; o.x = pk2(s[0 * 33], s[1 * 33]); o.y = pk2(s[2 * 33], s[3 * 33]); o.z = pk2(s[4 * 33], s[5 * 33]); o.w = pk2(s[6 * 33], s[7 * 33]);
        const int ng = n0 + n, orow = MODE == 1 ? (row_off + 32 * (ng >> 4) + (ng & 15)) : (row_off + ng);
        if (MODE == 1) {
            const int kk = k0 + 8 * c; const size_t blk = ((size_t)(orow >> 5) * 32 + (kk >> 5)) * 2 + ((orow >> 4) & 1);
            *(u32x4*)(WT + (blk * 64 + ((kk >> 3) & 3) * 16 + (orow & 15)) * 8) = o;
        } else if (MODE == 3) {
            const int kk = k0 + 8 * c, u = orow & 31; const size_t blk = (size_t)(2 * (orow >> 5) + ((u >> 2) & 1)) * (K >> 5) + (kk >> 5);
            *(u32x4*)(WT + (blk * 64 + ((kk >> 3) & 3) * 16 + 4 * (u >> 3) + (u & 3)) * 8) = o;
        } else if (MODE == 2) {
            const int kk = k0 + 8 * c; const size_t blk = (size_t)(orow >> 4) * (K >> 5) + (kk >> 5);
            *(u32x4*)(WT + (blk * 64 + ((kk >> 3) & 3) * 16 + (orow & 15)) * 8) = o;
        } else *(u32x4*)(WT + (size_t)orow * K + k0 + 8 * c) = o; }
    LDS_WAIT(); asm volatile("" ::: "memory");
}
__device__ __forceinline__ void phase_convert(const Params& P, const Geo& g, float* ldsf) {
    float* scr = ldsf + g.wave * (64 * 33);
    const int gw = g.vcu * 8 + g.wave, NGW = g.G * 8;
    unsigned char* ws = P.ws;
    for (int e = gw * 64 + g.lane; e < DEPTH * 48 * D; e += NGW * 64) { const int Lr = e / (48 * D), rem = e % (48 * D), ct = rem / (16 * D), s_ = (rem / 512) & 31, ln = (rem >> 3) & 63, jj = rem & 7;
        const int j = 16 * ct + (ln & 15), k = 32 * s_ + 8 * (ln >> 4) + jj;
        const float v = j < 4 ? P.in[I_WG][((size_t)Lr * D + k) * 4 + j] : (j < 36 ? P.in[I_WE][((size_t)Lr * D + k) * 32 + j - 4] : 0.f);
        const unsigned hi = f2bf(v); ((bf16_t*)(ws + WS_WRH))[e] = (bf16_t)hi; ((bf16_t*)(ws + WS_WRL))[e] = (bf16_t)f2bf(v - bf2f(hi)); }
    for (int e = gw * 64 + g.lane; e < 2 * 32 * D; e += NGW * 64) { const int ir = e / (32 * D), rem = e % (32 * D), ct = rem / (16 * D), s_ = (rem / 512) & 31, ln = (rem >> 3) & 63, jj = rem & 7;
        const int j = 16 * ct + (ln & 15), k = 32 * s_ + 8 * (ln >> 4) + jj;
        const float v = P.in[I_SSMIN][((size_t)ir * D + k) * SSM_IN + 6144 + j];
        const unsigned hi = f2bf(v); ((bf16_t*)(ws + WS_WDH))[e] = (bf16_t)hi; ((bf16_t*)(ws + WS_WDL))[e] = (bf16_t)f2bf(v - bf2f(hi)); }
    constexpr int C0 = 2 * 1024, C1 = C0 + 2 * 512, C2 = C1 + 2 * 2048, C3 = C2 + 2 * 1024, C4 = C3 + 2 * 1024, C5 = C4 + 8 * 8, C6 = C5 + 128 * 64, C7 = C6 + 128 * 64, C8 = C7 + 128 * 64;
    for (int it = gw; it < C8; it += NGW) {
        int r = it;
        if (r < C0) { const int mat = r / 1024, rem = r % 1024;
            transpose_item<0>(P.in[I_MIXIN] + (size_t)mat * D * MIX_IN, MIX_IN, D, (bf16_t*)(ws + WS_WMI) + (size_t)mat * MIX_IN * D, 0, scr, rem / 64, rem % 64, g.lane, nullptr); continue; }
        r -= C0;
        if (r < 2 * 512) { const int mat = r / 512, rem = r % 512;
            transpose_item<0>(P.in[I_MIXOUT] + (size_t)mat * D * D, D, D, (bf16_t*)(ws + WS_WMO) + (size_t)mat * D * D, 0, scr, rem / 32, rem % 32, g.lane, nullptr); continue; }
        r -= 2 * 512;
        if (r < 2 * 2048) { const int mat = r / 2048, rem = r % 2048;
            transpose_item<0>(P.in[I_SSMIN] + (size_t)mat * D * SSM_IN + 2048, SSM_IN, D, (bf16_t*)(ws + WS_WSX) + (size_t)mat * 4096 * D, 0, scr, rem / 128, rem % 128, g.lane, nullptr); continue; }
        r -= 2 * 2048;
        if (r < 2 * 1024) { const int mat = r / 1024, rem = r % 1024;
            transpose_item<0>(P.in[I_SSMIN] + (size_t)mat * D * SSM_IN, SSM_IN, D, (bf16_t*)(ws + WS_WSZ) + (size_t)mat * 2048 * D, 0, scr, rem / 64, rem % 64, g.lane, nullptr); continue; }
        r -= 2 * 1024;
        if (r < 2 * 1024) { const int mat = r / 1024, rem = r % 1024;
            transpose_item<0>(P.in[I_SSMOUT] + (size_t)mat * SSM_DI * D, D, SSM_DI, (bf16_t*)(ws + WS_WSO) + (size_t)mat * D * SSM_DI, 0, scr, rem / 32, rem % 32, g.lane, P.in[I_SSMNW] + mat * SSM_DI); continue; }
        r -= 2 * 1024;
        if (r < 64) { const int mat = r / 8, rem = r % 8;
            transpose_item<0>(P.in[I_POOLW] + (size_t)mat * 128 * 128, 128, 128, (bf16_t*)(ws + WS_WPL) + (size_t)mat * 128 * 128, 0, scr, rem / 4, rem % 4, g.lane, nullptr); continue; }
        r -= 64;
        if (r < 128 * 64) { const int mat = r / 64, rem = r % 64;
            transpose_item<1>(P.in[I_W1] + (size_t)mat * D * MOE_FF, MOE_FF, D, (bf16_t*)(ws + WS_W13) + (size_t)mat * 256 * D, 0, scr, rem / 4, rem % 4, g.lane, nullptr); continue; }
        r -= 128 * 64;
        if (r < 128 * 64) { const int mat = r / 64, rem = r % 64;
            transpose_item<1>(P.in[I_W3] + (size_t)mat * D * MOE_FF, MOE_FF, D, (bf16_t*)(ws + WS_W13) + (size_t)mat * 256 * D, 16, scr, rem / 4, rem % 4, g.lane, nullptr); continue; }
        r -= 128 * 64;
        { const int mat = r / 64, rem = r % 64;
            transpose_item<3>(P.in[I_W2] + (size_t)mat * MOE_FF * D, D, MOE_FF, (bf16_t*)(ws + WS_W2T) + (size_t)mat * D * MOE_FF, 0, scr, rem / 32, rem % 32, g.lane, nullptr); }
    }
}


#define LDS_BARRIER() do { asm volatile("s_waitcnt lgkmcnt(0)" ::: "memory"); __builtin_amdgcn_s_barrier(); asm volatile("" ::: "memory"); } while (0)
template <int NMT>
__device__ __forceinline__ void moe_pass(const Params& P, LAS unsigned char* l3, int L, int w, int lane, int bucket, int off, int nrows, int e0, int e1, bool dry) {
    constexpr int HS = 528, OFF_B1 = 67584, OFF_GT = 67584;
    constexpr int OFF_TOK = 133120, OFF_WLO = OFF_TOK + 512, OFF_WHI = OFF_WLO + 512;
    LAS int* tok = (LAS int*)(l3 + OFF_TOK); LAS float* wlo = (LAS float*)(l3 + OFF_WLO); LAS float* whi = (LAS float*)(l3 + OFF_WHI);
    unsigned char* ws = P.ws;
    const int* list = (const int*)(ws + WS_LIST);
    const float2* tokw = (const float2*)(ws + WS_TOKW);
    const bf16_t* H = (const bf16_t*)P.out;
    const float* gate2 = (const float*)(ws + WS_MOD) + (size_t)L * NB * 6144 + 5120;
    const int j16 = lane & 15, q4 = lane >> 4, tid = w * 64 + lane;
    float2 tww = make_float2(0.f, 0.f);
    if (tid < 128) { const int r = tid; int t = -1;
        if (r < nrows) { t = list[(size_t)bucket * T + off + r]; tww = tokw[t]; }
        tok[r] = t; }
    LDS_BARRIER();
#define MOE_GATHER(KC, BO) do { if (w < NMT) { _Pragma("unroll") for (int i = 0; i < 8; ++i) { int t = tok[16 * w + 2 * i + (lane >> 5)]; t = t < 0 ? 0 : t; \
        const int s = (lane & 31) ^ ((2 * i + (lane >> 5)) & 15); \
        __builtin_amdgcn_global_load_lds((const unsigned*)(H + (size_t)t * D + (KC) * 256 + s * 8), (LAS unsigned*)(l3 + (BO) + (16 * w + 2 * i) * 512), 16, 0, 0); } } } while (0)
    f32x4 gtv[4];
    {
        const char* Wu0 = (const char*)(ws + WS_W13) + ((size_t)(L * MOE_E + e0) * 256 * D + (size_t)w * 32 * 1024) * 2;
        const char* Wu1 = (const char*)(ws + WS_W13) + ((size_t)(L * MOE_E + e1) * 256 * D + (size_t)w * 32 * 1024) * 2;
        const unsigned lo16 = (unsigned)lane * 16u;
#define W13F(U, KS, S) (*(const bf16x8*)((U) + (size_t)(lo16 + (unsigned)(2048 * (KS) + 1024 * (S)))))
        f32x4 acc[2][NMT][2];
#pragma unroll
        for (int es = 0; es < 2; ++es)
#pragma unroll
            for (int mt = 0; mt < NMT; ++mt) { acc[es][mt][0] = (f32x4){0.f, 0.f, 0.f, 0.f}; acc[es][mt][1] = (f32x4){0.f, 0.f, 0.f, 0.f}; }
        MOE_GATHER(0, 0);
        asm volatile("" ::: "memory");
        bf16x8 rb[2][4];
#pragma unroll
        for (int j = 0; j < 2; ++j) { rb[j][0] = W13F(Wu0, j, 0); rb[j][1] = W13F(Wu0, j, 1); rb[j][2] = W13F(Wu1, j, 0); rb[j][3] = W13F(Wu1, j, 1); }
        if (tid < 128) { wlo[tid] = tww.x; whi[tid] = tww.y; }
        asm volatile("s_waitcnt vmcnt(8)" ::: "memory");
        LDS_BARRIER();
#pragma unroll 1
        for (int kc = 0; kc < 4; ++kc) {
            int lk = lane; asm volatile("" : "+v"(lk));
            const int lane = lk, j16 = lane & 15, q4 = lane >> 4; const unsigned lo16 = (unsigned)lane * 16u;
            const int aoff = j16 * 512 + ((q4 ^ j16) << 4);
            const int bo = (kc & 1) ? OFF_B1 : 0;
            if (kc < 3) { if (kc & 1) MOE_GATHER(kc + 1, 0); else MOE_GATHER(kc + 1, OFF_B1); }
            asm volatile("" ::: "memory");
#pragma unroll
            for (int ksl = 0; ksl < 8; ++ksl) {
                const int ks = 8 * kc + ksl;
                const LAS unsigned char* ap = l3 + bo + (aoff ^ (ksl << 6));
#pragma unroll
                for (int mt = 0; mt < NMT; ++mt) { const bf16x8 a = *(const LAS bf16x8*)(ap + mt * 8192);
                    acc[0][mt][0] = __builtin_amdgcn_mfma_f32_16x16x32_bf16(a, rb[ksl & 1][0], acc[0][mt][0], 0, 0, 0);
                    acc[0][mt][1] = __builtin_amdgcn_mfma_f32_16x16x32_bf16(a, rb[ksl & 1][1], acc[0][mt][1], 0, 0, 0); }
                if (kc < 3 || ksl < 6) { rb[ksl & 1][0] = W13F(Wu0, ks + 2, 0); rb[ksl & 1][1] = W13F(Wu0, ks + 2, 1); }
#pragma unroll
                for (int mt = 0; mt < NMT; ++mt) { const bf16x8 a = *(const LAS bf16x8*)(ap + mt * 8192);
                    acc[1][mt][0] = __builtin_amdgcn_mfma_f32_16x16x32_bf16(a, rb[ksl & 1][2], acc[1][mt][0], 0, 0, 0);
                    acc[1][mt][1] = __builtin_amdgcn_mfma_f32_16x16x32_bf16(a, rb[ksl & 1][3], acc[1][mt][1], 0, 0, 0); }
                if (kc < 3 || ksl < 6) { rb[ksl & 1][2] = W13F(Wu1, ks + 2, 0); rb[ksl & 1][3] = W13F(Wu1, ks + 2, 1); }
                __builtin_amdgcn_sched_barrier(0);
            }
            if (kc < 3) { asm volatile("s_waitcnt vmcnt(8)" ::: "memory"); LDS_BARRIER(); }
        }
        int l2 = lane; asm volatile("" : "+v"(l2));
        { const int lane = l2, j16 = lane & 15, q4 = lane >> 4, tid = w * 64 + lane;
#pragma unroll
        for (int i = 0; i < 4; ++i) { const int e = tid + 512 * i; gtv[i] = *(const f32x4*)(gate2 + (size_t)(e >> 8) * 6144 + (e & 255) * 4); }
#pragma unroll
        for (int es = 0; es < 2; ++es)
#pragma unroll
            for (int mt = 0; mt < NMT; ++mt) { LAS bf16_t* hb = (LAS bf16_t*)(l3 + (16 * mt + 4 * q4) * HS) + 128 * es + 16 * w + j16;
#pragma unroll
                for (int r = 0; r < 4; ++r) { const int l = 16 * mt + 4 * q4 + r; const float wt = es ? whi[l] : wlo[l];
                    hb[r * (HS / 2)] = (bf16_t)f2bf(silu_f(acc[es][mt][0][r]) * acc[es][mt][1][r] * wt); } }
        }
    }
#undef MOE_GATHER
#undef W13F
    int l4 = lane; asm volatile("" : "+v"(l4));
    { const int lane = l4, j16 = lane & 15, q4 = lane >> 4, tid = w * 64 + lane;
    LDS_BARRIER();
#pragma unroll
    for (int i = 0; i < 4; ++i) { const int e = tid + 512 * i; *(LAS f32x4*)(l3 + OFF_GT + (e >> 8) * 4112 + (e & 255) * 16) = gtv[i]; }
    LDS_BARRIER();
#pragma unroll 1
    for (int half = 0; half < 2; ++half) {
        int lh = lane; asm volatile("" : "+v"(lh));
        const int lane = lh, j16 = lane & 15, q4 = lane >> 4;
        const int nb = 128 * w + 64 * half;
        f32x4 acc[NMT][4];
#pragma unroll
        for (int mt = 0; mt < NMT; ++mt)
#pragma unroll
            for (int nt = 0; nt < 4; ++nt) acc[mt][nt] = (f32x4){0.f, 0.f, 0.f, 0.f};
        const char* Vu0 = (const char*)(ws + WS_W2T) + ((size_t)(L * MOE_E + e0) * D * MOE_FF + (size_t)(nb >> 4) * 4 * 512) * 2;
        const char* Vu1 = (const char*)(ws + WS_W2T) + ((size_t)(L * MOE_E + e1) * D * MOE_FF + (size_t)(nb >> 4) * 4 * 512) * 2;
        const unsigned lo16b = (unsigned)lane * 16u;
#define W2F(KS, NT) (*(const bf16x8*)((((KS) >> 2) ? Vu1 : Vu0) + (size_t)(lo16b + (unsigned)(1024 * ((KS) & 3) + 4096 * (NT)))))
#define MOE_XLOAD(MG, BUF) do { _Pragma("unroll") for (int m4 = 0; m4 < 2; ++m4) { int t = tok[16 * (2 * (MG) + m4) + j16]; asm volatile("" : "+v"(t)); tt[BUF][m4] = t; const int tc = t < 0 ? 0 : t; \
            const bf16_t* xr_ = (const bf16_t*)(ws + WS_XB) + (size_t)tc * D + nb + 8 * q4; \
            _Pragma("unroll") for (int np = 0; np < 2; ++np) xin[BUF][m4][np] = *(const u32x4*)(xr_ + 32 * np); } } while (0)
        int tt[2][2]; u32x4 xin[2][2][2];
        bf16x8 bw[2][4];
#pragma unroll
        for (int j = 0; j < 2; ++j)
#pragma unroll
            for (int nt = 0; nt < 4; ++nt) bw[j][nt] = W2F(j, nt);
#pragma unroll
        for (int ks = 0; ks < 8; ++ks) {
            bf16x8 b[4];
#pragma unroll
            for (int nt = 0; nt < 4; ++nt) b[nt] = bw[ks & 1][nt];
            if (ks + 2 < 8) {
#pragma unroll
                for (int nt = 0; nt < 4; ++nt) bw[ks & 1][nt] = W2F(ks + 2, nt); }
            if (ks == 6) MOE_XLOAD(0, 0);
#pragma unroll
            for (int mt = 0; mt < NMT; ++mt) { const bf16x8 a = *(const LAS bf16x8*)(l3 + (16 * mt + j16) * HS + (32 * ks + 8 * q4) * 2);
#pragma unroll
                for (int nt = 0; nt < 4; ++nt) acc[mt][nt] = __builtin_amdgcn_mfma_f32_16x16x32_bf16(b[nt], a, acc[mt][nt], 0, 0, 0); }
            __builtin_amdgcn_sched_barrier(0);
        }
#undef W2F
#pragma unroll
        for (int mg = 0; mg < NMT / 2; ++mg) {
            if (mg + 1 < NMT / 2) MOE_XLOAD(mg + 1, (mg + 1) & 1);
#pragma unroll
            for (int m4 = 0; m4 < 2; ++m4) { const int t = tt[mg & 1][m4], mt = 2 * mg + m4; float sq = 0.f;
                if (t >= 0) { const int b = t / SEQ; bf16_t* xr = (bf16_t*)(ws + WS_XB) + (size_t)t * D + nb + 8 * q4; const LAS float* gr = (const LAS float*)(l3 + OFF_GT) + b * 1028 + nb + 8 * q4;
#pragma unroll
                    for (int np = 0; np < 2; ++np) { const f32x4 g0 = *(const LAS f32x4*)(gr + 32 * np), g1 = *(const LAS f32x4*)(gr + 32 * np + 4);
                        const u32x4 x8 = xin[mg & 1][m4][np];
                        f32x4 x0, x1; x0[0] = bf2f(x8.x & 0xffffu); x0[1] = bf2f(x8.x >> 16); x0[2] = bf2f(x8.y & 0xffffu); x0[3] = bf2f(x8.y >> 16);
                        x1[0] = bf2f(x8.z & 0xffffu); x1[1] = bf2f(x8.z >> 16); x1[2] = bf2f(x8.w & 0xffffu); x1[3] = bf2f(x8.w >> 16);
                        const f32x4 o0 = x0 + g0 * acc[mt][2 * np], o1 = x1 + g1 * acc[mt][2 * np + 1];
                        sq += ((o0[0] * o0[0] + o0[1] * o0[1]) + (o0[2] * o0[2] + o0[3] * o0[3])) + ((o1[0] * o1[0] + o1[1] * o1[1]) + (o1[2] * o1[2] + o1[3] * o1[3]));
                        u32x4 w8; w8.x = pk2(o0[0], o0[1]); w8.y = pk2(o0[2], o0[3]); w8.z = pk2(o1[0], o1[1]); w8.w = pk2(o1[2], o1[3]);
                        if (!dry) *(u32x4*)(xr + 32 * np) = w8; } }
                sq = xhalf_sum(x16_sum(sq));
                if (!dry && t >= 0 && q4 == 0) ((float*)(ws + WS_SSP))[(size_t)t * 16 + 2 * w + half] = sq; }
        }
#undef MOE_XLOAD
    }
    }
    __syncthreads();
}
__device__ __forceinline__ void phase_moe(const Params& P, const Geo& g, LAS unsigned char* l3, int L, bool dry = false) {
    constexpr int HS = 528, OFF_B1 = 67584, OFF_GT = 67584;
    constexpr int OFF_TOK = 133120, OFF_WLO = OFF_TOK + 512, OFF_WHI = OFF_WLO + 512, OFF_PF = OFF_WHI + 512;
    LAS int* tok = (LAS int*)(l3 + OFF_TOK); LAS float* wlo = (LAS float*)(l3 + OFF_WLO); LAS float* whi = (LAS float*)(l3 + OFF_WHI); LAS int* pf = (LAS int*)(l3 + OFF_PF);
    unsigned char* ws = P.ws;
    const unsigned* cnt = (const unsigned*)(ws + WS_CTL) + CW_CNT + L * 128 * 16;
    const int* list = (const int*)(ws + WS_LIST);
    const float2* tokw = (const float2*)(ws + WS_TOKW);
    const bf16_t* H = (const bf16_t*)P.out;
    const float* gate2 = (const float*)(ws + WS_MOD) + (size_t)L * NB * 6144 + 5120;
    const int w = g.wave;
    LAS int* cn = pf + 128;
    if (g.tid < 128) { const int c = g.tid < NBUCKET ? (int)cnt[g.tid * 16] : 0; int sc = c;
#pragma unroll
        for (int o = 1; o < 64; o <<= 1) { const int nbv = __shfl_up(sc, o); sc += (g.lane >= o) ? nbv : 0; }
        pf[g.tid] = sc - c; if (g.tid == 63) cn[0] = sc; }
    __syncthreads();
    if (g.tid >= 64 && g.tid < 128) pf[g.tid] += cn[0];
    __syncthreads();
    const int rows_per = (T + g.G - 1) / g.G;
    int cur = g.vcu * rows_per; const int end = min(T, cur + rows_per);
    int bucket = 0;
    if (cur < end) {
#pragma unroll
        for (int st = 64; st > 0; st >>= 1) if (bucket + st <= NBUCKET - 1 && pf[bucket + st] <= cur) bucket += st; }
    while (cur < end) {
        int lane = g.lane; asm volatile("" : "+v"(lane));
        while (pf[bucket + 1] <= cur) ++bucket;
        const int off = cur - pf[bucket];
        const int nrows = min(min(128, end - cur), pf[bucket + 1] - cur);
        cur += nrows;
        const int nmt = (nrows + 15) >> 4;
        const int g4 = bucket / 28; int rem = bucket % 28, elo = 0;
        while (rem >= 7 - elo) { rem -= 7 - elo; ++elo; }
        const int ehi = elo + 1 + rem;
        const int e0 = g4 * 8 + elo, e1 = g4 * 8 + ehi;
        if (nmt > 6) moe_pass<8>(P, l3, L, w, lane, bucket, off, nrows, e0, e1, dry); else if (nmt > 4) moe_pass<6>(P, l3, L, w, lane, bucket, off, nrows, e0, e1, dry);
        else if (nmt > 2) moe_pass<4>(P, l3, L, w, lane, bucket, off, nrows, e0, e1, dry); else moe_pass<2>(P, l3, L, w, lane, bucket, off, nrows, e0, e1, dry);
    }
}


#define MFMA16(a, b, c) __builtin_amdgcn_mfma_f32_16x16x32_bf16(a, b, c, 0, 0, 0)
constexpr size_t WS_SLOC = WS_LIST;
constexpr size_t WS_ATOT = WS_TOKE;
constexpr size_t WS_XHALO = WS_TOKW;
template <int PASS>
__device__ __forceinline__ void scan_units(const Params& P, const Geo& g, LAS unsigned char* l3, int L, bool dry) {
    constexpr bool FULL = PASS >= 2;
    constexpr int S128 = 272, S64 = 144, SCB = 272;
    constexpr int O_CC = 0, O_BC = 17408, O_BCT = 34816, O_CB = 53248, O_XST = 70656, O_XPT = 107520;
    constexpr int O_ACS = 144384, O_DTV = O_ACS + 2048, O_SCL = O_DTV + 2048, O_EAL = O_SCL + 2048, O_HALO = O_EAL + 2048;
    const int i2 = L >> 1, lane = g.lane, w = g.wave, tid = g.tid;
    unsigned char* ws = P.ws;
    bf16_t* XS = (bf16_t*)(ws + WS_XS); const float* DT = (const float*)(ws + WS_DT);
    for (int u = g.vcu; u < 256; u += g.G) {
        const int b = u >> 5, gq = (u >> 2) & 7, sc = u & 3;
        const size_t tb = (size_t)b * SEQ + (size_t)sc * 1024;
        const int cp = tid & 255, half = tid >> 8;
        const bool act = FULL || (cp < 192);
        const int ch = cp < 128 ? (4 * gq) * 64 + 2 * cp : (cp < 192 ? 2048 + gq * 128 + 2 * (cp - 128) : 3072 + gq * 128 + 2 * (cp - 192));
        const unsigned colb = cp < 128 ? (unsigned)ch * 2u : (unsigned)(WS_BC - WS_XS) + (unsigned)(ch - 2048) * 2u;
        const unsigned voff = colb + (unsigned)half * 32u * 4096u;
        const int hd0 = 4 * gq;
        const float Ah_s0 = -__expf(P.in[I_ALOG][i2 * SSM_H + hd0 + (w & 3)]);
        float Dk[2]; Dk[0] = P.in[I_SSMD][i2 * SSM_H + hd0 + (w >> 2)]; Dk[1] = P.in[I_SSMD][i2 * SSM_H + hd0 + 2 + (w >> 2)];
        f32x4 S0[8], S1[8];
#pragma unroll
        for (int i = 0; i < 8; ++i) { S0[i] = (f32x4){0.f, 0.f, 0.f, 0.f}; S1[i] = (f32x4){0.f, 0.f, 0.f, 0.f}; }
        if (PASS == 2 && sc > 0) {
            const float* AT = (const float*)(ws + WS_ATOT);
#pragma unroll 1
            for (int j = 0; j < sc; ++j) {
                const int uj = (u >> 2) * 3 + j;
                float f0 = 0.f, f1 = 0.f;
                for (int i = j + 1; i < sc; ++i) { f0 += AT[((u & ~3) | i) * 4 + (w >> 2)]; f1 += AT[((u & ~3) | i) * 4 + 2 + (w >> 2)]; }
                f0 = __expf(f0); f1 = __expf(f1);
                const u32x4* sp0 = (const u32x4*)(ws + WS_SLOC) + (((size_t)uj * 2 + 0) * 8 + w) * 256 + lane * 4;
                const u32x4* sp1 = (const u32x4*)(ws + WS_SLOC) + (((size_t)uj * 2 + 1) * 8 + w) * 256 + lane * 4;
#pragma unroll
                for (int i = 0; i < 4; ++i) { const u32x4 a = sp0[i], c = sp1[i];
#pragma unroll
                    for (int e = 0; e < 4; ++e) { const int nt = 2 * i + (e >> 1), r = 2 * (e & 1);
                        S0[nt][r] += f0 * bf2f(a[e] & 0xffffu); S0[nt][r + 1] += f0 * bf2f(a[e] >> 16);
                        S1[nt][r] += f1 * bf2f(c[e] & 0xffffu); S1[nt][r + 1] += f1 * bf2f(c[e] >> 16); } }
            }
        }
        float atot = 0.f;
        unsigned raw[35]; float dt_pf = 0.f;
        {
            const char* rb = (const char*)XS + (tb - 3) * 4096;
#pragma unroll
            for (int i = 0; i < 35; ++i) raw[i] = act ? *(const unsigned*)(rb + (size_t)i * 4096 + voff) : 0u;
            if (half == 0) {
                if (sc == 0) { raw[0] = 0u; raw[1] = 0u; raw[2] = 0u; }
                else if (FULL && cp < 128) {
#pragma unroll
                    for (int i = 0; i < 3; ++i) raw[i] = ((const unsigned*)(ws + WS_XHALO))[((size_t)(u - 1) * 3 + i) * 128 + cp]; }
            }
            if (w < 4) dt_pf = DT[(tb + lane) * 32 + hd0 + w];
        }
#define SCAN_STEP0(CN) do { if (w < 4) { const int pn_ = (CN) & 1; const float dt = dt_pf; float a = dt * Ah_s0; \
            a = wave_incl_scan(a); const float aend = wave_last(a); \
            ((LAS float*)(l3 + O_ACS))[pn_ * 256 + w * 64 + lane] = a; ((LAS float*)(l3 + O_DTV))[pn_ * 256 + w * 64 + lane] = dt; \
            ((LAS float*)(l3 + O_SCL))[pn_ * 256 + w * 64 + lane] = dt * __expf(aend - a); ((LAS float*)(l3 + O_EAL))[pn_ * 256 + w * 64 + lane] = __expf(a); \
            atot += aend; \
            if ((CN) + 1 < 16) dt_pf = DT[(tb + (size_t)((CN) + 1) * 64 + lane) * 32 + hd0 + w]; } } while (0)
        SCAN_STEP0(0);
        __syncthreads();
#pragma unroll 1
        for (int c = 0; c < 16; ++c) {
            const size_t t0 = tb + (size_t)c * 64;
            const int par = c & 1;
            int lane_o = lane; asm volatile("" : "+v"(lane_o));
            const int j16 = lane_o & 15, q4 = lane_o >> 4;
            LAS float* acs = (LAS float*)(l3 + O_ACS) + par * 256; LAS float* dtv = (LAS float*)(l3 + O_DTV) + par * 256;
            LAS float* scl = (LAS float*)(l3 + O_SCL) + par * 256; LAS float* eal = (LAS float*)(l3 + O_EAL) + par * 256;
            if (act) {
                int cpo = cp; asm volatile("" : "+v"(cpo));
                float cw0[5], cw1[5];
                { const int cho = cpo < 128 ? (4 * gq) * 64 + 2 * cpo : (cpo < 192 ? 2048 + gq * 128 + 2 * (cpo - 128) : 3072 + gq * 128 + 2 * (cpo - 192));
                  const float* cwp = P.in[I_CONVW] + (size_t)i2 * 4 * SSM_CONV + cho;
#pragma unroll
                  for (int tp = 0; tp < 4; ++tp) { const f32x2 t2 = *(const f32x2*)(cwp + tp * SSM_CONV); cw0[tp] = t2.x; cw1[tp] = t2.y; }
                  const f32x2 t2 = *(const f32x2*)(P.in[I_CONVB] + (size_t)i2 * SSM_CONV + cho); cw0[4] = t2.x; cw1[4] = t2.y; }
                if (c > 0 && cpo < 128 && half == 0) {
#pragma unroll
                    for (int i = 0; i < 3; ++i) raw[i] = *(const LAS unsigned*)(l3 + O_HALO + (((c - 1) & 1) * 3 + i) * 512 + cpo * 4); }
                if (cpo < 128 && half == 1) {
#pragma unroll
                    for (int i = 0; i < 3; ++i) *(LAS unsigned*)(l3 + O_HALO + ((c & 1) * 3 + i) * 512 + cpo * 4) = raw[32 + i];
                    if (PASS == 1 && c == 15) {
#pragma unroll
                        for (int i = 0; i < 3; ++i) ((unsigned*)(ws + WS_XHALO))[((size_t)u * 3 + i) * 128 + cpo] = raw[32 + i]; }
                }
                const int hq = cpo >> 5;
#pragma unroll
                for (int j = 0; j < 8; ++j) {
                    const int l0 = 32 * half + 4 * j;
                    float v0[4], v1[4];
#pragma unroll
                    for (int o = 0; o < 4; ++o) { float a0 = cw0[4], a1 = cw1[4];
#pragma unroll
                        for (int tp = 0; tp < 4; ++tp) { a0 += cw0[tp] * bf2f(raw[4 * j + o + tp] & 0xffffu); a1 += cw1[tp] * bf2f(raw[4 * j + o + tp] >> 16); }
                        v0[o] = silu_f(a0); v1[o] = silu_f(a1); }
                    if (cpo < 128) {
                        const int p = 2 * (cpo & 31);
                        if (FULL) { u32x2 x0, x1; x0.x = pk2(v0[0], v0[1]); x0.y = pk2(v0[2], v0[3]); x1.x = pk2(v1[0], v1[1]); x1.y = pk2(v1[2], v1[3]);
                            *(LAS u32x2*)(l3 + O_XST + hq * 9216 + p * S64 + l0 * 2) = x0; *(LAS u32x2*)(l3 + O_XST + hq * 9216 + (p + 1) * S64 + l0 * 2) = x1; }
                        const f32x4 s4 = *(const LAS f32x4*)(scl + hq * 64 + l0);
                        u32x2 y0, y1; y0.x = pk2(v0[0] * s4.x, v0[1] * s4.y); y0.y = pk2(v0[2] * s4.z, v0[3] * s4.w); y1.x = pk2(v1[0] * s4.x, v1[1] * s4.y); y1.y = pk2(v1[2] * s4.z, v1[3] * s4.w);
                        *(LAS u32x2*)(l3 + O_XPT + hq * 9216 + p * S64 + l0 * 2) = y0; *(LAS u32x2*)(l3 + O_XPT + hq * 9216 + (p + 1) * S64 + l0 * 2) = y1;
                    } else if (cpo < 192) {
                        const int n = 2 * (cpo - 128);
                        if (FULL) {
#pragma unroll
                            for (int o = 0; o < 4; ++o) *(LAS unsigned*)(l3 + O_BC + (l0 + o) * S128 + n * 2) = pk2(v0[o], v1[o]); }
                        u32x2 x0, x1; x0.x = pk2(v0[0], v0[1]); x0.y = pk2(v0[2], v0[3]); x1.x = pk2(v1[0], v1[1]); x1.y = pk2(v1[2], v1[3]);
                        *(LAS u32x2*)(l3 + O_BCT + n * S64 + l0 * 2) = x0; *(LAS u32x2*)(l3 + O_BCT + (n + 1) * S64 + l0 * 2) = x1;
                    } else {
                        const int n = 2 * (cpo - 192);
#pragma unroll
                        for (int o = 0; o < 4; ++o) *(LAS unsigned*)(l3 + O_CC + (l0 + o) * S128 + n * 2) = pk2(v0[o], v1[o]);
                    }
                }
            }
            __syncthreads();
            if (PASS == 3) {
                const int r_ = tid >> 3, pc_ = tid & 7;
                const u32x4 c0_ = *(const LAS u32x4*)(l3 + O_CC + r_ * S128 + pc_ * 32), c1_ = *(const LAS u32x4*)(l3 + O_CC + r_ * S128 + pc_ * 32 + 16);
                u32x4* dst_ = (u32x4*)((bf16_t*)P.out + (size_t)T * D + (t0 + r_) * 1024 + gq * 128 + pc_ * 16);
                dst_[0] = c0_; dst_[1] = c1_; }
            if (c + 1 < 16 && act) {
                const char* rb = (const char*)XS + (t0 + 61) * 4096;
#pragma unroll
                for (int i = 0; i < 35; ++i) raw[i] = *(const unsigned*)(rb + (size_t)i * 4096 + voff);
            }
            if (FULL) {
                const int lt = w >> 1;
                bf16x8 cf[4];
#pragma unroll
                for (int ks = 0; ks < 4; ++ks) cf[ks] = *(const LAS bf16x8*)(l3 + O_CC + (16 * lt + j16) * S128 + (32 * ks + 8 * q4) * 2);
#pragma unroll
                for (int si = 0; si < 2; ++si) { const int st = 2 * (w & 1) + si;
                    if (st <= lt) { f32x4 acc = (f32x4){0.f, 0.f, 0.f, 0.f};
#pragma unroll
                        for (int ks = 0; ks < 4; ++ks) { const bf16x8 bfr = *(const LAS bf16x8*)(l3 + O_BC + (16 * st + j16) * S128 + (32 * ks + 8 * q4) * 2); acc = MFMA16(cf[ks], bfr, acc); }
#pragma unroll
                        for (int r = 0; r < 4; ++r) *(LAS float*)(l3 + O_CB + (16 * lt + 4 * q4 + r) * SCB + (16 * st + j16) * 4) = acc[r]; } }
                __syncthreads();
            }
#pragma unroll
            for (int rd = 0; rd < 2; ++rd) {
                const int hq = 2 * rd + (w >> 2), ps = w & 3;
                f32x4 (&S)[8] = rd ? S1 : S0;
                if (FULL) {
                    f32x4 yv[4];
#pragma unroll
                    for (int lt = 0; lt < 4; ++lt) yv[lt] = (f32x4){0.f, 0.f, 0.f, 0.f};
#pragma unroll
                    for (int t = 0; t < 4; ++t) { u32x4 a4; a4.x = pk2(S[2 * t][0], S[2 * t][1]); a4.y = pk2(S[2 * t][2], S[2 * t][3]); a4.z = pk2(S[2 * t + 1][0], S[2 * t + 1][1]); a4.w = pk2(S[2 * t + 1][2], S[2 * t + 1][3]);
                        const bf16x8 af = __builtin_bit_cast(bf16x8, a4);
#pragma unroll
                        for (int lt = 0; lt < 4; ++lt) { const LAS unsigned char* cpz = l3 + O_CC + (16 * lt + j16) * S128 + (32 * t + 4 * q4) * 2;
                            const u32x2 lo = *(const LAS u32x2*)cpz, hi = *(const LAS u32x2*)(cpz + 32);
                            u32x4 b4; b4.x = lo.x; b4.y = lo.y; b4.z = hi.x; b4.w = hi.y;
                            yv[lt] = MFMA16(af, __builtin_bit_cast(bf16x8, b4), yv[lt]); } }
#pragma unroll
                    for (int lt = 0; lt < 4; ++lt) yv[lt] = yv[lt] * eal[hq * 64 + 16 * lt + j16];
                    bf16x8 xf[2];
#pragma unroll
                    for (int ks = 0; ks < 2; ++ks) xf[ks] = *(const LAS bf16x8*)(l3 + O_XST + hq * 9216 + (16 * ps + j16) * S64 + (32 * ks + 8 * q4) * 2);
#pragma unroll
                    for (int lt = 0; lt < 4; ++lt) { const int l = 16 * lt + j16; const float al = acs[hq * 64 + l];
#pragma unroll
                        for (int ks = 0; ks < 2; ++ks) { if (32 * ks <= 16 * lt + 15) {
                                const int s0 = 32 * ks + 8 * q4;
                                const f32x4 c0 = *(const LAS f32x4*)(l3 + O_CB + l * SCB + s0 * 4), c1 = *(const LAS f32x4*)(l3 + O_CB + l * SCB + s0 * 4 + 16);
                                const f32x4 a0 = *(const LAS f32x4*)(acs + hq * 64 + s0), a1 = *(const LAS f32x4*)(acs + hq * 64 + s0 + 4);
                                const f32x4 d0 = *(const LAS f32x4*)(dtv + hq * 64 + s0), d1 = *(const LAS f32x4*)(dtv + hq * 64 + s0 + 4);
                                float m[8];
#pragma unroll
                                for (int e = 0; e < 4; ++e) { m[e] = (s0 + e <= l) ? c0[e] * __expf(al - a0[e]) * d0[e] : 0.f; m[4 + e] = (s0 + 4 + e <= l) ? c1[e] * __expf(al - a1[e]) * d1[e] : 0.f; }
                                u32x4 b4; b4.x = pk2(m[0], m[1]); b4.y = pk2(m[2], m[3]); b4.z = pk2(m[4], m[5]); b4.w = pk2(m[6], m[7]);
                                yv[lt] = MFMA16(xf[ks], __builtin_bit_cast(bf16x8, b4), yv[lt]); } }
                        __builtin_amdgcn_sched_barrier(0); }
                    u32x2 yo[4];
#pragma unroll
                    for (int lt = 0; lt < 4; ++lt) { const int l = 16 * lt + j16;
                        float xv[4];
#pragma unroll
                        for (int r = 0; r < 4; ++r) xv[r] = bf2f(*(const LAS bf16_t*)(l3 + O_XST + hq * 9216 + (16 * ps + 4 * q4 + r) * S64 + l * 2));
                        yo[lt].x = pk2(yv[lt][0] + Dk[rd] * xv[0], yv[lt][1] + Dk[rd] * xv[1]); yo[lt].y = pk2(yv[lt][2] + Dk[rd] * xv[2], yv[lt][3] + Dk[rd] * xv[3]); }
#pragma unroll
                    for (int lp = 0; lp < 4; lp += 2) {
                        const auto sx = __builtin_amdgcn_permlane16_swap(yo[lp].x, yo[lp + 1].x, false, false), sy = __builtin_amdgcn_permlane16_swap(yo[lp].y, yo[lp + 1].y, false, false);
                        u32x4 w4; w4.x = sx[0]; w4.y = sy[0]; w4.z = sx[1]; w4.w = sy[1];
                        const size_t yoff = (t0 + 16 * (lp + (q4 & 1)) + j16) * 2048 + (size_t)(hd0 + hq) * 64 + 16 * ps + 8 * (q4 >> 1);
                        bf16_t* yp = dry ? (bf16_t*)(ws + WS_LIST + 12 * MiB) + (yoff & (size_t)(512 * 1024 - 1)) : XS + yoff;
                        *(u32x4*)yp = w4; }
                }
                { const float dec = eal[hq * 64 + 63];
                  bf16x8 xp[2];
#pragma unroll
                  for (int ks = 0; ks < 2; ++ks) xp[ks] = *(const LAS bf16x8*)(l3 + O_XPT + hq * 9216 + (16 * ps + j16) * S64 + (32 * ks + 8 * q4) * 2);
#pragma unroll
                  for (int nt = 0; nt < 8; ++nt) { f32x4 acc = S[nt] * dec;
#pragma unroll
                      for (int ks = 0; ks < 2; ++ks) { const bf16x8 bt = *(const LAS bf16x8*)(l3 + O_BCT + (16 * nt + j16) * S64 + (32 * ks + 8 * q4) * 2); acc = MFMA16(bt, xp[ks], acc); }
                      S[nt] = acc; } }
            }
            if (c + 1 < 16) SCAN_STEP0(c + 1);
            __syncthreads();
        }
#undef SCAN_STEP0
        if (PASS == 1 || PASS == 3) {
            if (w < 4 && lane == 0) ((float*)(ws + WS_ATOT))[u * 4 + w] = atot;
            const int us = (u >> 2) * 3 + (sc < 3 ? sc : 0);
            u32x4* sp0 = (u32x4*)(ws + WS_SLOC) + (((size_t)us * 2 + 0) * 8 + w) * 256 + lane * 4;
            u32x4* sp1 = (u32x4*)(ws + WS_SLOC) + (((size_t)us * 2 + 1) * 8 + w) * 256 + lane * 4;
            if (sc < 3)
#pragma unroll
            for (int i = 0; i < 4; ++i) { u32x4 a, c;
#pragma unroll
                for (int e = 0; e < 4; ++e) { const int nt = 2 * i + (e >> 1), r = 2 * (e & 1); a[e] = pk2(S0[nt][r], S0[nt][r + 1]); c[e] = pk2(S1[nt][r], S1[nt][r + 1]); }
                sp0[i] = a; sp1[i] = c; }
        }
    }
}

__device__ __forceinline__ void scan_fix(const Params& P, const Geo& g, LAS unsigned char* l3, int L) {
    constexpr int S128 = 272, O_CC = 0, CCB = 17408, O_ECL = 2 * CCB;
    const int i2 = L >> 1, w = g.wave; int tid = g.tid; asm volatile("" : "+v"(tid));
    unsigned char* ws = P.ws;
    bf16_t* XS = (bf16_t*)(ws + WS_XS); const float* DT = (const float*)(ws + WS_DT);
    const bf16_t* CCV = (const bf16_t*)P.out + (size_t)T * D;
    const int NITEM = NB * 8 * 3 * 16, per = (NITEM + g.G - 1) / g.G;
    const int gc0 = g.vcu * per, gc1 = min(NITEM, gc0 + per);
    int cur_uu = -1, gq = 0, hd0 = 0; size_t tb = 0; float Ah_s0 = 0.f, atot = 0.f;
    bf16x8 af[2][4];
    u32x4 cr0, cr1; float dt_pf = 0.f;
#define FIX_GEO(GC, TB_, GQ_) const int uu_ = (GC) >> 4, bg_ = uu_ / 3, sc_ = 1 + uu_ % 3; const int GQ_ = bg_ & 7; const size_t TB_ = (size_t)(bg_ >> 3) * SEQ + (size_t)sc_ * 1024 + (size_t)((GC) & 15) * 64;
    if (gc0 < gc1) { FIX_GEO(gc0, t0n, gqn)
        const u32x4* src = (const u32x4*)(CCV + (t0n + (tid >> 3)) * 1024 + gqn * 128 + (tid & 7) * 16); cr0 = src[0]; cr1 = src[1];
        if (w < 4) dt_pf = DT[(t0n + (tid & 63)) * 32 + 4 * gqn + w]; }
    for (int gc = gc0; gc < gc1; ++gc) {
        int lane = tid & 63; asm volatile("" : "+v"(lane));
        const int j16 = lane & 15, q4 = lane >> 4, par = gc & 1;
        const int uu = gc >> 4, c = gc & 15;
        if (uu != cur_uu) {
            cur_uu = uu;
            const int bg = uu / 3, sc = 1 + uu % 3, u = bg * 4 + sc; gq = bg & 7; hd0 = 4 * gq; tb = (size_t)(bg >> 3) * SEQ + (size_t)sc * 1024;
            Ah_s0 = -__expf(P.in[I_ALOG][i2 * SSM_H + hd0 + (w & 3)]);
            f32x4 S0[8], S1[8];
#pragma unroll
            for (int i = 0; i < 8; ++i) { S0[i] = (f32x4){0.f, 0.f, 0.f, 0.f}; S1[i] = (f32x4){0.f, 0.f, 0.f, 0.f}; }
            const float* AT = (const float*)(ws + WS_ATOT);
#pragma unroll 1
            for (int j = 0; j < sc; ++j) {
                const int uj = (u >> 2) * 3 + j;
                float f0 = 0.f, f1 = 0.f;
                for (int i = j + 1; i < sc; ++i) { f0 += AT[((u & ~3) | i) * 4 + (w >> 2)]; f1 += AT[((u & ~3) | i) * 4 + 2 + (w >> 2)]; }
                f0 = __expf(f0); f1 = __expf(f1);
                const u32x4* sp0 = (const u32x4*)(ws + WS_SLOC) + (((size_t)uj * 2 + 0) * 8 + w) * 256 + lane * 4;
                const u32x4* sp1 = (const u32x4*)(ws + WS_SLOC) + (((size_t)uj * 2 + 1) * 8 + w) * 256 + lane * 4;
#pragma unroll
                for (int i = 0; i < 4; ++i) { const u32x4 a = sp0[i], cc = sp1[i];
#pragma unroll
                    for (int e = 0; e < 4; ++e) { const int nt = 2 * i + (e >> 1), r = 2 * (e & 1);
                        S0[nt][r] += f0 * bf2f(a[e] & 0xffffu); S0[nt][r + 1] += f0 * bf2f(a[e] >> 16);
                        S1[nt][r] += f1 * bf2f(cc[e] & 0xffffu); S1[nt][r + 1] += f1 * bf2f(cc[e] >> 16); } }
            }
#pragma unroll
            for (int t = 0; t < 4; ++t) { u32x4 a4;
                a4.x = pk2(S0[2 * t][0], S0[2 * t][1]); a4.y = pk2(S0[2 * t][2], S0[2 * t][3]); a4.z = pk2(S0[2 * t + 1][0], S0[2 * t + 1][1]); a4.w = pk2(S0[2 * t + 1][2], S0[2 * t + 1][3]);
                af[0][t] = __builtin_bit_cast(bf16x8, a4);
                a4.x = pk2(S1[2 * t][0], S1[2 * t][1]); a4.y = pk2(S1[2 * t][2], S1[2 * t][3]); a4.z = pk2(S1[2 * t + 1][0], S1[2 * t + 1][1]); a4.w = pk2(S1[2 * t + 1][2], S1[2 * t + 1][3]);
                af[1][t] = __builtin_bit_cast(bf16x8, a4); }
            atot = 0.f;
            if (w < 4) { float sdt = 0.f;
                for (int j = 0; j < c; ++j) sdt += DT[(tb + (size_t)j * 64 + lane) * 32 + hd0 + w];
                atot = wave_sum(sdt) * Ah_s0; }
        }
        const size_t t0 = tb + (size_t)c * 64;
        LAS float* ecl = (LAS float*)(l3 + O_ECL) + par * 256;
        *(LAS u32x4*)(l3 + O_CC + par * CCB + (tid >> 3) * S128 + (tid & 7) * 32) = cr0; *(LAS u32x4*)(l3 + O_CC + par * CCB + (tid >> 3) * S128 + (tid & 7) * 32 + 16) = cr1;
        if (w < 4) { float a = dt_pf * Ah_s0;
            a = wave_incl_scan(a);
            ecl[w * 64 + lane] = __expf(atot + a);
            atot += wave_last(a); }
        __syncthreads();
        if (gc + 1 < gc1) { FIX_GEO(gc + 1, t0n, gqn)
            const u32x4* src = (const u32x4*)(CCV + (t0n + (tid >> 3)) * 1024 + gqn * 128 + (tid & 7) * 16); cr0 = src[0]; cr1 = src[1];
            if (w < 4) dt_pf = DT[(t0n + lane) * 32 + 4 * gqn + w]; }
        u32x4 yin[2][2];
#pragma unroll
        for (int rd = 0; rd < 2; ++rd)
#pragma unroll
            for (int lp = 0; lp < 2; ++lp) yin[rd][lp] = *(const u32x4*)(XS + (t0 + 16 * (2 * lp + (q4 & 1)) + j16) * 2048 + (size_t)(hd0 + 2 * rd + (w >> 2)) * 64 + 16 * (w & 3) + 8 * (q4 >> 1));
#pragma unroll
        for (int rd = 0; rd < 2; ++rd) {
            const int hq = 2 * rd + (w >> 2), ps = w & 3;
            f32x4 yv[4];
#pragma unroll
            for (int lt = 0; lt < 4; ++lt) yv[lt] = (f32x4){0.f, 0.f, 0.f, 0.f};
#pragma unroll
            for (int t = 0; t < 4; ++t)
#pragma unroll
                for (int lt = 0; lt < 4; ++lt) { const LAS unsigned char* cpz = l3 + O_CC + par * CCB + (16 * lt + j16) * S128 + (32 * t + 4 * q4) * 2;
                    const u32x2 lo = *(const LAS u32x2*)cpz, hi = *(const LAS u32x2*)(cpz + 32);
                    u32x4 b4; b4.x = lo.x; b4.y = lo.y; b4.z = hi.x; b4.w = hi.y;
                    yv[lt] = MFMA16(af[rd][t], __builtin_bit_cast(bf16x8, b4), yv[lt]); }
#pragma unroll
            for (int lp = 0; lp < 4; lp += 2) {
                const u32x4 L4 = yin[rd][lp >> 1];
                const auto ax = __builtin_amdgcn_permlane16_swap(L4.x, L4.z, false, false), ay = __builtin_amdgcn_permlane16_swap(L4.y, L4.w, false, false);
                u32x2 o[2];
#pragma unroll
                for (int i = 0; i < 2; ++i) { const int lt = lp + i; const float sc_l = ecl[hq * 64 + 16 * lt + j16]; const unsigned yx = ax[i], yy = ay[i];
                    o[i].x = pk2(bf2f(yx & 0xffffu) + sc_l * yv[lt][0], bf2f(yx >> 16) + sc_l * yv[lt][1]); o[i].y = pk2(bf2f(yy & 0xffffu) + sc_l * yv[lt][2], bf2f(yy >> 16) + sc_l * yv[lt][3]); }
                const auto sx = __builtin_amdgcn_permlane16_swap(o[0].x, o[1].x, false, false), sy = __builtin_amdgcn_permlane16_swap(o[0].y, o[1].y, false, false);
                u32x4 w4; w4.x = sx[0]; w4.y = sy[0]; w4.z = sx[1]; w4.w = sy[1];
                *(u32x4*)(XS + (t0 + 16 * (lp + (q4 & 1)) + j16) * 2048 + (size_t)(hd0 + hq) * 64 + 16 * ps + 8 * (q4 >> 1)) = w4; }
        }
    }
#undef FIX_GEO
}

__device__ __forceinline__ void phase_scan(const Params& P, const Geo& g, LAS unsigned char* l3, int L, bool dry = false) {
    constexpr int S128 = 272, S64 = 144;
    constexpr int O_CC = 0, O_BC = 17408, O_BCT = 34816, O_XST = 53248, O_XPT = 62464, O_MM = 71680, O_SBF = 80896;
    constexpr int O_ACS = 98304, O_DTV = 98560, O_CW = 98816, O_HALO = 105216;
    LAS float* acs = (LAS float*)(l3 + O_ACS); LAS float* dtv = (LAS float*)(l3 + O_DTV);
    LAS f32x2* cwl = (LAS f32x2*)(l3 + O_CW);
    const int i2 = L >> 1, lane = g.lane, w = g.wave, tid = g.tid, j16 = lane & 15, q4 = lane >> 4;
    unsigned char* ws = P.ws;
    bf16_t* XS = (bf16_t*)(ws + WS_XS); const bf16_t* BC = (const bf16_t*)(ws + WS_BC); const float* DT = (const float*)(ws + WS_DT);
    for (int u = g.vcu; u < NB * SSM_H; u += g.G) {
        const int b = u / SSM_H, hd = u % SSM_H, gq = hd >> 2;
        const float Ah = -__expf(P.in[I_ALOG][i2 * SSM_H + hd]), Dk = P.in[I_SSMD][i2 * SSM_H + hd];
        const size_t tb = (size_t)b * SEQ;
        if (tid < 160) { const int cp = tid; const int ch = cp < 32 ? hd * 64 + 2 * cp : (cp < 96 ? 2048 + gq * 128 + 2 * (cp - 32) : 3072 + gq * 128 + 2 * (cp - 96));
            const float* cw = P.in[I_CONVW] + (size_t)i2 * 4 * SSM_CONV + ch;
#pragma unroll
            for (int tp = 0; tp < 4; ++tp) cwl[tp * 160 + cp] = (f32x2){cw[tp * SSM_CONV], cw[tp * SSM_CONV + 1]};
            const float* cb = P.in[I_CONVB] + (size_t)i2 * SSM_CONV + ch; cwl[4 * 160 + cp] = (f32x2){cb[0], cb[1]}; }
        for (int e = tid; e < 17408 / 4; e += 512) ((LAS unsigned*)(l3 + O_SBF))[e] = 0u;
        f32x4 S[4];
#pragma unroll
        for (int i = 0; i < 4; ++i) S[i] = (f32x4){0.f, 0.f, 0.f, 0.f};
        unsigned raw[5][7], voff[5]; float dt_pf = 0.f;
        if (w == 0) dt_pf = DT[(tb + lane) * 32 + hd];
#pragma unroll
        for (int k = 0; k < 5; ++k) {
            const int it = tid + 512 * k, cp = it % 160, strip = it / 160, l0 = 4 * strip;
            const unsigned colb = cp < 32 ? (unsigned)(hd * 64 + 2 * cp) * 2u : (unsigned)(WS_BC - WS_XS) + (unsigned)(cp < 96 ? gq * 128 + 2 * (cp - 32) : 1024 + gq * 128 + 2 * (cp - 96)) * 2u;
            voff[k] = (unsigned)l0 * 4096u + colb;
#pragma unroll
            for (int i = 0; i < 7; ++i) { const int rl = l0 - 3 + i; raw[k][i] = (rl >= 0) ? *(const unsigned*)((const char*)XS + (tb + rl) * 4096 + colb) : 0u; }
        }
        __syncthreads();
#pragma unroll 1
        for (int c = 0; c < NCH; ++c) {
            const size_t t0 = tb + (size_t)c * 64;
            if (w == 0) { const float dt = dt_pf; float a = dt * Ah;
#pragma unroll
                for (int o = 1; o < 64; o <<= 1) { const float nbv = __shfl_up(a, o); a += (lane >= o) ? nbv : 0.f; }
                acs[lane] = a; dtv[lane] = dt; }
            __syncthreads();
            const float aend = acs[63];
            int tA = tid; asm volatile("" : "+v"(tA));
#pragma unroll
            for (int k = 0; k < 5; ++k) {
                const int it = tA + 512 * k, cp = it % 160, strip = it / 160, l0 = 4 * strip;
                if (c > 0 && cp < 32 && strip == 0) {
#pragma unroll
                    for (int i = 0; i < 3; ++i) raw[k][i] = *(const LAS unsigned*)(l3 + O_HALO + (((c - 1) & 1) * 3 + i) * 128 + cp * 4); }
                if (cp < 32 && strip == 15) {
#pragma unroll
                    for (int i = 0; i < 3; ++i) *(LAS unsigned*)(l3 + O_HALO + ((c & 1) * 3 + i) * 128 + cp * 4) = raw[k][4 + i]; }
                float wx[5], wy[5];
#pragma unroll
                for (int tp = 0; tp < 5; ++tp) { const f32x2 ww = cwl[tp * 160 + cp]; wx[tp] = ww.x; wy[tp] = ww.y; }
                float v0[4], v1[4];
#pragma unroll
                for (int o = 0; o < 4; ++o) { float a0 = wx[4], a1 = wy[4];
#pragma unroll
                    for (int tp = 0; tp < 4; ++tp) { a0 += wx[tp] * bf2f(raw[k][o + tp] & 0xffffu); a1 += wy[tp] * bf2f(raw[k][o + tp] >> 16); }
                    v0[o] = silu_f(a0); v1[o] = silu_f(a1); }
                if (cp < 32) {
                    const int p = 2 * cp;
                    u32x2 x0, x1; x0.x = pk2(v0[0], v0[1]); x0.y = pk2(v0[2], v0[3]); x1.x = pk2(v1[0], v1[1]); x1.y = pk2(v1[2], v1[3]);
                    *(LAS u32x2*)(l3 + O_XST + p * S64 + l0 * 2) = x0; *(LAS u32x2*)(l3 + O_XST + (p + 1) * S64 + l0 * 2) = x1;
                    float sc[4];
#pragma unroll
                    for (int o = 0; o < 4; ++o) sc[o] = dtv[l0 + o] * __expf(aend - acs[l0 + o]);
                    x0.x = pk2(v0[0] * sc[0], v0[1] * sc[1]); x0.y = pk2(v0[2] * sc[2], v0[3] * sc[3]); x1.x = pk2(v1[0] * sc[0], v1[1] * sc[1]); x1.y = pk2(v1[2] * sc[2], v1[3] * sc[3]);
                    *(LAS u32x2*)(l3 + O_XPT + p * S64 + l0 * 2) = x0; *(LAS u32x2*)(l3 + O_XPT + (p + 1) * S64 + l0 * 2) = x1;
                } else if (cp < 96) {
                    const int n = 2 * (cp - 32);
#pragma unroll
                    for (int o = 0; o < 4; ++o) *(LAS unsigned*)(l3 + O_BC + (l0 + o) * S128 + n * 2) = pk2(v0[o], v1[o]);
                    u32x2 x0, x1; x0.x = pk2(v0[0], v0[1]); x0.y = pk2(v0[2], v0[3]); x1.x = pk2(v1[0], v1[1]); x1.y = pk2(v1[2], v1[3]);
                    *(LAS u32x2*)(l3 + O_BCT + n * S64 + l0 * 2) = x0; *(LAS u32x2*)(l3 + O_BCT + (n + 1) * S64 + l0 * 2) = x1;
                } else {
                    const int n = 2 * (cp - 96);
#pragma unroll
                    for (int o = 0; o < 4; ++o) *(LAS unsigned*)(l3 + O_CC + (l0 + o) * S128 + n * 2) = pk2(v0[o], v1[o]);
                }
            }
            __syncthreads();
            if (c + 1 < NCH) {
                if (w == 0) dt_pf = DT[(t0 + 64 + lane) * 32 + hd];
                const char* rb = (const char*)XS + (t0 + 61) * 4096;
#pragma unroll
                for (int i = 0; i < 7; ++i)
#pragma unroll
                    for (int k = 0; k < 5; ++k) raw[k][i] = *(const unsigned*)(rb + (size_t)i * 4096 + voff[k]);
            }
            const int lt = w >> 1, h2 = w & 1;
            f32x4 yo[2];
            {
                bf16x8 cf[4];
#pragma unroll
                for (int ks = 0; ks < 4; ++ks) cf[ks] = *(const LAS bf16x8*)(l3 + O_CC + (16 * lt + j16) * S128 + (32 * ks + 8 * q4) * 2);
#pragma unroll
                for (int si = 0; si < 2; ++si) { const int st = 2 * h2 + si;
                    f32x4 acc = (f32x4){0.f, 0.f, 0.f, 0.f};
                    if (st <= lt) {
#pragma unroll
                        for (int ks = 0; ks < 4; ++ks) { const bf16x8 bfr = *(const LAS bf16x8*)(l3 + O_BC + (16 * st + j16) * S128 + (32 * ks + 8 * q4) * 2); acc = MFMA16(cf[ks], bfr, acc); } }
                    const int sidx = 16 * st + j16; const float as = acs[sidx], ds = dtv[sidx];
#pragma unroll
                    for (int r = 0; r < 4; ++r) { const int l = 16 * lt + 4 * q4 + r;
                        const float m = (sidx <= l) ? acc[r] * __expf(acs[l] - as) * ds : 0.f;
                        *(LAS bf16_t*)(l3 + O_MM + l * S64 + sidx * 2) = (bf16_t)f2bf(m); } }
#pragma unroll
                for (int pi = 0; pi < 2; ++pi) { const int pt = 2 * h2 + pi; f32x4 acc = (f32x4){0.f, 0.f, 0.f, 0.f};
#pragma unroll
                    for (int ks = 0; ks < 4; ++ks) { const bf16x8 sf = *(const LAS bf16x8*)(l3 + O_SBF + (16 * pt + j16) * S128 + (32 * ks + 8 * q4) * 2); acc = MFMA16(cf[ks], sf, acc); }
                    yo[pi] = acc; }
            }
            {
                const float dec = __expf(aend);
                bf16x8 xf[2];
#pragma unroll
                for (int ks = 0; ks < 2; ++ks) xf[ks] = *(const LAS bf16x8*)(l3 + O_XPT + (16 * lt + j16) * S64 + (32 * ks + 8 * q4) * 2);
#pragma unroll
                for (int ni = 0; ni < 4; ++ni) { const int nt = 4 * h2 + ni; f32x4 acc = S[ni] * dec;
#pragma unroll
                    for (int ks = 0; ks < 2; ++ks) { const bf16x8 bt = *(const LAS bf16x8*)(l3 + O_BCT + (16 * nt + j16) * S64 + (32 * ks + 8 * q4) * 2); acc = MFMA16(xf[ks], bt, acc); }
                    S[ni] = acc; }
            }
            __syncthreads();
            {
                bf16x8 mf[2];
#pragma unroll
                for (int ks = 0; ks < 2; ++ks) mf[ks] = *(const LAS bf16x8*)(l3 + O_MM + (16 * lt + j16) * S64 + (32 * ks + 8 * q4) * 2);
#pragma unroll
                for (int pi = 0; pi < 2; ++pi) { const int pt = 2 * h2 + pi, p = 16 * pt + j16; f32x4 acc = (f32x4){0.f, 0.f, 0.f, 0.f};
#pragma unroll
                    for (int ks = 0; ks < 2; ++ks) { const bf16x8 xt = *(const LAS bf16x8*)(l3 + O_XST + (16 * pt + j16) * S64 + (32 * ks + 8 * q4) * 2); acc = MFMA16(mf[ks], xt, acc); }
                    const u32x2 xv = *(const LAS u32x2*)(l3 + O_XST + p * S64 + (16 * lt + 4 * q4) * 2);
                    const float xs0 = bf2f(xv.x & 0xffffu), xs1 = bf2f(xv.x >> 16), xs2 = bf2f(xv.y & 0xffffu), xs3 = bf2f(xv.y >> 16);
                    const int lb = 16 * lt + 4 * q4;
                    const size_t yoff = (t0 + lb) * 2048 + hd * 64 + p;
                    bf16_t* yp = dry ? (bf16_t*)(ws + WS_LIST) + (yoff & (size_t)(4 * 1024 * 1024 - 1)) : XS + yoff;
                    yp[0] = (bf16_t)f2bf(acc[0] + __expf(acs[lb]) * yo[pi][0] + Dk * xs0);
                    yp[2048] = (bf16_t)f2bf(acc[1] + __expf(acs[lb + 1]) * yo[pi][1] + Dk * xs1);
                    yp[4096] = (bf16_t)f2bf(acc[2] + __expf(acs[lb + 2]) * yo[pi][2] + Dk * xs2);
                    yp[6144] = (bf16_t)f2bf(acc[3] + __expf(acs[lb + 3]) * yo[pi][3] + Dk * xs3); }
#pragma unroll
                for (int ni = 0; ni < 4; ++ni) { const int n = 16 * (4 * h2 + ni) + j16;
#pragma unroll
                    for (int r = 0; r < 4; ++r) *(LAS bf16_t*)(l3 + O_SBF + (16 * lt + 4 * q4 + r) * S128 + n * 2) = (bf16_t)f2bf(S[ni][r]); }
            }
            __syncthreads();
        }
    }
}


typedef float f32x16 __attribute__((ext_vector_type(16)));
#define MFMA32(a, b, c) __builtin_amdgcn_mfma_f32_32x32x16_bf16(a, b, c, 0, 0, 0)
__device__ __forceinline__ void phase_e2(const Params& P, const Geo& g, LAS unsigned char* l3, int L) {
    const int i2 = L >> 1, lane = g.lane, w = g.wave, tid = g.tid, j16 = lane & 15, q4 = lane >> 4;
    unsigned char* ws = P.ws;
    const bf16_t* U = (const bf16_t*)(ws + WS_U); bf16_t* CAT = (bf16_t*)(ws + WS_CAT);
    {
        constexpr int O_UT = 0, O_PL = 20480, PS = 272;
        u32x4 pre[3];
#define POOL_FETCH(UU) do { const int gi_ = (UU) & 3, t0_ = ((UU) >> 2) * 64, s0_ = t0_ % SEQ; \
            _Pragma("unroll") for (int i = 0; i < 3; ++i) { const int e = tid + 512 * i, r = e >> 4, c16 = e & 15; pre[i] = (u32x4){0u, 0u, 0u, 0u}; \
                if (e < 79 * 16 && s0_ - 15 + r >= 0) pre[i] = *(const u32x4*)(U + (size_t)(t0_ - 15 + r) * 512 + gi_ * 128 + c16 * 8); } } while (0)
        if (g.vcu < (T / 64) * 4) POOL_FETCH(g.vcu);
        for (int u = g.vcu; u < (T / 64) * 4; u += g.G) {
            const int gi = u & 3, t0 = (u >> 2) * 64, s0 = t0 % SEQ, win = 2 << gi;
#pragma unroll
            for (int i = 0; i < 3; ++i) { const int e = tid + 512 * i, r = e >> 4, c16 = e & 15; if (e < 79 * 16) *(LAS u32x4*)(l3 + O_UT + r * 256 + c16 * 16) = pre[i]; }
            const bf16_t* Wb = (const bf16_t*)(ws + WS_WPL) + ((size_t)(i2 * 4 + gi) * 128 + 16 * w + j16) * 128 + 8 * q4;
            bf16x8 bwp[4];
#pragma unroll
            for (int ks = 0; ks < 4; ++ks) bwp[ks] = *(const bf16x8*)(Wb + 32 * ks);
            const f32x4 ps = *(const f32x4*)(P.in[I_POOLS] + i2 * 512 + gi * 128 + 16 * w + 4 * q4);
            __syncthreads();
            if (u + g.G < (T / 64) * 4) POOL_FETCH(u + g.G);
            { const int l = tid >> 3, cb = (tid & 7) * 16, s = s0 + l; const int cnt = (s + 1 < win) ? s + 1 : win;
                float acc[16];
#pragma unroll
                for (int i = 0; i < 16; ++i) acc[i] = 0.f;
                for (int j = 0; j < cnt; ++j) {
                    const u32x4 a = *(const LAS u32x4*)(l3 + O_UT + (l + 15 - j) * 256 + cb * 2), b = *(const LAS u32x4*)(l3 + O_UT + (l + 15 - j) * 256 + cb * 2 + 16);
#pragma unroll
                    for (int i = 0; i < 4; ++i) { acc[2 * i] += bf2f(a[i] & 0xffffu); acc[2 * i + 1] += bf2f(a[i] >> 16); acc[8 + 2 * i] += bf2f(b[i] & 0xffffu); acc[8 + 2 * i + 1] += bf2f(b[i] >> 16); }
                }
                const u32x4 a = *(const LAS u32x4*)(l3 + O_UT + (l + 15) * 256 + cb * 2), b = *(const LAS u32x4*)(l3 + O_UT + (l + 15) * 256 + cb * 2 + 16);
                const float inv = 1.f / (float)cnt;
                u32x4 o0, o1;
#pragma unroll
                for (int i = 0; i < 4; ++i) {
                    o0[i] = pk2(acc[2 * i] * inv - bf2f(a[i] & 0xffffu), acc[2 * i + 1] * inv - bf2f(a[i] >> 16));
                    o1[i] = pk2(acc[8 + 2 * i] * inv - bf2f(b[i] & 0xffffu), acc[8 + 2 * i + 1] * inv - bf2f(b[i] >> 16)); }
                *(LAS u32x4*)(l3 + O_PL + l * PS + cb * 2) = o0; *(LAS u32x4*)(l3 + O_PL + l * PS + cb * 2 + 16) = o1; }
            __syncthreads();
            {
                f32x4 acc[4];
#pragma unroll
                for (int lt = 0; lt < 4; ++lt) acc[lt] = (f32x4){0.f, 0.f, 0.f, 0.f};
#pragma unroll
                for (int ks = 0; ks < 4; ++ks) { const bf16x8 bw = bwp[ks];
#pragma unroll
                    for (int lt = 0; lt < 4; ++lt) { const bf16x8 a = *(const LAS bf16x8*)(l3 + O_PL + (16 * lt + j16) * PS + (32 * ks + 8 * q4) * 2); acc[lt] = MFMA16(bw, a, acc[lt]); } }
#pragma unroll
                for (int lt = 0; lt < 4; ++lt) { const f32x4 v = acc[lt] * ps; u32x2 o; o.x = pk2(v[0], v[1]); o.y = pk2(v[2], v[3]);
                    *(u32x2*)(CAT + (size_t)(t0 + 16 * lt + j16) * D + gi * 128 + 16 * w + 4 * q4) = o; }
            }
        }
#undef POOL_FETCH
        __syncthreads();
    }
    {
        constexpr int O_TB = 0, O_RING = 20480;
        for (int e = tid; e < 8 * 640; e += 512) { const int h = e / 640, i = e % 640; int rel = 575 - i; rel = rel > 256 ? 256 : rel; rel = rel < -256 ? -256 : rel;
            ((LAS float*)(l3 + O_TB))[e] = P.in[I_RELB][((size_t)i2 * NHEAD + h) * 513 + rel + 256] * LOG2E; }
        __syncthreads();
        const bf16_t* Qb = (const bf16_t*)(ws + WS_Q); const unsigned char* Kb = ws + WS_K; const unsigned char* VT = ws + WS_VT;
        const int l31 = lane & 31, hh = lane >> 5;
        for (int u8 = g.vcu; u8 < NB * NHEAD * 8; u8 += g.G) {
            const int cg = u8 & 7, h = (u8 >> 3) & 7, b = u8 >> 6;
            const int c0 = 8 * cg, c = c0 + w;
            const size_t tq0 = (size_t)b * SEQ + (size_t)c * 64;
            const size_t bhb = (((size_t)b * NHEAD + h) * 128) * 4096 + (size_t)tid * 16;
            if (cg > 0) {
#pragma unroll 2
                for (int j = 0; j < 8; ++j) { const size_t o = bhb + (size_t)(c0 - 8 + j) * 8192;
                    const u32x4 kv = *(const u32x4*)(Kb + o), vv = *(const u32x4*)(VT + o);
                    *(LAS u32x4*)(l3 + O_RING + j * 16384 + tid * 16) = kv; *(LAS u32x4*)(l3 + O_RING + j * 16384 + 8192 + tid * 16) = vv; }
            }
            bf16x8 qf[2][4];
#pragma unroll
            for (int qt = 0; qt < 2; ++qt)
#pragma unroll
                for (int ks = 0; ks < 4; ++ks) qf[qt][ks] = *(const bf16x8*)(Qb + (tq0 + 32 * qt + l31) * 512 + h * 64 + 16 * ks + 8 * hh);
            f32x16 ot[2][2];
#pragma unroll
            for (int dt = 0; dt < 2; ++dt)
#pragma unroll
                for (int qt = 0; qt < 2; ++qt)
#pragma unroll
                    for (int r = 0; r < 16; ++r) ot[dt][qt][r] = 0.f;
            float mrow[2] = {-1.0e30f, -1.0e30f}, lrow[2] = {0.f, 0.f};
            __syncthreads();
#define ATT_STEP(CJ, KT) do { \
                const LAS unsigned char* sb_ = l3 + O_RING + ((CJ) & 7) * 16384 + (KT) * 4096 + lane * 16; \
                bf16x8 kf[4], vf[2][2]; \
                _Pragma("unroll") for (int ks = 0; ks < 4; ++ks) kf[ks] = *(const LAS bf16x8*)(sb_ + ks * 1024); \
                _Pragma("unroll") for (int dt = 0; dt < 2; ++dt) _Pragma("unroll") for (int sp = 0; sp < 2; ++sp) vf[dt][sp] = *(const LAS bf16x8*)(sb_ + 8192 + (dt * 2 + sp) * 1024); \
                bf16x8 pf[2][2]; \
                _Pragma("unroll") for (int qt = 0; qt < 2; ++qt) { \
                    const LAS float* tb = (const LAS float*)(l3 + O_TB) + h * 640 + (575 - 64 * (c - (CJ)) - 32 * qt - l31 + 32 * (KT) + 4 * hh); \
                    f32x16 sa; \
                    _Pragma("unroll") for (int r = 0; r < 16; ++r) sa[r] = tb[(r & 3) + 8 * (r >> 2)]; \
                    _Pragma("unroll") for (int ks = 0; ks < 4; ++ks) sa = MFMA32(kf[ks], qf[qt][ks], sa); \
                    float mloc = sa[0]; \
                    _Pragma("unroll") for (int r = 1; r < 16; ++r) mloc = fmaxf(mloc, sa[r]); \
                    mloc = xhalf_max(mloc); \
                    const float mnew = fmaxf(mrow[qt], mloc), alpha = __builtin_amdgcn_exp2f(mrow[qt] - mnew); \
                    float ls = 0.f; \
                    _Pragma("unroll") for (int r = 0; r < 16; ++r) { sa[r] = __builtin_amdgcn_exp2f(sa[r] - mnew); ls += sa[r]; } \
                    ls = xhalf_sum(ls); \
                    lrow[qt] = lrow[qt] * alpha + ls; \
                    if (!__all(mnew == mrow[qt])) { \
                        _Pragma("unroll") for (int dt = 0; dt < 2; ++dt) _Pragma("unroll") for (int r = 0; r < 16; ++r) ot[dt][qt][r] *= alpha; } \
                    mrow[qt] = mnew; \
                    _Pragma("unroll") for (int sp = 0; sp < 2; ++sp) { u32x4 t4; \
                        t4.x = pk2(sa[8 * sp + 0], sa[8 * sp + 1]); t4.y = pk2(sa[8 * sp + 2], sa[8 * sp + 3]); t4.z = pk2(sa[8 * sp + 4], sa[8 * sp + 5]); t4.w = pk2(sa[8 * sp + 6], sa[8 * sp + 7]); \
                        pf[qt][sp] = __builtin_bit_cast(bf16x8, t4); } } \
                _Pragma("unroll") for (int dt = 0; dt < 2; ++dt) _Pragma("unroll") for (int qt = 0; qt < 2; ++qt) _Pragma("unroll") for (int sp = 0; sp < 2; ++sp) ot[dt][qt] = MFMA32(vf[dt][sp], pf[qt][sp], ot[dt][qt]); } while (0)
#pragma unroll 1
            for (int r = 0; r < 9; ++r) {
                u32x4 nk = (u32x4){0u, 0u, 0u, 0u}, nv = (u32x4){0u, 0u, 0u, 0u};
                if (r < 8) { const size_t o = bhb + (size_t)(c0 + r) * 8192; nk = *(const u32x4*)(Kb + o); nv = *(const u32x4*)(VT + o); }
                const int cj = c - 8 + r;
                if (cj >= 0) { ATT_STEP(cj, 0); ATT_STEP(cj, 1); }
                __syncthreads();
                if (r < 8) { *(LAS u32x4*)(l3 + O_RING + r * 16384 + tid * 16) = nk; *(LAS u32x4*)(l3 + O_RING + r * 16384 + 8192 + tid * 16) = nv; __syncthreads(); }
            }
#undef ATT_STEP
#pragma unroll
            for (int qt = 0; qt < 2; ++qt) { const float inv = 1.f / lrow[qt];
                bf16_t* op = CAT + (tq0 + 32 * qt + l31) * D + 512 + h * 64;
#pragma unroll
                for (int dt = 0; dt < 2; ++dt)
#pragma unroll
                    for (int gp = 0; gp < 4; gp += 2) { u32x2 o0, o1;
                        o0.x = pk2(ot[dt][qt][4 * gp] * inv, ot[dt][qt][4 * gp + 1] * inv); o0.y = pk2(ot[dt][qt][4 * gp + 2] * inv, ot[dt][qt][4 * gp + 3] * inv);
                        o1.x = pk2(ot[dt][qt][4 * gp + 4] * inv, ot[dt][qt][4 * gp + 5] * inv); o1.y = pk2(ot[dt][qt][4 * gp + 6] * inv, ot[dt][qt][4 * gp + 7] * inv);
                        const auto sx = __builtin_amdgcn_permlane32_swap(o0.x, o1.x, false, false), sy = __builtin_amdgcn_permlane32_swap(o0.y, o1.y, false, false);
                        u32x4 w4; w4.x = sx[0]; w4.y = sy[0]; w4.z = sx[1]; w4.w = sy[1];
                        *(u32x4*)(op + 32 * dt + 8 * (gp + hh)) = w4; } }
        }
    }
}

constexpr int LDS_BYTES = 160 * 1024, MISC_OFF = 160 * 1024 - 512;
constexpr int NPHASE = 34;
#ifndef PG8_SP2
#define PG8_SP2 true
#endif
#ifndef PG8_ALIGN
#define PG8_ALIGN true
#endif
__global__ void __launch_bounds__(512, 2) mk_fwd(Params P) {
    extern __shared__ __attribute__((aligned(16))) unsigned char lds[];
    LAS unsigned char* l3 = (LAS unsigned char*)lds;
    Geo g; g.tid = threadIdx.x; g.lane = g.tid & 63; g.wave = __builtin_amdgcn_readfirstlane(g.tid >> 6); g.G = gridDim.x;
    { const int bx = blockIdx.x; g.vcu = (g.G % 8 == 0) ? (bx % 8) * (g.G / 8) + bx / 8 : bx; }
    volatile LAS unsigned* MISC = (volatile LAS unsigned*)(l3 + MISC_OFF);
    if (g.tid < 64) MISC[g.tid] = 0u;
    __syncthreads();
    unsigned char* ws = P.ws;
    unsigned* ctl = (unsigned*)(ws + WS_CTL);
    XcdBarrier bar = xcd_barrier_post(ctl + CW_BAR, MISC + 8);
    const int lo = P.ph_lo, hi = P.ph_hi;
#define IN(k) (lo <= (k) && (k) < hi)
#define SEAM(k) do { if ((k) + 1 < hi) xcd_barrier(bar); } while (0)
    const float* mod = (const float*)(ws + WS_MOD);
    bf16_t* Hb = (bf16_t*)P.out; bf16_t* XB = (bf16_t*)(ws + WS_XB);

    if (IN(0)) { for (int rep_ = 0; rep_ < ((PROBE_DUP == 0) ? 2 : 1); ++rep_) { phase_mod(P, g, (float*)lds); phase_convert(P, g, (float*)(lds + 32768))  ; if (rep_ + 1 < ((PROBE_DUP == 0) ? 2 : 1)) xcd_barrier(bar); } SEAM(0); }

#define NREP(ty) ((PROBE_DUP == (ty)) ? 2 : 1)
#define DRYFLAG(ty) bool dry = false; if (PROBE_DUP == (ty)) { int d_ = (rep_ + 1 < NREP(ty)); asm volatile("" : "+s"(d_)); dry = d_ != 0; }
#define DRYBAR() do { if (dry) xcd_barrier(bar); } while (0)
#define G_E1 { pg8::Gemm gm{Hb, (const bf16_t*)(ws + WS_WMI) + (size_t)i2 * MIX_IN * D, T, MIX_IN, D}; pg8::StaticOrder S; S.init(T, MIX_IN, g.G, (int)blockIdx.x); \
                pg8::EpiE1x E{(bf16_t*)(ws + WS_U), (bf16_t*)(ws + WS_VT)}; \
                pg8::gemm_phase<pg8::EpiE1x, pg8::StaticOrder, PG8_ALIGN, PG8_SP2>(l3, gm, S, E); }
#define G_E3(F32B, BASEP) { pg8::Gemm gm{(const bf16_t*)(ws + WS_CAT), (const bf16_t*)(ws + WS_WMO) + (size_t)i2 * D * D, T, D, D}; pg8::StaticOrder S; S.init(T, D, g.G, (int)blockIdx.x); \
                pg8::EpiResGate<F32B> E{BASEP, XB, gate1, (float*)(ws + WS_SSP)}; \
                pg8::gemm_phase<pg8::EpiResGate<F32B>, pg8::StaticOrder, PG8_ALIGN, PG8_SP2>(l3, gm, S, E); }
#define G_O1A { pg8::Gemm gm{Hb, (const bf16_t*)(ws + WS_WSX) + (size_t)i2 * 4096 * D, T, 4096, D}; pg8::StaticOrder S; S.init(T, 4096, g.G, (int)blockIdx.x); \
                pg8::EpiSplitX E{(bf16_t*)(ws + WS_XS), (unsigned*)(ws + WS_XHALO)}; \
                pg8::gemm_phase<pg8::EpiSplitX, pg8::StaticOrder, PG8_ALIGN, PG8_SP2>(l3, gm, S, E); }
#define G_O1B { pg8::Gemm gm{Hb, (const bf16_t*)(ws + WS_WSZ) + (size_t)i2 * 2048 * D, T, 2048, D}; pg8::StaticOrder S; S.init(T, 2048, g.G, (int)blockIdx.x); \
                pg8::EpiGateNorm E{(bf16_t*)(ws + WS_XS), (LAS float*)(l3 + 131072)}; \
                pg8::gemm_phase<pg8::EpiGateNorm, pg8::StaticOrder, true, PG8_SP2>(l3, gm, S, E); }
#define G_O3 { pg8::Gemm gm{(const bf16_t*)(ws + WS_XS), (const bf16_t*)(ws + WS_WSO) + (size_t)i2 * D * SSM_DI, T, D, SSM_DI}; pg8::StaticOrder S; S.init(T, D, g.G, (int)blockIdx.x); \
                pg8::EpiResGate<false> E{XB, XB, gate1, (float*)(ws + WS_SSP)}; \
                pg8::gemm_phase<pg8::EpiResGate<false>, pg8::StaticOrder, PG8_ALIGN, PG8_SP2>(l3, gm, S, E); }
#define GDUP_2(...)
#define GDUP_4(...)
#define GDUP_8(...)
#define GDUP_10(...)
#define GDUP_12(...)
#if PROBE_DUP == 2
#undef GDUP_2
#define GDUP_2(...) __VA_ARGS__ xcd_barrier(bar);
#elif PROBE_DUP == 4
#undef GDUP_4
#define GDUP_4(...) __VA_ARGS__ xcd_barrier(bar);
#elif PROBE_DUP == 8
#undef GDUP_8
#define GDUP_8(...) __VA_ARGS__ xcd_barrier(bar);
#elif PROBE_DUP == 10
#undef GDUP_10
#define GDUP_10(...) __VA_ARGS__ xcd_barrier(bar);
#elif PROBE_DUP == 12
#undef GDUP_12
#define GDUP_12(...) __VA_ARGS__ xcd_barrier(bar);
#endif
#define GDUP(ty, ...) GDUP_##ty(__VA_ARGS__)
#define LAYER_BODY(LL) { const int L = (LL); \
        const int pb = 1 + 8 * L, i2 = L >> 1; \
        const float* gate1 = mod + (size_t)L * NB * 6144 + 2048; \
        if ((L & 1) == 0) { \
            if (IN(pb + 0)) { phase_norm<0>(P, g, (float*)lds, L, P.in[I_X], P.in[I_N1W] + L * D, 0, 1024, false, L == 0 ? (const bf16_t*)nullptr : (const bf16_t*)XB); SEAM(pb + 0); } \
            if (IN(pb + 1)) { G_E1 GDUP(2, G_E1) SEAM(pb + 1); } \
            if (IN(pb + 2)) { for (int rep_ = 0; rep_ < NREP(3); ++rep_) { DRYFLAG(3) phase_e2(P, g, l3, L); DRYBAR(); } SEAM(pb + 2); } \
            if (IN(pb + 3)) { if (L == 0) G_E3(true, P.in[I_X]) else G_E3(false, XB) SEAM(pb + 3); } \
            if (IN(pb + 4)) { for (int rep_ = 0; rep_ < NREP(5); ++rep_) { DRYFLAG(5) phase_norm16<2>(P, g, l3, L, XB, P.in[I_N2W] + L * D, 3072, 4096, dry); DRYBAR(); } SEAM(pb + 4); } \
            if (IN(pb + 5)) { for (int rep_ = 0; rep_ < NREP(6); ++rep_) { DRYFLAG(6) phase_moe(P, g, l3, L, dry); DRYBAR(); } SEAM(pb + 5); } \
        } else { \
            if (IN(pb + 0)) { phase_norm16<1>(P, g, l3, L, XB, P.in[I_N1W] + L * D, 0, 1024, false); SEAM(pb + 0); } \
            if (IN(pb + 1)) { G_O1A GDUP(8, G_O1A) SEAM(pb + 1); } \
            if (IN(pb + 2)) { for (int rep_ = 0; rep_ < NREP(9); ++rep_) { DRYFLAG(9) scan_units<3>(P, g, l3, L, dry); xcd_barrier(bar); scan_fix(P, g, l3, L); DRYBAR(); } SEAM(pb + 2); } \
            if (IN(pb + 3)) { G_O1B GDUP(10, G_O1B) SEAM(pb + 3); } \
            if (IN(pb + 5)) { G_O3 SEAM(pb + 5); } \
            if (IN(pb + 6)) { for (int rep_ = 0; rep_ < NREP(5); ++rep_) { DRYFLAG(5) phase_norm16<2>(P, g, l3, L, XB, P.in[I_N2W] + L * D, 3072, 4096, dry); DRYBAR(); } SEAM(pb + 6); } \
            if (IN(pb + 7)) { for (int rep_ = 0; rep_ < NREP(6); ++rep_) { DRYFLAG(6) phase_moe(P, g, l3, L, dry); DRYBAR(); } SEAM(pb + 7); } \
        } \
    }
    LAYER_BODY(0)
    LAYER_BODY(1)
    LAYER_BODY(2)
    LAYER_BODY(3)
#undef LAYER_BODY
    if (IN(33)) { for (int rep_ = 0; rep_ < NREP(13); ++rep_) { DRYFLAG(13) phase_final(P, g, dry); DRYBAR(); } }
#undef IN
#undef SEAM
}

extern "C" void kernel_launch(void* const* d_in, const int* in_sizes, int n_in, void* d_out, int out_size, void* d_ws, size_t ws_size, hipStream_t stream) {
    static int grid = 0;
    if (grid == 0) {
        if (n_in != 27 || out_size != T * D || ws_size < WS_END) { fprintf(stderr, "kernel_launch: bad shapes n_in %d out %d ws %zu (need %zu)\n", n_in, out_size, ws_size, (size_t)WS_END); grid = -1; return; }
        if (hipFuncSetAttribute((const void*)mk_fwd, hipFuncAttributeMaxDynamicSharedMemorySize, LDS_BYTES) != hipSuccess) { fprintf(stderr, "hipFuncSetAttribute failed\n"); grid = -1; return; }
        int dev = 0, cus = 0, per_cu = 0;
        if (hipGetDevice(&dev) != hipSuccess || hipDeviceGetAttribute(&cus, hipDeviceAttributeMultiprocessorCount, dev) != hipSuccess) { grid = -1; return; }
        if (hipOccupancyMaxActiveBlocksPerMultiprocessor(&per_cu, (const void*)mk_fwd, 512, LDS_BYTES) != hipSuccess || per_cu < 1) fprintf(stderr, "occupancy query says %d\n", per_cu);
        (void)hipGetLastError();
        grid = cus;
    }
    if (grid < 0) return;
    Params P{};
    for (int i = 0; i < 27; ++i) P.in[i] = (const float*)d_in[i];
    P.out = (float*)d_out; P.ws = (unsigned char*)d_ws;
    (void)hipMemsetAsync((unsigned char*)d_ws + WS_CTL, 0, CTL_BYTES, stream);
    const int G = grid;
    auto run = [&](int lo, int hi) { P.ph_lo = lo; P.ph_hi = hi; hipLaunchKernelGGL(mk_fwd, dim3(G), dim3(512), LDS_BYTES, stream, P); };
    run(0, NPHASE);
}
```

```cpp
#include <hip/hip_runtime.h>
#include <cstdio>
#include <cstdint>

#ifndef PROBE_DUP
#define PROBE_DUP -1
#endif
typedef unsigned short bf16_t;
typedef float f32x4 __attribute__((ext_vector_type(4)));
typedef unsigned u32x4 __attribute__((ext_vector_type(4)));
typedef unsigned u32x2 __attribute__((ext_vector_type(2)));
typedef float f32x2 __attribute__((ext_vector_type(2)));

constexpr int D = 1024, NB = 8, SEQ = 4096, DEPTH = 4, T = NB * SEQ;
constexpr int CHUNK = 64, NCH = SEQ / CHUNK;
constexpr float EPS = 1e-6f;
constexpr int POOLW = 512, NHEAD = 8, HD = 64, ATTW = 512, MIX_IN = 2048;
constexpr int SSM_DI = 2048, SSM_H = 32, SSM_G = 8, SSM_N = 128, SSM_P = 64, SSM_CONV = 4096, SSM_IN = 6176;
constexpr int MOE_E = 32, MOE_FF = 128, NBUCKET = 112;
constexpr float QSCALE = 0.125f * 1.4426950408889634f;
constexpr float LOG2E = 1.4426950408889634f;

constexpr size_t MiB = 1u << 20;
constexpr size_t WS_CTL = 0, CTL_BYTES = 1 * MiB;
constexpr size_t WS_MOD = 1 * MiB;
constexpr size_t WS_TOKE = 2 * MiB;
constexpr size_t WS_TOKW = 2 * MiB + 512 * 1024;
constexpr size_t WS_LIST = 3 * MiB;
constexpr size_t WS_WMI = 17 * MiB, WS_WMO = 25 * MiB, WS_WSX = 29 * MiB, WS_WSZ = 45 * MiB, WS_WSO = 53 * MiB, WS_WPL = 61 * MiB;
constexpr size_t WS_W13 = 62 * MiB, WS_W2T = 126 * MiB;
constexpr size_t WS_WRH = 61 * MiB + 256 * 1024, WS_WRL = WS_WRH + 384 * 1024;
constexpr size_t WS_WDH = 1 * MiB + 768 * 1024, WS_WDL = WS_WDH + 128 * 1024;
constexpr size_t WS_XB = 158 * MiB;
constexpr size_t WS_BIG = 222 * MiB;
constexpr size_t WS_U = WS_BIG, WS_Q = WS_BIG + 32 * MiB, WS_K = WS_BIG + 64 * MiB, WS_VT = WS_BIG + 96 * MiB, WS_CAT = WS_BIG + 128 * MiB;
constexpr size_t WS_XS = WS_BIG, WS_BC = WS_BIG + 128 * MiB, WS_DT = WS_BIG + 256 * MiB;
constexpr size_t WS_SSP = WS_BIG + 260 * MiB;
constexpr size_t WS_END = WS_SSP + 2 * MiB;
constexpr int CW_BAR = 4096;
constexpr int CW_CNT = 16384;

struct Params {
    const float* in[27];
    float* out;
    unsigned char* ws;
    int ph_lo, ph_hi;
};
enum { I_X = 0, I_C, I_ADAW, I_ADAB, I_N1W, I_N2W, I_MIXIN, I_POOLW, I_POOLS, I_RELB, I_MIXOUT, I_SSMIN, I_CONVW, I_CONVB, I_DTB, I_ALOG, I_SSMD, I_SSMNW, I_SSMOUT,
       I_WG, I_BG, I_WE, I_BE, I_W1, I_W3, I_W2, I_FNW };

#define LAS __attribute__((address_space(3)))
__device__ __forceinline__ float bf2f(unsigned v) { return __uint_as_float(v << 16); }
typedef __bf16 bf16x2_t __attribute__((ext_vector_type(2)));
__device__ __forceinline__ unsigned pk2(float lo, float hi) { f32x2 v = {lo, hi}; bf16x2_t b = __builtin_convertvector(v, bf16x2_t); return __builtin_bit_cast(unsigned, b); }
__device__ __forceinline__ unsigned f2bf(float f) { return pk2(f, f) & 0xffffu; }
__device__ __forceinline__ float xhalf_max(float x) { const auto r = __builtin_amdgcn_permlane32_swap(__float_as_uint(x), __float_as_uint(x), false, false); return fmaxf(__uint_as_float(r[0]), __uint_as_float(r[1])); }
__device__ __forceinline__ float xhalf_sum(float x) { const auto r = __builtin_amdgcn_permlane32_swap(__float_as_uint(x), __float_as_uint(x), false, false); return __uint_as_float(r[0]) + __uint_as_float(r[1]); }
__device__ __forceinline__ float x16_sum(float x) { const auto r = __builtin_amdgcn_permlane16_swap(__float_as_uint(x), __float_as_uint(x), false, false); return __uint_as_float(r[0]) + __uint_as_float(r[1]); }
#define DPP_F32(SRC, CTRL, RM) __uint_as_float(__builtin_amdgcn_update_dpp(0u, __float_as_uint(SRC), CTRL, RM, 0xf, false))
__device__ __forceinline__ float wave_incl_scan(float x) {
    x += DPP_F32(x, 0x111, 0xf); x += DPP_F32(x, 0x112, 0xf); x += DPP_F32(x, 0x114, 0xf); x += DPP_F32(x, 0x118, 0xf);
    x += DPP_F32(x, 0x142, 0xa); x += DPP_F32(x, 0x143, 0xc);
    return x;
}
__device__ __forceinline__ float wave_last(float x) { return __uint_as_float(__builtin_amdgcn_readlane(__float_as_uint(x), 63)); }
__device__ __forceinline__ float wave_sum(float v) {
#pragma unroll
    for (int o = 1; o < 64; o <<= 1) v += __shfl_xor(v, o);
    return v;
}
__device__ __forceinline__ float silu_f(float x) { return x * __builtin_amdgcn_rcpf(1.f + __expf(-x)); }
__device__ __forceinline__ float softplus_f(float x) { return x > 20.f ? x : log1pf(__expf(x)); }

struct Geo { int tid, lane, wave, vcu, G; };

__device__ __forceinline__ void phase_mod(const Params& P, const Geo& g, float* cs  ) {
    const float* c = P.in[I_C];
    for (int i = g.tid; i < NB * D; i += 512) cs[i] = silu_f(c[i]);
    __syncthreads();
    float* mod = (float*)(P.ws + WS_MOD);
    float* red = cs + 8192 + 8 * (64 * 33);
    const int cl = g.lane & 31, h = g.lane >> 5;
    for (int u = g.vcu; u < DEPTH * 192; u += g.G) {
        const int L = u / 192, col0 = (u % 192) * 32;
        const float* w = P.in[I_ADAW] + (size_t)L * D * 6144 + col0 + cl + (size_t)(g.wave * 128 + 4 * h) * 6144;
        const float* cw = cs + g.wave * 128 + 4 * h;
        float wv[64];
#pragma unroll
        for (int j = 0; j < 16; ++j)
#pragma unroll
            for (int e = 0; e < 4; ++e) wv[4 * j + e] = w[(size_t)(8 * j + e) * 6144];
        __builtin_amdgcn_sched_barrier(0);
        float acc[NB];
#pragma unroll
        for (int b = 0; b < NB; ++b) acc[b] = 0.f;
#pragma unroll
        for (int j = 0; j < 16; ++j)
#pragma unroll
            for (int b = 0; b < NB; ++b) { const f32x4 c4 = *(const f32x4*)(cw + b * D + 8 * j);
                acc[b] += c4.x * wv[4 * j] + c4.y * wv[4 * j + 1] + c4.z * wv[4 * j + 2] + c4.w * wv[4 * j + 3]; }
#pragma unroll
        for (int b = 0; b < NB; ++b) acc[b] += __shfl_xor(acc[b], 32);
        if (h == 0) {
#pragma unroll
            for (int b = 0; b < NB; ++b) red[(g.wave * NB + b) * 32 + cl] = acc[b]; }
        __syncthreads();
        if (g.tid < 256) { const int b = g.tid >> 5, col = col0 + (g.tid & 31); float sum = P.in[I_ADAB][L * 6144 + col];
#pragma unroll
            for (int ww = 0; ww < 8; ++ww) sum += red[(ww * NB + b) * 32 + (g.tid & 31)];
            mod[(size_t)(L * NB + b) * 6144 + col] = sum; }
        __syncthreads();
    }
}

template <int PROJ>
__device__ __forceinline__ void phase_norm(const Params& P, const Geo& g, float* wlds, int L, const float* xsrc, const float* nw, int shift_off, int scale_off, bool dry = false, const bf16_t* xb = nullptr  ) {
    constexpr int NPROJ = PROJ == 1 ? 32 : (PROJ == 2 ? 36 : 0);
    const int i2 = L >> 1;
    if (PROJ == 1) {
        const float* w = P.in[I_SSMIN] + (size_t)i2 * D * SSM_IN + 6144;
        for (int e = g.tid; e < 32 * D; e += 512) { const int k = e >> 5, j = e & 31; wlds[j * D + k] = w[(size_t)k * SSM_IN + j]; }
        __syncthreads();
    } else if (PROJ == 2) {
        const float* wg = P.in[I_WG] + (size_t)L * D * 4;
        const float* we = P.in[I_WE] + (size_t)L * D * 32;
        for (int e = g.tid; e < 4 * D; e += 512) { const int k = e >> 2, j = e & 3; wlds[j * D + k] = wg[e]; }
        for (int e = g.tid; e < 32 * D; e += 512) { const int k = e >> 5, j = e & 31; wlds[(4 + j) * D + k] = we[e]; }
        __syncthreads();
    }
    const float* mod = (const float*)(P.ws + WS_MOD);
    bf16_t* H = (bf16_t*)P.out;
    const int gw = g.vcu * 8 + g.wave, NGW = g.G * 8;
    int my_row = -1, my_bucket = 0; int nrows = 0;
    for (int m = gw; m < T; m += NGW) {
        const int b = m / SEQ;
        f32x4 v[4]; float ss = 0.f;
        if (xb) { const u32x2* xr2 = (const u32x2*)(xb + (size_t)m * D) + g.lane;
#pragma unroll
            for (int j = 0; j < 4; ++j) { const u32x2 t2 = xr2[64 * j]; v[j].x = bf2f(t2.x & 0xffffu); v[j].y = bf2f(t2.x >> 16); v[j].z = bf2f(t2.y & 0xffffu); v[j].w = bf2f(t2.y >> 16); } }
        else { const f32x4* xr = (const f32x4*)(xsrc + (size_t)m * D) + g.lane;
#pragma unroll
            for (int j = 0; j < 4; ++j) v[j] = xr[64 * j]; }
#pragma unroll
        for (int j = 0; j < 4; ++j) ss += v[j].x * v[j].x + v[j].y * v[j].y + v[j].z * v[j].z + v[j].w * v[j].w;
        const float rstd = rsqrtf(wave_sum(ss) * (1.f / D) + EPS);
        const float* mrow = mod + (size_t)(L * NB + b) * 6144;
#pragma unroll
        for (int j = 0; j < 4; ++j) {
            const int k = 4 * g.lane + 256 * j;
            const f32x4 w4 = *(const f32x4*)(nw + k), sc = *(const f32x4*)(mrow + scale_off + k), sh = *(const f32x4*)(mrow + shift_off + k);
            v[j] = v[j] * rstd * w4 * (sc + 1.f) + sh;
            u32x2 o; o.x = pk2(v[j].x, v[j].y); o.y = pk2(v[j].z, v[j].w);
            *(u32x2*)(H + (size_t)m * D + k) = o;
        }
        if (NPROJ > 0) {
            float mine = 0.f;
#pragma unroll 2
            for (int q = 0; q < NPROJ; ++q) {
                float a = 0.f;
#pragma unroll
                for (int j = 0; j < 4; ++j) { const f32x4 w4 = *(const f32x4*)(wlds + q * D + 4 * g.lane + 256 * j); a += v[j].x * w4.x + v[j].y * w4.y + v[j].z * w4.z + v[j].w * w4.w; }
                a = wave_sum(a);
                mine = (g.lane == q) ? a : mine;
            }
            if (PROJ == 1) {
                float* DT = (float*)(P.ws + WS_DT);
                const float* dtb = P.in[I_DTB] + i2 * SSM_H;
                if (g.lane < 32) DT[(size_t)m * 32 + g.lane] = softplus_f(mine + dtb[g.lane]);
            } else if (PROJ == 2) {
                const float* bg = P.in[I_BG] + L * 4; const float* be = P.in[I_BE] + L * 32;
                float gl[4]; float gm = -3.0e38f; int gi = 0;
#pragma unroll
                for (int q = 0; q < 4; ++q) { gl[q] = __shfl(mine, q) + bg[q]; if (gl[q] > gm) { gm = gl[q]; gi = q; } }
                float gs = 0.f;
#pragma unroll
                for (int q = 0; q < 4; ++q) gs += __expf(gl[q] - gm);
                const float gval = 1.f / gs;
                float el[8];
#pragma unroll
                for (int e = 0; e < 8; ++e) el[e] = __shfl(mine, 4 + gi * 8 + e) + be[gi * 8 + e];
                float m0 = -3.0e38f; int i0 = 0;
#pragma unroll
                for (int e = 0; e < 8; ++e) if (el[e] > m0) { m0 = el[e]; i0 = e; }
                float m1 = -3.0e38f; int i1 = 0;
#pragma unroll
                for (int e = 0; e < 8; ++e) if (e != i0 && el[e] > m1) { m1 = el[e]; i1 = e; }
                float es = 0.f;
#pragma unroll
                for (int e = 0; e < 8; ++e) es += __expf(el[e] - m0);
                const float p0 = 1.f / es, p1 = __expf(m1 - m0) / es;
                const float w0 = gval * (p0 / (p0 + p1)), w1 = gval * (p1 / (p0 + p1));
                const int lo = i0 < i1 ? i0 : i1, hi = i0 < i1 ? i1 : i0;
                const float wlo = i0 < i1 ? w0 : w1, whi = i0 < i1 ? w1 : w0;
                const int bucket = gi * 28 + 7 * lo - (lo * (lo - 1)) / 2 + (hi - lo - 1);
                if (g.lane == 0) {
                    ((int2*)(P.ws + WS_TOKE))[m] = make_int2(gi * 8 + lo, gi * 8 + hi);
                    ((float2*)(P.ws + WS_TOKW))[m] = make_float2(wlo, whi);
                }
                if (g.lane == (nrows & 63)) { my_row = m; my_bucket = bucket; }
                ++nrows;
                if ((nrows & 63) == 0 && !dry) {
                    unsigned* cnt = (unsigned*)(P.ws + WS_CTL) + CW_CNT + (L * 128 + my_bucket) * 16;
                    const unsigned rank = atomicAdd(cnt, 1u);
                    ((int*)(P.ws + WS_LIST))[(size_t)my_bucket * T + rank] = my_row;
                    my_row = -1;
                }
            }
        }
    }
    if (PROJ == 2) {
        if (my_row >= 0 && !dry) {
            unsigned* cnt = (unsigned*)(P.ws + WS_CTL) + CW_CNT + (L * 128 + my_bucket) * 16;
            const unsigned rank = atomicAdd(cnt, 1u);
            ((int*)(P.ws + WS_LIST))[(size_t)my_bucket * T + rank] = my_row;
        }
    }
}


typedef short bf16x8 __attribute__((ext_vector_type(8)));
template <int PROJ>
__device__ __forceinline__ void phase_norm16(const Params& P, const Geo& g, LAS unsigned char* l3, int L, const bf16_t* xsrc, const float* nw, int shift_off, int scale_off, bool dry = false) {
    constexpr int NT = PROJ == 1 ? 2 : 3, NBLK = NT * 16, PERW = NBLK / 8;
    constexpr int O_WB = 32768, WBUF = NBLK * 1024;
    const int i2 = L >> 1, lane = g.lane, r16 = lane & 15, q4 = lane >> 4, w = g.wave;
    unsigned char* ws = P.ws;
    const float* mod = (const float*)(ws + WS_MOD);
    const float* ssp = (const float*)(ws + WS_SSP);
    bf16_t* H = (bf16_t*)P.out;
    LAS float* msl = (LAS float*)l3;
    LAS float* shl = (LAS float*)(l3 + 4096);
    LAS float* lgw = (LAS float*)(l3 + 8192 + g.wave * (16 * 48 * 4));
    const bf16_t* WH = PROJ == 1 ? (const bf16_t*)(ws + WS_WDH) + (size_t)i2 * 32 * D : (const bf16_t*)(ws + WS_WRH) + (size_t)L * 48 * D;
    const bf16_t* WL = PROJ == 1 ? (const bf16_t*)(ws + WS_WDL) + (size_t)i2 * 32 * D : (const bf16_t*)(ws + WS_WRL) + (size_t)L * 48 * D;
    for (int blk = g.vcu; blk < T / 128; blk += g.G) {
        const int b = (blk * 128) / SEQ;
        const float* mrow = mod + (size_t)(L * NB + b) * 6144;
        __syncthreads();
        for (int k = g.tid; k < D; k += 512) { msl[k] = nw[k] * (1.f + mrow[scale_off + k]); shl[k] = mrow[shift_off + k]; }
        const int m0 = blk * 128 + w * 16;
        const bf16_t* xr = xsrc + (size_t)(m0 + r16) * D + 8 * q4;
        u32x4 xq[8];
#pragma unroll
        for (int sl = 0; sl < 8; ++sl) xq[sl] = *(const u32x4*)(xr + 32 * sl);
        float ss; { const f32x4 p4 = *(const f32x4*)(ssp + (size_t)(m0 + r16) * 16 + 4 * q4); ss = (p4[0] + p4[1]) + (p4[2] + p4[3]); }
        ss = xhalf_sum(x16_sum(ss));
        const float rstd = rsqrtf(ss * (1.f / D) + EPS);
        u32x4 wreg[PERW];
#define N16_LOADW(CH) do { _Pragma("unroll") for (int i = 0; i < PERW; ++i) { const int j = PERW * w + i, lo = j >= NT * 8, jj = lo ? j - NT * 8 : j, ct = jj >> 3, sl = jj & 7; \
            wreg[i] = *(const u32x4*)((lo ? WL : WH) + (size_t)(ct * 32 + 8 * (CH) + sl) * 512 + lane * 8); } } while (0)
#define N16_STOREW(BUF) do { _Pragma("unroll") for (int i = 0; i < PERW; ++i) *(LAS u32x4*)(l3 + O_WB + (BUF) * WBUF + (PERW * w + i) * 1024 + lane * 16) = wreg[i]; } while (0)
        N16_LOADW(0); N16_STOREW(0);
        __syncthreads();
        f32x4 acc[NT];
#pragma unroll
        for (int ct = 0; ct < NT; ++ct) acc[ct] = (f32x4){0.f, 0.f, 0.f, 0.f};
        bf16_t* hrow = H + (size_t)(m0 + r16) * D + 8 * q4;
#pragma unroll 1
        for (int ch = 0; ch < 4; ++ch) {
            if (ch < 3) N16_LOADW(ch + 1);
            u32x4 xn[8];
#pragma unroll
            for (int sl = 0; sl < 8; ++sl) xn[sl] = xq[sl];
            if (ch < 3) {
#pragma unroll
                for (int sl = 0; sl < 8; ++sl) xn[sl] = *(const u32x4*)(xr + 32 * (8 * (ch + 1) + sl)); }
            const LAS unsigned char* wb = l3 + O_WB + (ch & 1) * WBUF + lane * 16;
#pragma unroll
            for (int sl = 0; sl < 8; ++sl) {
                const int s = 8 * ch + sl;
                const u32x4 x8 = xq[sl];
                f32x4 a, c; a.x = bf2f(x8.x & 0xffffu); a.y = bf2f(x8.x >> 16); a.z = bf2f(x8.y & 0xffffu); a.w = bf2f(x8.y >> 16); c.x = bf2f(x8.z & 0xffffu); c.y = bf2f(x8.z >> 16); c.z = bf2f(x8.w & 0xffffu); c.w = bf2f(x8.w >> 16);
                const f32x4 m0v = *(const LAS f32x4*)(msl + 32 * s + 8 * q4), m1v = *(const LAS f32x4*)(msl + 32 * s + 8 * q4 + 4);
                const f32x4 s0v = *(const LAS f32x4*)(shl + 32 * s + 8 * q4), s1v = *(const LAS f32x4*)(shl + 32 * s + 8 * q4 + 4);
                const f32x4 h0 = a * rstd * m0v + s0v, h1 = c * rstd * m1v + s1v;
                u32x4 hi; hi.x = pk2(h0.x, h0.y); hi.y = pk2(h0.z, h0.w); hi.z = pk2(h1.x, h1.y); hi.w = pk2(h1.z, h1.w);
                *(u32x4*)(hrow + 32 * s) = hi;
                u32x4 lo;
                lo.x = pk2(h0.x - bf2f(hi.x & 0xffffu), h0.y - bf2f(hi.x >> 16)); lo.y = pk2(h0.z - bf2f(hi.y & 0xffffu), h0.w - bf2f(hi.y >> 16));
                lo.z = pk2(h1.x - bf2f(hi.z & 0xffffu), h1.y - bf2f(hi.z >> 16)); lo.w = pk2(h1.z - bf2f(hi.w & 0xffffu), h1.w - bf2f(hi.w >> 16));
                const bf16x8 ahi = __builtin_bit_cast(bf16x8, hi), alo = __builtin_bit_cast(bf16x8, lo);
#pragma unroll
                for (int ct = 0; ct < NT; ++ct) { const bf16x8 bh = *(const LAS bf16x8*)(wb + (ct * 8 + sl) * 1024), bl = *(const LAS bf16x8*)(wb + (NT * 8 + ct * 8 + sl) * 1024);
                    acc[ct] = __builtin_amdgcn_mfma_f32_16x16x32_bf16(ahi, bh, acc[ct], 0, 0, 0);
                    acc[ct] = __builtin_amdgcn_mfma_f32_16x16x32_bf16(ahi, bl, acc[ct], 0, 0, 0);
                    acc[ct] = __builtin_amdgcn_mfma_f32_16x16x32_bf16(alo, bh, acc[ct], 0, 0, 0); }
            }
            if (ch < 3) N16_STOREW((ch + 1) & 1);
            asm volatile("s_waitcnt lgkmcnt(0)" ::: "memory"); __builtin_amdgcn_s_barrier(); asm volatile("" ::: "memory");
#pragma unroll
            for (int sl = 0; sl < 8; ++sl) xq[sl] = xn[sl];
        }
#undef N16_LOADW
#undef N16_STOREW
        if (PROJ == 1) {
            float* DT = (float*)(ws + WS_DT); const float* dtb = P.in[I_DTB] + i2 * SSM_H;
#pragma unroll
            for (int ct = 0; ct < NT; ++ct) { const float bias = dtb[16 * ct + r16];
#pragma unroll
                for (int r = 0; r < 4; ++r) DT[(size_t)(m0 + 4 * q4 + r) * 32 + 16 * ct + r16] = softplus_f(acc[ct][r] + bias); }
        } else {
#pragma unroll
            for (int ct = 0; ct < NT; ++ct)
#pragma unroll
                for (int r = 0; r < 4; ++r) lgw[(4 * q4 + r) * 48 + 16 * ct + r16] = acc[ct][r];
            asm volatile("s_waitcnt lgkmcnt(0)" ::: "memory");
            if (lane < 16) {
                const LAS float* lg = lgw + lane * 48; const int m = m0 + lane;
                const float* bg = P.in[I_BG] + L * 4; const float* be = P.in[I_BE] + L * 32;
                float gl[4]; float gm = -3.0e38f; int gi = 0;
#pragma unroll
                for (int q = 0; q < 4; ++q) { gl[q] = lg[q] + bg[q]; if (gl[q] > gm) { gm = gl[q]; gi = q; } }
                float gs = 0.f;
#pragma unroll
                for (int q = 0; q < 4; ++q) gs += __expf(gl[q] - gm);
                const float gval = 1.f / gs;
                float el[8];
#pragma unroll
                for (int e = 0; e < 8; ++e) el[e] = lg[4 + gi * 8 + e] + be[gi * 8 + e];
                float mx0 = -3.0e38f; int i0 = 0;
#pragma unroll
                for (int e = 0; e < 8; ++e) if (el[e] > mx0) { mx0 = el[e]; i0 = e; }
                float mx1 = -3.0e38f; int i1 = 0;
#pragma unroll
                for (int e = 0; e < 8; ++e) if (e != i0 && el[e] > mx1) { mx1 = el[e]; i1 = e; }
                float es = 0.f;
#pragma unroll
                for (int e = 0; e < 8; ++e) es += __expf(el[e] - mx0);
                const float p0 = 1.f / es, p1 = __expf(mx1 - mx0) / es;
                const float w0 = gval * (p0 / (p0 + p1)), w1 = gval * (p1 / (p0 + p1));
                const int lo = i0 < i1 ? i0 : i1, hi = i0 < i1 ? i1 : i0;
                const float wlo = i0 < i1 ? w0 : w1, whi = i0 < i1 ? w1 : w0;
                const int bucket = gi * 28 + 7 * lo - (lo * (lo - 1)) / 2 + (hi - lo - 1);
                ((int2*)(ws + WS_TOKE))[m] = make_int2(gi * 8 + lo, gi * 8 + hi);
                ((float2*)(ws + WS_TOKW))[m] = make_float2(wlo, whi);
                if (!dry) {
                    unsigned* cnt = (unsigned*)(ws + WS_CTL) + CW_CNT + (L * 128 + bucket) * 16;
                    const unsigned rank = atomicAdd(cnt, 1u);
                    ((int*)(ws + WS_LIST))[(size_t)bucket * T + rank] = m;
                }
            }
        }
    }
}

__device__ __forceinline__ void phase_gate(const Params& P, const Geo& g, bool dry = false) {
    bf16_t* XS = (bf16_t*)(P.ws + WS_XS); const bf16_t* Z = (const bf16_t*)(P.ws + WS_BC);
    const int gw = g.vcu * 8 + g.wave, NGW = g.G * 8;
    for (int m = gw; m < T; m += NGW) {
        u32x4* yp = (u32x4*)(XS + (size_t)m * SSM_DI + 32 * g.lane);
        const u32x4* zp = (const u32x4*)(Z + (size_t)m * SSM_DI + 32 * g.lane);
        float gv[32]; float ss = 0.f;
#pragma unroll
        for (int j = 0; j < 4; ++j) {
            const u32x4 y4 = yp[j], z4 = zp[j];
#pragma unroll
            for (int e = 0; e < 4; ++e) {
                const unsigned yy = y4[e], zz = z4[e];
                const float y0 = bf2f(yy & 0xffffu), y1 = bf2f(yy >> 16), z0 = bf2f(zz & 0xffffu), z1 = bf2f(zz >> 16);
                const float g0 = y0 * silu_f(z0), g1 = y1 * silu_f(z1);
                gv[j * 8 + e * 2] = g0; gv[j * 8 + e * 2 + 1] = g1; ss += g0 * g0 + g1 * g1;
            }
        }
        ss += __shfl_xor(ss, 1); ss += __shfl_xor(ss, 2); ss += __shfl_xor(ss, 4);
        const float rs = rsqrtf(ss * (1.f / 256.f) + EPS);
#pragma unroll
        for (int j = 0; j < 4; ++j) { u32x4 o;
#pragma unroll
            for (int e = 0; e < 4; ++e) o[e] = pk2(gv[j * 8 + e * 2] * rs, gv[j * 8 + e * 2 + 1] * rs);
            if (!dry) yp[j] = o; else asm volatile("" :: "v"(o)); }
    }
}

__device__ __forceinline__ void phase_final(const Params& P, const Geo& g, bool dry = false) {
    const float* nw = P.in[I_FNW];
    const bf16_t* XB = (const bf16_t*)(P.ws + WS_XB);
    const int gw = g.vcu * 8 + g.wave, NGW = g.G * 8;
    for (int m = gw; m < T; m += NGW) {
        const u32x2* xr2 = (const u32x2*)(XB + (size_t)m * D) + g.lane;
        f32x4* orow = (f32x4*)(P.out + (size_t)m * D) + g.lane;
        f32x4 v[4]; float ss = 0.f;
#pragma unroll
        for (int j = 0; j < 4; ++j) { const u32x2 t2 = xr2[64 * j]; v[j].x = bf2f(t2.x & 0xffffu); v[j].y = bf2f(t2.x >> 16); v[j].z = bf2f(t2.y & 0xffffu); v[j].w = bf2f(t2.y >> 16);
            ss += v[j].x * v[j].x + v[j].y * v[j].y + v[j].z * v[j].z + v[j].w * v[j].w; }
        const float rstd = rsqrtf(wave_sum(ss) * (1.f / D) + EPS);
#pragma unroll
        for (int j = 0; j < 4; ++j) { const f32x4 w4 = *(const f32x4*)(nw + 4 * g.lane + 256 * j); orow[64 * j] = v[j] * rstd * w4; }
    }
}

namespace pg8 {
#define PG8_LAS __attribute__((address_space(3)))
typedef unsigned short bf16_t;
typedef short bf16x8 __attribute__((ext_vector_type(8)));
typedef float f32x4 __attribute__((ext_vector_type(4)));
typedef unsigned u32x4 __attribute__((ext_vector_type(4)));
constexpr int BM = 256, BK = 64, HALF = 128, HTB = HALF * BK * 2  , STAGE_BYTES = 8 * HTB, NXCD = 8, WGM = 8;

__host__ __device__ __forceinline__ int lds_byte(int r, int c) { const int st = (r >> 4) * 2 + (c >> 5), rr = r & 15, cc = c & 31, ob = rr * 64 + cc * 2; return st * 1024 + (ob ^ (((ob >> 9) & 1) << 5)); }
__host__ __device__ __forceinline__ void stage_rc(int b, int& R, int& C) { const int st = b / 1024, sb = b % 1024, swz = sb ^ (((sb >> 9) & 1) << 5); R = (st >> 1) * 16 + swz / 64; C = (st & 1) * 32 + (swz % 64) / 2; }
__host__ __device__ __forceinline__ int perm32(int rho) { const int n = rho >> 4, i = rho & 15; return 8 * (i >> 2) + 4 * n + (i & 3); }

struct Unit { int pm, pn; };
struct Gemm { const bf16_t* A; const bf16_t* Bt; int M, N, K; };

struct StaticOrder {
    int nM, nN, nwg, G, c;
    __host__ __device__ void init(int M, int N, int G_, int c_) { nM = M / BM; nN = N / BM; nwg = nM * nN; G = G_; c = c_; }
    __host__ __device__ bool next(int i, Unit& u) const {
        const long L = (long)i * G + c; if (L >= nwg) return false;
        int wgid = (int)L; { const int q = nwg / NXCD, r = nwg % NXCD, xcd = wgid % NXCD, off = wgid / NXCD; wgid = (xcd < r ? xcd * (q + 1) : r * (q + 1) + (xcd - r) * q) + off; }
        const int nig = WGM * nN, gid = wgid / nig, fm = gid * WGM, gsz = (nM - fm) < WGM ? (nM - fm) : WGM;
        u.pm = fm + ((wgid % nig) % gsz); u.pn = (wgid % nig) / gsz; return true;
    }
    __device__ __forceinline__ void a_ready(const Unit&) const {}
    __device__ __forceinline__ void done(const Unit&) const {}
};
template <class Epi, class Sched, bool ALIGN_EPI = false, bool SP2 = false>
__device__ __forceinline__ void gemm_phase(PG8_LAS unsigned char* lds, const Gemm g, const Sched& S, const Epi& E) {
    const int tid = threadIdx.x, wid = __builtin_amdgcn_readfirstlane(tid >> 6), lane = tid & 63, wr = wid >> 2, wc = wid & 3, fr = lane & 15, fq = lane >> 4;
    const int K = g.K, nt = K / BK;
    unsigned voffA[2], voffB[2];
#pragma unroll
    for (int i = 0; i < 2; ++i) { int R, C; stage_rc(tid * 16 + i * 8192, R, C); const int Rb = Epi::PERM ? ((R & ~31) + perm32(R & 31)) : R;
        voffA[i] = (unsigned)(R * K + C) * 2u; voffB[i] = (unsigned)(Rb * K + C) * 2u; }
    const size_t kstep = (size_t)(BK * 2);
    const size_t hstep = (size_t)HALF * K * 2;
    const size_t tstep = 2 * hstep;
    const unsigned ldsw = (unsigned)wid * 1024u;
    const int aoff = lds_byte(wr * 64 + fr, fq * 8), boff = lds_byte(wc * 32 + fr, fq * 8);
#define PG8_SA(b, h) (((b) * 2 + (h)) * HTB)
#define PG8_SB(b, h) ((4 + (b) * 2 + (h)) * HTB)
#define PG8_STAGE(bufoff, gbase, voff) do { _Pragma("unroll") for (int _i = 0; _i < 2; ++_i) \
        __builtin_amdgcn_global_load_lds((const unsigned*)((const char*)(gbase) + (voff)[_i]), (PG8_LAS unsigned*)(lds + (bufoff) + ldsw + _i * 8192), 16, 0, 0); } while (0)
#define PG8_LDA(dst, b, h) do { _Pragma("unroll") for (int m = 0; m < 4; ++m) _Pragma("unroll") for (int k = 0; k < 2; ++k) dst[m][k] = *(const PG8_LAS bf16x8*)(lds + PG8_SA(b, h) + aoff + m * 2048 + k * 1024); } while (0)
#define PG8_LDB(dst, b, h) do { _Pragma("unroll") for (int n = 0; n < 2; ++n) _Pragma("unroll") for (int k = 0; k < 2; ++k) dst[n][k] = *(const PG8_LAS bf16x8*)(lds + PG8_SB(b, h) + boff + n * 2048 + k * 1024); } while (0)
#define PG8_MMA(ai, bj, At, Bt) do { __builtin_amdgcn_s_setprio(1); _Pragma("unroll") for (int m = 0; m < 4; ++m) _Pragma("unroll") for (int n = 0; n < 2; ++n) _Pragma("unroll") for (int k = 0; k < 2; ++k) \
        acc[ai][bj][m][n] = __builtin_amdgcn_mfma_f32_16x16x32_bf16(Bt[n][k], At[m][k], acc[ai][bj][m][n], 0, 0, 0); __builtin_amdgcn_s_setprio(0); } while (0)
#define PG8_WAIT_V(n) asm volatile("s_waitcnt vmcnt(" #n ")" ::: "memory")
#define PG8_WAIT_L(n) asm volatile("s_waitcnt lgkmcnt(" #n ")" ::: "memory")
#define PG8_BAR __builtin_amdgcn_s_barrier()
#define PG8_SCHED __builtin_amdgcn_sched_barrier(0)
    Unit cur, nxt; int ui = 0;
    if (!S.next(0, cur)) return;
    f32x4 acc[2][2][4][2];
#pragma unroll
    for (int a = 0; a < 2; ++a)
#pragma unroll
        for (int b = 0; b < 2; ++b)
#pragma unroll
            for (int m = 0; m < 4; ++m)
#pragma unroll
                for (int n = 0; n < 2; ++n) acc[a][b][m][n] = (f32x4){0.f, 0.f, 0.f, 0.f};
    bf16x8 At[4][2], B0[2][2], B1[2][2];
    const char* cA = (const char*)g.A + (size_t)cur.pm * tstep; const char* cB = (const char*)g.Bt + (size_t)cur.pn * tstep;
    S.a_ready(cur);
    if constexpr (SP2) {
        PG8_STAGE(PG8_SB(0, 0), cB, voffB); PG8_STAGE(PG8_SB(0, 1), cB + hstep, voffB); PG8_STAGE(PG8_SA(0, 0), cA, voffA); PG8_STAGE(PG8_SA(0, 1), cA + hstep, voffA);
        if (wr == 1) PG8_BAR;
        PG8_WAIT_V(2); PG8_BAR;
        PG8_STAGE(PG8_SB(1, 0), cB + kstep, voffB); PG8_STAGE(PG8_SA(1, 0), cA + kstep, voffA); PG8_STAGE(PG8_SB(1, 1), cB + hstep + kstep, voffB);
        PG8_WAIT_V(6); PG8_BAR;
    } else {
        PG8_STAGE(PG8_SB(0, 0), cB, voffB); PG8_STAGE(PG8_SA(0, 0), cA, voffA); PG8_STAGE(PG8_SB(0, 1), cB + hstep, voffB); PG8_STAGE(PG8_SA(0, 1), cA + hstep, voffA);
        if (wr == 1) PG8_BAR;
        PG8_WAIT_V(4); PG8_BAR;
        PG8_STAGE(PG8_SB(1, 0), cB + kstep, voffB); PG8_STAGE(PG8_SA(1, 0), cA + kstep, voffA); PG8_STAGE(PG8_SB(1, 1), cB + hstep + kstep, voffB);
        PG8_WAIT_V(6); PG8_BAR;
    }
    for (;;) {
        const bool has_next = S.next(ui + 1, nxt);
        const char* nA = has_next ? (const char*)g.A + (size_t)nxt.pm * tstep : cA; const char* nB = has_next ? (const char*)g.Bt + (size_t)nxt.pn * tstep : cB;
        for (int t = 0; t < nt; t += 2) {
            const bool last = (t == nt - 2);
            const char* a1 = cA + (size_t)(t + 1) * kstep;
            const char* a2 = last ? nA : cA + (size_t)(t + 2) * kstep; const char* b2 = last ? nB : cB + (size_t)(t + 2) * kstep;
            const char* a3 = a2 + kstep; const char* b3 = b2 + kstep;
            if (last && has_next) S.a_ready(nxt);
            if constexpr (SP2) {
            PG8_LDB(B0, 0, 0); PG8_LDB(B1, 0, 1); PG8_SCHED; PG8_LDA(At, 0, 0); PG8_STAGE(PG8_SA(1, 1), a1 + hstep, voffA);
            PG8_WAIT_V(8); PG8_WAIT_L(0); PG8_BAR; PG8_MMA(0, 0, At, B0); PG8_MMA(0, 1, At, B1); PG8_BAR; PG8_SCHED;
            PG8_LDA(At, 0, 1); PG8_STAGE(PG8_SB(0, 0), b2, voffB); PG8_STAGE(PG8_SB(0, 1), b2 + hstep, voffB); PG8_STAGE(PG8_SA(0, 0), a2, voffA);
            PG8_WAIT_V(8); PG8_WAIT_L(0); PG8_BAR; PG8_MMA(1, 0, At, B0); PG8_MMA(1, 1, At, B1); PG8_BAR; PG8_SCHED;
            PG8_LDB(B0, 1, 0); PG8_LDB(B1, 1, 1); PG8_SCHED; PG8_LDA(At, 1, 0); PG8_STAGE(PG8_SA(0, 1), a2 + hstep, voffA);
            PG8_WAIT_V(8); PG8_WAIT_L(0); PG8_BAR; PG8_MMA(0, 0, At, B0); PG8_MMA(0, 1, At, B1); PG8_BAR; PG8_SCHED;
            PG8_LDA(At, 1, 1); PG8_STAGE(PG8_SB(1, 0), b3, voffB); PG8_STAGE(PG8_SB(1, 1), b3 + hstep, voffB); PG8_STAGE(PG8_SA(1, 0), a3, voffA);
            PG8_WAIT_V(8); PG8_WAIT_L(0); PG8_BAR; PG8_MMA(1, 0, At, B0); PG8_MMA(1, 1, At, B1); PG8_BAR; PG8_SCHED;
            } else {
            PG8_LDB(B0, 0, 0); PG8_SCHED; PG8_LDA(At, 0, 0); PG8_STAGE(PG8_SA(1, 1), a1 + hstep, voffA);
            PG8_WAIT_L(8); PG8_BAR; PG8_WAIT_L(0); PG8_MMA(0, 0, At, B0); PG8_BAR; PG8_SCHED;
            PG8_LDB(B1, 0, 1); PG8_STAGE(PG8_SB(0, 0), b2, voffB);
            PG8_BAR; PG8_WAIT_L(0); PG8_MMA(0, 1, At, B1); PG8_BAR;
            PG8_LDA(At, 0, 1); PG8_STAGE(PG8_SA(0, 0), a2, voffA);
            PG8_BAR; PG8_WAIT_L(0); PG8_MMA(1, 0, At, B0); PG8_BAR; PG8_SCHED;
            PG8_STAGE(PG8_SB(0, 1), b2 + hstep, voffB);
            PG8_WAIT_V(6); PG8_BAR; PG8_MMA(1, 1, At, B1); PG8_BAR;
            PG8_LDB(B0, 1, 0); PG8_SCHED; PG8_LDA(At, 1, 0); PG8_STAGE(PG8_SA(0, 1), a2 + hstep, voffA);
            PG8_WAIT_L(8); PG8_BAR; PG8_WAIT_L(0); PG8_MMA(0, 0, At, B0); PG8_BAR; PG8_SCHED;
            PG8_LDB(B1, 1, 1); PG8_STAGE(PG8_SB(1, 0), b3, voffB);
            PG8_BAR; PG8_WAIT_L(0); PG8_MMA(0, 1, At, B1); PG8_BAR;
            PG8_LDA(At, 1, 1); PG8_STAGE(PG8_SA(1, 0), a3, voffA);
            PG8_BAR; PG8_WAIT_L(0); PG8_MMA(1, 0, At, B0); PG8_BAR; PG8_SCHED;
            PG8_STAGE(PG8_SB(1, 1), b3 + hstep, voffB);
            PG8_WAIT_V(6); PG8_BAR; PG8_MMA(1, 1, At, B1); PG8_BAR;
            }
        }
        if constexpr (ALIGN_EPI) { if (wr == 0) PG8_BAR; }
        if constexpr (!Epi::AFTER_DRAIN) { E(acc, cur, wr, wc, fr, fq); S.done(cur); }
        if (!has_next) break;
#pragma unroll
        for (int a = 0; a < 2; ++a)
#pragma unroll
            for (int b = 0; b < 2; ++b)
#pragma unroll
                for (int m = 0; m < 4; ++m)
#pragma unroll
                    for (int n = 0; n < 2; ++n) acc[a][b][m][n] = (f32x4){0.f, 0.f, 0.f, 0.f};
        cur = nxt; cA = nA; cB = nB; ++ui;
        if constexpr (ALIGN_EPI) { if (wr == 1) PG8_BAR; }
    }
    PG8_WAIT_V(0);
    if constexpr (!ALIGN_EPI) { if (wr == 0) PG8_BAR; }
    PG8_BAR;
    if constexpr (Epi::AFTER_DRAIN) { E.fused(acc, cur, wr, wc, fr, fq, lds, wid, lane); S.done(cur); }
#undef PG8_SA
#undef PG8_SB
#undef PG8_STAGE
#undef PG8_LDA
#undef PG8_LDB
#undef PG8_MMA
#undef PG8_WAIT_V
#undef PG8_WAIT_L
#undef PG8_BAR
#undef PG8_SCHED
}
}

namespace pg8 {
__device__ __forceinline__ unsigned cvt_pk_bf16(float lo, float hi) { unsigned r; asm volatile("v_cvt_pk_bf16_f32 %0, %1, %2" : "=v"(r) : "v"(lo), "v"(hi)); return r; }
struct EpiE1x {
    static constexpr bool PERM = true, AFTER_DRAIN = false;
    bf16_t *U, *VT;
    __device__ __forceinline__ void operator()(const f32x4 (&acc)[2][2][4][2], const Unit& u, int wr, int wc, int fr, int fq) const {
        const int row0 = u.pm * BM + wr * 64 + fr, type = u.pn >> 1, colt = (u.pn & 1) * 256 + wc * 32 + 8 * fq;
        if (type < 2) {
            bf16_t* base = U + (size_t)type * ((size_t)T * 512);
            const float sc = type == 1 ? QSCALE : 1.f;
#pragma unroll
            for (int ai = 0; ai < 2; ++ai)
#pragma unroll
                for (int m = 0; m < 4; ++m) { bf16_t* rowp = base + (size_t)(row0 + ai * HALF + m * 16) * 512 + colt;
#pragma unroll
                    for (int bj = 0; bj < 2; ++bj) { const f32x4 v0 = acc[ai][bj][m][0] * sc, v1 = acc[ai][bj][m][1] * sc;
                        u32x4 w; w.x = cvt_pk_bf16(v0[0], v0[1]); w.y = cvt_pk_bf16(v0[2], v0[3]); w.z = cvt_pk_bf16(v1[0], v1[1]); w.w = cvt_pk_bf16(v1[2], v1[3]);
                        *(u32x4*)(rowp + bj * HALF) = w; } }
        } else if (type == 2) {
            bf16_t* KT = U + (size_t)2 * ((size_t)T * 512);
#pragma unroll
            for (int ai = 0; ai < 2; ++ai)
#pragma unroll
                for (int m = 0; m < 4; ++m) { const int row = row0 + ai * HALF + m * 16, b = row / SEQ, sq = row % SEQ;
#pragma unroll
                    for (int bj = 0; bj < 2; ++bj) { const int col = colt + bj * HALF, h = col >> 6, d0 = col & 63;
                        const f32x4 v0 = acc[ai][bj][m][0], v1 = acc[ai][bj][m][1];
                        u32x4 w; w.x = cvt_pk_bf16(v0[0], v0[1]); w.y = cvt_pk_bf16(v0[2], v0[3]); w.z = cvt_pk_bf16(v1[0], v1[1]); w.w = cvt_pk_bf16(v1[2], v1[3]);
                        *(u32x4*)(KT + ((((size_t)b * NHEAD + h) * 128 + (sq >> 5)) * 4 + (d0 >> 4)) * 512 + (((d0 >> 3) & 1) * 32 + (sq & 31)) * 8) = w; } }
        } else {
#pragma unroll
            for (int ai = 0; ai < 2; ++ai)
#pragma unroll
                for (int m = 0; m < 4; ++m) { const int row = row0 + ai * HALF + m * 16, b = row / SEQ, sq = row % SEQ, kvl = sq & 31;
                    const int sp = kvl >> 4, r = kvl & 15, hh = (r >> 2) & 1, e = (r & 3) + 4 * (r >> 3);
#pragma unroll
                    for (int bj = 0; bj < 2; ++bj) { const int col = colt + bj * HALF, h = col >> 6, d0 = col & 63;
                        bf16_t* p = VT + (((((size_t)b * NHEAD + h) * 128 + (sq >> 5)) * 2 + (d0 >> 5)) * 2 + sp) * 512 + (hh * 32 + (d0 & 31)) * 8 + e;
                        const f32x4 v0 = acc[ai][bj][m][0], v1 = acc[ai][bj][m][1];
                        const unsigned w0 = cvt_pk_bf16(v0[0], v0[1]), w1 = cvt_pk_bf16(v0[2], v0[3]), w2 = cvt_pk_bf16(v1[0], v1[1]), w3 = cvt_pk_bf16(v1[2], v1[3]);
                        p[0] = (bf16_t)w0; p[8] = (bf16_t)(w0 >> 16); p[16] = (bf16_t)w1; p[24] = (bf16_t)(w1 >> 16);
                        p[32] = (bf16_t)w2; p[40] = (bf16_t)(w2 >> 16); p[48] = (bf16_t)w3; p[56] = (bf16_t)(w3 >> 16); } }
        }
    }
};
struct EpiSplitX {
    static constexpr bool PERM = true, AFTER_DRAIN = false;
    bf16_t *A0;
    unsigned* xhalo;
    __device__ __forceinline__ void operator()(const f32x4 (&acc)[2][2][4][2], const Unit& u, int wr, int wc, int fr, int fq) const {
        const int row0 = u.pm * BM + wr * 64 + fr, colt = (u.pn & 7) * 256 + wc * 32 + 8 * fq;
        bf16_t* base = A0 + (size_t)(u.pn >> 3) * ((size_t)T * 2048);
#pragma unroll
        for (int ai = 0; ai < 2; ++ai)
#pragma unroll
            for (int m = 0; m < 4; ++m) { bf16_t* rowp = base + (size_t)(row0 + ai * HALF + m * 16) * 2048 + colt;
#pragma unroll
                for (int bj = 0; bj < 2; ++bj) { const f32x4 v0 = acc[ai][bj][m][0], v1 = acc[ai][bj][m][1];
                    u32x4 w; w.x = cvt_pk_bf16(v0[0], v0[1]); w.y = cvt_pk_bf16(v0[2], v0[3]); w.z = cvt_pk_bf16(v1[0], v1[1]); w.w = cvt_pk_bf16(v1[2], v1[3]);
                    *(u32x4*)(rowp + bj * HALF) = w;
                    if ((u.pn >> 3) == 0 && (u.pm & 3) == 3 && wr == 1 && ai == 1 && m == 3 && fr >= 13) { const int r = row0 + ai * HALF + m * 16;
                        const int unit = (r >> 12) * 32 + (u.pn & 7) * 4 + ((r >> 10) & 3);
                        *(u32x4*)(xhalo + ((size_t)unit * 3 + (fr - 13)) * 128 + (wc * 32 + 8 * fq + bj * HALF) / 2) = w; } } }
    }
};
struct EpiGateNorm {
    static constexpr bool PERM = true, AFTER_DRAIN = false;
    bf16_t* Y; PG8_LAS float* xch;
    __device__ __forceinline__ void operator()(f32x4 (&acc)[2][2][4][2], const Unit& u, int wr, int wc, int fr, int fq) const {
        const int row0 = u.pm * BM + wr * 64 + fr, colt = (u.pn & 7) * 256 + wc * 32 + 8 * fq;
#pragma unroll
        for (int ai = 0; ai < 2; ++ai)
#pragma unroll
            for (int m = 0; m < 4; ++m) { const bf16_t* rowp = Y + (size_t)(row0 + ai * HALF + m * 16) * 2048 + colt; float sq = 0.f;
#pragma unroll
                for (int bj = 0; bj < 2; ++bj) { const u32x4 y8 = *(const u32x4*)(rowp + bj * HALF);
#pragma unroll
                    for (int n = 0; n < 2; ++n)
#pragma unroll
                        for (int e = 0; e < 4; ++e) { const unsigned yw = y8[2 * n + (e >> 1)]; const float yv = (e & 1) ? __uint_as_float(yw & 0xffff0000u) : __uint_as_float(yw << 16);
                            const float z = acc[ai][bj][m][n][e]; const float gv = yv * z * __builtin_amdgcn_rcpf(1.f + __expf(-z));
                            acc[ai][bj][m][n][e] = gv; sq += gv * gv; } }
                sq = xhalf_sum(x16_sum(sq));
                if (fq == 0) xch[(ai * HALF + wr * 64 + m * 16 + fr) * 4 + wc] = sq; }
        asm volatile("s_waitcnt lgkmcnt(0)" ::: "memory"); __builtin_amdgcn_s_barrier(); asm volatile("" ::: "memory");
#pragma unroll
        for (int ai = 0; ai < 2; ++ai)
#pragma unroll
            for (int m = 0; m < 4; ++m) { const int r = ai * HALF + wr * 64 + m * 16 + fr; const f32x4 p4 = *(const PG8_LAS f32x4*)(xch + r * 4);
                const float rs = __builtin_amdgcn_rsqf(((p4[0] + p4[1]) + (p4[2] + p4[3])) * (1.0f / 256.0f) + 1e-6f);
                bf16_t* rowp = Y + (size_t)(row0 + ai * HALF + m * 16) * 2048 + colt;
#pragma unroll
                for (int bj = 0; bj < 2; ++bj) { const f32x4 v0 = acc[ai][bj][m][0] * rs, v1 = acc[ai][bj][m][1] * rs;
                    u32x4 w; w.x = cvt_pk_bf16(v0[0], v0[1]); w.y = cvt_pk_bf16(v0[2], v0[3]); w.z = cvt_pk_bf16(v1[0], v1[1]); w.w = cvt_pk_bf16(v1[2], v1[3]);
                    *(u32x4*)(rowp + bj * HALF) = w; } }
        asm volatile("s_waitcnt lgkmcnt(0)" ::: "memory"); __builtin_amdgcn_s_barrier(); asm volatile("" ::: "memory");
    }
};
template <bool BASE_F32>
struct EpiResGate {
    static constexpr bool PERM = true, AFTER_DRAIN = false;
    const void* base; bf16_t* out; const float* gate; float* ssp;
    __device__ __forceinline__ void operator()(const f32x4 (&acc)[2][2][4][2], const Unit& u, int wr, int wc, int fr, int fq) const {
        const int row0 = u.pm * BM + wr * 64 + fr, b = (u.pm * BM) / SEQ, col0 = u.pn * BM + wc * 32 + 8 * fq;
        f32x4 gv[2][2];
#pragma unroll
        for (int bj = 0; bj < 2; ++bj)
#pragma unroll
            for (int n = 0; n < 2; ++n) gv[bj][n] = *(const f32x4*)(gate + (size_t)b * 6144 + col0 + bj * HALF + n * 4);
        constexpr int MB = BASE_F32 ? 2 : 4;
#pragma unroll
        for (int ai = 0; ai < 2; ++ai)
#pragma unroll
            for (int m0 = 0; m0 < 4; m0 += MB) {
                f32x4 rf[MB][2][BASE_F32 ? 2 : 1]; u32x4 rx[MB][2];
#pragma unroll
                for (int mm = 0; mm < MB; ++mm) { const size_t off = (size_t)(row0 + ai * HALF + (m0 + mm) * 16) * D + col0;
#pragma unroll
                    for (int bj = 0; bj < 2; ++bj) {
                        if (BASE_F32) { rf[mm][bj][0] = *(const f32x4*)((const float*)base + off + bj * HALF); rf[mm][bj][BASE_F32 ? 1 : 0] = *(const f32x4*)((const float*)base + off + bj * HALF + 4); }
                        else rx[mm][bj] = *(const u32x4*)((const bf16_t*)base + off + bj * HALF); } }
#pragma unroll
                for (int mm = 0; mm < MB; ++mm) { const int m = m0 + mm; const size_t off = (size_t)(row0 + ai * HALF + m * 16) * D + col0; float sq = 0.f;
#pragma unroll
                    for (int bj = 0; bj < 2; ++bj) { f32x4 b0, b1;
                        if (BASE_F32) { b0 = rf[mm][bj][0]; b1 = rf[mm][bj][BASE_F32 ? 1 : 0]; }
                        else { const u32x4 x8 = rx[mm][bj];
                            b0[0] = __uint_as_float(x8.x << 16); b0[1] = __uint_as_float(x8.x & 0xffff0000u); b0[2] = __uint_as_float(x8.y << 16); b0[3] = __uint_as_float(x8.y & 0xffff0000u);
                            b1[0] = __uint_as_float(x8.z << 16); b1[1] = __uint_as_float(x8.z & 0xffff0000u); b1[2] = __uint_as_float(x8.w << 16); b1[3] = __uint_as_float(x8.w & 0xffff0000u); }
                        const f32x4 o0 = b0 + gv[bj][0] * acc[ai][bj][m][0], o1 = b1 + gv[bj][1] * acc[ai][bj][m][1];
                        sq += ((o0[0] * o0[0] + o0[1] * o0[1]) + (o0[2] * o0[2] + o0[3] * o0[3])) + ((o1[0] * o1[0] + o1[1] * o1[1]) + (o1[2] * o1[2] + o1[3] * o1[3]));
                        u32x4 w8; w8.x = cvt_pk_bf16(o0[0], o0[1]); w8.y = cvt_pk_bf16(o0[2], o0[3]); w8.z = cvt_pk_bf16(o1[0], o1[1]); w8.w = cvt_pk_bf16(o1[2], o1[3]);
                        *(u32x4*)(out + off + bj * HALF) = w8; }
                    sq = xhalf_sum(x16_sum(sq));
                    if (fq == 0) ssp[(size_t)(row0 + ai * HALF + m * 16) * 16 + u.pn * 4 + wc] = sq; }
            }
    }
};
}

#define XB_TMO      128
#define XB_XCNT(j)  (256  + 64 * (j))
#define XB_XSUB(j)  (1280 + 64 * (j))
#define XB_XGEN(j)  (2304 + 64 * (j))
#define XB_TOP      3328
#define XB_TOPGEN   3392
#define XCD_BAR_WORDS 3456
#define XB_SPIN_CAP (1u << 18)

__device__ __forceinline__ unsigned xb_ld(unsigned* p)              { return __hip_atomic_load(p, __ATOMIC_RELAXED, __HIP_MEMORY_SCOPE_AGENT); }
__device__ __forceinline__ unsigned xb_add(unsigned* p, unsigned v) { return __hip_atomic_fetch_add(p, v, __ATOMIC_RELAXED, __HIP_MEMORY_SCOPE_AGENT); }
__device__ __forceinline__ unsigned xb_xcc_id() { return (unsigned)__builtin_amdgcn_s_getreg((3 << 11) | 20) & 0xFu; }
#define XB_SPIN(cond, bar) do { unsigned _sp = 0; while (cond) { __builtin_amdgcn_s_sleep(1); \
    if ((++_sp & 255u) == 0u) { if (xb_ld(&(bar)[XB_TMO])) break; if (_sp > XB_SPIN_CAP) { atomicAdd(&(bar)[XB_TMO], 1u); break; } } } } while (0)

struct XcdBarrier {
    unsigned* bar; unsigned x;
    volatile LAS unsigned* st;
};

__device__ __forceinline__ XcdBarrier xcd_barrier_post(unsigned* bar, volatile LAS unsigned* st) {
    XcdBarrier b; b.bar = bar; b.x = xb_xcc_id(); b.st = st;
    if (threadIdx.x == 0) (void)xb_add(&bar[XB_XCNT(b.x)], 1u);
    return b;
}
__device__ __forceinline__ void xcd_barrier_complete(unsigned* bar, unsigned x, unsigned& nloc, unsigned& nx) {
    const unsigned G = gridDim.x * gridDim.y * gridDim.z;
    unsigned sum, cnt, mine, sp = 0u;
    for (;;) {
        sum = 0u; cnt = 0u; mine = 0u;
#pragma unroll
        for (unsigned j = 0; j < 16; ++j) { const unsigned c = xb_ld(&bar[XB_XCNT(j)]); sum += c; cnt += (c > 0u) ? 1u : 0u; mine = (j == x) ? c : mine; }
        if (sum == G) break;
        __builtin_amdgcn_s_sleep(1);
        if ((++sp & 255u) == 0u) { if (xb_ld(&bar[XB_TMO])) break; if (sp > XB_SPIN_CAP) { atomicAdd(&bar[XB_TMO], 1u); break; } }
    }
    nloc = mine > 0u ? mine : 1u; nx = cnt > 0u ? cnt : 1u;
}

__device__ __forceinline__ void xcd_barrier(const XcdBarrier& b) {
    asm volatile("s_waitcnt vmcnt(0)" ::: "memory");
    __syncthreads();
    if (threadIdx.x == 0) {
        unsigned* bar = b.bar;
        __builtin_amdgcn_s_waitcnt(0);
        unsigned nloc = b.st[0], nx = b.st[1];
        if (nloc == 0u) { xcd_barrier_complete(bar, b.x, nloc, nx); b.st[0] = nloc; b.st[1] = nx; }
        const unsigned old = xb_add(&bar[XB_XSUB(b.x)], 1u);
        const unsigned gen = old / nloc;
        if (old + 1u == (gen + 1u) * nloc) {
            __builtin_amdgcn_fence(__ATOMIC_RELEASE, "agent");
            asm volatile("s_waitcnt vmcnt(0)" ::: "memory");
            const unsigned og = xb_add(&bar[XB_TOP], 1u);
            const unsigned tg = og / nx;
            if (og + 1u == (tg + 1u) * nx) xb_add(&bar[XB_TOPGEN], 1u);
            else XB_SPIN(xb_ld(&bar[XB_TOPGEN]) == tg, bar);
            __builtin_amdgcn_fence(__ATOMIC_ACQUIRE, "agent");
            xb_add(&bar[XB_XGEN(b.x)], 1u);
            asm volatile("s_waitcnt vmcnt(0)" ::: "memory");
        } else {
            XB_SPIN(xb_ld(&bar[XB_XGEN(b.x)]) == gen, bar);
            __builtin_amdgcn_fence(__ATOMIC_ACQUIRE, "agent");
            asm volatile("s_waitcnt vmcnt(0)" ::: "memory");
        }
    }
    __syncthreads();
}

#define LDS_WAIT() asm volatile("s_waitcnt lgkmcnt(0)" ::: "memory")
template <int MODE>
__device__ __forceinline__ void transpose_item(const float* W, int ldw, int K, bf16_t* WT, int row_off, float* scr, int kb, int nb, int lane, const float* kscale) {
    const int k0 = 64 * kb, n0 = 64 * nb;
    const float* src = W + (size_t)k0 * ldw + n0 + lane;
    unsigned* scu = (unsigned*)scr;
    float v[64];
#pragma unroll
    for (int i = 0; i < 64; ++i) v[i] = src[(size_t)i * ldw];
    if (kscale) {
#pragma unroll
        for (int i = 0; i < 64; ++i) v[i] *= kscale[k0 + i]; }
#pragma unroll
    for (int i = 0; i < 32; ++i) scu[i * 66 + lane] = pk2(v[2 * i], v[2 * i + 1]);
    LDS_WAIT(); asm volatile("" ::: "memory");
    const int c = lane & 7;
#pragma unroll
    for (int j = 0; j < 8; ++j) { const int n = (lane >> 3) + 8 * j; const unsigned* s = scu + (4 * c) * 66 + n;
        u32x4 o; o.x = s[0]; o.y = s[66]; o.z = s[132]; o.w = s[198];
        const int ng = n0 + n, orow = MODE == 1 ? (row_off + 32 * (ng >> 4) + (ng & 15)) : (row_off + ng);
        if (MODE == 1) {
            const int kk = k0 + 8 * c; const size_t blk = ((size_t)(orow >> 5) * 32 + (kk >> 5)) * 2 + ((orow >> 4) & 1);
            *(u32x4*)(WT + (blk * 64 + ((kk >> 3) & 3) * 16 + (orow & 15)) * 8) = o;
        } else if (MODE == 3) {
            const int kk = k0 + 8 * c, u = orow & 31; const size_t blk = (size_t)(2 * (orow >> 5) + ((u >> 2) & 1)) * (K >> 5) + (kk >> 5);
            *(u32x4*)(WT + (blk * 64 + ((kk >> 3) & 3) * 16 + 4 * (u >> 3) + (u & 3)) * 8) = o;
        } else if (MODE == 2) {
            const int kk = k0 + 8 * c; const size_t blk = (size_t)(orow >> 4) * (K >> 5) + (kk >> 5);
            *(u32x4*)(WT + (blk * 64 + ((kk >> 3) & 3) * 16 + (orow & 15)) * 8) = o;
        } else *(u32x4*)(WT + (size_t)orow * K + k0 + 8 * c) = o; }
    LDS_WAIT(); asm volatile("" ::: "memory");
}
__device__ __forceinline__ void phase_convert(const Params& P, const Geo& g, float* ldsf) {
    float* scr = ldsf + g.wave * (64 * 33);
    const int gw = g.vcu * 8 + g.wave, NGW = g.G * 8;
    unsigned char* ws = P.ws;
    for (int e = gw * 64 + g.lane; e < DEPTH * 48 * D; e += NGW * 64) { const int Lr = e / (48 * D), rem = e % (48 * D), ct = rem / (16 * D), s_ = (rem / 512) & 31, ln = (rem >> 3) & 63, jj = rem & 7;
        const int j = 16 * ct + (ln & 15), k = 32 * s_ + 8 * (ln >> 4) + jj;
        const float v = j < 4 ? P.in[I_WG][((size_t)Lr * D + k) * 4 + j] : (j < 36 ? P.in[I_WE][((size_t)Lr * D + k) * 32 + j - 4] : 0.f);
        const unsigned hi = f2bf(v); ((bf16_t*)(ws + WS_WRH))[e] = (bf16_t)hi; ((bf16_t*)(ws + WS_WRL))[e] = (bf16_t)f2bf(v - bf2f(hi)); }
    for (int e = gw * 64 + g.lane; e < 2 * 32 * D; e += NGW * 64) { const int ir = e / (32 * D), rem = e % (32 * D), ct = rem / (16 * D), s_ = (rem / 512) & 31, ln = (rem >> 3) & 63, jj = rem & 7;
        const int j = 16 * ct + (ln & 15), k = 32 * s_ + 8 * (ln >> 4) + jj;
        const float v = P.in[I_SSMIN][((size_t)ir * D + k) * SSM_IN + 6144 + j];
        const unsigned hi = f2bf(v); ((bf16_t*)(ws + WS_WDH))[e] = (bf16_t)hi; ((bf16_t*)(ws + WS_WDL))[e] = (bf16_t)f2bf(v - bf2f(hi)); }
    constexpr int C0 = 2 * 512, C1 = C0 + 2 * 256, C2 = C1 + 2 * 1024, C3 = C2 + 2 * 512, C4 = C3 + 2 * 512, C5 = C4 + 8 * 4, C6 = C5 + 128 * 32, C7 = C6 + 128 * 32, C8 = C7 + 128 * 32;
    for (int it = gw; it < C8; it += NGW) {
        int r = it;
        if (r < C0) { const int mat = r / 512, rem = r % 512;
            transpose_item<0>(P.in[I_MIXIN] + (size_t)mat * D * MIX_IN, MIX_IN, D, (bf16_t*)(ws + WS_WMI) + (size_t)mat * MIX_IN * D, 0, scr, rem / 32, rem % 32, g.lane, nullptr); continue; }
        r -= C0;
        if (r < 2 * 256) { const int mat = r / 256, rem = r % 256;
            transpose_item<0>(P.in[I_MIXOUT] + (size_t)mat * D * D, D, D, (bf16_t*)(ws + WS_WMO) + (size_t)mat * D * D, 0, scr, rem / 16, rem % 16, g.lane, nullptr); continue; }
        r -= 2 * 256;
        if (r < 2 * 1024) { const int mat = r / 1024, rem = r % 1024;
            transpose_item<0>(P.in[I_SSMIN] + (size_t)mat * D * SSM_IN + 2048, SSM_IN, D, (bf16_t*)(ws + WS_WSX) + (size_t)mat * 4096 * D, 0, scr, rem / 64, rem % 64, g.lane, nullptr); continue; }
        r -= 2 * 1024;
        if (r < 2 * 512) { const int mat = r / 512, rem = r % 512;
            transpose_item<0>(P.in[I_SSMIN] + (size_t)mat * D * SSM_IN, SSM_IN, D, (bf16_t*)(ws + WS_WSZ) + (size_t)mat * 2048 * D, 0, scr, rem / 32, rem % 32, g.lane, nullptr); continue; }
        r -= 2 * 512;
        if (r < 2 * 512) { const int mat = r / 512, rem = r % 512;
            transpose_item<0>(P.in[I_SSMOUT] + (size_t)mat * SSM_DI * D, D, SSM_DI, (bf16_t*)(ws + WS_WSO) + (size_t)mat * D * SSM_DI, 0, scr, rem / 16, rem % 16, g.lane, P.in[I_SSMNW] + mat * SSM_DI); continue; }
        r -= 2 * 512;
        if (r < 32) { const int mat = r / 4, rem = r % 4;
            transpose_item<0>(P.in[I_POOLW] + (size_t)mat * 128 * 128, 128, 128, (bf16_t*)(ws + WS_WPL) + (size_t)mat * 128 * 128, 0, scr, rem / 2, rem % 2, g.lane, nullptr); continue; }
        r -= 32;
        if (r < 128 * 32) { const int mat = r / 32, rem = r % 32;
            transpose_item<1>(P.in[I_W1] + (size_t)mat * D * MOE_FF, MOE_FF, D, (bf16_t*)(ws + WS_W13) + (size_t)mat * 256 * D, 0, scr, rem / 2, rem % 2, g.lane, nullptr); continue; }
        r -= 128 * 32;
        if (r < 128 * 32) { const int mat = r / 32, rem = r % 32;
            transpose_item<1>(P.in[I_W3] + (size_t)mat * D * MOE_FF, MOE_FF, D, (bf16_t*)(ws + WS_W13) + (size_t)mat * 256 * D, 16, scr, rem / 2, rem % 2, g.lane, nullptr); continue; }
        r -= 128 * 32;
        { const int mat = r / 32, rem = r % 32;
            transpose_item<3>(P.in[I_W2] + (size_t)mat * MOE_FF * D, D, MOE_FF, (bf16_t*)(ws + WS_W2T) + (size_t)mat * D * MOE_FF, 0, scr, rem / 16, rem % 16, g.lane, nullptr); }
    }
}


#define LDS_BARRIER() do { asm volatile("s_waitcnt lgkmcnt(0)" ::: "memory"); __builtin_amdgcn_s_barrier(); asm volatile("" ::: "memory"); } while (0)
template <int NMT>
__device__ __forceinline__ void moe_pass(const Params& P, LAS unsigned char* l3, int L, int w, int lane, int bucket, int off, int nrows, int e0, int e1, bool dry) {
    constexpr int HS = 528, OFF_B1 = 67584, OFF_GT = 67584;
    constexpr int OFF_TOK = 133120, OFF_WLO = OFF_TOK + 512, OFF_WHI = OFF_WLO + 512;
    LAS int* tok = (LAS int*)(l3 + OFF_TOK); LAS float* wlo = (LAS float*)(l3 + OFF_WLO); LAS float* whi = (LAS float*)(l3 + OFF_WHI);
    unsigned char* ws = P.ws;
    const int* list = (const int*)(ws + WS_LIST);
    const float2* tokw = (const float2*)(ws + WS_TOKW);
    const bf16_t* H = (const bf16_t*)P.out;
    const float* gate2 = (const float*)(ws + WS_MOD) + (size_t)L * NB * 6144 + 5120;
    const int j16 = lane & 15, q4 = lane >> 4, tid = w * 64 + lane;
    float2 tww = make_float2(0.f, 0.f);
    if (tid < 128) { const int r = tid; int t = -1;
        if (r < nrows) { t = list[(size_t)bucket * T + off + r]; tww = tokw[t]; }
        tok[r] = t; }
    LDS_BARRIER();
#define MOE_GATHER(KC, BO) do { if (w < NMT) { _Pragma("unroll") for (int i = 0; i < 8; ++i) { int t = tok[16 * w + 2 * i + (lane >> 5)]; t = t < 0 ? 0 : t; \
        const int s = (lane & 31) ^ ((2 * i + (lane >> 5)) & 15); \
        __builtin_amdgcn_global_load_lds((const unsigned*)(H + (size_t)t * D + (KC) * 256 + s * 8), (LAS unsigned*)(l3 + (BO) + (16 * w + 2 * i) * 512), 16, 0, 0); } } } while (0)
    f32x4 gtv[4];
    {
        const char* Wu0 = (const char*)(ws + WS_W13) + ((size_t)(L * MOE_E + e0) * 256 * D + (size_t)w * 32 * 1024) * 2;
        const char* Wu1 = (const char*)(ws + WS_W13) + ((size_t)(L * MOE_E + e1) * 256 * D + (size_t)w * 32 * 1024) * 2;
        const unsigned lo16 = (unsigned)lane * 16u;
#define W13F(U, KS, S) (*(const bf16x8*)((U) + (size_t)(lo16 + (unsigned)(2048 * (KS) + 1024 * (S)))))
        f32x4 acc[2][NMT][2];
#pragma unroll
        for (int es = 0; es < 2; ++es)
#pragma unroll
            for (int mt = 0; mt < NMT; ++mt) { acc[es][mt][0] = (f32x4){0.f, 0.f, 0.f, 0.f}; acc[es][mt][1] = (f32x4){0.f, 0.f, 0.f, 0.f}; }
        MOE_GATHER(0, 0);
        asm volatile("" ::: "memory");
        bf16x8 rb[2][4];
#pragma unroll
        for (int j = 0; j < 2; ++j) { rb[j][0] = W13F(Wu0, j, 0); rb[j][1] = W13F(Wu0, j, 1); rb[j][2] = W13F(Wu1, j, 0); rb[j][3] = W13F(Wu1, j, 1); }
        if (tid < 128) { wlo[tid] = tww.x; whi[tid] = tww.y; }
        asm volatile("s_waitcnt vmcnt(8)" ::: "memory");
        LDS_BARRIER();
#pragma unroll 1
        for (int kc = 0; kc < 4; ++kc) {
            int lk = lane; asm volatile("" : "+v"(lk));
            const int lane = lk, j16 = lane & 15, q4 = lane >> 4; const unsigned lo16 = (unsigned)lane * 16u;
            const int aoff = j16 * 512 + ((q4 ^ j16) << 4);
            const int bo = (kc & 1) ? OFF_B1 : 0;
            if (kc < 3) { if (kc & 1) MOE_GATHER(kc + 1, 0); else MOE_GATHER(kc + 1, OFF_B1); }
            asm volatile("" ::: "memory");
#pragma unroll
            for (int ksl = 0; ksl < 8; ++ksl) {
                const int ks = 8 * kc + ksl;
                const LAS unsigned char* ap = l3 + bo + (aoff ^ (ksl << 6));
#pragma unroll
                for (int mt = 0; mt < NMT; ++mt) { const bf16x8 a = *(const LAS bf16x8*)(ap + mt * 8192);
                    acc[0][mt][0] = __builtin_amdgcn_mfma_f32_16x16x32_bf16(a, rb[ksl & 1][0], acc[0][mt][0], 0, 0, 0);
                    acc[0][mt][1] = __builtin_amdgcn_mfma_f32_16x16x32_bf16(a, rb[ksl & 1][1], acc[0][mt][1], 0, 0, 0); }
                if (kc < 3 || ksl < 6) { rb[ksl & 1][0] = W13F(Wu0, ks + 2, 0); rb[ksl & 1][1] = W13F(Wu0, ks + 2, 1); }
#pragma unroll
                for (int mt = 0; mt < NMT; ++mt) { const bf16x8 a = *(const LAS bf16x8*)(ap + mt * 8192);
                    acc[1][mt][0] = __builtin_amdgcn_mfma_f32_16x16x32_bf16(a, rb[ksl & 1][2], acc[1][mt][0], 0, 0, 0);
                    acc[1][mt][1] = __builtin_amdgcn_mfma_f32_16x16x32_bf16(a, rb[ksl & 1][3], acc[1][mt][1], 0, 0, 0); }
                if (kc < 3 || ksl < 6) { rb[ksl & 1][2] = W13F(Wu1, ks + 2, 0); rb[ksl & 1][3] = W13F(Wu1, ks + 2, 1); }
                __builtin_amdgcn_sched_barrier(0);
            }
            if (kc < 3) { asm volatile("s_waitcnt vmcnt(8)" ::: "memory"); LDS_BARRIER(); }
        }
        int l2 = lane; asm volatile("" : "+v"(l2));
        { const int lane = l2, j16 = lane & 15, q4 = lane >> 4, tid = w * 64 + lane;
#pragma unroll
        for (int i = 0; i < 4; ++i) { const int e = tid + 512 * i; gtv[i] = *(const f32x4*)(gate2 + (size_t)(e >> 8) * 6144 + (e & 255) * 4); }
#pragma unroll
        for (int es = 0; es < 2; ++es)
#pragma unroll
            for (int mt = 0; mt < NMT; ++mt) {
#pragma unroll
                for (int r = 0; r < 4; ++r) { const int l = 16 * mt + 4 * q4 + r; const float wt = es ? whi[l] : wlo[l];
                    *(LAS bf16_t*)(l3 + l * 512 + (((16 * es + 2 * w + (j16 >> 3)) ^ (4 * q4 + r)) << 4) + (j16 & 7) * 2) = (bf16_t)f2bf(silu_f(acc[es][mt][0][r]) * acc[es][mt][1][r] * wt); } }
        }
    }
#undef MOE_GATHER
#undef W13F
    int l4 = lane; asm volatile("" : "+v"(l4));
    { const int lane = l4, j16 = lane & 15, q4 = lane >> 4, tid = w * 64 + lane;
    LDS_BARRIER();
#pragma unroll
    for (int i = 0; i < 4; ++i) { const int e = tid + 512 * i; *(LAS f32x4*)(l3 + OFF_GT + (e >> 8) * 4112 + (e & 255) * 16) = gtv[i]; }
    LDS_BARRIER();
#pragma unroll 1
    for (int half = 0; half < 2; ++half) {
        int lh = lane; asm volatile("" : "+v"(lh));
        const int lane = lh, j16 = lane & 15, q4 = lane >> 4;
        const int nb = 128 * w + 64 * half;
        f32x4 acc[NMT][4];
#pragma unroll
        for (int mt = 0; mt < NMT; ++mt)
#pragma unroll
            for (int nt = 0; nt < 4; ++nt) acc[mt][nt] = (f32x4){0.f, 0.f, 0.f, 0.f};
        const char* Vu0 = (const char*)(ws + WS_W2T) + ((size_t)(L * MOE_E + e0) * D * MOE_FF + (size_t)(nb >> 4) * 4 * 512) * 2;
        const char* Vu1 = (const char*)(ws + WS_W2T) + ((size_t)(L * MOE_E + e1) * D * MOE_FF + (size_t)(nb >> 4) * 4 * 512) * 2;
        const unsigned lo16b = (unsigned)lane * 16u;
#define W2F(KS, NT) (*(const bf16x8*)((((KS) >> 2) ? Vu1 : Vu0) + (size_t)(lo16b + (unsigned)(1024 * ((KS) & 3) + 4096 * (NT)))))
#define MOE_XLOAD(MG, BUF) do { _Pragma("unroll") for (int m4 = 0; m4 < 2; ++m4) { int t = tok[16 * (2 * (MG) + m4) + j16]; asm volatile("" : "+v"(t)); tt[BUF][m4] = t; const int tc = t < 0 ? 0 : t; \
            const bf16_t* xr_ = (const bf16_t*)(ws + WS_XB) + (size_t)tc * D + nb + 8 * q4; \
            _Pragma("unroll") for (int np = 0; np < 2; ++np) xin[BUF][m4][np] = *(const u32x4*)(xr_ + 32 * np); } } while (0)
        int tt[2][2]; u32x4 xin[2][2][2];
        bf16x8 bw[2][4];
#pragma unroll
        for (int j = 0; j < 2; ++j)
#pragma unroll
            for (int nt = 0; nt < 4; ++nt) bw[j][nt] = W2F(j, nt);
#pragma unroll
        for (int ks = 0; ks < 8; ++ks) {
            bf16x8 b[4];
#pragma unroll
            for (int nt = 0; nt < 4; ++nt) b[nt] = bw[ks & 1][nt];
            if (ks + 2 < 8) {
#pragma unroll
                for (int nt = 0; nt < 4; ++nt) bw[ks & 1][nt] = W2F(ks + 2, nt); }
            if (ks == 6) MOE_XLOAD(0, 0);
#pragma unroll
            for (int mt = 0; mt < NMT; ++mt) { const bf16x8 a = *(const LAS bf16x8*)(l3 + (16 * mt + j16) * 512 + (((4 * ks + q4) ^ j16) << 4));
#pragma unroll
                for (int nt = 0; nt < 4; ++nt) acc[mt][nt] = __builtin_amdgcn_mfma_f32_16x16x32_bf16(b[nt], a, acc[mt][nt], 0, 0, 0); }
            __builtin_amdgcn_sched_barrier(0);
        }
#undef W2F
#pragma unroll
        for (int mg = 0; mg < NMT / 2; ++mg) {
            if (mg + 1 < NMT / 2) MOE_XLOAD(mg + 1, (mg + 1) & 1);
#pragma unroll
            for (int m4 = 0; m4 < 2; ++m4) { const int t = tt[mg & 1][m4], mt = 2 * mg + m4; float sq = 0.f;
                if (t >= 0) { const int b = t / SEQ; bf16_t* xr = (bf16_t*)(ws + WS_XB) + (size_t)t * D + nb + 8 * q4; const LAS float* gr = (const LAS float*)(l3 + OFF_GT) + b * 1028 + nb + 8 * q4;
#pragma unroll
                    for (int np = 0; np < 2; ++np) { const f32x4 g0 = *(const LAS f32x4*)(gr + 32 * np), g1 = *(const LAS f32x4*)(gr + 32 * np + 4);
                        const u32x4 x8 = xin[mg & 1][m4][np];
                        f32x4 x0, x1; x0[0] = bf2f(x8.x & 0xffffu); x0[1] = bf2f(x8.x >> 16); x0[2] = bf2f(x8.y & 0xffffu); x0[3] = bf2f(x8.y >> 16);
                        x1[0] = bf2f(x8.z & 0xffffu); x1[1] = bf2f(x8.z >> 16); x1[2] = bf2f(x8.w & 0xffffu); x1[3] = bf2f(x8.w >> 16);
                        const f32x4 o0 = x0 + g0 * acc[mt][2 * np], o1 = x1 + g1 * acc[mt][2 * np + 1];
                        sq += ((o0[0] * o0[0] + o0[1] * o0[1]) + (o0[2] * o0[2] + o0[3] * o0[3])) + ((o1[0] * o1[0] + o1[1] * o1[1]) + (o1[2] * o1[2] + o1[3] * o1[3]));
                        u32x4 w8; w8.x = pk2(o0[0], o0[1]); w8.y = pk2(o0[2], o0[3]); w8.z = pk2(o1[0], o1[1]); w8.w = pk2(o1[2], o1[3]);
                        if (!dry) *(u32x4*)(xr + 32 * np) = w8; } }
                sq = xhalf_sum(x16_sum(sq));
                if (!dry && t >= 0 && q4 == 0) ((float*)(ws + WS_SSP))[(size_t)t * 16 + 2 * w + half] = sq; }
        }
#undef MOE_XLOAD
    }
    }
    __syncthreads();
}
__device__ __forceinline__ void phase_moe(const Params& P, const Geo& g, LAS unsigned char* l3, int L, bool dry = false) {
    constexpr int HS = 528, OFF_B1 = 67584, OFF_GT = 67584;
    constexpr int OFF_TOK = 133120, OFF_WLO = OFF_TOK + 512, OFF_WHI = OFF_WLO + 512, OFF_PF = OFF_WHI + 512;
    LAS int* tok = (LAS int*)(l3 + OFF_TOK); LAS float* wlo = (LAS float*)(l3 + OFF_WLO); LAS float* whi = (LAS float*)(l3 + OFF_WHI); LAS int* pf = (LAS int*)(l3 + OFF_PF);
    unsigned char* ws = P.ws;
    const unsigned* cnt = (const unsigned*)(ws + WS_CTL) + CW_CNT + L * 128 * 16;
    const int* list = (const int*)(ws + WS_LIST);
    const float2* tokw = (const float2*)(ws + WS_TOKW);
    const bf16_t* H = (const bf16_t*)P.out;
    const float* gate2 = (const float*)(ws + WS_MOD) + (size_t)L * NB * 6144 + 5120;
    const int w = g.wave;
    LAS int* cn = pf + 128;
    if (g.tid < 128) { const int c = g.tid < NBUCKET ? (int)cnt[g.tid * 16] : 0; int sc = c;
#pragma unroll
        for (int o = 1; o < 64; o <<= 1) { const int nbv = __shfl_up(sc, o); sc += (g.lane >= o) ? nbv : 0; }
        pf[g.tid] = sc - c; if (g.tid == 63) cn[0] = sc; }
    __syncthreads();
    if (g.tid >= 64 && g.tid < 128) pf[g.tid] += cn[0];
    __syncthreads();
    const int rows_per = (T + g.G - 1) / g.G;
    int cur = g.vcu * rows_per; const int end = min(T, cur + rows_per);
    int bucket = 0;
    if (cur < end) {
#pragma unroll
        for (int st = 64; st > 0; st >>= 1) if (bucket + st <= NBUCKET - 1 && pf[bucket + st] <= cur) bucket += st; }
    while (cur < end) {
        int lane = g.lane; asm volatile("" : "+v"(lane));
        while (pf[bucket + 1] <= cur) ++bucket;
        const int off = cur - pf[bucket];
        const int nrows = min(min(128, end - cur), pf[bucket + 1] - cur);
        cur += nrows;
        const int nmt = (nrows + 15) >> 4;
        const int g4 = bucket / 28; int rem = bucket % 28, elo = 0;
        while (rem >= 7 - elo) { rem -= 7 - elo; ++elo; }
        const int ehi = elo + 1 + rem;
        const int e0 = g4 * 8 + elo, e1 = g4 * 8 + ehi;
        if (nmt > 6) moe_pass<8>(P, l3, L, w, lane, bucket, off, nrows, e0, e1, dry); else if (nmt > 4) moe_pass<6>(P, l3, L, w, lane, bucket, off, nrows, e0, e1, dry);
        else if (nmt > 2) moe_pass<4>(P, l3, L, w, lane, bucket, off, nrows, e0, e1, dry); else moe_pass<2>(P, l3, L, w, lane, bucket, off, nrows, e0, e1, dry);
    }
}


#define MFMA16(a, b, c) __builtin_amdgcn_mfma_f32_16x16x32_bf16(a, b, c, 0, 0, 0)
constexpr size_t WS_SLOC = WS_LIST;
constexpr size_t WS_ATOT = WS_TOKE;
constexpr size_t WS_XHALO = WS_TOKW;
template <int PASS>
__device__ __forceinline__ void scan_units(const Params& P, const Geo& g, LAS unsigned char* l3, int L, bool dry) {
    constexpr bool FULL = PASS >= 2;
    constexpr int S128 = 272, S64 = 144, SCB = 272;
    constexpr int O_CC = 0, O_BC = 17408, O_BCT = 34816, O_CB = 53248, O_XST = 70656, O_XPT = 107520;
    constexpr int O_ACS = 144384, O_DTV = O_ACS + 2048, O_SCL = O_DTV + 2048, O_EAL = O_SCL + 2048, O_HALO = O_EAL + 2048;
    const int i2 = L >> 1, lane = g.lane, w = g.wave, tid = g.tid;
    unsigned char* ws = P.ws;
    bf16_t* XS = (bf16_t*)(ws + WS_XS); const float* DT = (const float*)(ws + WS_DT);
    const auto rsx = __builtin_amdgcn_make_buffer_rsrc((void*)((char*)XS - 3 * 4096), (short)0, (int)((256u << 20) + 3 * 4096), 0x00020000);
    for (int u = g.vcu; u < 256; u += g.G) {
        const int b = u >> 5, gq = (u >> 2) & 7, sc = u & 3;
        const size_t tb = (size_t)b * SEQ + (size_t)sc * 1024;
        const int cp = tid & 255, half = tid >> 8;
        const bool act = FULL || (cp < 192);
        const int ch = cp < 128 ? (4 * gq) * 64 + 2 * cp : (cp < 192 ? 2048 + gq * 128 + 2 * (cp - 128) : 3072 + gq * 128 + 2 * (cp - 192));
        const unsigned colb = cp < 128 ? (unsigned)ch * 2u : (unsigned)(WS_BC - WS_XS) + (unsigned)(ch - 2048) * 2u;
        const unsigned voff = colb + (unsigned)half * 32u * 4096u;
        const int hd0 = 4 * gq;
        const float Ah_s0 = -__expf(P.in[I_ALOG][i2 * SSM_H + hd0 + (w & 3)]);
        float Dk[2]; Dk[0] = P.in[I_SSMD][i2 * SSM_H + hd0 + (w >> 1)]; Dk[1] = Dk[0];
        f32x4 S0[8], S1[8];
#pragma unroll
        for (int i = 0; i < 8; ++i) { S0[i] = (f32x4){0.f, 0.f, 0.f, 0.f}; S1[i] = (f32x4){0.f, 0.f, 0.f, 0.f}; }
        if (PASS == 2 && sc > 0) {
            const float* AT = (const float*)(ws + WS_ATOT);
#pragma unroll 1
            for (int j = 0; j < sc; ++j) {
                const int uj = (u >> 2) * 3 + j;
                float f0 = 0.f, f1 = 0.f;
                for (int i = j + 1; i < sc; ++i) { f0 += AT[((u & ~3) | i) * 4 + (w >> 2)]; f1 += AT[((u & ~3) | i) * 4 + 2 + (w >> 2)]; }
                f0 = __expf(f0); f1 = __expf(f1);
                const u32x4* sp0 = (const u32x4*)(ws + WS_SLOC) + (((size_t)uj * 2 + 0) * 8 + w) * 256 + lane * 4;
                const u32x4* sp1 = (const u32x4*)(ws + WS_SLOC) + (((size_t)uj * 2 + 1) * 8 + w) * 256 + lane * 4;
#pragma unroll
                for (int i = 0; i < 4; ++i) { const u32x4 a = sp0[i], c = sp1[i];
#pragma unroll
                    for (int e = 0; e < 4; ++e) { const int nt = 2 * i + (e >> 1), r = 2 * (e & 1);
                        S0[nt][r] += f0 * bf2f(a[e] & 0xffffu); S0[nt][r + 1] += f0 * bf2f(a[e] >> 16);
                        S1[nt][r] += f1 * bf2f(c[e] & 0xffffu); S1[nt][r + 1] += f1 * bf2f(c[e] >> 16); } }
            }
        }
        float atot = 0.f;
        unsigned raw[35]; float dt_pf = 0.f;
        {
#pragma unroll
            for (int i = 0; i < 35; ++i) raw[i] = act ? (unsigned)__builtin_amdgcn_raw_buffer_load_b32(rsx, voff, (unsigned)(((int)tb + i) * 4096), 0) : 0u;
            if (half == 0) {
                if (sc == 0) { raw[0] = 0u; raw[1] = 0u; raw[2] = 0u; }
                else if (FULL && cp < 128) {
#pragma unroll
                    for (int i = 0; i < 3; ++i) raw[i] = ((const unsigned*)(ws + WS_XHALO))[((size_t)(u - 1) * 3 + i) * 128 + cp]; }
            }
            if (w < 4) dt_pf = DT[(tb + lane) * 32 + hd0 + w];
        }
#define SCAN_STEP0(CN) do { if (w < 4) { const int pn_ = (CN) & 1; const float dt = dt_pf; float a = dt * Ah_s0; \
            a = wave_incl_scan(a); const float aend = wave_last(a); \
            ((LAS float*)(l3 + O_ACS))[pn_ * 256 + w * 64 + lane] = a * LOG2E; ((LAS float*)(l3 + O_DTV))[pn_ * 256 + w * 64 + lane] = a * LOG2E - __builtin_amdgcn_logf(dt);   \
            ((LAS float*)(l3 + O_SCL))[pn_ * 256 + w * 64 + lane] = dt * __expf(aend - a); ((LAS float*)(l3 + O_EAL))[pn_ * 256 + w * 64 + lane] = __expf(a); \
            atot += aend; \
            if ((CN) + 1 < 16) dt_pf = DT[(tb + (size_t)((CN) + 1) * 64 + lane) * 32 + hd0 + w]; } } while (0)
        SCAN_STEP0(0);
        __syncthreads();
#pragma unroll 1
        for (int c = 0; c < 16; ++c) {
            const size_t t0 = tb + (size_t)c * 64;
            const int par = c & 1;
            int lane_o = lane; asm volatile("" : "+v"(lane_o));
            const int j16 = lane_o & 15, q4 = lane_o >> 4;
            LAS float* acs = (LAS float*)(l3 + O_ACS) + par * 256; LAS float* dtv = (LAS float*)(l3 + O_DTV) + par * 256;
            LAS float* scl = (LAS float*)(l3 + O_SCL) + par * 256; LAS float* eal = (LAS float*)(l3 + O_EAL) + par * 256;
            if (act) {
                int cpo = cp; asm volatile("" : "+v"(cpo));
                float cw0[5], cw1[5];
                { const int cho = cpo < 128 ? (4 * gq) * 64 + 2 * cpo : (cpo < 192 ? 2048 + gq * 128 + 2 * (cpo - 128) : 3072 + gq * 128 + 2 * (cpo - 192));
                  const float* cwp = P.in[I_CONVW] + (size_t)i2 * 4 * SSM_CONV + cho;
#pragma unroll
                  for (int tp = 0; tp < 4; ++tp) { const f32x2 t2 = *(const f32x2*)(cwp + tp * SSM_CONV); cw0[tp] = t2.x; cw1[tp] = t2.y; }
                  const f32x2 t2 = *(const f32x2*)(P.in[I_CONVB] + (size_t)i2 * SSM_CONV + cho); cw0[4] = t2.x; cw1[4] = t2.y; }
                if (c > 0 && cpo < 128 && half == 0) {
#pragma unroll
                    for (int i = 0; i < 3; ++i) raw[i] = *(const LAS unsigned*)(l3 + O_HALO + (((c - 1) & 1) * 3 + i) * 512 + cpo * 4); }
                if (cpo < 128 && half == 1) {
#pragma unroll
                    for (int i = 0; i < 3; ++i) *(LAS unsigned*)(l3 + O_HALO + ((c & 1) * 3 + i) * 512 + cpo * 4) = raw[32 + i];
                    if (PASS == 1 && c == 15) {
#pragma unroll
                        for (int i = 0; i < 3; ++i) ((unsigned*)(ws + WS_XHALO))[((size_t)u * 3 + i) * 128 + cpo] = raw[32 + i]; }
                }
                const int hq = cpo >> 5;
                LAS unsigned char* bxs = l3 + O_XST + hq * 9216 + (2 * (cpo & 31)) * S64 + 64 * half;
                LAS unsigned char* bbc = l3 + O_BC + (32 * half) * S128 + (2 * (cpo - 128)) * 2;
                LAS unsigned char* bbt = l3 + O_BCT + (2 * (cpo - 128)) * S64 + 64 * half;
                LAS unsigned char* bcc = l3 + O_CC + (32 * half) * S128 + (2 * (cpo - 192)) * 2;
                const LAS float* scb = scl + hq * 64 + 32 * half;
#pragma unroll
                for (int j = 0; j < 8; ++j) {
                    float v0[4], v1[4];
#pragma unroll
                    for (int o = 0; o < 4; ++o) { float a0 = cw0[4], a1 = cw1[4];
#pragma unroll
                        for (int tp = 0; tp < 4; ++tp) { a0 += cw0[tp] * bf2f(raw[4 * j + o + tp] & 0xffffu); a1 += cw1[tp] * bf2f(raw[4 * j + o + tp] >> 16); }
                        const f32x2 ap = (f32x2){a0, a1}; const f32x2 tp2 = ap * (-LOG2E);
                        f32x2 den; den.x = __builtin_amdgcn_exp2f(tp2.x); den.y = __builtin_amdgcn_exp2f(tp2.y); den = den + 1.f;
                        f32x2 rc; rc.x = __builtin_amdgcn_rcpf(den.x); rc.y = __builtin_amdgcn_rcpf(den.y);
                        const f32x2 sv = ap * rc; v0[o] = sv.x; v1[o] = sv.y; }
                    if (cpo < 128) {
                        if (FULL) { u32x2 x0, x1; x0.x = pk2(v0[0], v0[1]); x0.y = pk2(v0[2], v0[3]); x1.x = pk2(v1[0], v1[1]); x1.y = pk2(v1[2], v1[3]);
                            *(LAS u32x2*)(bxs + 8 * j) = x0; *(LAS u32x2*)(bxs + S64 + 8 * j) = x1; }
                        const f32x4 s4 = *(const LAS f32x4*)(scb + 4 * j);
                        u32x2 y0, y1; y0.x = pk2(v0[0] * s4.x, v0[1] * s4.y); y0.y = pk2(v0[2] * s4.z, v0[3] * s4.w); y1.x = pk2(v1[0] * s4.x, v1[1] * s4.y); y1.y = pk2(v1[2] * s4.z, v1[3] * s4.w);
                        *(LAS u32x2*)(bxs + (O_XPT - O_XST) + 8 * j) = y0; *(LAS u32x2*)(bxs + (O_XPT - O_XST) + S64 + 8 * j) = y1;
                    } else if (cpo < 192) {
                        if (FULL) {
#pragma unroll
                            for (int o = 0; o < 4; ++o) *(LAS unsigned*)(bbc + (4 * j + o) * S128) = pk2(v0[o], v1[o]); }
                        u32x2 x0, x1; x0.x = pk2(v0[0], v0[1]); x0.y = pk2(v0[2], v0[3]); x1.x = pk2(v1[0], v1[1]); x1.y = pk2(v1[2], v1[3]);
                        *(LAS u32x2*)(bbt + 8 * j) = x0; *(LAS u32x2*)(bbt + S64 + 8 * j) = x1;
                    } else {
#pragma unroll
                        for (int o = 0; o < 4; ++o) *(LAS unsigned*)(bcc + (4 * j + o) * S128) = pk2(v0[o], v1[o]);
                    }
                }
            }
            __syncthreads();
            if (PASS == 3 && sc > 0) {
                const int r_ = tid >> 3, pc_ = tid & 7;
                const u32x4 c0_ = *(const LAS u32x4*)(l3 + O_CC + r_ * S128 + pc_ * 32), c1_ = *(const LAS u32x4*)(l3 + O_CC + r_ * S128 + pc_ * 32 + 16);
                u32x4* dst_ = (u32x4*)((bf16_t*)P.out + (size_t)T * D + (t0 + r_) * 1024 + gq * 128 + pc_ * 16);
                dst_[0] = c0_; dst_[1] = c1_; }
            if (c + 1 < 16 && act) {
#pragma unroll
                for (int i = 0; i < 35; ++i) raw[i] = (unsigned)__builtin_amdgcn_raw_buffer_load_b32(rsx, voff, (unsigned)(((int)t0 + 64 + i) * 4096), 0);
            }
            if (FULL) {
                const int lt = w >> 1;
                bf16x8 cf[4];
#pragma unroll
                for (int ks = 0; ks < 4; ++ks) cf[ks] = *(const LAS bf16x8*)(l3 + O_CC + (16 * lt + j16) * S128 + (32 * ks + 8 * q4) * 2);
#pragma unroll
                for (int si = 0; si < 2; ++si) { const int st = 2 * (w & 1) + si;
                    if (st <= lt) { f32x4 acc = (f32x4){0.f, 0.f, 0.f, 0.f};
#pragma unroll
                        for (int ks = 0; ks < 4; ++ks) { const bf16x8 bfr = *(const LAS bf16x8*)(l3 + O_BC + (16 * st + j16) * S128 + (32 * ks + 8 * q4) * 2); acc = MFMA16(cf[ks], bfr, acc); }
#pragma unroll
                        for (int r = 0; r < 4; ++r) *(LAS float*)(l3 + O_CB + (16 * lt + 4 * q4 + r) * SCB + (16 * st + j16) * 4) = acc[r]; } }
                __syncthreads();
            }
            {
                const int hq = w >> 1, ps0 = 2 * (w & 1);
                if (FULL) {
                    f32x4 yv[2][4];
#pragma unroll
                    for (int pt = 0; pt < 2; ++pt)
#pragma unroll
                        for (int lt = 0; lt < 4; ++lt) yv[pt][lt] = (f32x4){0.f, 0.f, 0.f, 0.f};
#pragma unroll
                    for (int t = 0; t < 4; ++t) { u32x4 a4, a5;
                        a4.x = pk2(S0[2 * t][0], S0[2 * t][1]); a4.y = pk2(S0[2 * t][2], S0[2 * t][3]); a4.z = pk2(S0[2 * t + 1][0], S0[2 * t + 1][1]); a4.w = pk2(S0[2 * t + 1][2], S0[2 * t + 1][3]);
                        a5.x = pk2(S1[2 * t][0], S1[2 * t][1]); a5.y = pk2(S1[2 * t][2], S1[2 * t][3]); a5.z = pk2(S1[2 * t + 1][0], S1[2 * t + 1][1]); a5.w = pk2(S1[2 * t + 1][2], S1[2 * t + 1][3]);
                        const bf16x8 af0 = __builtin_bit_cast(bf16x8, a4), af1 = __builtin_bit_cast(bf16x8, a5);
#pragma unroll
                        for (int lt = 0; lt < 4; ++lt) { const LAS unsigned char* cpz = l3 + O_CC + (16 * lt + j16) * S128 + (32 * t + 4 * q4) * 2;
                            const u32x2 lo = *(const LAS u32x2*)cpz, hi = *(const LAS u32x2*)(cpz + 32);
                            u32x4 b4; b4.x = lo.x; b4.y = lo.y; b4.z = hi.x; b4.w = hi.y;
                            yv[0][lt] = MFMA16(af0, __builtin_bit_cast(bf16x8, b4), yv[0][lt]); yv[1][lt] = MFMA16(af1, __builtin_bit_cast(bf16x8, b4), yv[1][lt]); } }
#pragma unroll
                    for (int lt = 0; lt < 4; ++lt) { const float el = eal[hq * 64 + 16 * lt + j16]; yv[0][lt] = yv[0][lt] * el; yv[1][lt] = yv[1][lt] * el; }
                    bf16x8 xf[2][2];
#pragma unroll
                    for (int pt = 0; pt < 2; ++pt)
#pragma unroll
                        for (int ks = 0; ks < 2; ++ks) xf[pt][ks] = *(const LAS bf16x8*)(l3 + O_XST + hq * 9216 + (16 * (ps0 + pt) + j16) * S64 + (32 * ks + 8 * q4) * 2);
#pragma unroll
                    for (int lt = 0; lt < 4; ++lt) { const int l = 16 * lt + j16; const float al = acs[hq * 64 + l];
#pragma unroll
                        for (int ks = 0; ks < 2; ++ks) { if (32 * ks <= 16 * lt + 15) {
                                const int s0 = 32 * ks + 8 * q4;
                                const f32x4 c0 = *(const LAS f32x4*)(l3 + O_CB + l * SCB + s0 * 4), c1 = *(const LAS f32x4*)(l3 + O_CB + l * SCB + s0 * 4 + 16);
                                const f32x4 a0 = *(const LAS f32x4*)(dtv + hq * 64 + s0), a1 = *(const LAS f32x4*)(dtv + hq * 64 + s0 + 4);
                                float m[8];
                                if (32 * ks + 31 <= 16 * lt) {
#pragma unroll
                                    for (int e = 0; e < 4; ++e) { m[e] = c0[e] * __builtin_amdgcn_exp2f(al - a0[e]); m[4 + e] = c1[e] * __builtin_amdgcn_exp2f(al - a1[e]); }
                                } else {
#pragma unroll
                                    for (int e = 0; e < 4; ++e) { m[e] = (s0 + e <= l) ? c0[e] * __builtin_amdgcn_exp2f(al - a0[e]) : 0.f; m[4 + e] = (s0 + 4 + e <= l) ? c1[e] * __builtin_amdgcn_exp2f(al - a1[e]) : 0.f; } }
                                u32x4 b4; b4.x = pk2(m[0], m[1]); b4.y = pk2(m[2], m[3]); b4.z = pk2(m[4], m[5]); b4.w = pk2(m[6], m[7]);
                                yv[0][lt] = MFMA16(xf[0][ks], __builtin_bit_cast(bf16x8, b4), yv[0][lt]); yv[1][lt] = MFMA16(xf[1][ks], __builtin_bit_cast(bf16x8, b4), yv[1][lt]); } } }
#pragma unroll
                    for (int pt = 0; pt < 2; ++pt) { const int ps = ps0 + pt;
                        u32x2 yo[4];
#pragma unroll
                        for (int lt = 0; lt < 4; ++lt) { const int l = 16 * lt + j16;
                            float xv[4];
#pragma unroll
                            for (int r = 0; r < 4; ++r) xv[r] = bf2f(*(const LAS bf16_t*)(l3 + O_XST + hq * 9216 + (16 * ps + 4 * q4 + r) * S64 + l * 2));
                            yo[lt].x = pk2(yv[pt][lt][0] + Dk[0] * xv[0], yv[pt][lt][1] + Dk[0] * xv[1]); yo[lt].y = pk2(yv[pt][lt][2] + Dk[0] * xv[2], yv[pt][lt][3] + Dk[0] * xv[3]); }
#pragma unroll
                        for (int lp = 0; lp < 4; lp += 2) {
                            const auto sx = __builtin_amdgcn_permlane16_swap(yo[lp].x, yo[lp + 1].x, false, false), sy = __builtin_amdgcn_permlane16_swap(yo[lp].y, yo[lp + 1].y, false, false);
                            u32x4 w4; w4.x = sx[0]; w4.y = sy[0]; w4.z = sx[1]; w4.w = sy[1];
                            const size_t yoff = (t0 + 16 * (lp + (q4 & 1)) + j16) * 2048 + (size_t)(hd0 + hq) * 64 + 16 * ps + 8 * (q4 >> 1);
                            bf16_t* yp = dry ? (bf16_t*)(ws + WS_LIST + 12 * MiB) + (yoff & (size_t)(512 * 1024 - 1)) : XS + yoff;
                            *(u32x4*)yp = w4; } }
                }
                { const float dec = eal[hq * 64 + 63];
                  bf16x8 xp[2][2];
#pragma unroll
                  for (int pt = 0; pt < 2; ++pt)
#pragma unroll
                      for (int ks = 0; ks < 2; ++ks) xp[pt][ks] = *(const LAS bf16x8*)(l3 + O_XPT + hq * 9216 + (16 * (ps0 + pt) + j16) * S64 + (32 * ks + 8 * q4) * 2);
#pragma unroll
                  for (int nt = 0; nt < 8; ++nt) { f32x4 acc0 = S0[nt] * dec, acc1 = S1[nt] * dec;
#pragma unroll
                      for (int ks = 0; ks < 2; ++ks) { const bf16x8 bt = *(const LAS bf16x8*)(l3 + O_BCT + (16 * nt + j16) * S64 + (32 * ks + 8 * q4) * 2); acc0 = MFMA16(bt, xp[0][ks], acc0); acc1 = MFMA16(bt, xp[1][ks], acc1); }
                      S0[nt] = acc0; S1[nt] = acc1; } }
            }
            if (c + 1 < 16) SCAN_STEP0(c + 1);
            __syncthreads();
        }
#undef SCAN_STEP0
        if (PASS == 1 || PASS == 3) {
            if (w < 4 && lane == 0) ((float*)(ws + WS_ATOT))[u * 4 + w] = atot;
            const int us = (u >> 2) * 3 + (sc < 3 ? sc : 0);
            u32x4* sp0 = (u32x4*)(ws + WS_SLOC) + (((size_t)us * 2 + 0) * 8 + w) * 256 + lane * 4;
            u32x4* sp1 = (u32x4*)(ws + WS_SLOC) + (((size_t)us * 2 + 1) * 8 + w) * 256 + lane * 4;
            if (sc < 3)
#pragma unroll
            for (int i = 0; i < 4; ++i) { u32x4 a, c;
#pragma unroll
                for (int e = 0; e < 4; ++e) { const int nt = 2 * i + (e >> 1), r = 2 * (e & 1); a[e] = pk2(S0[nt][r], S0[nt][r + 1]); c[e] = pk2(S1[nt][r], S1[nt][r + 1]); }
                sp0[i] = a; sp1[i] = c; }
        }
    }
}

__device__ __forceinline__ void scan_fix(const Params& P, const Geo& g, LAS unsigned char* l3, int L) {
    constexpr int S128 = 272, O_CC = 0, CCB = 17408, O_ECL = 2 * CCB;
    const int i2 = L >> 1, w = g.wave; int tid = g.tid; asm volatile("" : "+v"(tid));
    unsigned char* ws = P.ws;
    bf16_t* XS = (bf16_t*)(ws + WS_XS); const float* DT = (const float*)(ws + WS_DT);
    const bf16_t* CCV = (const bf16_t*)P.out + (size_t)T * D;
    const int NITEM = NB * 8 * 3 * 16, per = (NITEM + g.G - 1) / g.G;
    const int gc0 = g.vcu * per, gc1 = min(NITEM, gc0 + per);
    int cur_uu = -1, gq = 0, hd0 = 0; size_t tb = 0; float Ah_s0 = 0.f, atot = 0.f;
    bf16x8 af[2][4];
    u32x4 cr0, cr1; float dt_pf = 0.f;
    u32x4 yq[2][2];
#define FIX_YLOAD(T0_, GQ_) do { const int j16_ = tid & 15, q4_ = (tid & 63) >> 4; _Pragma("unroll") for (int rd = 0; rd < 2; ++rd) _Pragma("unroll") for (int lp = 0; lp < 2; ++lp) \
        yq[rd][lp] = *(const u32x4*)(XS + ((T0_) + 16 * (2 * lp + (q4_ & 1)) + j16_) * 2048 + (size_t)(4 * (GQ_) + (w >> 1)) * 64 + 16 * (2 * (w & 1) + rd) + 8 * (q4_ >> 1)); } while (0)
#define FIX_GEO(GC, TB_, GQ_) const int uu_ = (GC) >> 4, bg_ = uu_ / 3, sc_ = 1 + uu_ % 3; const int GQ_ = bg_ & 7; const size_t TB_ = (size_t)(bg_ >> 3) * SEQ + (size_t)sc_ * 1024 + (size_t)((GC) & 15) * 64;
    if (gc0 < gc1) { FIX_GEO(gc0, t0n, gqn)
        const u32x4* src = (const u32x4*)(CCV + (t0n + (tid >> 3)) * 1024 + gqn * 128 + (tid & 7) * 16); cr0 = src[0]; cr1 = src[1];
        if (w < 4) dt_pf = DT[(t0n + (tid & 63)) * 32 + 4 * gqn + w];
        FIX_YLOAD(t0n, gqn); }
    for (int gc = gc0; gc < gc1; ++gc) {
        int lane = tid & 63; asm volatile("" : "+v"(lane));
        const int j16 = lane & 15, q4 = lane >> 4, par = gc & 1;
        const int uu = gc >> 4, c = gc & 15;
        if (uu != cur_uu) {
            cur_uu = uu;
            const int bg = uu / 3, sc = 1 + uu % 3, u = bg * 4 + sc; gq = bg & 7; hd0 = 4 * gq; tb = (size_t)(bg >> 3) * SEQ + (size_t)sc * 1024;
            Ah_s0 = -__expf(P.in[I_ALOG][i2 * SSM_H + hd0 + (w & 3)]);
            f32x4 S0[8], S1[8];
#pragma unroll
            for (int i = 0; i < 8; ++i) { S0[i] = (f32x4){0.f, 0.f, 0.f, 0.f}; S1[i] = (f32x4){0.f, 0.f, 0.f, 0.f}; }
            const float* AT = (const float*)(ws + WS_ATOT);
#pragma unroll 1
            for (int j = 0; j < sc; ++j) {
                const int uj = (u >> 2) * 3 + j;
                float f0 = 0.f, f1 = 0.f;
                for (int i = j + 1; i < sc; ++i) { f0 += AT[((u & ~3) | i) * 4 + (w >> 1)]; } f1 = f0;
                f0 = __expf(f0); f1 = __expf(f1);
                const u32x4* sp0 = (const u32x4*)(ws + WS_SLOC) + (((size_t)uj * 2 + 0) * 8 + w) * 256 + lane * 4;
                const u32x4* sp1 = (const u32x4*)(ws + WS_SLOC) + (((size_t)uj * 2 + 1) * 8 + w) * 256 + lane * 4;
#pragma unroll
                for (int i = 0; i < 4; ++i) { const u32x4 a = sp0[i], cc = sp1[i];
#pragma unroll
                    for (int e = 0; e < 4; ++e) { const int nt = 2 * i + (e >> 1), r = 2 * (e & 1);
                        S0[nt][r] += f0 * bf2f(a[e] & 0xffffu); S0[nt][r + 1] += f0 * bf2f(a[e] >> 16);
                        S1[nt][r] += f1 * bf2f(cc[e] & 0xffffu); S1[nt][r + 1] += f1 * bf2f(cc[e] >> 16); } }
            }
#pragma unroll
            for (int t = 0; t < 4; ++t) { u32x4 a4;
                a4.x = pk2(S0[2 * t][0], S0[2 * t][1]); a4.y = pk2(S0[2 * t][2], S0[2 * t][3]); a4.z = pk2(S0[2 * t + 1][0], S0[2 * t + 1][1]); a4.w = pk2(S0[2 * t + 1][2], S0[2 * t + 1][3]);
                af[0][t] = __builtin_bit_cast(bf16x8, a4);
                a4.x = pk2(S1[2 * t][0], S1[2 * t][1]); a4.y = pk2(S1[2 * t][2], S1[2 * t][3]); a4.z = pk2(S1[2 * t + 1][0], S1[2 * t + 1][1]); a4.w = pk2(S1[2 * t + 1][2], S1[2 * t + 1][3]);
                af[1][t] = __builtin_bit_cast(bf16x8, a4); }
            atot = 0.f;
            if (w < 4) { float sdt = 0.f;
                for (int j = 0; j < c; ++j) sdt += DT[(tb + (size_t)j * 64 + lane) * 32 + hd0 + w];
                atot = wave_sum(sdt) * Ah_s0; }
        }
        const size_t t0 = tb + (size_t)c * 64;
        LAS float* ecl = (LAS float*)(l3 + O_ECL) + par * 256;
        *(LAS u32x4*)(l3 + O_CC + par * CCB + (tid >> 3) * S128 + (tid & 7) * 32) = cr0; *(LAS u32x4*)(l3 + O_CC + par * CCB + (tid >> 3) * S128 + (tid & 7) * 32 + 16) = cr1;
        if (w < 4) { float a = dt_pf * Ah_s0;
            a = wave_incl_scan(a);
            ecl[w * 64 + lane] = __expf(atot + a);
            atot += wave_last(a); }
        __syncthreads();
        u32x4 yin[2][2];
#pragma unroll
        for (int rd = 0; rd < 2; ++rd)
#pragma unroll
            for (int lp = 0; lp < 2; ++lp) yin[rd][lp] = yq[rd][lp];
        if (gc + 1 < gc1) { FIX_GEO(gc + 1, t0n, gqn)
            FIX_YLOAD(t0n, gqn);
            const u32x4* src = (const u32x4*)(CCV + (t0n + (tid >> 3)) * 1024 + gqn * 128 + (tid & 7) * 16); cr0 = src[0]; cr1 = src[1];
            if (w < 4) dt_pf = DT[(t0n + lane) * 32 + 4 * gqn + w]; }
#pragma unroll
        for (int rd = 0; rd < 2; ++rd) {
            const int hq = w >> 1, ps = 2 * (w & 1) + rd;
            f32x4 yv[4];
#pragma unroll
            for (int lt = 0; lt < 4; ++lt) yv[lt] = (f32x4){0.f, 0.f, 0.f, 0.f};
#pragma unroll
            for (int t = 0; t < 4; ++t)
#pragma unroll
                for (int lt = 0; lt < 4; ++lt) { const LAS unsigned char* cpz = l3 + O_CC + par * CCB + (16 * lt + j16) * S128 + (32 * t + 4 * q4) * 2;
                    const u32x2 lo = *(const LAS u32x2*)cpz, hi = *(const LAS u32x2*)(cpz + 32);
                    u32x4 b4; b4.x = lo.x; b4.y = lo.y; b4.z = hi.x; b4.w = hi.y;
                    yv[lt] = MFMA16(af[rd][t], __builtin_bit_cast(bf16x8, b4), yv[lt]); }
#pragma unroll
            for (int lp = 0; lp < 4; lp += 2) {
                const u32x4 L4 = yin[rd][lp >> 1];
                const auto ax = __builtin_amdgcn_permlane16_swap(L4.x, L4.z, false, false), ay = __builtin_amdgcn_permlane16_swap(L4.y, L4.w, false, false);
                u32x2 o[2];
#pragma unroll
                for (int i = 0; i < 2; ++i) { const int lt = lp + i; const float sc_l = ecl[hq * 64 + 16 * lt + j16]; const unsigned yx = ax[i], yy = ay[i];
                    o[i].x = pk2(bf2f(yx & 0xffffu) + sc_l * yv[lt][0], bf2f(yx >> 16) + sc_l * yv[lt][1]); o[i].y = pk2(bf2f(yy & 0xffffu) + sc_l * yv[lt][2], bf2f(yy >> 16) + sc_l * yv[lt][3]); }
                const auto sx = __builtin_amdgcn_permlane16_swap(o[0].x, o[1].x, false, false), sy = __builtin_amdgcn_permlane16_swap(o[0].y, o[1].y, false, false);
                u32x4 w4; w4.x = sx[0]; w4.y = sy[0]; w4.z = sx[1]; w4.w = sy[1];
                *(u32x4*)(XS + (t0 + 16 * (lp + (q4 & 1)) + j16) * 2048 + (size_t)(hd0 + hq) * 64 + 16 * ps + 8 * (q4 >> 1)) = w4; }
        }
    }
#undef FIX_GEO
#undef FIX_YLOAD
}

__device__ __forceinline__ void phase_scan(const Params& P, const Geo& g, LAS unsigned char* l3, int L, bool dry = false) {
    constexpr int S128 = 272, S64 = 144;
    constexpr int O_CC = 0, O_BC = 17408, O_BCT = 34816, O_XST = 53248, O_XPT = 62464, O_MM = 71680, O_SBF = 80896;
    constexpr int O_ACS = 98304, O_DTV = 98560, O_CW = 98816, O_HALO = 105216;
    LAS float* acs = (LAS float*)(l3 + O_ACS); LAS float* dtv = (LAS float*)(l3 + O_DTV);
    LAS f32x2* cwl = (LAS f32x2*)(l3 + O_CW);
    const int i2 = L >> 1, lane = g.lane, w = g.wave, tid = g.tid, j16 = lane & 15, q4 = lane >> 4;
    unsigned char* ws = P.ws;
    bf16_t* XS = (bf16_t*)(ws + WS_XS); const bf16_t* BC = (const bf16_t*)(ws + WS_BC); const float* DT = (const float*)(ws + WS_DT);
    for (int u = g.vcu; u < NB * SSM_H; u += g.G) {
        const int b = u / SSM_H, hd = u % SSM_H, gq = hd >> 2;
        const float Ah = -__expf(P.in[I_ALOG][i2 * SSM_H + hd]), Dk = P.in[I_SSMD][i2 * SSM_H + hd];
        const size_t tb = (size_t)b * SEQ;
        if (tid < 160) { const int cp = tid; const int ch = cp < 32 ? hd * 64 + 2 * cp : (cp < 96 ? 2048 + gq * 128 + 2 * (cp - 32) : 3072 + gq * 128 + 2 * (cp - 96));
            const float* cw = P.in[I_CONVW] + (size_t)i2 * 4 * SSM_CONV + ch;
#pragma unroll
            for (int tp = 0; tp < 4; ++tp) cwl[tp * 160 + cp] = (f32x2){cw[tp * SSM_CONV], cw[tp * SSM_CONV + 1]};
            const float* cb = P.in[I_CONVB] + (size_t)i2 * SSM_CONV + ch; cwl[4 * 160 + cp] = (f32x2){cb[0], cb[1]}; }
        for (int e = tid; e < 17408 / 4; e += 512) ((LAS unsigned*)(l3 + O_SBF))[e] = 0u;
        f32x4 S[4];
#pragma unroll
        for (int i = 0; i < 4; ++i) S[i] = (f32x4){0.f, 0.f, 0.f, 0.f};
        unsigned raw[5][7], voff[5]; float dt_pf = 0.f;
        if (w == 0) dt_pf = DT[(tb + lane) * 32 + hd];
#pragma unroll
        for (int k = 0; k < 5; ++k) {
            const int it = tid + 512 * k, cp = it % 160, strip = it / 160, l0 = 4 * strip;
            const unsigned colb = cp < 32 ? (unsigned)(hd * 64 + 2 * cp) * 2u : (unsigned)(WS_BC - WS_XS) + (unsigned)(cp < 96 ? gq * 128 + 2 * (cp - 32) : 1024 + gq * 128 + 2 * (cp - 96)) * 2u;
            voff[k] = (unsigned)l0 * 4096u + colb;
#pragma unroll
            for (int i = 0; i < 7; ++i) { const int rl = l0 - 3 + i; raw[k][i] = (rl >= 0) ? *(const unsigned*)((const char*)XS + (tb + rl) * 4096 + colb) : 0u; }
        }
        __syncthreads();
#pragma unroll 1
        for (int c = 0; c < NCH; ++c) {
            const size_t t0 = tb + (size_t)c * 64;
            if (w == 0) { const float dt = dt_pf; float a = dt * Ah;
#pragma unroll
                for (int o = 1; o < 64; o <<= 1) { const float nbv = __shfl_up(a, o); a += (lane >= o) ? nbv : 0.f; }
                acs[lane] = a; dtv[lane] = dt; }
            __syncthreads();
            const float aend = acs[63];
            int tA = tid; asm volatile("" : "+v"(tA));
#pragma unroll
            for (int k = 0; k < 5; ++k) {
                const int it = tA + 512 * k, cp = it % 160, strip = it / 160, l0 = 4 * strip;
                if (c > 0 && cp < 32 && strip == 0) {
#pragma unroll
                    for (int i = 0; i < 3; ++i) raw[k][i] = *(const LAS unsigned*)(l3 + O_HALO + (((c - 1) & 1) * 3 + i) * 128 + cp * 4); }
                if (cp < 32 && strip == 15) {
#pragma unroll
                    for (int i = 0; i < 3; ++i) *(LAS unsigned*)(l3 + O_HALO + ((c & 1) * 3 + i) * 128 + cp * 4) = raw[k][4 + i]; }
                float wx[5], wy[5];
#pragma unroll
                for (int tp = 0; tp < 5; ++tp) { const f32x2 ww = cwl[tp * 160 + cp]; wx[tp] = ww.x; wy[tp] = ww.y; }
                float v0[4], v1[4];
#pragma unroll
                for (int o = 0; o < 4; ++o) { float a0 = wx[4], a1 = wy[4];
#pragma unroll
                    for (int tp = 0; tp < 4; ++tp) { a0 += wx[tp] * bf2f(raw[k][o + tp] & 0xffffu); a1 += wy[tp] * bf2f(raw[k][o + tp] >> 16); }
                    v0[o] = silu_f(a0); v1[o] = silu_f(a1); }
                if (cp < 32) {
                    const int p = 2 * cp;
                    u32x2 x0, x1; x0.x = pk2(v0[0], v0[1]); x0.y = pk2(v0[2], v0[3]); x1.x = pk2(v1[0], v1[1]); x1.y = pk2(v1[2], v1[3]);
                    *(LAS u32x2*)(l3 + O_XST + p * S64 + l0 * 2) = x0; *(LAS u32x2*)(l3 + O_XST + (p + 1) * S64 + l0 * 2) = x1;
                    float sc[4];
#pragma unroll
                    for (int o = 0; o < 4; ++o) sc[o] = dtv[l0 + o] * __expf(aend - acs[l0 + o]);
                    x0.x = pk2(v0[0] * sc[0], v0[1] * sc[1]); x0.y = pk2(v0[2] * sc[2], v0[3] * sc[3]); x1.x = pk2(v1[0] * sc[0], v1[1] * sc[1]); x1.y = pk2(v1[2] * sc[2], v1[3] * sc[3]);
                    *(LAS u32x2*)(l3 + O_XPT + p * S64 + l0 * 2) = x0; *(LAS u32x2*)(l3 + O_XPT + (p + 1) * S64 + l0 * 2) = x1;
                } else if (cp < 96) {
                    const int n = 2 * (cp - 32);
#pragma unroll
                    for (int o = 0; o < 4; ++o) *(LAS unsigned*)(l3 + O_BC + (l0 + o) * S128 + n * 2) = pk2(v0[o], v1[o]);
                    u32x2 x0, x1; x0.x = pk2(v0[0], v0[1]); x0.y = pk2(v0[2], v0[3]); x1.x = pk2(v1[0], v1[1]); x1.y = pk2(v1[2], v1[3]);
                    *(LAS u32x2*)(l3 + O_BCT + n * S64 + l0 * 2) = x0; *(LAS u32x2*)(l3 + O_BCT + (n + 1) * S64 + l0 * 2) = x1;
                } else {
                    const int n = 2 * (cp - 96);
#pragma unroll
                    for (int o = 0; o < 4; ++o) *(LAS unsigned*)(l3 + O_CC + (l0 + o) * S128 + n * 2) = pk2(v0[o], v1[o]);
                }
            }
            __syncthreads();
            if (c + 1 < NCH) {
                if (w == 0) dt_pf = DT[(t0 + 64 + lane) * 32 + hd];
                const char* rb = (const char*)XS + (t0 + 61) * 4096;
#pragma unroll
                for (int i = 0; i < 7; ++i)
#pragma unroll
                    for (int k = 0; k < 5; ++k) raw[k][i] = *(const unsigned*)(rb + (size_t)i * 4096 + voff[k]);
            }
            const int lt = w >> 1, h2 = w & 1;
            f32x4 yo[2];
            {
                bf16x8 cf[4];
#pragma unroll
                for (int ks = 0; ks < 4; ++ks) cf[ks] = *(const LAS bf16x8*)(l3 + O_CC + (16 * lt + j16) * S128 + (32 * ks + 8 * q4) * 2);
#pragma unroll
                for (int si = 0; si < 2; ++si) { const int st = 2 * h2 + si;
                    f32x4 acc = (f32x4){0.f, 0.f, 0.f, 0.f};
                    if (st <= lt) {
#pragma unroll
                        for (int ks = 0; ks < 4; ++ks) { const bf16x8 bfr = *(const LAS bf16x8*)(l3 + O_BC + (16 * st + j16) * S128 + (32 * ks + 8 * q4) * 2); acc = MFMA16(cf[ks], bfr, acc); } }
                    const int sidx = 16 * st + j16; const float as = acs[sidx], ds = dtv[sidx];
#pragma unroll
                    for (int r = 0; r < 4; ++r) { const int l = 16 * lt + 4 * q4 + r;
                        const float m = (sidx <= l) ? acc[r] * __expf(acs[l] - as) * ds : 0.f;
                        *(LAS bf16_t*)(l3 + O_MM + l * S64 + sidx * 2) = (bf16_t)f2bf(m); } }
#pragma unroll
                for (int pi = 0; pi < 2; ++pi) { const int pt = 2 * h2 + pi; f32x4 acc = (f32x4){0.f, 0.f, 0.f, 0.f};
#pragma unroll
                    for (int ks = 0; ks < 4; ++ks) { const bf16x8 sf = *(const LAS bf16x8*)(l3 + O_SBF + (16 * pt + j16) * S128 + (32 * ks + 8 * q4) * 2); acc = MFMA16(cf[ks], sf, acc); }
                    yo[pi] = acc; }
            }
            {
                const float dec = __expf(aend);
                bf16x8 xf[2];
#pragma unroll
                for (int ks = 0; ks < 2; ++ks) xf[ks] = *(const LAS bf16x8*)(l3 + O_XPT + (16 * lt + j16) * S64 + (32 * ks + 8 * q4) * 2);
#pragma unroll
                for (int ni = 0; ni < 4; ++ni) { const int nt = 4 * h2 + ni; f32x4 acc = S[ni] * dec;
#pragma unroll
                    for (int ks = 0; ks < 2; ++ks) { const bf16x8 bt = *(const LAS bf16x8*)(l3 + O_BCT + (16 * nt + j16) * S64 + (32 * ks + 8 * q4) * 2); acc = MFMA16(xf[ks], bt, acc); }
                    S[ni] = acc; }
            }
            __syncthreads();
            {
                bf16x8 mf[2];
#pragma unroll
                for (int ks = 0; ks < 2; ++ks) mf[ks] = *(const LAS bf16x8*)(l3 + O_MM + (16 * lt + j16) * S64 + (32 * ks + 8 * q4) * 2);
#pragma unroll
                for (int pi = 0; pi < 2; ++pi) { const int pt = 2 * h2 + pi, p = 16 * pt + j16; f32x4 acc = (f32x4){0.f, 0.f, 0.f, 0.f};
#pragma unroll
                    for (int ks = 0; ks < 2; ++ks) { const bf16x8 xt = *(const LAS bf16x8*)(l3 + O_XST + (16 * pt + j16) * S64 + (32 * ks + 8 * q4) * 2); acc = MFMA16(mf[ks], xt, acc); }
                    const u32x2 xv = *(const LAS u32x2*)(l3 + O_XST + p * S64 + (16 * lt + 4 * q4) * 2);
                    const float xs0 = bf2f(xv.x & 0xffffu), xs1 = bf2f(xv.x >> 16), xs2 = bf2f(xv.y & 0xffffu), xs3 = bf2f(xv.y >> 16);
                    const int lb = 16 * lt + 4 * q4;
                    const size_t yoff = (t0 + lb) * 2048 + hd * 64 + p;
                    bf16_t* yp = dry ? (bf16_t*)(ws + WS_LIST) + (yoff & (size_t)(4 * 1024 * 1024 - 1)) : XS + yoff;
                    yp[0] = (bf16_t)f2bf(acc[0] + __expf(acs[lb]) * yo[pi][0] + Dk * xs0);
                    yp[2048] = (bf16_t)f2bf(acc[1] + __expf(acs[lb + 1]) * yo[pi][1] + Dk * xs1);
                    yp[4096] = (bf16_t)f2bf(acc[2] + __expf(acs[lb + 2]) * yo[pi][2] + Dk * xs2);
                    yp[6144] = (bf16_t)f2bf(acc[3] + __expf(acs[lb + 3]) * yo[pi][3] + Dk * xs3); }
#pragma unroll
                for (int ni = 0; ni < 4; ++ni) { const int n = 16 * (4 * h2 + ni) + j16;
#pragma unroll
                    for (int r = 0; r < 4; ++r) *(LAS bf16_t*)(l3 + O_SBF + (16 * lt + 4 * q4 + r) * S128 + n * 2) = (bf16_t)f2bf(S[ni][r]); }
            }
            __syncthreads();
        }
    }
}


typedef float f32x16 __attribute__((ext_vector_type(16)));
#define MFMA32(a, b, c) __builtin_amdgcn_mfma_f32_32x32x16_bf16(a, b, c, 0, 0, 0)
__device__ __forceinline__ void phase_e2(const Params& P, const Geo& g, LAS unsigned char* l3, int L) {
    const int i2 = L >> 1, lane = g.lane, w = g.wave, tid = g.tid, j16 = lane & 15, q4 = lane >> 4;
    unsigned char* ws = P.ws;
    const bf16_t* U = (const bf16_t*)(ws + WS_U); bf16_t* CAT = (bf16_t*)(ws + WS_CAT);
    {
        constexpr int O_UT = 0, O_PL = 20480, PS = 272;
        u32x4 pre[3];
#define POOL_FETCH(UU) do { const int gi_ = (UU) & 3, t0_ = ((UU) >> 2) * 64, s0_ = t0_ % SEQ; \
            _Pragma("unroll") for (int i = 0; i < 3; ++i) { const int e = tid + 512 * i, r = e >> 4, c16 = e & 15; pre[i] = (u32x4){0u, 0u, 0u, 0u}; \
                if (e < 79 * 16 && s0_ - 15 + r >= 0) pre[i] = *(const u32x4*)(U + (size_t)(t0_ - 15 + r) * 512 + gi_ * 128 + c16 * 8); } } while (0)
        if (g.vcu < (T / 64) * 4) POOL_FETCH(g.vcu);
        for (int u = g.vcu; u < (T / 64) * 4; u += g.G) {
            const int gi = u & 3, t0 = (u >> 2) * 64, s0 = t0 % SEQ, win = 2 << gi;
#pragma unroll
            for (int i = 0; i < 3; ++i) { const int e = tid + 512 * i, r = e >> 4, c16 = e & 15; if (e < 79 * 16) *(LAS u32x4*)(l3 + O_UT + r * 256 + c16 * 16) = pre[i]; }
            const bf16_t* Wb = (const bf16_t*)(ws + WS_WPL) + ((size_t)(i2 * 4 + gi) * 128 + 16 * w + j16) * 128 + 8 * q4;
            bf16x8 bwp[4];
#pragma unroll
            for (int ks = 0; ks < 4; ++ks) bwp[ks] = *(const bf16x8*)(Wb + 32 * ks);
            const f32x4 ps = *(const f32x4*)(P.in[I_POOLS] + i2 * 512 + gi * 128 + 16 * w + 4 * q4);
            __syncthreads();
            if (u + g.G < (T / 64) * 4) POOL_FETCH(u + g.G);
            { const int l = tid >> 3, cb = (tid & 7) * 16, s = s0 + l; const int cnt = (s + 1 < win) ? s + 1 : win;
                float acc[16];
#pragma unroll
                for (int i = 0; i < 16; ++i) acc[i] = 0.f;
                for (int j = 0; j < cnt; ++j) {
                    const u32x4 a = *(const LAS u32x4*)(l3 + O_UT + (l + 15 - j) * 256 + cb * 2), b = *(const LAS u32x4*)(l3 + O_UT + (l + 15 - j) * 256 + cb * 2 + 16);
#pragma unroll
                    for (int i = 0; i < 4; ++i) { acc[2 * i] += bf2f(a[i] & 0xffffu); acc[2 * i + 1] += bf2f(a[i] >> 16); acc[8 + 2 * i] += bf2f(b[i] & 0xffffu); acc[8 + 2 * i + 1] += bf2f(b[i] >> 16); }
                }
                const u32x4 a = *(const LAS u32x4*)(l3 + O_UT + (l + 15) * 256 + cb * 2), b = *(const LAS u32x4*)(l3 + O_UT + (l + 15) * 256 + cb * 2 + 16);
                const float inv = 1.f / (float)cnt;
                u32x4 o0, o1;
#pragma unroll
                for (int i = 0; i < 4; ++i) {
                    o0[i] = pk2(acc[2 * i] * inv - bf2f(a[i] & 0xffffu), acc[2 * i + 1] * inv - bf2f(a[i] >> 16));
                    o1[i] = pk2(acc[8 + 2 * i] * inv - bf2f(b[i] & 0xffffu), acc[8 + 2 * i + 1] * inv - bf2f(b[i] >> 16)); }
                *(LAS u32x4*)(l3 + O_PL + l * PS + cb * 2) = o0; *(LAS u32x4*)(l3 + O_PL + l * PS + cb * 2 + 16) = o1; }
            __syncthreads();
            {
                f32x4 acc[4];
#pragma unroll
                for (int lt = 0; lt < 4; ++lt) acc[lt] = (f32x4){0.f, 0.f, 0.f, 0.f};
#pragma unroll
                for (int ks = 0; ks < 4; ++ks) { const bf16x8 bw = bwp[ks];
#pragma unroll
                    for (int lt = 0; lt < 4; ++lt) { const bf16x8 a = *(const LAS bf16x8*)(l3 + O_PL + (16 * lt + j16) * PS + (32 * ks + 8 * q4) * 2); acc[lt] = MFMA16(bw, a, acc[lt]); } }
#pragma unroll
                for (int lt = 0; lt < 4; ++lt) { const f32x4 v = acc[lt] * ps; u32x2 o; o.x = pk2(v[0], v[1]); o.y = pk2(v[2], v[3]);
                    *(u32x2*)(CAT + (size_t)(t0 + 16 * lt + j16) * D + gi * 128 + 16 * w + 4 * q4) = o; }
            }
        }
#undef POOL_FETCH
        __syncthreads();
    }
    {
        constexpr int O_TB = 0, O_RING = 20480;
        for (int e = tid; e < 8 * 640; e += 512) { const int h = e / 640, i = e % 640; int rel = 575 - i; rel = rel > 256 ? 256 : rel; rel = rel < -256 ? -256 : rel;
            ((LAS float*)(l3 + O_TB))[e] = P.in[I_RELB][((size_t)i2 * NHEAD + h) * 513 + rel + 256] * LOG2E; }
        __syncthreads();
        const bf16_t* Qb = (const bf16_t*)(ws + WS_Q); const unsigned char* Kb = ws + WS_K; const unsigned char* VT = ws + WS_VT;
        const int l31 = lane & 31, hh = lane >> 5;
        for (int u8 = g.vcu; u8 < NB * NHEAD * 8; u8 += g.G) {
            const int cg = u8 & 7, h = (u8 >> 3) & 7, b = u8 >> 6;
            const int c0 = 8 * cg, c = c0 + w;
            const size_t tq0 = (size_t)b * SEQ + (size_t)c * 64;
            const size_t bhb = (((size_t)b * NHEAD + h) * 128) * 4096 + (size_t)tid * 16;
            if (cg > 0) {
#pragma unroll 2
                for (int j = 0; j < 8; ++j) { const size_t o = bhb + (size_t)(c0 - 8 + j) * 8192;
                    const u32x4 kv = *(const u32x4*)(Kb + o), vv = *(const u32x4*)(VT + o);
                    *(LAS u32x4*)(l3 + O_RING + j * 16384 + tid * 16) = kv; *(LAS u32x4*)(l3 + O_RING + j * 16384 + 8192 + tid * 16) = vv; }
            }
            bf16x8 qf[2][4];
#pragma unroll
            for (int qt = 0; qt < 2; ++qt)
#pragma unroll
                for (int ks = 0; ks < 4; ++ks) qf[qt][ks] = *(const bf16x8*)(Qb + (tq0 + 32 * qt + l31) * 512 + h * 64 + 16 * ks + 8 * hh);
            f32x16 ot[2][2];
#pragma unroll
            for (int dt = 0; dt < 2; ++dt)
#pragma unroll
                for (int qt = 0; qt < 2; ++qt)
#pragma unroll
                    for (int r = 0; r < 16; ++r) ot[dt][qt][r] = 0.f;
            float mrow[2] = {-1.0e30f, -1.0e30f}, lrow[2] = {0.f, 0.f};
            const float bfar = ((const LAS float*)(l3 + O_TB))[h * 640];
            __syncthreads();
#define ATT_STEP(CJ, KT, FARF) do { \
                const LAS unsigned char* sb_ = l3 + O_RING + ((CJ) & 7) * 16384 + (KT) * 4096 + lane * 16; \
                bf16x8 kf[4], vf[2][2]; \
                _Pragma("unroll") for (int ks = 0; ks < 4; ++ks) kf[ks] = *(const LAS bf16x8*)(sb_ + ks * 1024); \
                _Pragma("unroll") for (int dt = 0; dt < 2; ++dt) _Pragma("unroll") for (int sp = 0; sp < 2; ++sp) vf[dt][sp] = *(const LAS bf16x8*)(sb_ + 8192 + (dt * 2 + sp) * 1024); \
                bf16x8 pf[2][2]; \
                _Pragma("unroll") for (int qt = 0; qt < 2; ++qt) { \
                    f32x16 sa; \
                      \
                      \
                    if (FARF) { _Pragma("unroll") for (int r = 0; r < 16; ++r) sa[r] = 0.f; } \
                    else if ((KT) == 1 && qt == 1) sa = bsv_;     \
                    else { const LAS float* tb = (const LAS float*)(l3 + O_TB) + h * 640 + (575 - 64 * (c - (CJ)) - 32 * qt - l31 + 32 * (KT) + 4 * hh); \
                        _Pragma("unroll") for (int r = 0; r < 16; ++r) sa[r] = tb[(r & 3) + 8 * (r >> 2)]; \
                        if ((KT) == 0 && qt == 0) bsv_ = sa; } \
                    _Pragma("unroll") for (int ks = 0; ks < 4; ++ks) sa = MFMA32(kf[ks], qf[qt][ks], sa); \
                    float mloc = sa[0]; \
                    _Pragma("unroll") for (int r = 1; r < 16; ++r) mloc = fmaxf(mloc, sa[r]); \
                    mloc = xhalf_max(mloc); if (FARF) mloc += bfar; \
                      \
                      \
                    if (!__all(mloc <= mrow[qt] + 8.f)) { \
                        const float mnew = fmaxf(mrow[qt], mloc), alpha = __builtin_amdgcn_exp2f(mrow[qt] - mnew); \
                        _Pragma("unroll") for (int dt = 0; dt < 2; ++dt) _Pragma("unroll") for (int r = 0; r < 16; ++r) ot[dt][qt][r] *= alpha; \
                        lrow[qt] *= alpha; mrow[qt] = mnew; } \
                    const float mr_ = (FARF) ? mrow[qt] - bfar : mrow[qt]; \
                    float ls = 0.f; \
                    _Pragma("unroll") for (int r = 0; r < 16; ++r) { sa[r] = __builtin_amdgcn_exp2f(sa[r] - mr_); ls += sa[r]; } \
                    lrow[qt] += ls;     \
                    _Pragma("unroll") for (int sp = 0; sp < 2; ++sp) { u32x4 t4; \
                        t4.x = pk2(sa[8 * sp + 0], sa[8 * sp + 1]); t4.y = pk2(sa[8 * sp + 2], sa[8 * sp + 3]); t4.z = pk2(sa[8 * sp + 4], sa[8 * sp + 5]); t4.w = pk2(sa[8 * sp + 6], sa[8 * sp + 7]); \
                        pf[qt][sp] = __builtin_bit_cast(bf16x8, t4); } } \
                _Pragma("unroll") for (int dt = 0; dt < 2; ++dt) _Pragma("unroll") for (int qt = 0; qt < 2; ++qt) _Pragma("unroll") for (int sp = 0; sp < 2; ++sp) ot[dt][qt] = MFMA32(vf[dt][sp], pf[qt][sp], ot[dt][qt]); } while (0)
#define ATT_ITER(FARF) { \
                u32x4 nk = (u32x4){0u, 0u, 0u, 0u}, nv = (u32x4){0u, 0u, 0u, 0u}; \
                if (r < 8) { const size_t o = bhb + (size_t)(c0 + r) * 8192; nk = *(const u32x4*)(Kb + o); nv = *(const u32x4*)(VT + o); } \
                const int cj = c - 8 + r; \
                if (cj >= 0) { f32x16 bsv_; ATT_STEP(cj, 0, FARF); ATT_STEP(cj, 1, FARF); } \
                __syncthreads(); \
                if (r < 8) { *(LAS u32x4*)(l3 + O_RING + r * 16384 + tid * 16) = nk; *(LAS u32x4*)(l3 + O_RING + r * 16384 + 8192 + tid * 16) = nv; __syncthreads(); } }
#pragma unroll 1
            for (int r = 0; r < 4; ++r) ATT_ITER(1)
#pragma unroll 1
            for (int r = 4; r < 9; ++r) ATT_ITER(0)
#undef ATT_ITER
#undef ATT_STEP
#pragma unroll
            for (int qt = 0; qt < 2; ++qt) { const float inv = 1.f / xhalf_sum(lrow[qt]);
                bf16_t* op = CAT + (tq0 + 32 * qt + l31) * D + 512 + h * 64;
#pragma unroll
                for (int dt = 0; dt < 2; ++dt)
#pragma unroll
                    for (int gp = 0; gp < 4; gp += 2) { u32x2 o0, o1;
                        o0.x = pk2(ot[dt][qt][4 * gp] * inv, ot[dt][qt][4 * gp + 1] * inv); o0.y = pk2(ot[dt][qt][4 * gp + 2] * inv, ot[dt][qt][4 * gp + 3] * inv);
                        o1.x = pk2(ot[dt][qt][4 * gp + 4] * inv, ot[dt][qt][4 * gp + 5] * inv); o1.y = pk2(ot[dt][qt][4 * gp + 6] * inv, ot[dt][qt][4 * gp + 7] * inv);
                        const auto sx = __builtin_amdgcn_permlane32_swap(o0.x, o1.x, false, false), sy = __builtin_amdgcn_permlane32_swap(o0.y, o1.y, false, false);
                        u32x4 w4; w4.x = sx[0]; w4.y = sy[0]; w4.z = sx[1]; w4.w = sy[1];
                        *(u32x4*)(op + 32 * dt + 8 * (gp + hh)) = w4; } }
        }
    }
}

constexpr int LDS_BYTES = 160 * 1024, MISC_OFF = 160 * 1024 - 512;
constexpr int NPHASE = 34;
#ifndef PG8_SP2
#define PG8_SP2 true
#endif
#ifndef PG8_ALIGN
#define PG8_ALIGN true
#endif
__global__ void __launch_bounds__(512, 2) mk_fwd(Params P) {
    extern __shared__ __attribute__((aligned(16))) unsigned char lds[];
    LAS unsigned char* l3 = (LAS unsigned char*)lds;
    Geo g; g.tid = threadIdx.x; g.lane = g.tid & 63; g.wave = __builtin_amdgcn_readfirstlane(g.tid >> 6); g.G = gridDim.x;
    { const int bx = blockIdx.x; g.vcu = (g.G % 8 == 0) ? (bx % 8) * (g.G / 8) + bx / 8 : bx; }
    volatile LAS unsigned* MISC = (volatile LAS unsigned*)(l3 + MISC_OFF);
    if (g.tid < 64) MISC[g.tid] = 0u;
    __syncthreads();
    unsigned char* ws = P.ws;
    unsigned* ctl = (unsigned*)(ws + WS_CTL);
    XcdBarrier bar = xcd_barrier_post(ctl + CW_BAR, MISC + 8);
    const int lo = P.ph_lo, hi = P.ph_hi;
#define IN(k) (lo <= (k) && (k) < hi)
#define SEAM(k) do { if ((k) + 1 < hi) xcd_barrier(bar); } while (0)
    const float* mod = (const float*)(ws + WS_MOD);
    bf16_t* Hb = (bf16_t*)P.out; bf16_t* XB = (bf16_t*)(ws + WS_XB);

    if (IN(0)) { for (int rep_ = 0; rep_ < ((PROBE_DUP == 0) ? 2 : 1); ++rep_) { phase_mod(P, g, (float*)lds); phase_convert(P, g, (float*)(lds + 32768))  ; if (rep_ + 1 < ((PROBE_DUP == 0) ? 2 : 1)) xcd_barrier(bar); } SEAM(0); }

#define NREP(ty) ((PROBE_DUP == (ty)) ? 2 : 1)
#define DRYFLAG(ty) bool dry = false; if (PROBE_DUP == (ty)) { int d_ = (rep_ + 1 < NREP(ty)); asm volatile("" : "+s"(d_)); dry = d_ != 0; }
#define DRYBAR() do { if (dry) xcd_barrier(bar); } while (0)
#define G_E1 { pg8::Gemm gm{Hb, (const bf16_t*)(ws + WS_WMI) + (size_t)i2 * MIX_IN * D, T, MIX_IN, D}; pg8::StaticOrder S; S.init(T, MIX_IN, g.G, (int)blockIdx.x); \
                pg8::EpiE1x E{(bf16_t*)(ws + WS_U), (bf16_t*)(ws + WS_VT)}; \
                pg8::gemm_phase<pg8::EpiE1x, pg8::StaticOrder, PG8_ALIGN, PG8_SP2>(l3, gm, S, E); }
#define G_E3(F32B, BASEP) { pg8::Gemm gm{(const bf16_t*)(ws + WS_CAT), (const bf16_t*)(ws + WS_WMO) + (size_t)i2 * D * D, T, D, D}; pg8::StaticOrder S; S.init(T, D, g.G, (int)blockIdx.x); \
                pg8::EpiResGate<F32B> E{BASEP, XB, gate1, (float*)(ws + WS_SSP)}; \
                pg8::gemm_phase<pg8::EpiResGate<F32B>, pg8::StaticOrder, PG8_ALIGN, PG8_SP2>(l3, gm, S, E); }
#define G_O1A { pg8::Gemm gm{Hb, (const bf16_t*)(ws + WS_WSX) + (size_t)i2 * 4096 * D, T, 4096, D}; pg8::StaticOrder S; S.init(T, 4096, g.G, (int)blockIdx.x); \
                pg8::EpiSplitX E{(bf16_t*)(ws + WS_XS), (unsigned*)(ws + WS_XHALO)}; \
                pg8::gemm_phase<pg8::EpiSplitX, pg8::StaticOrder, PG8_ALIGN, PG8_SP2>(l3, gm, S, E); }
#define G_O1B { pg8::Gemm gm{Hb, (const bf16_t*)(ws + WS_WSZ) + (size_t)i2 * 2048 * D, T, 2048, D}; pg8::StaticOrder S; S.init(T, 2048, g.G, (int)blockIdx.x); \
                pg8::EpiGateNorm E{(bf16_t*)(ws + WS_XS), (LAS float*)(l3 + 131072)}; \
                pg8::gemm_phase<pg8::EpiGateNorm, pg8::StaticOrder, true, PG8_SP2>(l3, gm, S, E); }
#define G_O3 { pg8::Gemm gm{(const bf16_t*)(ws + WS_XS), (const bf16_t*)(ws + WS_WSO) + (size_t)i2 * D * SSM_DI, T, D, SSM_DI}; pg8::StaticOrder S; S.init(T, D, g.G, (int)blockIdx.x); \
                pg8::EpiResGate<false> E{XB, XB, gate1, (float*)(ws + WS_SSP)}; \
                pg8::gemm_phase<pg8::EpiResGate<false>, pg8::StaticOrder, PG8_ALIGN, PG8_SP2>(l3, gm, S, E); }
#define GDUP_2(...)
#define GDUP_4(...)
#define GDUP_8(...)
#define GDUP_10(...)
#define GDUP_12(...)
#if PROBE_DUP == 2
#undef GDUP_2
#define GDUP_2(...) __VA_ARGS__ xcd_barrier(bar);
#elif PROBE_DUP == 4
#undef GDUP_4
#define GDUP_4(...) __VA_ARGS__ xcd_barrier(bar);
#elif PROBE_DUP == 8
#undef GDUP_8
#define GDUP_8(...) __VA_ARGS__ xcd_barrier(bar);
#elif PROBE_DUP == 10
#undef GDUP_10
#define GDUP_10(...) __VA_ARGS__ xcd_barrier(bar);
#elif PROBE_DUP == 12
#undef GDUP_12
#define GDUP_12(...) __VA_ARGS__ xcd_barrier(bar);
#endif
#define GDUP(ty, ...) GDUP_##ty(__VA_ARGS__)
#define LAYER_BODY(LL) { const int L = (LL); \
        const int pb = 1 + 8 * L, i2 = L >> 1; \
        const float* gate1 = mod + (size_t)L * NB * 6144 + 2048; \
        if ((L & 1) == 0) { \
            if (IN(pb + 0)) { phase_norm<0>(P, g, (float*)lds, L, P.in[I_X], P.in[I_N1W] + L * D, 0, 1024, false, L == 0 ? (const bf16_t*)nullptr : (const bf16_t*)XB); SEAM(pb + 0); } \
            if (IN(pb + 1)) { G_E1 GDUP(2, G_E1) SEAM(pb + 1); } \
            if (IN(pb + 2)) { for (int rep_ = 0; rep_ < NREP(3); ++rep_) { DRYFLAG(3) phase_e2(P, g, l3, L); DRYBAR(); } SEAM(pb + 2); } \
            if (IN(pb + 3)) { if (L == 0) G_E3(true, P.in[I_X]) else G_E3(false, XB) SEAM(pb + 3); } \
            if (IN(pb + 4)) { for (int rep_ = 0; rep_ < NREP(5); ++rep_) { DRYFLAG(5) phase_norm16<2>(P, g, l3, L, XB, P.in[I_N2W] + L * D, 3072, 4096, dry); DRYBAR(); } SEAM(pb + 4); } \
            if (IN(pb + 5)) { for (int rep_ = 0; rep_ < NREP(6); ++rep_) { DRYFLAG(6) phase_moe(P, g, l3, L, dry); DRYBAR(); } SEAM(pb + 5); } \
        } else { \
            if (IN(pb + 0)) { phase_norm16<1>(P, g, l3, L, XB, P.in[I_N1W] + L * D, 0, 1024, false); SEAM(pb + 0); } \
            if (IN(pb + 1)) { G_O1A GDUP(8, G_O1A) SEAM(pb + 1); } \
            if (IN(pb + 2)) { for (int rep_ = 0; rep_ < NREP(9); ++rep_) { DRYFLAG(9) scan_units<3>(P, g, l3, L, dry); xcd_barrier(bar); scan_fix(P, g, l3, L); DRYBAR(); } SEAM(pb + 2); } \
            if (IN(pb + 3)) { G_O1B GDUP(10, G_O1B) SEAM(pb + 3); } \
            if (IN(pb + 5)) { G_O3 SEAM(pb + 5); } \
            if (IN(pb + 6)) { for (int rep_ = 0; rep_ < NREP(5); ++rep_) { DRYFLAG(5) phase_norm16<2>(P, g, l3, L, XB, P.in[I_N2W] + L * D, 3072, 4096, dry); DRYBAR(); } SEAM(pb + 6); } \
            if (IN(pb + 7)) { for (int rep_ = 0; rep_ < NREP(6); ++rep_) { DRYFLAG(6) phase_moe(P, g, l3, L, dry); DRYBAR(); } SEAM(pb + 7); } \
        } \
    }
    LAYER_BODY(0)
    LAYER_BODY(1)
    LAYER_BODY(2)
    LAYER_BODY(3)
#undef LAYER_BODY
    if (IN(33)) { for (int rep_ = 0; rep_ < NREP(13); ++rep_) { DRYFLAG(13) phase_final(P, g, dry); DRYBAR(); } }
#undef IN
#undef SEAM
}

extern "C" void kernel_launch(void* const* d_in, const int* in_sizes, int n_in, void* d_out, int out_size, void* d_ws, size_t ws_size, hipStream_t stream) {
    static int grid = 0;
    if (grid == 0) {
        if (n_in != 27 || out_size != T * D || ws_size < WS_END) { fprintf(stderr, "kernel_launch: bad shapes n_in %d out %d ws %zu (need %zu)\n", n_in, out_size, ws_size, (size_t)WS_END); grid = -1; return; }
        if (hipFuncSetAttribute((const void*)mk_fwd, hipFuncAttributeMaxDynamicSharedMemorySize, LDS_BYTES) != hipSuccess) { fprintf(stderr, "hipFuncSetAttribute failed\n"); grid = -1; return; }
        int dev = 0, cus = 0, per_cu = 0;
        if (hipGetDevice(&dev) != hipSuccess || hipDeviceGetAttribute(&cus, hipDeviceAttributeMultiprocessorCount, dev) != hipSuccess) { grid = -1; return; }
        if (hipOccupancyMaxActiveBlocksPerMultiprocessor(&per_cu, (const void*)mk_fwd, 512, LDS_BYTES) != hipSuccess || per_cu < 1) fprintf(stderr, "occupancy query says %d\n", per_cu);
        (void)hipGetLastError();
        grid = cus;
    }
    if (grid < 0) return;
    Params P{};
    for (int i = 0; i < 27; ++i) P.in[i] = (const float*)d_in[i];
    P.out = (float*)d_out; P.ws = (unsigned char*)d_ws;
    (void)hipMemsetAsync((unsigned char*)d_ws + WS_CTL, 0, CTL_BYTES, stream);
    const int G = grid;
    auto run = [&](int lo, int hi) { P.ph_lo = lo; P.ph_hi = hi; hipLaunchKernelGGL(mk_fwd, dim3(G), dim3(512), LDS_BYTES, stream, P); };
    run(0, NPHASE);
}
```
